# Optimizing an MI355X kernel written in HIP

```python
import jax, jax.numpy as jnp
from jax import lax
import numpy as np

D_MODEL = 2048
BATCH = 1
SEQ = 16384
DEPTH = 1

CHUNK = 64
PLE_DIM = 256
EPS = 1e-6

ATT_HEAD_DIM = 64
ATT_WIDTH = D_MODEL // 2
ATT_HEADS = ATT_WIDTH // ATT_HEAD_DIM
BAND_CHUNKS = 9
MAX_REL_DIST = 256

GLA_HEADS = 4
GLA_WIDTH = D_MODEL // 2
GLA_DV = GLA_WIDTH // GLA_HEADS
GLA_KEY_WIDTH = GLA_WIDTH // 2
GLA_DK = GLA_KEY_WIDTH // GLA_HEADS
GLA_GATE_RANK = 16
GLA_GATE_TAU = 16.0

MIX_WIDTH = ATT_WIDTH + GLA_WIDTH
IN_SPLITS = (ATT_WIDTH, ATT_WIDTH, ATT_WIDTH,
             GLA_KEY_WIDTH, GLA_KEY_WIDTH,
             GLA_WIDTH, GLA_WIDTH,
             GLA_GATE_RANK)
IN_PROJ_WIDTH = sum(IN_SPLITS)

D_FF = 5632
CONV_WIDTH = 3

kernel_name = "hybrid_chunked_attn_gla_convffn_ple"


def rms_norm(x, w):
    xf = x.astype(jnp.float32)
    y = xf * lax.rsqrt(jnp.mean(xf * xf, axis=-1, keepdims=True) + EPS)
    return (y * w.astype(jnp.float32)).astype(x.dtype)


def split_cols(t, sizes):
    idx = [int(v) for v in np.cumsum(sizes)[:-1]]
    return jnp.split(t, idx, axis=-1)


def rel_pos_bias(table):
    q_idx = jnp.arange(CHUNK) + (BAND_CHUNKS - 1) * CHUNK
    k_idx = jnp.arange(BAND_CHUNKS * CHUNK)
    dist = jnp.clip(q_idx[:, None] - k_idx[None, :], -MAX_REL_DIST, MAX_REL_DIST) + MAX_REL_DIST
    return table[:, dist]


def chunked_band_attention(q, k, v, bias_table):
    B, T, H, hd = q.shape
    nc = T // CHUNK
    pad = (BAND_CHUNKS - 1) * CHUNK
    band = BAND_CHUNKS * CHUNK
    k_pad = jnp.pad(k, ((0, 0), (pad, 0), (0, 0), (0, 0)))
    v_pad = jnp.pad(v, ((0, 0), (pad, 0), (0, 0), (0, 0)))
    bias = rel_pos_bias(bias_table).astype(jnp.float32)[None]
    key_off = jnp.arange(band) - pad
    q_chunks = q.reshape(B, nc, CHUNK, H, hd).transpose(1, 0, 2, 3, 4)
    scale = hd ** -0.5
    neg = jnp.finfo(jnp.float32).min

    def one_chunk(args):
        c, qc = args
        start = c * CHUNK
        kb = lax.dynamic_slice_in_dim(k_pad, start, band, axis=1)
        vb = lax.dynamic_slice_in_dim(v_pad, start, band, axis=1)
        s = jnp.einsum('bqhd,bkhd->bhqk', qc, kb).astype(jnp.float32) * scale + bias
        valid = (start + key_off) >= 0
        s = jnp.where(valid[None, None, None, :], s, neg)
        pr = jax.nn.softmax(s, axis=-1).astype(vb.dtype)
        return jnp.einsum('bhqk,bkhd->bqhd', pr, vb)

    out = lax.map(one_chunk, (jnp.arange(nc), q_chunks))
    return out.transpose(1, 0, 2, 3, 4).reshape(B, T, H * hd)


def gated_linear_attention(q, k, v, log_a):
    B, T, H, dk = q.shape
    dv = v.shape[-1]
    nc = T // CHUNK

    def to_chunks(t):
        return t.reshape(B, nc, CHUNK, H, t.shape[-1]).transpose(0, 1, 3, 2, 4).astype(jnp.float32)

    qc = to_chunks(q) * (dk ** -0.5)
    kc = to_chunks(k)
    vc = to_chunks(v)
    b = jnp.cumsum(to_chunks(log_a), axis=3)
    b_last = b[:, :, :, -1:, :]
    q_dec = qc * jnp.exp(b)
    k_inv = kc * jnp.exp(-b)
    k_to_end = kc * jnp.exp(b_last - b)
    causal = jnp.tril(jnp.ones((CHUNK, CHUNK), dtype=bool))
    attn = jnp.where(causal, jnp.einsum('bnhid,bnhjd->bnhij', q_dec, k_inv), 0.0)
    o_intra = jnp.einsum('bnhij,bnhjv->bnhiv', attn, vc)

    chunk_update = jnp.einsum('bnhjd,bnhjv->bnhdv', k_to_end, vc)
    chunk_decay = jnp.exp(b_last[:, :, :, 0, :])

    def step(S, xs):
        upd, dec = xs
        return dec[..., None] * S + upd, S

    S0 = jnp.zeros((B, H, dk, dv), jnp.float32)
    _, S_prev = lax.scan(step, S0, (chunk_update.transpose(1, 0, 2, 3, 4),
                                    chunk_decay.transpose(1, 0, 2, 3)))
    S_prev = S_prev.transpose(1, 0, 2, 3, 4)
    o_inter = jnp.einsum('bnhid,bnhdv->bnhiv', q_dec, S_prev)
    o = o_intra + o_inter
    return o.transpose(0, 1, 3, 2, 4).reshape(B, T, H, dv)


def causal_depthwise_conv(u, w, bias):
    T = u.shape[1]
    up = jnp.pad(u, ((0, 0), (CONV_WIDTH - 1, 0), (0, 0)))
    y = bias
    for tap in range(CONV_WIDTH):
        y = y + up[:, tap:tap + T] * w[tap]
    return y


def setup_inputs(seed: int = 0) -> dict:
    key = jax.random.key(seed)
    ks = jax.random.split(key, 20)
    f32 = jnp.float32

    def nrm(k, shape, scale):
        return jax.random.normal(k, shape, f32) * scale

    def gain(k, shape):
        return 1.0 + 0.05 * jax.random.normal(k, shape, f32)

    return {
        "x": nrm(ks[0], (BATCH, SEQ, D_MODEL), 1.0),
        "p": nrm(ks[1], (DEPTH, BATCH, SEQ, PLE_DIM), 1.0),
        "norm_mix_w": gain(ks[2], (DEPTH, D_MODEL)),
        "w_in": nrm(ks[3], (DEPTH, D_MODEL, IN_PROJ_WIDTH), D_MODEL ** -0.5),
        "att_rel_bias": nrm(ks[4], (DEPTH, ATT_HEADS, 2 * MAX_REL_DIST + 1), 0.3),
        "w_gla_gate_up": nrm(ks[5], (DEPTH, GLA_GATE_RANK, GLA_KEY_WIDTH), GLA_GATE_RANK ** -0.5),
        "b_gla_gate": nrm(ks[6], (DEPTH, GLA_KEY_WIDTH), 0.5),
        "gla_norm_w": gain(ks[7], (DEPTH, GLA_DV)),
        "w_out": nrm(ks[8], (DEPTH, MIX_WIDTH, D_MODEL), MIX_WIDTH ** -0.5),
        "norm_ffn_w": gain(ks[9], (DEPTH, D_MODEL)),
        "w_ffn_up": nrm(ks[10], (DEPTH, D_MODEL, 2 * D_FF), D_MODEL ** -0.5),
        "w_ffn_conv": nrm(ks[11], (DEPTH, CONV_WIDTH, 2 * D_FF), CONV_WIDTH ** -0.5),
        "b_ffn_conv": nrm(ks[12], (DEPTH, 2 * D_FF), 0.02),
        "w_ffn_down": nrm(ks[13], (DEPTH, D_FF, D_MODEL), D_FF ** -0.5),
        "norm_ple_w": gain(ks[14], (DEPTH, D_MODEL)),
        "w_ple_gate": nrm(ks[15], (DEPTH, D_MODEL, D_MODEL), D_MODEL ** -0.5),
        "w_ple_proj": nrm(ks[16], (DEPTH, PLE_DIM, D_MODEL), PLE_DIM ** -0.5),
        "final_norm_w": gain(ks[17], (D_MODEL,)),
    }


def reference(x, p, norm_mix_w, w_in, att_rel_bias, w_gla_gate_up, b_gla_gate, gla_norm_w,
              w_out, norm_ffn_w, w_ffn_up, w_ffn_conv, b_ffn_conv, w_ffn_down,
              norm_ple_w, w_ple_gate, w_ple_proj, final_norm_w):
    B, T, _ = x.shape
    for i in range(DEPTH):
        h = rms_norm(x, norm_mix_w[i])
        proj = h @ w_in[i]
        q_a, k_a, v_a, q_g, k_g, v_g, r_g, gate_lr = split_cols(proj, IN_SPLITS)

        hs_a = (B, T, ATT_HEADS, ATT_HEAD_DIM)
        y_a = chunked_band_attention(q_a.reshape(hs_a), k_a.reshape(hs_a), v_a.reshape(hs_a),
                                     att_rel_bias[i])

        gate_logit = (gate_lr @ w_gla_gate_up[i] + b_gla_gate[i]).astype(jnp.float32)
        log_a = (jax.nn.log_sigmoid(gate_logit) / GLA_GATE_TAU).reshape(B, T, GLA_HEADS, GLA_DK)
        o_g = gated_linear_attention(q_g.reshape(B, T, GLA_HEADS, GLA_DK),
                                     k_g.reshape(B, T, GLA_HEADS, GLA_DK),
                                     v_g.reshape(B, T, GLA_HEADS, GLA_DV), log_a)
        o_g = rms_norm(o_g.astype(x.dtype), gla_norm_w[i]).reshape(B, T, GLA_WIDTH)
        y_g = o_g * jax.nn.silu(r_g)

        x = x + jnp.concatenate([y_a, y_g], axis=-1) @ w_out[i]

        h = rms_norm(x, norm_ffn_w[i])
        u = causal_depthwise_conv(h @ w_ffn_up[i], w_ffn_conv[i], b_ffn_conv[i])
        u_gate, u_val = jnp.split(u, 2, axis=-1)
        x = x + (jax.nn.gelu(u_gate) * u_val) @ w_ffn_down[i]

        h = rms_norm(x, norm_ple_w[i])
        g = jax.nn.sigmoid(h @ w_ple_gate[i])
        x = x + g * (p[i] @ w_ple_proj[i])
    return rms_norm(x, final_norm_w)
```

```cpp
#include <hip/hip_runtime.h>
#include <hip/hip_cooperative_groups.h>
#include <cstdio>
#include <cstdint>
namespace cg = cooperative_groups;

#define LAS __attribute__((address_space(3)))
typedef unsigned short bf16_t;
typedef short bf16x8 __attribute__((ext_vector_type(8)));
typedef float f32x4 __attribute__((ext_vector_type(4)));
typedef float f32x2 __attribute__((ext_vector_type(2)));
typedef unsigned u32x4 __attribute__((ext_vector_type(4)));
typedef unsigned u32x2 __attribute__((ext_vector_type(2)));

constexpr int T = 16384, D = 2048, FF = 5632, NR = 4096, PLE = 256, NCH = 256;
constexpr int QA = 0, KA = 1024, QG = 2048, KG = 2560, RG = 3072;
constexpr float EPS = 1e-6f;
constexpr size_t MiB = 1u << 20;
constexpr size_t WS_SSQ1 = 0, WS_SSQ2 = 65536, WS_SSQ3 = 131072, WS_GLR = 1 * MiB, WS_WG = 2 * MiB, WS_WPP = 3 * MiB;
constexpr size_t WS_WIN = 4 * MiB, WS_WOUT = 28 * MiB, WS_WUP = 36 * MiB, WS_WDN = 80 * MiB, WS_WPG = 102 * MiB, WS_PB = 110 * MiB;
constexpr size_t WS_H0 = 118 * MiB;
constexpr size_t WS_PROJ = 182 * MiB;
constexpr size_t WS_VT = 310 * MiB;
constexpr size_t WS_X1B = 182 * MiB, WS_G = 246 * MiB, WS_TAIL = 422 * MiB, WS_HEAD = 444 * MiB, WS_PP = 182 * MiB, WS_YCAT = WS_H0, WS_X2B = WS_H0;
constexpr size_t WS_END = 512 * MiB;
constexpr int LDS_BYTES = 147456;

__device__ __forceinline__ unsigned f2bf(float f) { unsigned u = __builtin_bit_cast(unsigned, f); return (u + 0x7fffu + ((u >> 16) & 1u)) >> 16; }
__device__ __forceinline__ unsigned pk2(float lo, float hi) { return f2bf(lo) | (f2bf(hi) << 16); }
__device__ __forceinline__ float bf2f(unsigned short b) { return __builtin_bit_cast(float, (unsigned)b << 16); }
__device__ __forceinline__ float bflo(unsigned w) { return __builtin_bit_cast(float, w << 16); }
__device__ __forceinline__ float bfhi(unsigned w) { return __builtin_bit_cast(float, w & 0xffff0000u); }
__device__ __forceinline__ float wave_sum(float v) {
#pragma unroll
    for (int o = 1; o < 64; o <<= 1) v += __shfl_xor(v, o);
    return v;
}

namespace pg8 {
#define PG8_LAS __attribute__((address_space(3)))
constexpr int BM = 256, BK = 64, HALF = 128, HTB = HALF * BK * 2, STAGE_BYTES = 8 * HTB, NXCD = 8, WGM = 8;
__host__ __device__ __forceinline__ int lds_byte(int r, int c) { const int st = (r >> 4) * 2 + (c >> 5), rr = r & 15, cc = c & 31, ob = rr * 64 + cc * 2; return st * 1024 + (ob ^ (((ob >> 9) & 1) << 5)); }
__host__ __device__ __forceinline__ void stage_rc(int b, int& R, int& C) { const int st = b / 1024, sb = b % 1024, swz = sb ^ (((sb >> 9) & 1) << 5); R = (st >> 1) * 16 + swz / 64; C = (st & 1) * 32 + (swz % 64) / 2; }
__host__ __device__ __forceinline__ int perm32(int rho) { const int n = rho >> 4, i = rho & 15; return 8 * (i >> 2) + 4 * n + (i & 3); }

struct Unit { int pm, pn; };
struct Gemm { const bf16_t* A; const bf16_t* Bt; int M, N, K; };

struct StaticOrder {
    int nM, nN, nwg, G, c;
    __host__ __device__ void init(int M, int N, int G_, int c_) { nM = M / BM; nN = N / BM; nwg = nM * nN; G = G_; c = c_; }
    __host__ __device__ bool next(int i, Unit& u) const {
        const long L = (long)i * G + c; if (L >= nwg) return false;
        int wgid = (int)L; { const int q = nwg / NXCD, r = nwg % NXCD, xcd = wgid % NXCD, off = wgid / NXCD; wgid = (xcd < r ? xcd * (q + 1) : r * (q + 1) + (xcd - r) * q) + off; }
        const int nig = WGM * nN, gid = wgid / nig, fm = gid * WGM, gsz = (nM - fm) < WGM ? (nM - fm) : WGM;
        u.pm = fm + ((wgid % nig) % gsz); u.pn = (wgid % nig) / gsz; return true;
    }
    __device__ __forceinline__ void a_ready(const Unit&) const {}
    __device__ __forceinline__ void done(const Unit&) const {}
};

__device__ __forceinline__ unsigned cvt_pk_bf16(float lo, float hi) { unsigned r; asm volatile("v_cvt_pk_bf16_f32 %0, %1, %2" : "=v"(r) : "v"(lo), "v"(hi)); return r; }

struct EpiBf16 {
    static constexpr bool PERM = true, AFTER_DRAIN = false;
    bf16_t* O; int ldc;
    __device__ __forceinline__ void operator()(const f32x4 (&acc)[2][2][4][2], const Unit& u, int wr, int wc, int fr, int fq) const {
        const int row0 = u.pm * BM + wr * 64 + fr; const int col0 = u.pn * BM + wc * 32 + 8 * fq;
#pragma unroll
        for (int ai = 0; ai < 2; ++ai)
#pragma unroll
            for (int m = 0; m < 4; ++m) { bf16_t* rowp = O + (size_t)(row0 + ai * HALF + m * 16) * ldc + col0;
#pragma unroll
                for (int bj = 0; bj < 2; ++bj) { const f32x4 v0 = acc[ai][bj][m][0], v1 = acc[ai][bj][m][1];
                    u32x4 w; w.x = cvt_pk_bf16(v0[0], v0[1]); w.y = cvt_pk_bf16(v0[2], v0[3]); w.z = cvt_pk_bf16(v1[0], v1[1]); w.w = cvt_pk_bf16(v1[2], v1[3]);
                    *(u32x4*)(rowp + bj * HALF) = w; } }
    }
};
struct EpiResid {
    static constexpr bool PERM = true, AFTER_DRAIN = false;
    const float* base; float* out; bf16_t* ob; float* ssq;
    __device__ __forceinline__ void operator()(const f32x4 (&acc)[2][2][4][2], const Unit& u, int wr, int wc, int fr, int fq) const {
        const int row0 = u.pm * BM + wr * 64 + fr; const int col0 = u.pn * BM + wc * 32 + 8 * fq;
#pragma unroll
        for (int ai = 0; ai < 2; ++ai)
#pragma unroll
            for (int m = 0; m < 4; ++m) { const int row = row0 + ai * HALF + m * 16; const size_t off = (size_t)row * D + col0; float ss = 0.f;
#pragma unroll
                for (int bj = 0; bj < 2; ++bj) {
                    const f32x4 b0 = *(const f32x4*)(base + off + bj * HALF), b1 = *(const f32x4*)(base + off + bj * HALF + 4);
                    const f32x4 v0 = acc[ai][bj][m][0] + b0, v1 = acc[ai][bj][m][1] + b1;
                    *(f32x4*)(out + off + bj * HALF) = v0; *(f32x4*)(out + off + bj * HALF + 4) = v1;
                    u32x4 w; w.x = cvt_pk_bf16(v0[0], v0[1]); w.y = cvt_pk_bf16(v0[2], v0[3]); w.z = cvt_pk_bf16(v1[0], v1[1]); w.w = cvt_pk_bf16(v1[2], v1[3]);
                    *(u32x4*)(ob + off + bj * HALF) = w;
                    ss += (v0[0] * v0[0] + v0[1] * v0[1]) + (v0[2] * v0[2] + v0[3] * v0[3]) + (v1[0] * v1[0] + v1[1] * v1[1]) + (v1[2] * v1[2] + v1[3] * v1[3]); }
                ss += __shfl_xor(ss, 16); ss += __shfl_xor(ss, 32);
                if (fq == 0) atomicAdd(ssq + row, ss); }
    }
};
struct EpiPle {
    static constexpr bool PERM = true, AFTER_DRAIN = false;
    float* out; const bf16_t* pp; const float* ssq2; float* ssq3;
    __device__ __forceinline__ void operator()(const f32x4 (&acc)[2][2][4][2], const Unit& u, int wr, int wc, int fr, int fq) const {
        const int row0 = u.pm * BM + wr * 64 + fr; const int col0 = u.pn * BM + wc * 32 + 8 * fq;
#pragma unroll
        for (int ai = 0; ai < 2; ++ai)
#pragma unroll
            for (int m = 0; m < 4; ++m) { const int row = row0 + ai * HALF + m * 16; const size_t off = (size_t)row * D + col0; float ss = 0.f;
                const float rstd = 1.0f / sqrtf(ssq2[row] * (1.0f / D) + EPS);
#pragma unroll
                for (int bj = 0; bj < 2; ++bj) {
                    const f32x4 b0 = *(const f32x4*)(out + off + bj * HALF), b1 = *(const f32x4*)(out + off + bj * HALF + 4);
                    const u32x4 pw = *(const u32x4*)(pp + off + bj * HALF);
                    f32x4 p0 = {bflo(pw.x), bfhi(pw.x), bflo(pw.y), bfhi(pw.y)}, p1 = {bflo(pw.z), bfhi(pw.z), bflo(pw.w), bfhi(pw.w)};
                    f32x4 v0, v1;
#pragma unroll
                    for (int e = 0; e < 4; ++e) { const float g0 = 1.0f / (1.0f + __expf(-acc[ai][bj][m][0][e] * rstd)), g1 = 1.0f / (1.0f + __expf(-acc[ai][bj][m][1][e] * rstd));
                        v0[e] = b0[e] + g0 * p0[e]; v1[e] = b1[e] + g1 * p1[e]; }
                    *(f32x4*)(out + off + bj * HALF) = v0; *(f32x4*)(out + off + bj * HALF + 4) = v1;
                    ss += (v0[0] * v0[0] + v0[1] * v0[1]) + (v0[2] * v0[2] + v0[3] * v0[3]) + (v1[0] * v1[0] + v1[1] * v1[1]) + (v1[2] * v1[2] + v1[3] * v1[3]); }
                ss += __shfl_xor(ss, 16); ss += __shfl_xor(ss, 32);
                if (fq == 0) atomicAdd(ssq3 + row, ss); }
    }
};
__device__ __forceinline__ float gelu_tanh(float x) {
    const float z = 1.5957691216057308f * (x + 0.044715f * x * x * x);
    return x / (1.0f + __expf(-z));
}
template <int CTRL> __device__ __forceinline__ float dppz(float v) { return __builtin_bit_cast(float, __builtin_amdgcn_update_dpp(0, __builtin_bit_cast(int, v), CTRL, 0xf, 0xf, true)); }
struct EpiUp {
    static constexpr bool PERM = true, AFTER_DRAIN = false;
    bf16_t* G; const float* ssq1; const float* cw; const float* cb; float* tail; float* head;
    __device__ __forceinline__ void operator()(const f32x4 (&acc)[2][2][4][2], const Unit& u, int wr, int wc, int fr, int fq) const {
        const int C0 = u.pn * 128 + wc * 32 + 8 * fq;
#pragma unroll
        for (int ai = 0; ai < 2; ++ai) {
            const int rbase = u.pm * BM + ai * HALF + wr * 64; const int grp = rbase >> 6;
            float rstd[4];
#pragma unroll
            for (int m = 0; m < 4; ++m) rstd[m] = 1.0f / sqrtf(ssq1[rbase + m * 16 + fr] * (1.0f / D) + EPS);
            if (fr < 2) { float* hp = head + ((size_t)grp * 2 + fr) * (2 * FF) + C0;
#pragma unroll
                for (int bj = 0; bj < 2; ++bj) { *(f32x4*)(hp + bj * FF) = acc[ai][bj][0][0] * rstd[0]; *(f32x4*)(hp + bj * FF + 4) = acc[ai][bj][0][1] * rstd[0]; } }
            if (fr >= 14) { float* tp = tail + ((size_t)grp * 2 + (fr - 14)) * (2 * FF) + C0;
#pragma unroll
                for (int bj = 0; bj < 2; ++bj) { *(f32x4*)(tp + bj * FF) = acc[ai][bj][3][0] * rstd[3]; *(f32x4*)(tp + bj * FF + 4) = acc[ai][bj][3][1] * rstd[3]; } }
            __builtin_amdgcn_sched_barrier(0);
#pragma unroll
            for (int n = 0; n < 2; ++n) {
                unsigned outw[4][2];
#pragma unroll
                for (int e = 0; e < 4; ++e) {
                    int C = C0 + 4 * n + e; asm volatile("" : "+v"(C));
                    const float wg0 = cw[C], wg1 = cw[2 * FF + C], wg2 = cw[4 * FF + C], bg = cb[C];
                    const float wv0 = cw[FF + C], wv1 = cw[3 * FF + C], wv2 = cw[5 * FF + C], bv = cb[FF + C];
                    float pg1 = 0.f, pg2 = 0.f, pv1 = 0.f, pv2 = 0.f;
#pragma unroll
                    for (int m = 0; m < 4; ++m) {
                        float ug = acc[ai][0][m][n][e] * rstd[m], uv = acc[ai][1][m][n][e] * rstd[m];
                        asm volatile("" : "+v"(ug), "+v"(uv));
                        const float ugm1 = dppz<0x111>(ug) + pg1, ugm2 = dppz<0x112>(ug) + pg2, uvm1 = dppz<0x111>(uv) + pv1, uvm2 = dppz<0x112>(uv) + pv2;
                        const float yg = bg + wg0 * ugm2 + wg1 * ugm1 + wg2 * ug;
                        const float yv = bv + wv0 * uvm2 + wv1 * uvm1 + wv2 * uv;
                        unsigned rb = f2bf(gelu_tanh(yg) * yv); asm volatile("" : "+v"(rb));
                        if (e & 1) outw[m][e >> 1] |= rb << 16; else outw[m][e >> 1] = rb;
                        pg1 = dppz<0x10F>(ug); pg2 = dppz<0x10E>(ug); pv1 = dppz<0x10F>(uv); pv2 = dppz<0x10E>(uv);
                    }
                    __builtin_amdgcn_sched_barrier(0);
                }
#pragma unroll
                for (int m = 0; m < 4; ++m) if (m > 0 || fr >= 2) { u32x2 w = {outw[m][0], outw[m][1]}; *(u32x2*)(G + (size_t)(rbase + m * 16 + fr) * FF + C0 + 4 * n) = w; }
                __builtin_amdgcn_sched_barrier(0);
            }
        }
    }
};

template <class Epi, class Sched, bool ALIGN_EPI = false, bool SP2 = false>
__device__ __forceinline__ void gemm_phase(PG8_LAS unsigned char* lds, const Gemm g, const Sched& S, const Epi& E) {
    const int tid = threadIdx.x, wid = __builtin_amdgcn_readfirstlane(tid >> 6), lane = tid & 63, wr = wid >> 2, wc = wid & 3, fr = lane & 15, fq = lane >> 4;
    const int K = g.K, nt = K / BK;
    unsigned voffA[2], voffB[2];
#pragma unroll
    for (int i = 0; i < 2; ++i) { int R, C; stage_rc(tid * 16 + i * 8192, R, C); const int Rb = Epi::PERM ? ((R & ~31) + perm32(R & 31)) : R;
        voffA[i] = (unsigned)(R * K + C) * 2u; voffB[i] = (unsigned)(Rb * K + C) * 2u; }
    const size_t kstep = (size_t)(BK * 2);
    const size_t hstep = (size_t)HALF * K * 2;
    const size_t tstep = 2 * hstep;
    const unsigned ldsw = (unsigned)wid * 1024u;
    const int aoff = lds_byte(wr * 64 + fr, fq * 8), boff = lds_byte(wc * 32 + fr, fq * 8);
#define PG8_SA(b, h) (((b) * 2 + (h)) * HTB)
#define PG8_SB(b, h) ((4 + (b) * 2 + (h)) * HTB)
#define PG8_STAGE(bufoff, gbase, voff) do { _Pragma("unroll") for (int _i = 0; _i < 2; ++_i) \
        __builtin_amdgcn_global_load_lds((const unsigned*)((const char*)(gbase) + (voff)[_i]), (PG8_LAS unsigned*)(lds + (bufoff) + ldsw + _i * 8192), 16, 0, 0); } while (0)
#define PG8_LDA(dst, b, h) do { _Pragma("unroll") for (int m = 0; m < 4; ++m) _Pragma("unroll") for (int k = 0; k < 2; ++k) dst[m][k] = *(const PG8_LAS bf16x8*)(lds + PG8_SA(b, h) + aoff + m * 2048 + k * 1024); } while (0)
#define PG8_LDB(dst, b, h) do { _Pragma("unroll") for (int n = 0; n < 2; ++n) _Pragma("unroll") for (int k = 0; k < 2; ++k) dst[n][k] = *(const PG8_LAS bf16x8*)(lds + PG8_SB(b, h) + boff + n * 2048 + k * 1024); } while (0)
#define PG8_MMA(ai, bj, At, Bt) do { __builtin_amdgcn_s_setprio(1); _Pragma("unroll") for (int m = 0; m < 4; ++m) _Pragma("unroll") for (int n = 0; n < 2; ++n) _Pragma("unroll") for (int k = 0; k < 2; ++k) \
        acc[ai][bj][m][n] = __builtin_amdgcn_mfma_f32_16x16x32_bf16(Bt[n][k], At[m][k], acc[ai][bj][m][n], 0, 0, 0); __builtin_amdgcn_s_setprio(0); } while (0)
#define PG8_WAIT_V(n) asm volatile("s_waitcnt vmcnt(" #n ")" ::: "memory")
#define PG8_WAIT_L(n) asm volatile("s_waitcnt lgkmcnt(" #n ")" ::: "memory")
#define PG8_BAR __builtin_amdgcn_s_barrier()
#define PG8_SCHED __builtin_amdgcn_sched_barrier(0)
    Unit cur, nxt; int ui = 0;
    if (!S.next(0, cur)) return;
    f32x4 acc[2][2][4][2];
#pragma unroll
    for (int a = 0; a < 2; ++a)
#pragma unroll
        for (int b = 0; b < 2; ++b)
#pragma unroll
            for (int m = 0; m < 4; ++m)
#pragma unroll
                for (int n = 0; n < 2; ++n) acc[a][b][m][n] = (f32x4){0.f, 0.f, 0.f, 0.f};
    bf16x8 At[4][2], B0[2][2], B1[2][2];
    const char* cA = (const char*)g.A + (size_t)cur.pm * tstep; const char* cB = (const char*)g.Bt + (size_t)cur.pn * tstep;
    S.a_ready(cur);
    if constexpr (SP2) {
        PG8_STAGE(PG8_SB(0, 0), cB, voffB); PG8_STAGE(PG8_SB(0, 1), cB + hstep, voffB); PG8_STAGE(PG8_SA(0, 0), cA, voffA); PG8_STAGE(PG8_SA(0, 1), cA + hstep, voffA);
        if (wr == 1) PG8_BAR;
        PG8_WAIT_V(2); PG8_BAR;
        PG8_STAGE(PG8_SB(1, 0), cB + kstep, voffB); PG8_STAGE(PG8_SA(1, 0), cA + kstep, voffA); PG8_STAGE(PG8_SB(1, 1), cB + hstep + kstep, voffB);
        PG8_WAIT_V(6); PG8_BAR;
    } else {
        PG8_STAGE(PG8_SB(0, 0), cB, voffB); PG8_STAGE(PG8_SA(0, 0), cA, voffA); PG8_STAGE(PG8_SB(0, 1), cB + hstep, voffB); PG8_STAGE(PG8_SA(0, 1), cA + hstep, voffA);
        if (wr == 1) PG8_BAR;
        PG8_WAIT_V(4); PG8_BAR;
        PG8_STAGE(PG8_SB(1, 0), cB + kstep, voffB); PG8_STAGE(PG8_SA(1, 0), cA + kstep, voffA); PG8_STAGE(PG8_SB(1, 1), cB + hstep + kstep, voffB);
        PG8_WAIT_V(6); PG8_BAR;
    }
    for (;;) {
        const bool has_next = S.next(ui + 1, nxt);
        const char* nA = has_next ? (const char*)g.A + (size_t)nxt.pm * tstep : cA; const char* nB = has_next ? (const char*)g.Bt + (size_t)nxt.pn * tstep : cB;
        for (int t = 0; t < nt; t += 2) {
            const bool last = (t == nt - 2);
            const char* a1 = cA + (size_t)(t + 1) * kstep;
            const char* a2 = last ? nA : cA + (size_t)(t + 2) * kstep; const char* b2 = last ? nB : cB + (size_t)(t + 2) * kstep;
            const char* a3 = a2 + kstep; const char* b3 = b2 + kstep;
            if (last && has_next) S.a_ready(nxt);
            if constexpr (SP2) {
            PG8_LDB(B0, 0, 0); PG8_LDB(B1, 0, 1); PG8_SCHED; PG8_LDA(At, 0, 0); PG8_STAGE(PG8_SA(1, 1), a1 + hstep, voffA);
            PG8_WAIT_V(8); PG8_WAIT_L(0); PG8_BAR; PG8_MMA(0, 0, At, B0); PG8_MMA(0, 1, At, B1); PG8_BAR; PG8_SCHED;
            PG8_LDA(At, 0, 1); PG8_STAGE(PG8_SB(0, 0), b2, voffB); PG8_STAGE(PG8_SB(0, 1), b2 + hstep, voffB); PG8_STAGE(PG8_SA(0, 0), a2, voffA);
            PG8_WAIT_V(8); PG8_WAIT_L(0); PG8_BAR; PG8_MMA(1, 0, At, B0); PG8_MMA(1, 1, At, B1); PG8_BAR; PG8_SCHED;
            PG8_LDB(B0, 1, 0); PG8_LDB(B1, 1, 1); PG8_SCHED; PG8_LDA(At, 1, 0); PG8_STAGE(PG8_SA(0, 1), a2 + hstep, voffA);
            PG8_WAIT_V(8); PG8_WAIT_L(0); PG8_BAR; PG8_MMA(0, 0, At, B0); PG8_MMA(0, 1, At, B1); PG8_BAR; PG8_SCHED;
            PG8_LDA(At, 1, 1); PG8_STAGE(PG8_SB(1, 0), b3, voffB); PG8_STAGE(PG8_SB(1, 1), b3 + hstep, voffB); PG8_STAGE(PG8_SA(1, 0), a3, voffA);
            PG8_WAIT_V(8); PG8_WAIT_L(0); PG8_BAR; PG8_MMA(1, 0, At, B0); PG8_MMA(1, 1, At, B1); PG8_BAR; PG8_SCHED;
            } else {
            PG8_LDB(B0, 0, 0); PG8_SCHED; PG8_LDA(At, 0, 0); PG8_STAGE(PG8_SA(1, 1), a1 + hstep, voffA);
            PG8_WAIT_L(8); PG8_BAR; PG8_WAIT_L(0); PG8_MMA(0, 0, At, B0); PG8_BAR; PG8_SCHED;
            PG8_LDB(B1, 0, 1); PG8_STAGE(PG8_SB(0, 0), b2, voffB);
            PG8_BAR; PG8_WAIT_L(0); PG8_MMA(0, 1, At, B1); PG8_BAR;
            PG8_LDA(At, 0, 1); PG8_STAGE(PG8_SA(0, 0), a2, voffA);
            PG8_BAR; PG8_WAIT_L(0); PG8_MMA(1, 0, At, B0); PG8_BAR; PG8_SCHED;
            PG8_STAGE(PG8_SB(0, 1), b2 + hstep, voffB);
            PG8_WAIT_V(6); PG8_BAR; PG8_MMA(1, 1, At, B1); PG8_BAR;
            PG8_LDB(B0, 1, 0); PG8_SCHED; PG8_LDA(At, 1, 0); PG8_STAGE(PG8_SA(0, 1), a2 + hstep, voffA);
            PG8_WAIT_L(8); PG8_BAR; PG8_WAIT_L(0); PG8_MMA(0, 0, At, B0); PG8_BAR; PG8_SCHED;
            PG8_LDB(B1, 1, 1); PG8_STAGE(PG8_SB(1, 0), b3, voffB);
            PG8_BAR; PG8_WAIT_L(0); PG8_MMA(0, 1, At, B1); PG8_BAR;
            PG8_LDA(At, 1, 1); PG8_STAGE(PG8_SA(1, 0), a3, voffA);
            PG8_BAR; PG8_WAIT_L(0); PG8_MMA(1, 0, At, B0); PG8_BAR; PG8_SCHED;
            PG8_STAGE(PG8_SB(1, 1), b3 + hstep, voffB);
            PG8_WAIT_V(6); PG8_BAR; PG8_MMA(1, 1, At, B1); PG8_BAR;
            }
        }
        if constexpr (ALIGN_EPI) { if (wr == 0) PG8_BAR; }
        if constexpr (!Epi::AFTER_DRAIN) { E(acc, cur, wr, wc, fr, fq); S.done(cur); }
        if (!has_next) break;
#pragma unroll
        for (int a = 0; a < 2; ++a)
#pragma unroll
            for (int b = 0; b < 2; ++b)
#pragma unroll
                for (int m = 0; m < 4; ++m)
#pragma unroll
                    for (int n = 0; n < 2; ++n) acc[a][b][m][n] = (f32x4){0.f, 0.f, 0.f, 0.f};
        cur = nxt; cA = nA; cB = nB; ++ui;
        if constexpr (ALIGN_EPI) { if (wr == 1) PG8_BAR; }
    }
    PG8_WAIT_V(0);
    if constexpr (!ALIGN_EPI) { if (wr == 0) PG8_BAR; }
    PG8_BAR;
#undef PG8_SA
#undef PG8_SB
#undef PG8_STAGE
#undef PG8_LDA
#undef PG8_LDB
#undef PG8_MMA
#undef PG8_WAIT_V
#undef PG8_WAIT_L
#undef PG8_BAR
#undef PG8_SCHED
}
}

struct Args {
    const float *x, *p, *norm_mix_w, *w_in, *att_rel_bias, *w_gla_gate_up, *b_gla_gate, *gla_norm_w, *w_out, *norm_ffn_w, *w_ffn_up, *w_ffn_conv, *b_ffn_conv, *w_ffn_down,
                *norm_ple_w, *w_ple_gate, *w_ple_proj, *final_norm_w;
    float* out; unsigned char* ws;
};

__device__ __forceinline__ int map_row(int mode, int n) {
    if (mode == 1) { if (n < 2048) return n; if (n < 3072) return n + 2048; if (n < 4096) return n - 1024; if (n < 5120) return n + 1024; return n - 2048; }
    if (mode == 2) { const int half = n >= FF ? 1 : 0; const int c = n - half * FF; return (c >> 7) * 256 + half * 128 + (c & 127); }
    return n;
}
__device__ __forceinline__ void transpose_item(const float* W, int K, int ldn, int nblk, bf16_t* WT, LAS float* scr, int item, int lane, const float* kscale, int mode) {
    const int kb = item / nblk, nb = item % nblk, k0 = 64 * kb, n0 = 32 * nb;
#pragma unroll 8
    for (int i = 0; i < 32; ++i) { const int kk = 2 * i + (lane >> 5); float v = W[(size_t)(k0 + kk) * ldn + n0 + (lane & 31)]; if (kscale) v *= kscale[k0 + kk]; scr[kk * 33 + (lane & 31)] = v; }
    asm volatile("s_waitcnt lgkmcnt(0)" ::: "memory");
    const int c = lane & 7; const int drow0 = map_row(mode, n0);
#pragma unroll
    for (int j = 0; j < 4; ++j) { const int n = (lane >> 3) + 8 * j; const LAS float* s = scr + (8 * c) * 33 + n;
        u32x4 o; o.x = pk2(s[0 * 33], s[1 * 33]); o.y = pk2(s[2 * 33], s[3 * 33]); o.z = pk2(s[4 * 33], s[5 * 33]); o.w = pk2(s[6 * 33], s[7 * 33]);
        *(u32x4*)(WT + (size_t)(drow0 + n) * K + k0 + 8 * c) = o; }
    asm volatile("s_waitcnt lgkmcnt(0)" ::: "memory");
}

__global__ void __launch_bounds__(512, 2) fwd_megakernel(Args a) {
    extern __shared__ __attribute__((aligned(16))) unsigned char lds_raw[];
    cg::grid_group grid = cg::this_grid();
    LAS unsigned char* lds = (LAS unsigned char*)lds_raw;
    const int tid = threadIdx.x, lane = tid & 63, wave = __builtin_amdgcn_readfirstlane(tid >> 6);
    const int G = gridDim.x, bx = blockIdx.x;
    const int gw = bx * 8 + wave, NGW = G * 8;
    const int gtid = bx * 512 + tid, NT = G * 512;
    unsigned char* ws = a.ws;
    float* ssq1 = (float*)(ws + WS_SSQ1); float* ssq2 = (float*)(ws + WS_SSQ2); float* ssq3 = (float*)(ws + WS_SSQ3);
    float* glr = (float*)(ws + WS_GLR);
    bf16_t* WgT = (bf16_t*)(ws + WS_WG); bf16_t* WppT = (bf16_t*)(ws + WS_WPP); bf16_t* WinT = (bf16_t*)(ws + WS_WIN); bf16_t* WoutT = (bf16_t*)(ws + WS_WOUT);
    bf16_t* WupT = (bf16_t*)(ws + WS_WUP); bf16_t* WdnT = (bf16_t*)(ws + WS_WDN); bf16_t* WpgT = (bf16_t*)(ws + WS_WPG); bf16_t* pb = (bf16_t*)(ws + WS_PB);
    bf16_t* h0 = (bf16_t*)(ws + WS_H0); bf16_t* projR = (bf16_t*)(ws + WS_PROJ); bf16_t* vT = (bf16_t*)(ws + WS_VT);
    bf16_t* ycat = (bf16_t*)(ws + WS_YCAT); bf16_t* x1b = (bf16_t*)(ws + WS_X1B); bf16_t* gbuf = (bf16_t*)(ws + WS_G);
    float* tailb = (float*)(ws + WS_TAIL); float* headb = (float*)(ws + WS_HEAD); bf16_t* ppb = (bf16_t*)(ws + WS_PP); bf16_t* x2b = (bf16_t*)(ws + WS_X2B);

    {
        LAS float* scr = (LAS float*)(lds + wave * 16384);
        constexpr int I_IN = 32 * 192, I_OUT = 32 * 64, I_UP = 32 * 352, I_DN = 88 * 64, I_PG = 32 * 64, I_PP = 4 * 64;
        constexpr int NITEMS = I_IN + I_OUT + I_UP + I_DN + I_PG + I_PP;
        for (int it = gw; it < NITEMS; it += NGW) {
            int r = it;
            if (r < I_IN) { transpose_item(a.w_in, 2048, 6160, 192, WinT, scr, r, lane, nullptr, 1); continue; } r -= I_IN;
            if (r < I_OUT) { transpose_item(a.w_out, 2048, 2048, 64, WoutT, scr, r, lane, nullptr, 0); continue; } r -= I_OUT;
            if (r < I_UP) { transpose_item(a.w_ffn_up, 2048, 2 * FF, 352, WupT, scr, r, lane, a.norm_ffn_w, 2); continue; } r -= I_UP;
            if (r < I_DN) { transpose_item(a.w_ffn_down, FF, 2048, 64, WdnT, scr, r, lane, nullptr, 0); continue; } r -= I_DN;
            if (r < I_PG) { transpose_item(a.w_ple_gate, 2048, 2048, 64, WpgT, scr, r, lane, a.norm_ple_w, 0); continue; } r -= I_PG;
            transpose_item(a.w_ple_proj, PLE, 2048, 64, WppT, scr, r, lane, nullptr, 0);
        }
        for (int i = gtid; i < 16 * 2048; i += NT) { const int j = i >> 11, k = i & 2047; WgT[i] = (bf16_t)f2bf(a.w_in[(size_t)k * 6160 + 6144 + j]); }
        for (int m = gw; m < T; m += NGW) {
            const f32x4* xr = (const f32x4*)(a.x + (size_t)m * D) + lane; const f32x4* wr4 = (const f32x4*)a.norm_mix_w + lane;
            f32x4 v[8]; float s = 0.f;
#pragma unroll
            for (int j = 0; j < 8; ++j) { v[j] = xr[64 * j]; s += (v[j].x * v[j].x + v[j].y * v[j].y) + (v[j].z * v[j].z + v[j].w * v[j].w); }
            const float rstd = 1.0f / sqrtf(wave_sum(s) * (1.0f / D) + EPS);
            u32x2* o8 = (u32x2*)(h0 + (size_t)m * D) + lane;
#pragma unroll
            for (int j = 0; j < 8; ++j) { const f32x4 w = wr4[64 * j]; u32x2 o; o.x = pk2(v[j].x * rstd * w.x, v[j].y * rstd * w.y); o.y = pk2(v[j].z * rstd * w.z, v[j].w * rstd * w.w); o8[64 * j] = o; }
        }
        for (int i = gtid; i < T * PLE / 4; i += NT) { const f32x4 v = ((const f32x4*)a.p)[i]; u32x2 o; o.x = pk2(v.x, v.y); o.y = pk2(v.z, v.w); ((u32x2*)pb)[i] = o; }
        for (int i = gtid; i < 3 * T; i += NT) ssq1[i] = 0.f;
    }
    grid.sync();

    {
        for (int task = gw; task < T / 16; task += NGW) {
            const int fr = lane & 15, fq = lane >> 4; const int r0 = task * 16;
            const bf16_t* ap = h0 + (size_t)(r0 + fr) * D + 8 * fq; const bf16_t* bp = WgT + (size_t)fr * D + 8 * fq;
            f32x4 acc = {0.f, 0.f, 0.f, 0.f};
#pragma unroll 4
            for (int k0 = 0; k0 < D; k0 += 32) { const bf16x8 av = *(const bf16x8*)(ap + k0), bv = *(const bf16x8*)(bp + k0); acc = __builtin_amdgcn_mfma_f32_16x16x32_bf16(av, bv, acc, 0, 0, 0); }
#pragma unroll
            for (int j = 0; j < 4; ++j) glr[(size_t)(r0 + 4 * fq + j) * 16 + fr] = acc[j];
        }
        __syncthreads();
        { pg8::Gemm g{h0, WinT, T, NR, D}; pg8::StaticOrder S; S.init(T, NR, G, bx); pg8::EpiBf16 E{projR, NR};
          pg8::gemm_phase<pg8::EpiBf16, pg8::StaticOrder, true, true>(lds, g, S, E); }
        { pg8::Gemm g{WinT + (size_t)NR * D, h0, 2048, T, D}; pg8::StaticOrder S; S.init(2048, T, G, bx); pg8::EpiBf16 E{vT, T};
          pg8::gemm_phase<pg8::EpiBf16, pg8::StaticOrder, true, true>(lds, g, S, E); }
    }
    grid.sync();

#ifndef NO_GLA
    if (bx < 4 && G > 4) {
        LAS float* aL = (LAS float*)lds; LAS float* kL = aL + 8 * 128; LAS float* qL = kL + 8 * 128; LAS float* vL = qL + 8 * 128; LAS float* oL = vL + 8 * 256; LAS float* red = oL + 8 * 512;
        const int half = tid >> 8, dv = tid & 255, hg = bx;
        float S[64];
#pragma unroll
        for (int i = 0; i < 64; ++i) S[i] = 0.f;
        const float gw_ = a.gla_norm_w[dv];
        for (int t0 = 0; t0 < T; t0 += 8) {
#pragma unroll 1
            for (int r = 0; r < 2; ++r) { const int idx = tid + 512 * r, s = idx >> 7, c = idx & 127, col = hg * 128 + c, t = t0 + s;
                float logit = a.b_gla_gate[col];
#pragma unroll
                for (int j = 0; j < 16; ++j) logit += glr[(size_t)t * 16 + j] * a.w_gla_gate_up[j * 512 + col];
                const float ls = fminf(logit, 0.f) - log1pf(__expf(-fabsf(logit)));
                aL[s * 128 + c] = __expf(ls * (1.0f / 16.0f));
                kL[s * 128 + c] = bf2f(projR[(size_t)t * NR + KG + col]);
                qL[s * 128 + c] = bf2f(projR[(size_t)t * NR + QG + col]) * 0.08838834764831845f; }
            if (half == 0) { const u32x4 vw = *(const u32x4*)(vT + (size_t)(1024 + hg * 256 + dv) * T + t0);
              vL[0 * 256 + dv] = bflo(vw.x); vL[1 * 256 + dv] = bfhi(vw.x); vL[2 * 256 + dv] = bflo(vw.y); vL[3 * 256 + dv] = bfhi(vw.y);
              vL[4 * 256 + dv] = bflo(vw.z); vL[5 * 256 + dv] = bfhi(vw.z); vL[6 * 256 + dv] = bflo(vw.w); vL[7 * 256 + dv] = bfhi(vw.w); }
            __syncthreads();
#pragma unroll 1
            for (int s = 0; s < 8; ++s) { float o = 0.f; const float vs = vL[s * 256 + dv];
                const LAS f32x4* a4 = (const LAS f32x4*)(aL + s * 128 + half * 64); const LAS f32x4* k4 = (const LAS f32x4*)(kL + s * 128 + half * 64); const LAS f32x4* q4 = (const LAS f32x4*)(qL + s * 128 + half * 64);
#pragma unroll
                for (int d4 = 0; d4 < 16; ++d4) { const f32x4 av = a4[d4], kv = k4[d4], qv = q4[d4];
#pragma unroll
                    for (int e = 0; e < 4; ++e) { S[4 * d4 + e] = av[e] * S[4 * d4 + e] + kv[e] * vs; o += qv[e] * S[4 * d4 + e]; } }
                oL[s * 512 + tid] = o; }
            __syncthreads();
#pragma unroll 1
            for (int s = 0; s < 8; ++s) { const float o = oL[s * 512 + dv] + oL[s * 512 + 256 + dv]; const float ss = wave_sum(o * o); if (lane == 0) red[s * 8 + wave] = ss; }
            __syncthreads();
            if (half == 0) {
#pragma unroll 1
            for (int s = 0; s < 8; ++s) { const float ss = (red[s * 8 + 0] + red[s * 8 + 1]) + (red[s * 8 + 2] + red[s * 8 + 3]);
                const float rstd = 1.0f / sqrtf(ss * (1.0f / 256.0f) + EPS); const int t = t0 + s;
                const float r = bf2f(projR[(size_t)t * NR + RG + hg * 256 + dv]);
                const float o = oL[s * 512 + dv] + oL[s * 512 + 256 + dv];
                const float y = o * rstd * gw_ * (r / (1.0f + __expf(-r)));
                ycat[(size_t)t * D + 1024 + hg * 256 + dv] = (bf16_t)f2bf(y); } }
            __syncthreads();
        }
    } else
#endif
    {
#ifndef NO_ATT
        LAS bf16_t* Ks = (LAS bf16_t*)(lds + wave * 16384); LAS bf16_t* Vs = Ks + 4096;
        const int aw = (G > 4 ? (bx - 4) : bx) * 8 + wave, NAW = (G > 4 ? (G - 4) : G) * 8;
        for (int unit = aw; unit < NCH * 16; unit += NAW) {
            const int c = unit >> 4, h = unit & 15; const int t = c * 64 + lane;
            float qf[64];
            { const u32x4* qp = (const u32x4*)(projR + (size_t)t * NR + QA + 64 * h);
#pragma unroll
              for (int i = 0; i < 8; ++i) { const u32x4 w = qp[i]; qf[8 * i] = bflo(w.x) * 0.125f; qf[8 * i + 1] = bfhi(w.x) * 0.125f; qf[8 * i + 2] = bflo(w.y) * 0.125f; qf[8 * i + 3] = bfhi(w.y) * 0.125f;
                  qf[8 * i + 4] = bflo(w.z) * 0.125f; qf[8 * i + 5] = bfhi(w.z) * 0.125f; qf[8 * i + 6] = bflo(w.w) * 0.125f; qf[8 * i + 7] = bfhi(w.w) * 0.125f; } }
            const float* btab = a.att_rel_bias + h * 513;
            float mx = -1e30f;
            for (int pass = 0; pass < 2; ++pass) {
                float l = 0.f; float o[64];
#pragma unroll
                for (int i = 0; i < 64; ++i) o[i] = 0.f;
                for (int j = 0; j < 9; ++j) { const int kc = c - 8 + j; if (kc < 0) continue;
                    __builtin_amdgcn_wave_barrier();
#pragma unroll 2
                    for (int it = 0; it < 8; ++it) { const int idx = it * 64 + lane, row = idx >> 3, seg = idx & 7;
                        *(LAS u32x4*)(Ks + row * 64 + seg * 8) = *(const u32x4*)(projR + (size_t)(kc * 64 + row) * NR + KA + 64 * h + seg * 8);
                        if (pass) { const u32x4 w = *(const u32x4*)(vT + (size_t)(64 * h + row) * T + kc * 64 + seg * 8);
                            LAS bf16_t* vp = Vs + (seg * 8) * 64 + row;
                            vp[0] = (bf16_t)(w.x & 0xffff); vp[64] = (bf16_t)(w.x >> 16); vp[128] = (bf16_t)(w.y & 0xffff); vp[192] = (bf16_t)(w.y >> 16);
                            vp[256] = (bf16_t)(w.z & 0xffff); vp[320] = (bf16_t)(w.z >> 16); vp[384] = (bf16_t)(w.w & 0xffff); vp[448] = (bf16_t)(w.w >> 16); } }
                    asm volatile("s_waitcnt vmcnt(0) lgkmcnt(0)" ::: "memory");
                    __builtin_amdgcn_wave_barrier();
                    for (int kk = 0; kk < 64; ++kk) {
                        float s = 0.f;
#pragma unroll
                        for (int i = 0; i < 8; ++i) { const u32x4 w = *(const LAS u32x4*)(Ks + kk * 64 + 8 * i);
                            s += qf[8 * i] * bflo(w.x) + qf[8 * i + 1] * bfhi(w.x) + qf[8 * i + 2] * bflo(w.y) + qf[8 * i + 3] * bfhi(w.y) + qf[8 * i + 4] * bflo(w.z) + qf[8 * i + 5] * bfhi(w.z) + qf[8 * i + 6] * bflo(w.w) + qf[8 * i + 7] * bfhi(w.w); }
                        int rel = (lane + 512) - (64 * j + kk); rel = rel > 256 ? 256 : (rel < -256 ? -256 : rel);
                        s += btab[rel + 256];
                        if (pass == 0) { mx = fmaxf(mx, s); }
                        else { const float pr = __expf(s - mx); l += pr;
#pragma unroll
                            for (int i = 0; i < 8; ++i) { const u32x4 w = *(const LAS u32x4*)(Vs + kk * 64 + 8 * i);
                                o[8 * i] += pr * bflo(w.x); o[8 * i + 1] += pr * bfhi(w.x); o[8 * i + 2] += pr * bflo(w.y); o[8 * i + 3] += pr * bfhi(w.y);
                                o[8 * i + 4] += pr * bflo(w.z); o[8 * i + 5] += pr * bfhi(w.z); o[8 * i + 6] += pr * bflo(w.w); o[8 * i + 7] += pr * bfhi(w.w); } }
                    }
                }
                if (pass) { const float inv = 1.0f / l; u32x4* op = (u32x4*)(ycat + (size_t)t * D + 64 * h);
#pragma unroll
                    for (int i = 0; i < 8; ++i) { u32x4 w; w.x = pk2(o[8 * i] * inv, o[8 * i + 1] * inv); w.y = pk2(o[8 * i + 2] * inv, o[8 * i + 3] * inv); w.z = pk2(o[8 * i + 4] * inv, o[8 * i + 5] * inv); w.w = pk2(o[8 * i + 6] * inv, o[8 * i + 7] * inv); op[i] = w; } }
            }
        }
#endif
    }
    grid.sync();

    { pg8::Gemm g{ycat, WoutT, T, D, D}; pg8::StaticOrder S; S.init(T, D, G, bx); pg8::EpiResid E{a.x, a.out, x1b, ssq1};
      pg8::gemm_phase<pg8::EpiResid, pg8::StaticOrder, true, true>(lds, g, S, E); }
    grid.sync();

#ifndef NO_UP
    { pg8::Gemm g{x1b, WupT, T, 2 * FF, D}; pg8::StaticOrder S; S.init(T, 2 * FF, G, bx); pg8::EpiUp E{gbuf, ssq1, a.w_ffn_conv, a.b_ffn_conv, tailb, headb};
      pg8::gemm_phase<pg8::EpiUp, pg8::StaticOrder, true, true>(lds, g, S, E); }
#endif
    grid.sync();

    for (int i = gtid; i < NCH * 2 * FF; i += NT) {
        const int C = i % FF, gj = i / FF, j = gj & 1, grp = gj >> 1; const int row = grp * 64 + j;
        float ug[3], uv[3];
        const float* tl = tailb + (size_t)(grp - 1) * 2 * (2 * FF); const float* hd = headb + (size_t)grp * 2 * (2 * FF);
        if (j == 0) { ug[0] = grp ? tl[C] : 0.f; uv[0] = grp ? tl[FF + C] : 0.f; ug[1] = grp ? tl[2 * FF + C] : 0.f; uv[1] = grp ? tl[3 * FF + C] : 0.f; ug[2] = hd[C]; uv[2] = hd[FF + C]; }
        else { ug[0] = grp ? tl[2 * FF + C] : 0.f; uv[0] = grp ? tl[3 * FF + C] : 0.f; ug[1] = hd[C]; uv[1] = hd[FF + C]; ug[2] = hd[2 * FF + C]; uv[2] = hd[3 * FF + C]; }
        const float* cw = a.w_ffn_conv; const float* cb = a.b_ffn_conv;
        const float yg = cb[C] + cw[C] * ug[0] + cw[2 * FF + C] * ug[1] + cw[4 * FF + C] * ug[2];
        const float yv = cb[FF + C] + cw[FF + C] * uv[0] + cw[3 * FF + C] * uv[1] + cw[5 * FF + C] * uv[2];
        gbuf[(size_t)row * FF + C] = (bf16_t)f2bf(pg8::gelu_tanh(yg) * yv);
    }
    grid.sync();

    { pg8::Gemm g{gbuf, WdnT, T, D, FF}; pg8::StaticOrder S; S.init(T, D, G, bx); pg8::EpiResid E{a.out, a.out, x2b, ssq2};
      pg8::gemm_phase<pg8::EpiResid, pg8::StaticOrder, true, true>(lds, g, S, E); }
    { pg8::Gemm g{pb, WppT, T, D, PLE}; pg8::StaticOrder S; S.init(T, D, G, bx); pg8::EpiBf16 E{ppb, D};
      pg8::gemm_phase<pg8::EpiBf16, pg8::StaticOrder, true, true>(lds, g, S, E); }
    grid.sync();

    { pg8::Gemm g{x2b, WpgT, T, D, D}; pg8::StaticOrder S; S.init(T, D, G, bx); pg8::EpiPle E{a.out, ppb, ssq2, ssq3};
      pg8::gemm_phase<pg8::EpiPle, pg8::StaticOrder, true, true>(lds, g, S, E); }
    grid.sync();

    for (int m = gw; m < T; m += NGW) {
        const float rstd = 1.0f / sqrtf(ssq3[m] * (1.0f / D) + EPS);
        f32x4* xr = (f32x4*)(a.out + (size_t)m * D) + lane; const f32x4* wr4 = (const f32x4*)a.final_norm_w + lane;
#pragma unroll
        for (int j = 0; j < 8; ++j) { f32x4 v = xr[64 * j]; const f32x4 w = wr4[64 * j]; v.x *= rstd * w.x; v.y *= rstd * w.y; v.z *= rstd * w.z; v.w *= rstd * w.w; xr[64 * j] = v; }
    }
}

extern "C" void kernel_launch(void* const* d_in, const int* in_sizes, int n_in, void* d_out, int out_size, void* d_ws, size_t ws_size, hipStream_t stream) {
    static int grid = 0;
    if (grid == 0) {
        if (n_in != 18 || out_size != T * D || ws_size < WS_END) { fprintf(stderr, "kernel_launch: unexpected problem (n_in %d out %d ws %zu)\n", n_in, out_size, ws_size); grid = -1; return; }
        int dev = 0, cus = 0, per_cu = 0;
        hipGetDevice(&dev); hipDeviceGetAttribute(&cus, hipDeviceAttributeMultiprocessorCount, dev);
        if (hipFuncSetAttribute((const void*)fwd_megakernel, hipFuncAttributeMaxDynamicSharedMemorySize, LDS_BYTES) != hipSuccess) { fprintf(stderr, "kernel_launch: hipFuncSetAttribute failed\n"); grid = -1; return; }
        if (hipOccupancyMaxActiveBlocksPerMultiprocessor(&per_cu, (const void*)fwd_megakernel, 512, LDS_BYTES) != hipSuccess || per_cu < 1) { fprintf(stderr, "kernel_launch: occupancy query says %d\n", per_cu); per_cu = 1; }
        (void)hipGetLastError();
        grid = cus * per_cu;
    }
    if (grid < 0) return;
    Args a{};
    const float** f = (const float**)&a;
    for (int i = 0; i < 18; ++i) f[i] = (const float*)d_in[i];
    a.out = (float*)d_out; a.ws = (unsigned char*)d_ws;
    void* args[] = {&a};
    hipError_t e = hipLaunchCooperativeKernel((const void*)fwd_megakernel, dim3(grid), dim3(512), args, LDS_BYTES, stream);
    if (e != hipSuccess) fprintf(stderr, "cooperative launch failed: %s (grid %d)\n", hipGetErrorString(e), grid);
}
```

```cpp
#include <hip/hip_runtime.h>
#include <hip/hip_cooperative_groups.h>
#include <cstdio>
#include <cstdint>
namespace cg = cooperative_groups;

#define LAS __attribute__((address_space(3)))
typedef unsigned short bf16_t;
typedef short bf16x8 __attribute__((ext_vector_type(8)));
typedef float f32x4 __attribute__((ext_vector_type(4)));
typedef float f32x2 __attribute__((ext_vector_type(2)));
typedef unsigned u32x4 __attribute__((ext_vector_type(4)));
typedef unsigned u32x2 __attribute__((ext_vector_type(2)));

constexpr int T = 16384, D = 2048, FF = 5632, NR = 4096, PLE = 256, NCH = 256;
constexpr int QA = 0, KA = 1024, QG = 2048, KG = 2560, RG = 3072;
constexpr float EPS = 1e-6f;
constexpr size_t MiB = 1u << 20;
constexpr size_t WS_SSQ1 = 0, WS_SSQ2 = 65536, WS_SSQ3 = 131072, WS_GLR = 1 * MiB, WS_WG = 2 * MiB, WS_WPP = 3 * MiB;
constexpr size_t WS_WIN = 4 * MiB, WS_WOUT = 28 * MiB, WS_WUP = 36 * MiB, WS_WDN = 80 * MiB, WS_WPG = 102 * MiB, WS_PB = 110 * MiB;
constexpr size_t WS_H0 = 118 * MiB;
constexpr size_t WS_PROJ = 182 * MiB;
constexpr size_t WS_VT = 310 * MiB;
constexpr size_t WS_X1B = 182 * MiB, WS_G = 246 * MiB, WS_TAIL = 422 * MiB, WS_HEAD = 444 * MiB, WS_PP = 182 * MiB, WS_YCAT = WS_H0, WS_X2B = WS_H0;
constexpr size_t WS_DEC = 256 * 1024, WS_UPD = 406 * MiB;
constexpr size_t WS_END = 512 * MiB;
constexpr int LDS_BYTES = 147456;

__device__ __forceinline__ unsigned f2bf(float f) { unsigned u = __builtin_bit_cast(unsigned, f); return (u + 0x7fffu + ((u >> 16) & 1u)) >> 16; }
__device__ __forceinline__ unsigned pk2(float lo, float hi) { return f2bf(lo) | (f2bf(hi) << 16); }
__device__ __forceinline__ float bf2f(unsigned short b) { return __builtin_bit_cast(float, (unsigned)b << 16); }
__device__ __forceinline__ float bflo(unsigned w) { return __builtin_bit_cast(float, w << 16); }
__device__ __forceinline__ float bfhi(unsigned w) { return __builtin_bit_cast(float, w & 0xffff0000u); }
__device__ __forceinline__ float wave_sum(float v) {
#pragma unroll
    for (int o = 1; o < 64; o <<= 1) v += __shfl_xor(v, o);
    return v;
}

namespace pg8 {
#define PG8_LAS __attribute__((address_space(3)))
constexpr int BM = 256, BK = 64, HALF = 128, HTB = HALF * BK * 2, STAGE_BYTES = 8 * HTB, NXCD = 8, WGM = 8;
__host__ __device__ __forceinline__ int lds_byte(int r, int c) { const int st = (r >> 4) * 2 + (c >> 5), rr = r & 15, cc = c & 31, ob = rr * 64 + cc * 2; return st * 1024 + (ob ^ (((ob >> 9) & 1) << 5)); }
__host__ __device__ __forceinline__ void stage_rc(int b, int& R, int& C) { const int st = b / 1024, sb = b % 1024, swz = sb ^ (((sb >> 9) & 1) << 5); R = (st >> 1) * 16 + swz / 64; C = (st & 1) * 32 + (swz % 64) / 2; }
__host__ __device__ __forceinline__ int perm32(int rho) { const int n = rho >> 4, i = rho & 15; return 8 * (i >> 2) + 4 * n + (i & 3); }

struct Unit { int pm, pn; };
struct Gemm { const bf16_t* A; const bf16_t* Bt; int M, N, K; };

struct StaticOrder {
    int nM, nN, nwg, G, c;
    __host__ __device__ void init(int M, int N, int G_, int c_) { nM = M / BM; nN = N / BM; nwg = nM * nN; G = G_; c = c_; }
    __host__ __device__ bool next(int i, Unit& u) const {
        const long L = (long)i * G + c; if (L >= nwg) return false;
        int wgid = (int)L; { const int q = nwg / NXCD, r = nwg % NXCD, xcd = wgid % NXCD, off = wgid / NXCD; wgid = (xcd < r ? xcd * (q + 1) : r * (q + 1) + (xcd - r) * q) + off; }
        const int nig = WGM * nN, gid = wgid / nig, fm = gid * WGM, gsz = (nM - fm) < WGM ? (nM - fm) : WGM;
        u.pm = fm + ((wgid % nig) % gsz); u.pn = (wgid % nig) / gsz; return true;
    }
    __device__ __forceinline__ void a_ready(const Unit&) const {}
    __device__ __forceinline__ void done(const Unit&) const {}
};

__device__ __forceinline__ unsigned cvt_pk_bf16(float lo, float hi) { unsigned r; asm volatile("v_cvt_pk_bf16_f32 %0, %1, %2" : "=v"(r) : "v"(lo), "v"(hi)); return r; }

struct EpiBf16 {
    static constexpr bool PERM = true, AFTER_DRAIN = false;
    bf16_t* O; int ldc;
    __device__ __forceinline__ void operator()(const f32x4 (&acc)[2][2][4][2], const Unit& u, int wr, int wc, int fr, int fq) const {
        const int row0 = u.pm * BM + wr * 64 + fr; const int col0 = u.pn * BM + wc * 32 + 8 * fq;
#pragma unroll
        for (int ai = 0; ai < 2; ++ai)
#pragma unroll
            for (int m = 0; m < 4; ++m) { bf16_t* rowp = O + (size_t)(row0 + ai * HALF + m * 16) * ldc + col0;
#pragma unroll
                for (int bj = 0; bj < 2; ++bj) { const f32x4 v0 = acc[ai][bj][m][0], v1 = acc[ai][bj][m][1];
                    u32x4 w; w.x = cvt_pk_bf16(v0[0], v0[1]); w.y = cvt_pk_bf16(v0[2], v0[3]); w.z = cvt_pk_bf16(v1[0], v1[1]); w.w = cvt_pk_bf16(v1[2], v1[3]);
                    *(u32x4*)(rowp + bj * HALF) = w; } }
    }
};
struct EpiResid {
    static constexpr bool PERM = true, AFTER_DRAIN = false;
    const float* base; float* out; bf16_t* ob; float* ssq;
    __device__ __forceinline__ void operator()(const f32x4 (&acc)[2][2][4][2], const Unit& u, int wr, int wc, int fr, int fq) const {
        const int row0 = u.pm * BM + wr * 64 + fr; const int col0 = u.pn * BM + wc * 32 + 8 * fq;
#pragma unroll
        for (int ai = 0; ai < 2; ++ai)
#pragma unroll
            for (int m = 0; m < 4; ++m) { const int row = row0 + ai * HALF + m * 16; const size_t off = (size_t)row * D + col0; float ss = 0.f;
#pragma unroll
                for (int bj = 0; bj < 2; ++bj) {
                    const f32x4 b0 = *(const f32x4*)(base + off + bj * HALF), b1 = *(const f32x4*)(base + off + bj * HALF + 4);
                    const f32x4 v0 = acc[ai][bj][m][0] + b0, v1 = acc[ai][bj][m][1] + b1;
                    *(f32x4*)(out + off + bj * HALF) = v0; *(f32x4*)(out + off + bj * HALF + 4) = v1;
                    u32x4 w; w.x = cvt_pk_bf16(v0[0], v0[1]); w.y = cvt_pk_bf16(v0[2], v0[3]); w.z = cvt_pk_bf16(v1[0], v1[1]); w.w = cvt_pk_bf16(v1[2], v1[3]);
                    *(u32x4*)(ob + off + bj * HALF) = w;
                    ss += (v0[0] * v0[0] + v0[1] * v0[1]) + (v0[2] * v0[2] + v0[3] * v0[3]) + (v1[0] * v1[0] + v1[1] * v1[1]) + (v1[2] * v1[2] + v1[3] * v1[3]); }
                ss += __shfl_xor(ss, 16); ss += __shfl_xor(ss, 32);
                if (fq == 0) atomicAdd(ssq + row, ss); }
    }
};
struct EpiPle {
    static constexpr bool PERM = true, AFTER_DRAIN = false;
    float* out; const bf16_t* pp; const float* ssq2; float* ssq3;
    __device__ __forceinline__ void operator()(const f32x4 (&acc)[2][2][4][2], const Unit& u, int wr, int wc, int fr, int fq) const {
        const int row0 = u.pm * BM + wr * 64 + fr; const int col0 = u.pn * BM + wc * 32 + 8 * fq;
#pragma unroll
        for (int ai = 0; ai < 2; ++ai)
#pragma unroll
            for (int m = 0; m < 4; ++m) { const int row = row0 + ai * HALF + m * 16; const size_t off = (size_t)row * D + col0; float ss = 0.f;
                const float rstd = 1.0f / sqrtf(ssq2[row] * (1.0f / D) + EPS);
#pragma unroll
                for (int bj = 0; bj < 2; ++bj) {
                    const f32x4 b0 = *(const f32x4*)(out + off + bj * HALF), b1 = *(const f32x4*)(out + off + bj * HALF + 4);
                    const u32x4 pw = *(const u32x4*)(pp + off + bj * HALF);
                    f32x4 p0 = {bflo(pw.x), bfhi(pw.x), bflo(pw.y), bfhi(pw.y)}, p1 = {bflo(pw.z), bfhi(pw.z), bflo(pw.w), bfhi(pw.w)};
                    f32x4 v0, v1;
#pragma unroll
                    for (int e = 0; e < 4; ++e) { const float g0 = 1.0f / (1.0f + __expf(-acc[ai][bj][m][0][e] * rstd)), g1 = 1.0f / (1.0f + __expf(-acc[ai][bj][m][1][e] * rstd));
                        v0[e] = b0[e] + g0 * p0[e]; v1[e] = b1[e] + g1 * p1[e]; }
                    *(f32x4*)(out + off + bj * HALF) = v0; *(f32x4*)(out + off + bj * HALF + 4) = v1;
                    ss += (v0[0] * v0[0] + v0[1] * v0[1]) + (v0[2] * v0[2] + v0[3] * v0[3]) + (v1[0] * v1[0] + v1[1] * v1[1]) + (v1[2] * v1[2] + v1[3] * v1[3]); }
                ss += __shfl_xor(ss, 16); ss += __shfl_xor(ss, 32);
                if (fq == 0) atomicAdd(ssq3 + row, ss); }
    }
};
__device__ __forceinline__ float gelu_tanh(float x) {
    const float z = 1.5957691216057308f * (x + 0.044715f * x * x * x);
    return x / (1.0f + __expf(-z));
}
template <int CTRL> __device__ __forceinline__ float dppz(float v) { return __builtin_bit_cast(float, __builtin_amdgcn_update_dpp(0, __builtin_bit_cast(int, v), CTRL, 0xf, 0xf, true)); }
struct EpiUp {
    static constexpr bool PERM = true, AFTER_DRAIN = false;
    bf16_t* G; const float* ssq1; const float* cw; const float* cb; float* tail; float* head;
    __device__ __forceinline__ void operator()(const f32x4 (&acc)[2][2][4][2], const Unit& u, int wr, int wc, int fr, int fq) const {
        const int C0 = u.pn * 128 + wc * 32 + 8 * fq;
#pragma unroll
        for (int ai = 0; ai < 2; ++ai) {
            const int rbase = u.pm * BM + ai * HALF + wr * 64; const int grp = rbase >> 6;
            float rstd[4];
#pragma unroll
            for (int m = 0; m < 4; ++m) rstd[m] = 1.0f / sqrtf(ssq1[rbase + m * 16 + fr] * (1.0f / D) + EPS);
            if (fr < 2) { float* hp = head + ((size_t)grp * 2 + fr) * (2 * FF) + C0;
#pragma unroll
                for (int bj = 0; bj < 2; ++bj) { *(f32x4*)(hp + bj * FF) = acc[ai][bj][0][0] * rstd[0]; *(f32x4*)(hp + bj * FF + 4) = acc[ai][bj][0][1] * rstd[0]; } }
            if (fr >= 14) { float* tp = tail + ((size_t)grp * 2 + (fr - 14)) * (2 * FF) + C0;
#pragma unroll
                for (int bj = 0; bj < 2; ++bj) { *(f32x4*)(tp + bj * FF) = acc[ai][bj][3][0] * rstd[3]; *(f32x4*)(tp + bj * FF + 4) = acc[ai][bj][3][1] * rstd[3]; } }
            __builtin_amdgcn_sched_barrier(0);
#pragma unroll
            for (int n = 0; n < 2; ++n) {
                unsigned outw[4][2];
#pragma unroll
                for (int e = 0; e < 4; ++e) {
                    int C = C0 + 4 * n + e; asm volatile("" : "+v"(C));
                    const float wg0 = cw[C], wg1 = cw[2 * FF + C], wg2 = cw[4 * FF + C], bg = cb[C];
                    const float wv0 = cw[FF + C], wv1 = cw[3 * FF + C], wv2 = cw[5 * FF + C], bv = cb[FF + C];
                    float pg1 = 0.f, pg2 = 0.f, pv1 = 0.f, pv2 = 0.f;
#pragma unroll
                    for (int m = 0; m < 4; ++m) {
                        float ug = acc[ai][0][m][n][e] * rstd[m], uv = acc[ai][1][m][n][e] * rstd[m];
                        asm volatile("" : "+v"(ug), "+v"(uv));
                        const float ugm1 = dppz<0x111>(ug) + pg1, ugm2 = dppz<0x112>(ug) + pg2, uvm1 = dppz<0x111>(uv) + pv1, uvm2 = dppz<0x112>(uv) + pv2;
                        const float yg = bg + wg0 * ugm2 + wg1 * ugm1 + wg2 * ug;
                        const float yv = bv + wv0 * uvm2 + wv1 * uvm1 + wv2 * uv;
                        unsigned rb = f2bf(gelu_tanh(yg) * yv); asm volatile("" : "+v"(rb));
                        if (e & 1) outw[m][e >> 1] |= rb << 16; else outw[m][e >> 1] = rb;
                        pg1 = dppz<0x10F>(ug); pg2 = dppz<0x10E>(ug); pv1 = dppz<0x10F>(uv); pv2 = dppz<0x10E>(uv);
                    }
                    __builtin_amdgcn_sched_barrier(0);
                }
#pragma unroll
                for (int m = 0; m < 4; ++m) if (m > 0 || fr >= 2) { u32x2 w = {outw[m][0], outw[m][1]}; *(u32x2*)(G + (size_t)(rbase + m * 16 + fr) * FF + C0 + 4 * n) = w; }
                __builtin_amdgcn_sched_barrier(0);
            }
        }
    }
};

template <class Epi, class Sched, bool ALIGN_EPI = false, bool SP2 = false>
__device__ __forceinline__ void gemm_phase(PG8_LAS unsigned char* lds, const Gemm g, const Sched& S, const Epi& E) {
    int tid_ = threadIdx.x; asm volatile("" : "+v"(tid_));
    const int tid = tid_, wid = __builtin_amdgcn_readfirstlane(tid >> 6), lane = tid & 63, wr = wid >> 2, wc = wid & 3, fr = lane & 15, fq = lane >> 4;
    const int K = g.K, nt = K / BK;
    unsigned voffA[2], voffB[2];
#pragma unroll
    for (int i = 0; i < 2; ++i) { int R, C; stage_rc(tid * 16 + i * 8192, R, C); const int Rb = Epi::PERM ? ((R & ~31) + perm32(R & 31)) : R;
        voffA[i] = (unsigned)(R * K + C) * 2u; voffB[i] = (unsigned)(Rb * K + C) * 2u; }
    const size_t kstep = (size_t)(BK * 2);
    const size_t hstep = (size_t)HALF * K * 2;
    const size_t tstep = 2 * hstep;
    const unsigned ldsw = (unsigned)wid * 1024u;
    const int aoff = lds_byte(wr * 64 + fr, fq * 8), boff = lds_byte(wc * 32 + fr, fq * 8);
#define PG8_SA(b, h) (((b) * 2 + (h)) * HTB)
#define PG8_SB(b, h) ((4 + (b) * 2 + (h)) * HTB)
#define PG8_STAGE(bufoff, gbase, voff) do { _Pragma("unroll") for (int _i = 0; _i < 2; ++_i) \
        __builtin_amdgcn_global_load_lds((const unsigned*)((const char*)(gbase) + (voff)[_i]), (PG8_LAS unsigned*)(lds + (bufoff) + ldsw + _i * 8192), 16, 0, 0); } while (0)
#define PG8_LDA(dst, b, h) do { _Pragma("unroll") for (int m = 0; m < 4; ++m) _Pragma("unroll") for (int k = 0; k < 2; ++k) dst[m][k] = *(const PG8_LAS bf16x8*)(lds + PG8_SA(b, h) + aoff + m * 2048 + k * 1024); } while (0)
#define PG8_LDB(dst, b, h) do { _Pragma("unroll") for (int n = 0; n < 2; ++n) _Pragma("unroll") for (int k = 0; k < 2; ++k) dst[n][k] = *(const PG8_LAS bf16x8*)(lds + PG8_SB(b, h) + boff + n * 2048 + k * 1024); } while (0)
#define PG8_MMA(ai, bj, At, Bt) do { __builtin_amdgcn_s_setprio(1); _Pragma("unroll") for (int m = 0; m < 4; ++m) _Pragma("unroll") for (int n = 0; n < 2; ++n) _Pragma("unroll") for (int k = 0; k < 2; ++k) \
        acc[ai][bj][m][n] = __builtin_amdgcn_mfma_f32_16x16x32_bf16(Bt[n][k], At[m][k], acc[ai][bj][m][n], 0, 0, 0); __builtin_amdgcn_s_setprio(0); } while (0)
#define PG8_WAIT_V(n) asm volatile("s_waitcnt vmcnt(" #n ")" ::: "memory")
#define PG8_WAIT_L(n) asm volatile("s_waitcnt lgkmcnt(" #n ")" ::: "memory")
#define PG8_BAR __builtin_amdgcn_s_barrier()
#define PG8_SCHED __builtin_amdgcn_sched_barrier(0)
    Unit cur, nxt; int ui = 0;
    if (!S.next(0, cur)) return;
    f32x4 acc[2][2][4][2];
#pragma unroll
    for (int a = 0; a < 2; ++a)
#pragma unroll
        for (int b = 0; b < 2; ++b)
#pragma unroll
            for (int m = 0; m < 4; ++m)
#pragma unroll
                for (int n = 0; n < 2; ++n) acc[a][b][m][n] = (f32x4){0.f, 0.f, 0.f, 0.f};
    bf16x8 At[4][2], B0[2][2], B1[2][2];
    const char* cA = (const char*)g.A + (size_t)cur.pm * tstep; const char* cB = (const char*)g.Bt + (size_t)cur.pn * tstep;
    S.a_ready(cur);
    if constexpr (SP2) {
        PG8_STAGE(PG8_SB(0, 0), cB, voffB); PG8_STAGE(PG8_SB(0, 1), cB + hstep, voffB); PG8_STAGE(PG8_SA(0, 0), cA, voffA); PG8_STAGE(PG8_SA(0, 1), cA + hstep, voffA);
        if (wr == 1) PG8_BAR;
        PG8_WAIT_V(2); PG8_BAR;
        PG8_STAGE(PG8_SB(1, 0), cB + kstep, voffB); PG8_STAGE(PG8_SA(1, 0), cA + kstep, voffA); PG8_STAGE(PG8_SB(1, 1), cB + hstep + kstep, voffB);
        PG8_WAIT_V(6); PG8_BAR;
    } else {
        PG8_STAGE(PG8_SB(0, 0), cB, voffB); PG8_STAGE(PG8_SA(0, 0), cA, voffA); PG8_STAGE(PG8_SB(0, 1), cB + hstep, voffB); PG8_STAGE(PG8_SA(0, 1), cA + hstep, voffA);
        if (wr == 1) PG8_BAR;
        PG8_WAIT_V(4); PG8_BAR;
        PG8_STAGE(PG8_SB(1, 0), cB + kstep, voffB); PG8_STAGE(PG8_SA(1, 0), cA + kstep, voffA); PG8_STAGE(PG8_SB(1, 1), cB + hstep + kstep, voffB);
        PG8_WAIT_V(6); PG8_BAR;
    }
    for (;;) {
        const bool has_next = S.next(ui + 1, nxt);
        const char* nA = has_next ? (const char*)g.A + (size_t)nxt.pm * tstep : cA; const char* nB = has_next ? (const char*)g.Bt + (size_t)nxt.pn * tstep : cB;
        for (int t = 0; t < nt; t += 2) {
            const bool last = (t == nt - 2);
            const char* a1 = cA + (size_t)(t + 1) * kstep;
            const char* a2 = last ? nA : cA + (size_t)(t + 2) * kstep; const char* b2 = last ? nB : cB + (size_t)(t + 2) * kstep;
            const char* a3 = a2 + kstep; const char* b3 = b2 + kstep;
            if (last && has_next) S.a_ready(nxt);
            if constexpr (SP2) {
            PG8_LDB(B0, 0, 0); PG8_LDB(B1, 0, 1); PG8_SCHED; PG8_LDA(At, 0, 0); PG8_STAGE(PG8_SA(1, 1), a1 + hstep, voffA);
            PG8_WAIT_V(8); PG8_WAIT_L(0); PG8_BAR; PG8_MMA(0, 0, At, B0); PG8_MMA(0, 1, At, B1); PG8_BAR; PG8_SCHED;
            PG8_LDA(At, 0, 1); PG8_STAGE(PG8_SB(0, 0), b2, voffB); PG8_STAGE(PG8_SB(0, 1), b2 + hstep, voffB); PG8_STAGE(PG8_SA(0, 0), a2, voffA);
            PG8_WAIT_V(8); PG8_WAIT_L(0); PG8_BAR; PG8_MMA(1, 0, At, B0); PG8_MMA(1, 1, At, B1); PG8_BAR; PG8_SCHED;
            PG8_LDB(B0, 1, 0); PG8_LDB(B1, 1, 1); PG8_SCHED; PG8_LDA(At, 1, 0); PG8_STAGE(PG8_SA(0, 1), a2 + hstep, voffA);
            PG8_WAIT_V(8); PG8_WAIT_L(0); PG8_BAR; PG8_MMA(0, 0, At, B0); PG8_MMA(0, 1, At, B1); PG8_BAR; PG8_SCHED;
            PG8_LDA(At, 1, 1); PG8_STAGE(PG8_SB(1, 0), b3, voffB); PG8_STAGE(PG8_SB(1, 1), b3 + hstep, voffB); PG8_STAGE(PG8_SA(1, 0), a3, voffA);
            PG8_WAIT_V(8); PG8_WAIT_L(0); PG8_BAR; PG8_MMA(1, 0, At, B0); PG8_MMA(1, 1, At, B1); PG8_BAR; PG8_SCHED;
            } else {
            PG8_LDB(B0, 0, 0); PG8_SCHED; PG8_LDA(At, 0, 0); PG8_STAGE(PG8_SA(1, 1), a1 + hstep, voffA);
            PG8_WAIT_L(8); PG8_BAR; PG8_WAIT_L(0); PG8_MMA(0, 0, At, B0); PG8_BAR; PG8_SCHED;
            PG8_LDB(B1, 0, 1); PG8_STAGE(PG8_SB(0, 0), b2, voffB);
            PG8_BAR; PG8_WAIT_L(0); PG8_MMA(0, 1, At, B1); PG8_BAR;
            PG8_LDA(At, 0, 1); PG8_STAGE(PG8_SA(0, 0), a2, voffA);
            PG8_BAR; PG8_WAIT_L(0); PG8_MMA(1, 0, At, B0); PG8_BAR; PG8_SCHED;
            PG8_STAGE(PG8_SB(0, 1), b2 + hstep, voffB);
            PG8_WAIT_V(6); PG8_BAR; PG8_MMA(1, 1, At, B1); PG8_BAR;
            PG8_LDB(B0, 1, 0); PG8_SCHED; PG8_LDA(At, 1, 0); PG8_STAGE(PG8_SA(0, 1), a2 + hstep, voffA);
            PG8_WAIT_L(8); PG8_BAR; PG8_WAIT_L(0); PG8_MMA(0, 0, At, B0); PG8_BAR; PG8_SCHED;
            PG8_LDB(B1, 1, 1); PG8_STAGE(PG8_SB(1, 0), b3, voffB);
            PG8_BAR; PG8_WAIT_L(0); PG8_MMA(0, 1, At, B1); PG8_BAR;
            PG8_LDA(At, 1, 1); PG8_STAGE(PG8_SA(1, 0), a3, voffA);
            PG8_BAR; PG8_WAIT_L(0); PG8_MMA(1, 0, At, B0); PG8_BAR; PG8_SCHED;
            PG8_STAGE(PG8_SB(1, 1), b3 + hstep, voffB);
            PG8_WAIT_V(6); PG8_BAR; PG8_MMA(1, 1, At, B1); PG8_BAR;
            }
        }
        if constexpr (ALIGN_EPI) { if (wr == 0) PG8_BAR; }
        if constexpr (!Epi::AFTER_DRAIN) { E(acc, cur, wr, wc, fr, fq); S.done(cur); }
        if (!has_next) break;
#pragma unroll
        for (int a = 0; a < 2; ++a)
#pragma unroll
            for (int b = 0; b < 2; ++b)
#pragma unroll
                for (int m = 0; m < 4; ++m)
#pragma unroll
                    for (int n = 0; n < 2; ++n) acc[a][b][m][n] = (f32x4){0.f, 0.f, 0.f, 0.f};
        cur = nxt; cA = nA; cB = nB; ++ui;
        if constexpr (ALIGN_EPI) { if (wr == 1) PG8_BAR; }
    }
    PG8_WAIT_V(0);
    if constexpr (!ALIGN_EPI) { if (wr == 0) PG8_BAR; }
    PG8_BAR;
#undef PG8_SA
#undef PG8_SB
#undef PG8_STAGE
#undef PG8_LDA
#undef PG8_LDB
#undef PG8_MMA
#undef PG8_WAIT_V
#undef PG8_WAIT_L
#undef PG8_BAR
#undef PG8_SCHED
}
}

struct Args {
    const float *x, *p, *norm_mix_w, *w_in, *att_rel_bias, *w_gla_gate_up, *b_gla_gate, *gla_norm_w, *w_out, *norm_ffn_w, *w_ffn_up, *w_ffn_conv, *b_ffn_conv, *w_ffn_down,
                *norm_ple_w, *w_ple_gate, *w_ple_proj, *final_norm_w;
    float* out; unsigned char* ws;
};

__device__ __forceinline__ int map_row(int mode, int n) {
    if (mode == 1) { if (n < 2048) return n; if (n < 3072) return n + 2048; if (n < 4096) return n - 1024; if (n < 5120) return n + 1024; return n - 2048; }
    if (mode == 2) { const int half = n >= FF ? 1 : 0; const int c = n - half * FF; return (c >> 7) * 256 + half * 128 + (c & 127); }
    return n;
}
__device__ __forceinline__ void transpose_item(const float* W, int K, int ldn, int nblk, bf16_t* WT, LAS float* scr, int item, int lane, const float* kscale, int mode) {
    const int kb = item / nblk, nb = item % nblk, k0 = 64 * kb, n0 = 32 * nb;
#pragma unroll 8
    for (int i = 0; i < 32; ++i) { const int kk = 2 * i + (lane >> 5); float v = W[(size_t)(k0 + kk) * ldn + n0 + (lane & 31)]; if (kscale) v *= kscale[k0 + kk]; scr[kk * 33 + (lane & 31)] = v; }
    asm volatile("s_waitcnt lgkmcnt(0)" ::: "memory");
    const int c = lane & 7; const int drow0 = map_row(mode, n0);
#pragma unroll
    for (int j = 0; j < 4; ++j) { const int n = (lane >> 3) + 8 * j; const LAS float* s = scr + (8 * c) * 33 + n;
        u32x4 o; o.x = pk2(s[0 * 33], s[1 * 33]); o.y = pk2(s[2 * 33], s[3 * 33]); o.z = pk2(s[4 * 33], s[5 * 33]); o.w = pk2(s[6 * 33], s[7 * 33]);
        *(u32x4*)(WT + (size_t)(drow0 + n) * K + k0 + 8 * c) = o; }
    asm volatile("s_waitcnt lgkmcnt(0)" ::: "memory");
}

__device__ __forceinline__ void gla_decay(const Args& a, const float* glr, int n, int hg, int tid, LAS float* gL, LAS float* segtot, float (&bv)[16], float& blast) {
    const int dk = tid & 127, seg = tid >> 7, col = hg * 128 + dk;
    if (tid < 256) ((LAS f32x4*)gL)[tid] = ((const f32x4*)(glr + (size_t)n * 64 * 16))[tid];
    float w[16];
#pragma unroll
    for (int j = 0; j < 16; ++j) w[j] = a.w_gla_gate_up[j * 512 + col];
    const float bias = a.b_gla_gate[col];
    __syncthreads();
    float c = 0.f;
#pragma unroll
    for (int s = 0; s < 16; ++s) { const LAS f32x4* g4 = (const LAS f32x4*)(gL + (16 * seg + s) * 16); float logit = bias;
#pragma unroll
        for (int q = 0; q < 4; ++q) { const f32x4 g = g4[q]; logit += g[0] * w[4 * q] + g[1] * w[4 * q + 1] + g[2] * w[4 * q + 2] + g[3] * w[4 * q + 3]; }
        const float ls = fminf(logit, 0.f) - log1pf(__expf(-fabsf(logit)));
        c += ls * (1.0f / 16.0f); bv[s] = c; if ((s & 3) == 3) asm volatile("" ::: "memory"); }
    segtot[seg * 128 + dk] = c;
    __syncthreads();
    float off = 0.f, tot = 0.f;
#pragma unroll
    for (int q = 0; q < 4; ++q) { const float v = segtot[q * 128 + dk]; tot += v; if (q < seg) off += v; }
#pragma unroll
    for (int s = 0; s < 16; ++s) bv[s] += off;
    blast = tot;
}

__global__ void __launch_bounds__(512, 2) fwd_megakernel(Args a) {
    extern __shared__ __attribute__((aligned(16))) unsigned char lds_raw[];
    cg::grid_group grid = cg::this_grid();
    LAS unsigned char* lds = (LAS unsigned char*)lds_raw;
    const int tid = threadIdx.x, lane = tid & 63, wave = __builtin_amdgcn_readfirstlane(tid >> 6);
    const int G = gridDim.x, bx = blockIdx.x;
    const int gw = bx * 8 + wave, NGW = G * 8;
    const int gtid = bx * 512 + tid, NT = G * 512;
    unsigned char* ws = a.ws;
    float* ssq1 = (float*)(ws + WS_SSQ1); float* ssq2 = (float*)(ws + WS_SSQ2); float* ssq3 = (float*)(ws + WS_SSQ3);
    float* glr = (float*)(ws + WS_GLR); float* decb = (float*)(ws + WS_DEC); bf16_t* upd = (bf16_t*)(ws + WS_UPD);
    bf16_t* WgT = (bf16_t*)(ws + WS_WG); bf16_t* WppT = (bf16_t*)(ws + WS_WPP); bf16_t* WinT = (bf16_t*)(ws + WS_WIN); bf16_t* WoutT = (bf16_t*)(ws + WS_WOUT);
    bf16_t* WupT = (bf16_t*)(ws + WS_WUP); bf16_t* WdnT = (bf16_t*)(ws + WS_WDN); bf16_t* WpgT = (bf16_t*)(ws + WS_WPG); bf16_t* pb = (bf16_t*)(ws + WS_PB);
    bf16_t* h0 = (bf16_t*)(ws + WS_H0); bf16_t* projR = (bf16_t*)(ws + WS_PROJ); bf16_t* vT = (bf16_t*)(ws + WS_VT);
    bf16_t* ycat = (bf16_t*)(ws + WS_YCAT); bf16_t* x1b = (bf16_t*)(ws + WS_X1B); bf16_t* gbuf = (bf16_t*)(ws + WS_G);
    float* tailb = (float*)(ws + WS_TAIL); float* headb = (float*)(ws + WS_HEAD); bf16_t* ppb = (bf16_t*)(ws + WS_PP); bf16_t* x2b = (bf16_t*)(ws + WS_X2B);

    {
        LAS float* scr = (LAS float*)(lds + wave * 16384);
        constexpr int I_IN = 32 * 192, I_OUT = 32 * 64, I_UP = 32 * 352, I_DN = 88 * 64, I_PG = 32 * 64, I_PP = 4 * 64;
        constexpr int NITEMS = I_IN + I_OUT + I_UP + I_DN + I_PG + I_PP;
        for (int it = gw; it < NITEMS; it += NGW) {
            int r = it;
            if (r < I_IN) { transpose_item(a.w_in, 2048, 6160, 192, WinT, scr, r, lane, nullptr, 1); continue; } r -= I_IN;
            if (r < I_OUT) { transpose_item(a.w_out, 2048, 2048, 64, WoutT, scr, r, lane, nullptr, 0); continue; } r -= I_OUT;
            if (r < I_UP) { transpose_item(a.w_ffn_up, 2048, 2 * FF, 352, WupT, scr, r, lane, a.norm_ffn_w, 2); continue; } r -= I_UP;
            if (r < I_DN) { transpose_item(a.w_ffn_down, FF, 2048, 64, WdnT, scr, r, lane, nullptr, 0); continue; } r -= I_DN;
            if (r < I_PG) { transpose_item(a.w_ple_gate, 2048, 2048, 64, WpgT, scr, r, lane, a.norm_ple_w, 0); continue; } r -= I_PG;
            transpose_item(a.w_ple_proj, PLE, 2048, 64, WppT, scr, r, lane, nullptr, 0);
        }
        for (int i = gtid; i < 16 * 2048; i += NT) { const int j = i >> 11, k = i & 2047; WgT[i] = (bf16_t)f2bf(a.w_in[(size_t)k * 6160 + 6144 + j]); }
        for (int m = gw; m < T; m += NGW) {
            const f32x4* xr = (const f32x4*)(a.x + (size_t)m * D) + lane; const f32x4* wr4 = (const f32x4*)a.norm_mix_w + lane;
            f32x4 v[8]; float s = 0.f;
#pragma unroll
            for (int j = 0; j < 8; ++j) { v[j] = xr[64 * j]; s += (v[j].x * v[j].x + v[j].y * v[j].y) + (v[j].z * v[j].z + v[j].w * v[j].w); }
            const float rstd = 1.0f / sqrtf(wave_sum(s) * (1.0f / D) + EPS);
            u32x2* o8 = (u32x2*)(h0 + (size_t)m * D) + lane;
#pragma unroll
            for (int j = 0; j < 8; ++j) { const f32x4 w = wr4[64 * j]; u32x2 o; o.x = pk2(v[j].x * rstd * w.x, v[j].y * rstd * w.y); o.y = pk2(v[j].z * rstd * w.z, v[j].w * rstd * w.w); o8[64 * j] = o; }
        }
        for (int i = gtid; i < T * PLE / 4; i += NT) { const f32x4 v = ((const f32x4*)a.p)[i]; u32x2 o; o.x = pk2(v.x, v.y); o.y = pk2(v.z, v.w); ((u32x2*)pb)[i] = o; }
        for (int i = gtid; i < 3 * T; i += NT) ssq1[i] = 0.f;
    }
    grid.sync();

    {
        for (int task = gw; task < T / 16; task += NGW) {
            const int fr = lane & 15, fq = lane >> 4; const int r0 = task * 16;
            const bf16_t* ap = h0 + (size_t)(r0 + fr) * D + 8 * fq; const bf16_t* bp = WgT + (size_t)fr * D + 8 * fq;
            f32x4 acc = {0.f, 0.f, 0.f, 0.f};
#pragma unroll 4
            for (int k0 = 0; k0 < D; k0 += 32) { const bf16x8 av = *(const bf16x8*)(ap + k0), bv = *(const bf16x8*)(bp + k0); acc = __builtin_amdgcn_mfma_f32_16x16x32_bf16(av, bv, acc, 0, 0, 0); }
#pragma unroll
            for (int j = 0; j < 4; ++j) glr[(size_t)(r0 + 4 * fq + j) * 16 + fr] = acc[j];
        }
        __syncthreads();
        { pg8::Gemm g{h0, WinT, T, NR, D}; pg8::StaticOrder S; S.init(T, NR, G, bx); pg8::EpiBf16 E{projR, NR};
          pg8::gemm_phase<pg8::EpiBf16, pg8::StaticOrder, true, true>(lds, g, S, E); }
        { pg8::Gemm g{WinT + (size_t)NR * D, h0, 2048, T, D}; pg8::StaticOrder S; S.init(2048, T, G, bx); pg8::EpiBf16 E{vT, T};
          pg8::gemm_phase<pg8::EpiBf16, pg8::StaticOrder, true, true>(lds, g, S, E); }
    }
    grid.sync();

    {
        LAS float* gL = (LAS float*)lds; LAS float* segtot = (LAS float*)(lds + 4096); LAS bf16_t* kT = (LAS bf16_t*)(lds + 8192);
        const int fr = lane & 15, fq = lane >> 4;
        for (int unit = bx; unit < NCH * 4; unit += G) {
            const int n = unit >> 2, hg = unit & 3; const int dk = tid & 127, seg = tid >> 7, col = hg * 128 + dk;
            float bv[16], blast;
            gla_decay(a, glr, n, hg, tid, gL, segtot, bv, blast);
            unsigned kw[8];
#pragma unroll
            for (int s = 0; s < 16; s += 2) { const size_t t = (size_t)n * 64 + 16 * seg + s;
                const float k0 = bf2f(projR[t * NR + KG + col]) * __expf(blast - bv[s]), k1 = bf2f(projR[(t + 1) * NR + KG + col]) * __expf(blast - bv[s + 1]);
                kw[s >> 1] = pk2(k0, k1); }
            *(LAS u32x4*)(kT + dk * 72 + 16 * seg) = (u32x4){kw[0], kw[1], kw[2], kw[3]}; *(LAS u32x4*)(kT + dk * 72 + 16 * seg + 8) = (u32x4){kw[4], kw[5], kw[6], kw[7]};
            if (seg == 0) decb[(size_t)unit * 128 + dk] = __expf(blast);
            __syncthreads();
            f32x4 acc[8][2];
#pragma unroll
            for (int mt = 0; mt < 8; ++mt) { acc[mt][0] = (f32x4){0.f, 0.f, 0.f, 0.f}; acc[mt][1] = (f32x4){0.f, 0.f, 0.f, 0.f}; }
            bf16x8 vB[2][2];
#pragma unroll
            for (int nt2 = 0; nt2 < 2; ++nt2)
#pragma unroll
                for (int ks = 0; ks < 2; ++ks) vB[nt2][ks] = *(const bf16x8*)(vT + (size_t)(1024 + hg * 256 + 16 * (2 * wave + nt2) + fr) * T + n * 64 + 32 * ks + 8 * fq);
#pragma unroll
            for (int mt = 0; mt < 8; ++mt)
#pragma unroll
                for (int ks = 0; ks < 2; ++ks) { const bf16x8 ak = *(const LAS bf16x8*)(kT + (16 * mt + fr) * 72 + 32 * ks + 8 * fq);
                    acc[mt][0] = __builtin_amdgcn_mfma_f32_16x16x32_bf16(ak, vB[0][ks], acc[mt][0], 0, 0, 0);
                    acc[mt][1] = __builtin_amdgcn_mfma_f32_16x16x32_bf16(ak, vB[1][ks], acc[mt][1], 0, 0, 0); }
#pragma unroll
            for (int mt = 0; mt < 8; ++mt)
#pragma unroll
                for (int nt2 = 0; nt2 < 2; ++nt2) { const int dvv = 16 * (2 * wave + nt2) + fr; u32x2 w; w.x = pk2(acc[mt][nt2][0], acc[mt][nt2][1]); w.y = pk2(acc[mt][nt2][2], acc[mt][nt2][3]);
                    *(u32x2*)(upd + (size_t)unit * 32768 + dvv * 128 + 16 * mt + 4 * fq) = w; }
        }
    }
    grid.sync();

    for (int g = gtid; g < 4 * 32768; g += NT) {
        const int hg = g >> 15, rem = g & 32767, dk = g & 127;
        bf16_t* p = upd + (size_t)hg * 32768 + rem; const float* dp = decb + hg * 128 + dk;
        float S = 0.f;
        for (int n = 0; n < NCH; n += 8) {
            float uu[8], dd[8];
#pragma unroll
            for (int k = 0; k < 8; ++k) { uu[k] = bf2f(p[(size_t)(n + k) * 131072]); dd[k] = dp[(n + k) * 512]; }
#pragma unroll
            for (int k = 0; k < 8; ++k) { p[(size_t)(n + k) * 131072] = (bf16_t)f2bf(S); S = dd[k] * S + uu[k]; }
        }
    }
    {
#ifndef NO_ATT
        LAS bf16_t* Ks = (LAS bf16_t*)(lds + wave * 16384); LAS bf16_t* Vs = Ks + 4096;
        const int aw = gw, NAW = NGW;
        for (int unit = aw; unit < NCH * 16; unit += NAW) {
            const int c = unit >> 4, h = unit & 15; const int t = c * 64 + lane;
            float qf[64];
            { const u32x4* qp = (const u32x4*)(projR + (size_t)t * NR + QA + 64 * h);
#pragma unroll
              for (int i = 0; i < 8; ++i) { const u32x4 w = qp[i]; qf[8 * i] = bflo(w.x) * 0.125f; qf[8 * i + 1] = bfhi(w.x) * 0.125f; qf[8 * i + 2] = bflo(w.y) * 0.125f; qf[8 * i + 3] = bfhi(w.y) * 0.125f;
                  qf[8 * i + 4] = bflo(w.z) * 0.125f; qf[8 * i + 5] = bfhi(w.z) * 0.125f; qf[8 * i + 6] = bflo(w.w) * 0.125f; qf[8 * i + 7] = bfhi(w.w) * 0.125f; } }
            const float* btab = a.att_rel_bias + h * 513;
            float mx = -1e30f;
            for (int pass = 0; pass < 2; ++pass) {
                float l = 0.f; float o[64];
#pragma unroll
                for (int i = 0; i < 64; ++i) o[i] = 0.f;
                for (int j = 0; j < 9; ++j) { const int kc = c - 8 + j; if (kc < 0) continue;
                    __builtin_amdgcn_wave_barrier();
#pragma unroll 2
                    for (int it = 0; it < 8; ++it) { const int idx = it * 64 + lane, row = idx >> 3, seg = idx & 7;
                        *(LAS u32x4*)(Ks + row * 64 + seg * 8) = *(const u32x4*)(projR + (size_t)(kc * 64 + row) * NR + KA + 64 * h + seg * 8);
                        if (pass) { const u32x4 w = *(const u32x4*)(vT + (size_t)(64 * h + row) * T + kc * 64 + seg * 8);
                            LAS bf16_t* vp = Vs + (seg * 8) * 64 + row;
                            vp[0] = (bf16_t)(w.x & 0xffff); vp[64] = (bf16_t)(w.x >> 16); vp[128] = (bf16_t)(w.y & 0xffff); vp[192] = (bf16_t)(w.y >> 16);
                            vp[256] = (bf16_t)(w.z & 0xffff); vp[320] = (bf16_t)(w.z >> 16); vp[384] = (bf16_t)(w.w & 0xffff); vp[448] = (bf16_t)(w.w >> 16); } }
                    asm volatile("s_waitcnt vmcnt(0) lgkmcnt(0)" ::: "memory");
                    __builtin_amdgcn_wave_barrier();
                    for (int kk = 0; kk < 64; ++kk) {
                        float s = 0.f;
#pragma unroll
                        for (int i = 0; i < 8; ++i) { const u32x4 w = *(const LAS u32x4*)(Ks + kk * 64 + 8 * i);
                            s += qf[8 * i] * bflo(w.x) + qf[8 * i + 1] * bfhi(w.x) + qf[8 * i + 2] * bflo(w.y) + qf[8 * i + 3] * bfhi(w.y) + qf[8 * i + 4] * bflo(w.z) + qf[8 * i + 5] * bfhi(w.z) + qf[8 * i + 6] * bflo(w.w) + qf[8 * i + 7] * bfhi(w.w); }
                        int rel = (lane + 512) - (64 * j + kk); rel = rel > 256 ? 256 : (rel < -256 ? -256 : rel);
                        s += btab[rel + 256];
                        if (pass == 0) { mx = fmaxf(mx, s); }
                        else { const float pr = __expf(s - mx); l += pr;
#pragma unroll
                            for (int i = 0; i < 8; ++i) { const u32x4 w = *(const LAS u32x4*)(Vs + kk * 64 + 8 * i);
                                o[8 * i] += pr * bflo(w.x); o[8 * i + 1] += pr * bfhi(w.x); o[8 * i + 2] += pr * bflo(w.y); o[8 * i + 3] += pr * bfhi(w.y);
                                o[8 * i + 4] += pr * bflo(w.z); o[8 * i + 5] += pr * bfhi(w.z); o[8 * i + 6] += pr * bflo(w.w); o[8 * i + 7] += pr * bfhi(w.w); } }
                    }
                }
                if (pass) { const float inv = 1.0f / l; u32x4* op = (u32x4*)(ycat + (size_t)t * D + 64 * h);
#pragma unroll
                    for (int i = 0; i < 8; ++i) { u32x4 w; w.x = pk2(o[8 * i] * inv, o[8 * i + 1] * inv); w.y = pk2(o[8 * i + 2] * inv, o[8 * i + 3] * inv); w.z = pk2(o[8 * i + 4] * inv, o[8 * i + 5] * inv); w.w = pk2(o[8 * i + 6] * inv, o[8 * i + 7] * inv); op[i] = w; } }
            }
        }
#endif
    }
    grid.sync();

    {
        LAS float* gL = (LAS float*)lds; LAS float* segtot = (LAS float*)(lds + 4096); LAS float* red = (LAS float*)(lds + 6144);
        LAS bf16_t* qd = (LAS bf16_t*)(lds + 8192); LAS bf16_t* ki = (LAS bf16_t*)(lds + 25600); LAS bf16_t* aL = (LAS bf16_t*)(lds + 43008);
        const int fr = lane & 15, fq = lane >> 4;
        for (int unit = bx; unit < NCH * 4; unit += G) {
            const int n = unit >> 2, hg = unit & 3; const int dk = tid & 127, seg = tid >> 7, col = hg * 128 + dk;
            {
                float bv[16], blast;
                gla_decay(a, glr, n, hg, tid, gL, segtot, bv, blast);
#pragma unroll
                for (int s = 0; s < 16; ++s) { const int i = 16 * seg + s; const size_t t = (size_t)n * 64 + i;
                    const float qf = bf2f(projR[t * NR + QG + col]) * 0.08838834764831845f * __expf(bv[s]);
                    const float kf = bf2f(projR[t * NR + KG + col]) * __expf(-bv[s]);
                    qd[i * 136 + dk] = (bf16_t)f2bf(qf); ki[i * 136 + dk] = (bf16_t)f2bf(kf); }
            }
            __syncthreads();
#pragma unroll
            for (int rep = 0; rep < 2; ++rep) { const int idx = wave + 8 * rep, it = idx >> 2, jt = idx & 3;
                f32x4 c = {0.f, 0.f, 0.f, 0.f};
                if (jt <= it) {
#pragma unroll
                    for (int ks = 0; ks < 4; ++ks) { const bf16x8 av = *(const LAS bf16x8*)(qd + (16 * it + fr) * 136 + 32 * ks + 8 * fq), bv8 = *(const LAS bf16x8*)(ki + (16 * jt + fr) * 136 + 32 * ks + 8 * fq);
                        c = __builtin_amdgcn_mfma_f32_16x16x32_bf16(av, bv8, c, 0, 0, 0); } }
#pragma unroll
                for (int jj = 0; jj < 4; ++jj) { const int i = 16 * it + 4 * fq + jj, j = 16 * jt + fr; aL[i * 72 + j] = (bf16_t)f2bf(j <= i ? c[jj] : 0.f); } }
            __syncthreads();
            f32x4 acc[4][2];
#pragma unroll
            for (int mt = 0; mt < 4; ++mt) { acc[mt][0] = (f32x4){0.f, 0.f, 0.f, 0.f}; acc[mt][1] = (f32x4){0.f, 0.f, 0.f, 0.f}; }
#pragma unroll
            for (int nt2 = 0; nt2 < 2; ++nt2) { const int dvv = 16 * (2 * wave + nt2) + fr;
                bf16x8 vB[2], sB[4];
#pragma unroll
                for (int ks = 0; ks < 2; ++ks) vB[ks] = *(const bf16x8*)(vT + (size_t)(1024 + hg * 256 + dvv) * T + n * 64 + 32 * ks + 8 * fq);
#pragma unroll
                for (int ks = 0; ks < 4; ++ks) sB[ks] = *(const bf16x8*)(upd + (size_t)unit * 32768 + dvv * 128 + 32 * ks + 8 * fq);
#pragma unroll
                for (int mt = 0; mt < 4; ++mt) {
#pragma unroll
                    for (int ks = 0; ks < 2; ++ks) acc[mt][nt2] = __builtin_amdgcn_mfma_f32_16x16x32_bf16(*(const LAS bf16x8*)(aL + (16 * mt + fr) * 72 + 32 * ks + 8 * fq), vB[ks], acc[mt][nt2], 0, 0, 0);
#pragma unroll
                    for (int ks = 0; ks < 4; ++ks) acc[mt][nt2] = __builtin_amdgcn_mfma_f32_16x16x32_bf16(*(const LAS bf16x8*)(qd + (16 * mt + fr) * 136 + 32 * ks + 8 * fq), sB[ks], acc[mt][nt2], 0, 0, 0); } }
#pragma unroll
            for (int mt = 0; mt < 4; ++mt)
#pragma unroll
                for (int jj = 0; jj < 4; ++jj) { float p = acc[mt][0][jj] * acc[mt][0][jj] + acc[mt][1][jj] * acc[mt][1][jj];
                    p += __shfl_xor(p, 1); p += __shfl_xor(p, 2); p += __shfl_xor(p, 4); p += __shfl_xor(p, 8);
                    if (fr == 0) red[wave * 64 + 16 * mt + 4 * fq + jj] = p; }
            __syncthreads();
#pragma unroll
            for (int mt = 0; mt < 4; ++mt)
#pragma unroll
                for (int jj = 0; jj < 4; ++jj) { const int i = 16 * mt + 4 * fq + jj; float ss = 0.f;
#pragma unroll
                    for (int w8 = 0; w8 < 8; ++w8) ss += red[w8 * 64 + i];
                    const float rstd = 1.0f / sqrtf(ss * (1.0f / 256.0f) + EPS); const size_t t = (size_t)n * 64 + i;
#pragma unroll
                    for (int nt2 = 0; nt2 < 2; ++nt2) { const int dvv = 16 * (2 * wave + nt2) + fr;
                        const float r = bf2f(projR[t * NR + RG + hg * 256 + dvv]);
                        const float y = acc[mt][nt2][jj] * rstd * a.gla_norm_w[dvv] * (r / (1.0f + __expf(-r)));
                        ycat[t * D + 1024 + hg * 256 + dvv] = (bf16_t)f2bf(y); } }
            __syncthreads();
        }
    }
    grid.sync();

    { pg8::Gemm g{ycat, WoutT, T, D, D}; pg8::StaticOrder S; S.init(T, D, G, bx); pg8::EpiResid E{a.x, a.out, x1b, ssq1};
      pg8::gemm_phase<pg8::EpiResid, pg8::StaticOrder, true, true>(lds, g, S, E); }
    grid.sync();

#ifndef NO_UP
    { pg8::Gemm g{x1b, WupT, T, 2 * FF, D}; pg8::StaticOrder S; S.init(T, 2 * FF, G, bx); pg8::EpiUp E{gbuf, ssq1, a.w_ffn_conv, a.b_ffn_conv, tailb, headb};
      pg8::gemm_phase<pg8::EpiUp, pg8::StaticOrder, true, true>(lds, g, S, E); }
#endif
    grid.sync();

    for (int i = gtid; i < NCH * 2 * FF; i += NT) {
        const int C = i % FF, gj = i / FF, j = gj & 1, grp = gj >> 1; const int row = grp * 64 + j;
        float ug[3], uv[3];
        const float* tl = tailb + (size_t)(grp - 1) * 2 * (2 * FF); const float* hd = headb + (size_t)grp * 2 * (2 * FF);
        if (j == 0) { ug[0] = grp ? tl[C] : 0.f; uv[0] = grp ? tl[FF + C] : 0.f; ug[1] = grp ? tl[2 * FF + C] : 0.f; uv[1] = grp ? tl[3 * FF + C] : 0.f; ug[2] = hd[C]; uv[2] = hd[FF + C]; }
        else { ug[0] = grp ? tl[2 * FF + C] : 0.f; uv[0] = grp ? tl[3 * FF + C] : 0.f; ug[1] = hd[C]; uv[1] = hd[FF + C]; ug[2] = hd[2 * FF + C]; uv[2] = hd[3 * FF + C]; }
        const float* cw = a.w_ffn_conv; const float* cb = a.b_ffn_conv;
        const float yg = cb[C] + cw[C] * ug[0] + cw[2 * FF + C] * ug[1] + cw[4 * FF + C] * ug[2];
        const float yv = cb[FF + C] + cw[FF + C] * uv[0] + cw[3 * FF + C] * uv[1] + cw[5 * FF + C] * uv[2];
        gbuf[(size_t)row * FF + C] = (bf16_t)f2bf(pg8::gelu_tanh(yg) * yv);
    }
    grid.sync();

    { pg8::Gemm g{gbuf, WdnT, T, D, FF}; pg8::StaticOrder S; S.init(T, D, G, bx); pg8::EpiResid E{a.out, a.out, x2b, ssq2};
      pg8::gemm_phase<pg8::EpiResid, pg8::StaticOrder, true, true>(lds, g, S, E); }
    { pg8::Gemm g{pb, WppT, T, D, PLE}; pg8::StaticOrder S; S.init(T, D, G, bx); pg8::EpiBf16 E{ppb, D};
      pg8::gemm_phase<pg8::EpiBf16, pg8::StaticOrder, true, true>(lds, g, S, E); }
    grid.sync();

    { pg8::Gemm g{x2b, WpgT, T, D, D}; pg8::StaticOrder S; S.init(T, D, G, bx); pg8::EpiPle E{a.out, ppb, ssq2, ssq3};
      pg8::gemm_phase<pg8::EpiPle, pg8::StaticOrder, true, true>(lds, g, S, E); }
    grid.sync();

    for (int m = gw; m < T; m += NGW) {
        const float rstd = 1.0f / sqrtf(ssq3[m] * (1.0f / D) + EPS);
        f32x4* xr = (f32x4*)(a.out + (size_t)m * D) + lane; const f32x4* wr4 = (const f32x4*)a.final_norm_w + lane;
#pragma unroll
        for (int j = 0; j < 8; ++j) { f32x4 v = xr[64 * j]; const f32x4 w = wr4[64 * j]; v.x *= rstd * w.x; v.y *= rstd * w.y; v.z *= rstd * w.z; v.w *= rstd * w.w; xr[64 * j] = v; }
    }
}

extern "C" void kernel_launch(void* const* d_in, const int* in_sizes, int n_in, void* d_out, int out_size, void* d_ws, size_t ws_size, hipStream_t stream) {
    static int grid = 0;
    if (grid == 0) {
        if (n_in != 18 || out_size != T * D || ws_size < WS_END) { fprintf(stderr, "kernel_launch: unexpected problem (n_in %d out %d ws %zu)\n", n_in, out_size, ws_size); grid = -1; return; }
        int dev = 0, cus = 0, per_cu = 0;
        hipGetDevice(&dev); hipDeviceGetAttribute(&cus, hipDeviceAttributeMultiprocessorCount, dev);
        if (hipFuncSetAttribute((const void*)fwd_megakernel, hipFuncAttributeMaxDynamicSharedMemorySize, LDS_BYTES) != hipSuccess) { fprintf(stderr, "kernel_launch: hipFuncSetAttribute failed\n"); grid = -1; return; }
        if (hipOccupancyMaxActiveBlocksPerMultiprocessor(&per_cu, (const void*)fwd_megakernel, 512, LDS_BYTES) != hipSuccess || per_cu < 1) { fprintf(stderr, "kernel_launch: occupancy query says %d\n", per_cu); per_cu = 1; }
        (void)hipGetLastError();
        grid = cus * per_cu;
    }
    if (grid < 0) return;
    Args a{};
    const float** f = (const float**)&a;
    for (int i = 0; i < 18; ++i) f[i] = (const float*)d_in[i];
    a.out = (float*)d_out; a.ws = (unsigned char*)d_ws;
    void* args[] = {&a};
    hipError_t e = hipLaunchCooperativeKernel((const void*)fwd_megakernel, dim3(grid), dim3(512), args, LDS_BYTES, stream);
    if (e != hipSuccess) fprintf(stderr, "cooperative launch failed: %s (grid %d)\n", hipGetErrorString(e), grid);
}
```

```cpp
#include <hip/hip_runtime.h>
#include <hip/hip_cooperative_groups.h>
#include <cstdio>
#include <cstdint>
namespace cg = cooperative_groups;

#define LAS __attribute__((address_space(3)))
typedef unsigned short bf16_t;
typedef short bf16x8 __attribute__((ext_vector_type(8)));
typedef float f32x4 __attribute__((ext_vector_type(4)));
typedef float f32x2 __attribute__((ext_vector_type(2)));
typedef unsigned u32x4 __attribute__((ext_vector_type(4)));
typedef unsigned u32x2 __attribute__((ext_vector_type(2)));

constexpr int T = 16384, D = 2048, FF = 5632, NR = 4096, PLE = 256, NCH = 256;
constexpr int QA = 0, KA = 1024, QG = 2048, KG = 2560, RG = 3072;
constexpr float EPS = 1e-6f;
constexpr size_t MiB = 1u << 20;
constexpr size_t WS_SSQ1 = 0, WS_SSQ2 = 65536, WS_SSQ3 = 131072, WS_GLR = 1 * MiB, WS_WG = 2 * MiB, WS_WPP = 3 * MiB;
constexpr size_t WS_WIN = 4 * MiB, WS_WOUT = 28 * MiB, WS_WUP = 36 * MiB, WS_WDN = 80 * MiB, WS_WPG = 102 * MiB, WS_PB = 110 * MiB;
constexpr size_t WS_H0 = 118 * MiB;
constexpr size_t WS_PROJ = 182 * MiB;
constexpr size_t WS_VT = 310 * MiB;
constexpr size_t WS_X1B = 182 * MiB, WS_G = 246 * MiB, WS_TAIL = 422 * MiB, WS_HEAD = 444 * MiB, WS_PP = 182 * MiB, WS_YCAT = WS_H0, WS_X2B = WS_H0;
constexpr size_t WS_DEC = 256 * 1024, WS_UPD = 406 * MiB;
constexpr size_t WS_END = 512 * MiB;
constexpr int LDS_BYTES = 147456;

__device__ __forceinline__ unsigned f2bf(float f) { unsigned u = __builtin_bit_cast(unsigned, f); return (u + 0x7fffu + ((u >> 16) & 1u)) >> 16; }
__device__ __forceinline__ unsigned pk2(float lo, float hi) { return f2bf(lo) | (f2bf(hi) << 16); }
__device__ __forceinline__ float bf2f(unsigned short b) { return __builtin_bit_cast(float, (unsigned)b << 16); }
__device__ __forceinline__ float bflo(unsigned w) { return __builtin_bit_cast(float, w << 16); }
__device__ __forceinline__ float bfhi(unsigned w) { return __builtin_bit_cast(float, w & 0xffff0000u); }
__device__ __forceinline__ float wave_sum(float v) {
#pragma unroll
    for (int o = 1; o < 64; o <<= 1) v += __shfl_xor(v, o);
    return v;
}

namespace pg8 {
#define PG8_LAS __attribute__((address_space(3)))
constexpr int BM = 256, BK = 64, HALF = 128, HTB = HALF * BK * 2, STAGE_BYTES = 8 * HTB, NXCD = 8, WGM = 8;
__host__ __device__ __forceinline__ int lds_byte(int r, int c) { const int st = (r >> 4) * 2 + (c >> 5), rr = r & 15, cc = c & 31, ob = rr * 64 + cc * 2; return st * 1024 + (ob ^ (((ob >> 9) & 1) << 5)); }
__host__ __device__ __forceinline__ void stage_rc(int b, int& R, int& C) { const int st = b / 1024, sb = b % 1024, swz = sb ^ (((sb >> 9) & 1) << 5); R = (st >> 1) * 16 + swz / 64; C = (st & 1) * 32 + (swz % 64) / 2; }
__host__ __device__ __forceinline__ int perm32(int rho) { const int n = rho >> 4, i = rho & 15; return 8 * (i >> 2) + 4 * n + (i & 3); }

struct Unit { int pm, pn; };
struct Gemm { const bf16_t* A; const bf16_t* Bt; int M, N, K; };

struct StaticOrder {
    int nM, nN, nwg, G, c;
    __host__ __device__ void init(int M, int N, int G_, int c_) { nM = M / BM; nN = N / BM; nwg = nM * nN; G = G_; c = c_; }
    __host__ __device__ bool next(int i, Unit& u) const {
        const long L = (long)i * G + c; if (L >= nwg) return false;
        int wgid = (int)L; { const int q = nwg / NXCD, r = nwg % NXCD, xcd = wgid % NXCD, off = wgid / NXCD; wgid = (xcd < r ? xcd * (q + 1) : r * (q + 1) + (xcd - r) * q) + off; }
        const int nig = WGM * nN, gid = wgid / nig, fm = gid * WGM, gsz = (nM - fm) < WGM ? (nM - fm) : WGM;
        u.pm = fm + ((wgid % nig) % gsz); u.pn = (wgid % nig) / gsz; return true;
    }
    __device__ __forceinline__ void a_ready(const Unit&) const {}
    __device__ __forceinline__ void done(const Unit&) const {}
};

__device__ __forceinline__ unsigned cvt_pk_bf16(float lo, float hi) { unsigned r; asm volatile("v_cvt_pk_bf16_f32 %0, %1, %2" : "=v"(r) : "v"(lo), "v"(hi)); return r; }

struct EpiBf16 {
    static constexpr bool PERM = true, AFTER_DRAIN = false;
    bf16_t* O; int ldc;
    __device__ __forceinline__ void operator()(const f32x4 (&acc)[2][2][4][2], const Unit& u, int wr, int wc, int fr, int fq) const {
        const int row0 = u.pm * BM + wr * 64 + fr; const int col0 = u.pn * BM + wc * 32 + 8 * fq;
#pragma unroll
        for (int ai = 0; ai < 2; ++ai)
#pragma unroll
            for (int m = 0; m < 4; ++m) { bf16_t* rowp = O + (size_t)(row0 + ai * HALF + m * 16) * ldc + col0;
#pragma unroll
                for (int bj = 0; bj < 2; ++bj) { const f32x4 v0 = acc[ai][bj][m][0], v1 = acc[ai][bj][m][1];
                    u32x4 w; w.x = cvt_pk_bf16(v0[0], v0[1]); w.y = cvt_pk_bf16(v0[2], v0[3]); w.z = cvt_pk_bf16(v1[0], v1[1]); w.w = cvt_pk_bf16(v1[2], v1[3]);
                    *(u32x4*)(rowp + bj * HALF) = w; } }
    }
};
struct EpiResid {
    static constexpr bool PERM = true, AFTER_DRAIN = false;
    const float* base; float* out; bf16_t* ob; float* ssq;
    __device__ __forceinline__ void operator()(const f32x4 (&acc)[2][2][4][2], const Unit& u, int wr, int wc, int fr, int fq) const {
        const int row0 = u.pm * BM + wr * 64 + fr; const int col0 = u.pn * BM + wc * 32 + 8 * fq;
#pragma unroll
        for (int ai = 0; ai < 2; ++ai)
#pragma unroll
            for (int m = 0; m < 4; ++m) { const int row = row0 + ai * HALF + m * 16; const size_t off = (size_t)row * D + col0; float ss = 0.f;
#pragma unroll
                for (int bj = 0; bj < 2; ++bj) {
                    const f32x4 b0 = *(const f32x4*)(base + off + bj * HALF), b1 = *(const f32x4*)(base + off + bj * HALF + 4);
                    const f32x4 v0 = acc[ai][bj][m][0] + b0, v1 = acc[ai][bj][m][1] + b1;
                    *(f32x4*)(out + off + bj * HALF) = v0; *(f32x4*)(out + off + bj * HALF + 4) = v1;
                    u32x4 w; w.x = cvt_pk_bf16(v0[0], v0[1]); w.y = cvt_pk_bf16(v0[2], v0[3]); w.z = cvt_pk_bf16(v1[0], v1[1]); w.w = cvt_pk_bf16(v1[2], v1[3]);
                    *(u32x4*)(ob + off + bj * HALF) = w;
                    ss += (v0[0] * v0[0] + v0[1] * v0[1]) + (v0[2] * v0[2] + v0[3] * v0[3]) + (v1[0] * v1[0] + v1[1] * v1[1]) + (v1[2] * v1[2] + v1[3] * v1[3]); }
                ss += __shfl_xor(ss, 16); ss += __shfl_xor(ss, 32);
                if (fq == 0) atomicAdd(ssq + row, ss); }
    }
};
struct EpiPle {
    static constexpr bool PERM = true, AFTER_DRAIN = false;
    float* out; const bf16_t* pp; const float* ssq2; float* ssq3;
    __device__ __forceinline__ void operator()(const f32x4 (&acc)[2][2][4][2], const Unit& u, int wr, int wc, int fr, int fq) const {
        const int row0 = u.pm * BM + wr * 64 + fr; const int col0 = u.pn * BM + wc * 32 + 8 * fq;
#pragma unroll
        for (int ai = 0; ai < 2; ++ai)
#pragma unroll
            for (int m = 0; m < 4; ++m) { const int row = row0 + ai * HALF + m * 16; const size_t off = (size_t)row * D + col0; float ss = 0.f;
                const float rstd = 1.0f / sqrtf(ssq2[row] * (1.0f / D) + EPS);
#pragma unroll
                for (int bj = 0; bj < 2; ++bj) {
                    const f32x4 b0 = *(const f32x4*)(out + off + bj * HALF), b1 = *(const f32x4*)(out + off + bj * HALF + 4);
                    const u32x4 pw = *(const u32x4*)(pp + off + bj * HALF);
                    f32x4 p0 = {bflo(pw.x), bfhi(pw.x), bflo(pw.y), bfhi(pw.y)}, p1 = {bflo(pw.z), bfhi(pw.z), bflo(pw.w), bfhi(pw.w)};
                    f32x4 v0, v1;
#pragma unroll
                    for (int e = 0; e < 4; ++e) { const float g0 = 1.0f / (1.0f + __expf(-acc[ai][bj][m][0][e] * rstd)), g1 = 1.0f / (1.0f + __expf(-acc[ai][bj][m][1][e] * rstd));
                        v0[e] = b0[e] + g0 * p0[e]; v1[e] = b1[e] + g1 * p1[e]; }
                    *(f32x4*)(out + off + bj * HALF) = v0; *(f32x4*)(out + off + bj * HALF + 4) = v1;
                    ss += (v0[0] * v0[0] + v0[1] * v0[1]) + (v0[2] * v0[2] + v0[3] * v0[3]) + (v1[0] * v1[0] + v1[1] * v1[1]) + (v1[2] * v1[2] + v1[3] * v1[3]); }
                ss += __shfl_xor(ss, 16); ss += __shfl_xor(ss, 32);
                if (fq == 0) atomicAdd(ssq3 + row, ss); }
    }
};
__device__ __forceinline__ float gelu_tanh(float x) {
    const float z = 1.5957691216057308f * (x + 0.044715f * x * x * x);
    return x / (1.0f + __expf(-z));
}
template <int CTRL> __device__ __forceinline__ float dppz(float v) { return __builtin_bit_cast(float, __builtin_amdgcn_update_dpp(0, __builtin_bit_cast(int, v), CTRL, 0xf, 0xf, true)); }
struct EpiUp {
    static constexpr bool PERM = true, AFTER_DRAIN = false;
    bf16_t* G; const float* ssq1; const float* cw; const float* cb; float* tail; float* head;
    __device__ __forceinline__ void operator()(const f32x4 (&acc)[2][2][4][2], const Unit& u, int wr, int wc, int fr, int fq) const {
        const int C0 = u.pn * 128 + wc * 32 + 8 * fq;
#pragma unroll
        for (int ai = 0; ai < 2; ++ai) {
            const int rbase = u.pm * BM + ai * HALF + wr * 64; const int grp = rbase >> 6;
            float rstd[4];
#pragma unroll
            for (int m = 0; m < 4; ++m) rstd[m] = 1.0f / sqrtf(ssq1[rbase + m * 16 + fr] * (1.0f / D) + EPS);
            if (fr < 2) { float* hp = head + ((size_t)grp * 2 + fr) * (2 * FF) + C0;
#pragma unroll
                for (int bj = 0; bj < 2; ++bj) { *(f32x4*)(hp + bj * FF) = acc[ai][bj][0][0] * rstd[0]; *(f32x4*)(hp + bj * FF + 4) = acc[ai][bj][0][1] * rstd[0]; } }
            if (fr >= 14) { float* tp = tail + ((size_t)grp * 2 + (fr - 14)) * (2 * FF) + C0;
#pragma unroll
                for (int bj = 0; bj < 2; ++bj) { *(f32x4*)(tp + bj * FF) = acc[ai][bj][3][0] * rstd[3]; *(f32x4*)(tp + bj * FF + 4) = acc[ai][bj][3][1] * rstd[3]; } }
            __builtin_amdgcn_sched_barrier(0);
#pragma unroll
            for (int n = 0; n < 2; ++n) {
                unsigned outw[4][2];
#pragma unroll
                for (int e = 0; e < 4; ++e) {
                    int C = C0 + 4 * n + e; asm volatile("" : "+v"(C));
                    const float wg0 = cw[C], wg1 = cw[2 * FF + C], wg2 = cw[4 * FF + C], bg = cb[C];
                    const float wv0 = cw[FF + C], wv1 = cw[3 * FF + C], wv2 = cw[5 * FF + C], bv = cb[FF + C];
                    float pg1 = 0.f, pg2 = 0.f, pv1 = 0.f, pv2 = 0.f;
#pragma unroll
                    for (int m = 0; m < 4; ++m) {
                        float ug = acc[ai][0][m][n][e] * rstd[m], uv = acc[ai][1][m][n][e] * rstd[m];
                        asm volatile("" : "+v"(ug), "+v"(uv));
                        const float ugm1 = dppz<0x111>(ug) + pg1, ugm2 = dppz<0x112>(ug) + pg2, uvm1 = dppz<0x111>(uv) + pv1, uvm2 = dppz<0x112>(uv) + pv2;
                        const float yg = bg + wg0 * ugm2 + wg1 * ugm1 + wg2 * ug;
                        const float yv = bv + wv0 * uvm2 + wv1 * uvm1 + wv2 * uv;
                        unsigned rb = f2bf(gelu_tanh(yg) * yv); asm volatile("" : "+v"(rb));
                        if (e & 1) outw[m][e >> 1] |= rb << 16; else outw[m][e >> 1] = rb;
                        pg1 = dppz<0x10F>(ug); pg2 = dppz<0x10E>(ug); pv1 = dppz<0x10F>(uv); pv2 = dppz<0x10E>(uv);
                    }
                    __builtin_amdgcn_sched_barrier(0);
                }
#pragma unroll
                for (int m = 0; m < 4; ++m) if (m > 0 || fr >= 2) { u32x2 w = {outw[m][0], outw[m][1]}; *(u32x2*)(G + (size_t)(rbase + m * 16 + fr) * FF + C0 + 4 * n) = w; }
                __builtin_amdgcn_sched_barrier(0);
            }
        }
    }
};

template <class Epi, class Sched, bool ALIGN_EPI = false, bool SP2 = false>
__device__ __forceinline__ void gemm_phase(PG8_LAS unsigned char* lds, const Gemm g, const Sched& S, const Epi& E) {
    int tid_ = threadIdx.x; asm volatile("" : "+v"(tid_));
    const int tid = tid_, wid = __builtin_amdgcn_readfirstlane(tid >> 6), lane = tid & 63, wr = wid >> 2, wc = wid & 3, fr = lane & 15, fq = lane >> 4;
    const int K = g.K, nt = K / BK;
    unsigned voffA[2], voffB[2];
#pragma unroll
    for (int i = 0; i < 2; ++i) { int R, C; stage_rc(tid * 16 + i * 8192, R, C); const int Rb = Epi::PERM ? ((R & ~31) + perm32(R & 31)) : R;
        voffA[i] = (unsigned)(R * K + C) * 2u; voffB[i] = (unsigned)(Rb * K + C) * 2u; }
    const size_t kstep = (size_t)(BK * 2);
    const size_t hstep = (size_t)HALF * K * 2;
    const size_t tstep = 2 * hstep;
    const unsigned ldsw = (unsigned)wid * 1024u;
    const int aoff = lds_byte(wr * 64 + fr, fq * 8), boff = lds_byte(wc * 32 + fr, fq * 8);
#define PG8_SA(b, h) (((b) * 2 + (h)) * HTB)
#define PG8_SB(b, h) ((4 + (b) * 2 + (h)) * HTB)
#define PG8_STAGE(bufoff, gbase, voff) do { _Pragma("unroll") for (int _i = 0; _i < 2; ++_i) \
        __builtin_amdgcn_global_load_lds((const unsigned*)((const char*)(gbase) + (voff)[_i]), (PG8_LAS unsigned*)(lds + (bufoff) + ldsw + _i * 8192), 16, 0, 0); } while (0)
#define PG8_LDA(dst, b, h) do { _Pragma("unroll") for (int m = 0; m < 4; ++m) _Pragma("unroll") for (int k = 0; k < 2; ++k) dst[m][k] = *(const PG8_LAS bf16x8*)(lds + PG8_SA(b, h) + aoff + m * 2048 + k * 1024); } while (0)
#define PG8_LDB(dst, b, h) do { _Pragma("unroll") for (int n = 0; n < 2; ++n) _Pragma("unroll") for (int k = 0; k < 2; ++k) dst[n][k] = *(const PG8_LAS bf16x8*)(lds + PG8_SB(b, h) + boff + n * 2048 + k * 1024); } while (0)
#define PG8_MMA(ai, bj, At, Bt) do { __builtin_amdgcn_s_setprio(1); _Pragma("unroll") for (int m = 0; m < 4; ++m) _Pragma("unroll") for (int n = 0; n < 2; ++n) _Pragma("unroll") for (int k = 0; k < 2; ++k) \
        acc[ai][bj][m][n] = __builtin_amdgcn_mfma_f32_16x16x32_bf16(Bt[n][k], At[m][k], acc[ai][bj][m][n], 0, 0, 0); __builtin_amdgcn_s_setprio(0); } while (0)
#define PG8_WAIT_V(n) asm volatile("s_waitcnt vmcnt(" #n ")" ::: "memory")
#define PG8_WAIT_L(n) asm volatile("s_waitcnt lgkmcnt(" #n ")" ::: "memory")
#define PG8_BAR __builtin_amdgcn_s_barrier()
#define PG8_SCHED __builtin_amdgcn_sched_barrier(0)
    Unit cur, nxt; int ui = 0;
    if (!S.next(0, cur)) return;
    f32x4 acc[2][2][4][2];
#pragma unroll
    for (int a = 0; a < 2; ++a)
#pragma unroll
        for (int b = 0; b < 2; ++b)
#pragma unroll
            for (int m = 0; m < 4; ++m)
#pragma unroll
                for (int n = 0; n < 2; ++n) acc[a][b][m][n] = (f32x4){0.f, 0.f, 0.f, 0.f};
    bf16x8 At[4][2], B0[2][2], B1[2][2];
    const char* cA = (const char*)g.A + (size_t)cur.pm * tstep; const char* cB = (const char*)g.Bt + (size_t)cur.pn * tstep;
    S.a_ready(cur);
    if constexpr (SP2) {
        PG8_STAGE(PG8_SB(0, 0), cB, voffB); PG8_STAGE(PG8_SB(0, 1), cB + hstep, voffB); PG8_STAGE(PG8_SA(0, 0), cA, voffA); PG8_STAGE(PG8_SA(0, 1), cA + hstep, voffA);
        if (wr == 1) PG8_BAR;
        PG8_WAIT_V(2); PG8_BAR;
        PG8_STAGE(PG8_SB(1, 0), cB + kstep, voffB); PG8_STAGE(PG8_SA(1, 0), cA + kstep, voffA); PG8_STAGE(PG8_SB(1, 1), cB + hstep + kstep, voffB);
        PG8_WAIT_V(6); PG8_BAR;
    } else {
        PG8_STAGE(PG8_SB(0, 0), cB, voffB); PG8_STAGE(PG8_SA(0, 0), cA, voffA); PG8_STAGE(PG8_SB(0, 1), cB + hstep, voffB); PG8_STAGE(PG8_SA(0, 1), cA + hstep, voffA);
        if (wr == 1) PG8_BAR;
        PG8_WAIT_V(4); PG8_BAR;
        PG8_STAGE(PG8_SB(1, 0), cB + kstep, voffB); PG8_STAGE(PG8_SA(1, 0), cA + kstep, voffA); PG8_STAGE(PG8_SB(1, 1), cB + hstep + kstep, voffB);
        PG8_WAIT_V(6); PG8_BAR;
    }
    for (;;) {
        const bool has_next = S.next(ui + 1, nxt);
        const char* nA = has_next ? (const char*)g.A + (size_t)nxt.pm * tstep : cA; const char* nB = has_next ? (const char*)g.Bt + (size_t)nxt.pn * tstep : cB;
        for (int t = 0; t < nt; t += 2) {
            const bool last = (t == nt - 2);
            const char* a1 = cA + (size_t)(t + 1) * kstep;
            const char* a2 = last ? nA : cA + (size_t)(t + 2) * kstep; const char* b2 = last ? nB : cB + (size_t)(t + 2) * kstep;
            const char* a3 = a2 + kstep; const char* b3 = b2 + kstep;
            if (last && has_next) S.a_ready(nxt);
            if constexpr (SP2) {
            PG8_LDB(B0, 0, 0); PG8_LDB(B1, 0, 1); PG8_SCHED; PG8_LDA(At, 0, 0); PG8_STAGE(PG8_SA(1, 1), a1 + hstep, voffA);
            PG8_WAIT_V(8); PG8_WAIT_L(0); PG8_BAR; PG8_MMA(0, 0, At, B0); PG8_MMA(0, 1, At, B1); PG8_BAR; PG8_SCHED;
            PG8_LDA(At, 0, 1); PG8_STAGE(PG8_SB(0, 0), b2, voffB); PG8_STAGE(PG8_SB(0, 1), b2 + hstep, voffB); PG8_STAGE(PG8_SA(0, 0), a2, voffA);
            PG8_WAIT_V(8); PG8_WAIT_L(0); PG8_BAR; PG8_MMA(1, 0, At, B0); PG8_MMA(1, 1, At, B1); PG8_BAR; PG8_SCHED;
            PG8_LDB(B0, 1, 0); PG8_LDB(B1, 1, 1); PG8_SCHED; PG8_LDA(At, 1, 0); PG8_STAGE(PG8_SA(0, 1), a2 + hstep, voffA);
            PG8_WAIT_V(8); PG8_WAIT_L(0); PG8_BAR; PG8_MMA(0, 0, At, B0); PG8_MMA(0, 1, At, B1); PG8_BAR; PG8_SCHED;
            PG8_LDA(At, 1, 1); PG8_STAGE(PG8_SB(1, 0), b3, voffB); PG8_STAGE(PG8_SB(1, 1), b3 + hstep, voffB); PG8_STAGE(PG8_SA(1, 0), a3, voffA);
            PG8_WAIT_V(8); PG8_WAIT_L(0); PG8_BAR; PG8_MMA(1, 0, At, B0); PG8_MMA(1, 1, At, B1); PG8_BAR; PG8_SCHED;
            } else {
            PG8_LDB(B0, 0, 0); PG8_SCHED; PG8_LDA(At, 0, 0); PG8_STAGE(PG8_SA(1, 1), a1 + hstep, voffA);
            PG8_WAIT_L(8); PG8_BAR; PG8_WAIT_L(0); PG8_MMA(0, 0, At, B0); PG8_BAR; PG8_SCHED;
            PG8_LDB(B1, 0, 1); PG8_STAGE(PG8_SB(0, 0), b2, voffB);
            PG8_BAR; PG8_WAIT_L(0); PG8_MMA(0, 1, At, B1); PG8_BAR;
            PG8_LDA(At, 0, 1); PG8_STAGE(PG8_SA(0, 0), a2, voffA);
            PG8_BAR; PG8_WAIT_L(0); PG8_MMA(1, 0, At, B0); PG8_BAR; PG8_SCHED;
            PG8_STAGE(PG8_SB(0, 1), b2 + hstep, voffB);
            PG8_WAIT_V(6); PG8_BAR; PG8_MMA(1, 1, At, B1); PG8_BAR;
            PG8_LDB(B0, 1, 0); PG8_SCHED; PG8_LDA(At, 1, 0); PG8_STAGE(PG8_SA(0, 1), a2 + hstep, voffA);
            PG8_WAIT_L(8); PG8_BAR; PG8_WAIT_L(0); PG8_MMA(0, 0, At, B0); PG8_BAR; PG8_SCHED;
            PG8_LDB(B1, 1, 1); PG8_STAGE(PG8_SB(1, 0), b3, voffB);
            PG8_BAR; PG8_WAIT_L(0); PG8_MMA(0, 1, At, B1); PG8_BAR;
            PG8_LDA(At, 1, 1); PG8_STAGE(PG8_SA(1, 0), a3, voffA);
            PG8_BAR; PG8_WAIT_L(0); PG8_MMA(1, 0, At, B0); PG8_BAR; PG8_SCHED;
            PG8_STAGE(PG8_SB(1, 1), b3 + hstep, voffB);
            PG8_WAIT_V(6); PG8_BAR; PG8_MMA(1, 1, At, B1); PG8_BAR;
            }
        }
        if constexpr (ALIGN_EPI) { if (wr == 0) PG8_BAR; }
        if constexpr (!Epi::AFTER_DRAIN) { E(acc, cur, wr, wc, fr, fq); S.done(cur); }
        if (!has_next) break;
#pragma unroll
        for (int a = 0; a < 2; ++a)
#pragma unroll
            for (int b = 0; b < 2; ++b)
#pragma unroll
                for (int m = 0; m < 4; ++m)
#pragma unroll
                    for (int n = 0; n < 2; ++n) acc[a][b][m][n] = (f32x4){0.f, 0.f, 0.f, 0.f};
        cur = nxt; cA = nA; cB = nB; ++ui;
        if constexpr (ALIGN_EPI) { if (wr == 1) PG8_BAR; }
    }
    PG8_WAIT_V(0);
    if constexpr (!ALIGN_EPI) { if (wr == 0) PG8_BAR; }
    PG8_BAR;
#undef PG8_SA
#undef PG8_SB
#undef PG8_STAGE
#undef PG8_LDA
#undef PG8_LDB
#undef PG8_MMA
#undef PG8_WAIT_V
#undef PG8_WAIT_L
#undef PG8_BAR
#undef PG8_SCHED
}
}

struct Args {
    const float *x, *p, *norm_mix_w, *w_in, *att_rel_bias, *w_gla_gate_up, *b_gla_gate, *gla_norm_w, *w_out, *norm_ffn_w, *w_ffn_up, *w_ffn_conv, *b_ffn_conv, *w_ffn_down,
                *norm_ple_w, *w_ple_gate, *w_ple_proj, *final_norm_w;
    float* out; unsigned char* ws;
};

__device__ __forceinline__ int map_row(int mode, int n) {
    if (mode == 1) { if (n < 2048) return n; if (n < 3072) return n + 2048; if (n < 4096) return n - 1024; if (n < 5120) return n + 1024; return n - 2048; }
    if (mode == 2) { const int half = n >= FF ? 1 : 0; const int c = n - half * FF; return (c >> 7) * 256 + half * 128 + (c & 127); }
    return n;
}
__device__ __forceinline__ void transpose_item(const float* W, int K, int ldn, int nblk, bf16_t* WT, LAS float* scr, int item, int lane, const float* kscale, int mode) {
    const int kb = item / nblk, nb = item % nblk, k0 = 64 * kb, n0 = 32 * nb;
#pragma unroll 8
    for (int i = 0; i < 32; ++i) { const int kk = 2 * i + (lane >> 5); float v = W[(size_t)(k0 + kk) * ldn + n0 + (lane & 31)]; if (kscale) v *= kscale[k0 + kk]; scr[kk * 33 + (lane & 31)] = v; }
    asm volatile("s_waitcnt lgkmcnt(0)" ::: "memory");
    const int c = lane & 7; const int drow0 = map_row(mode, n0);
#pragma unroll
    for (int j = 0; j < 4; ++j) { const int n = (lane >> 3) + 8 * j; const LAS float* s = scr + (8 * c) * 33 + n;
        u32x4 o; o.x = pk2(s[0 * 33], s[1 * 33]); o.y = pk2(s[2 * 33], s[3 * 33]); o.z = pk2(s[4 * 33], s[5 * 33]); o.w = pk2(s[6 * 33], s[7 * 33]);
        *(u32x4*)(WT + (size_t)(drow0 + n) * K + k0 + 8 * c) = o; }
    asm volatile("s_waitcnt lgkmcnt(0)" ::: "memory");
}

__device__ __forceinline__ void gla_decay(const Args& a, const float* glr, int n, int hg, int tid, LAS float* gL, LAS float* segtot, float (&bv)[16], float& blast) {
    const int dk = tid & 127, seg = tid >> 7, col = hg * 128 + dk;
    if (tid < 256) ((LAS f32x4*)gL)[tid] = ((const f32x4*)(glr + (size_t)n * 64 * 16))[tid];
    float w[16];
#pragma unroll
    for (int j = 0; j < 16; ++j) w[j] = a.w_gla_gate_up[j * 512 + col];
    const float bias = a.b_gla_gate[col];
    __syncthreads();
    float c = 0.f;
#pragma unroll
    for (int s = 0; s < 16; ++s) { const LAS f32x4* g4 = (const LAS f32x4*)(gL + (16 * seg + s) * 16); float logit = bias;
#pragma unroll
        for (int q = 0; q < 4; ++q) { const f32x4 g = g4[q]; logit += g[0] * w[4 * q] + g[1] * w[4 * q + 1] + g[2] * w[4 * q + 2] + g[3] * w[4 * q + 3]; }
        const float ls = fminf(logit, 0.f) - log1pf(__expf(-fabsf(logit)));
        c += ls * (1.0f / 16.0f); bv[s] = c; if ((s & 3) == 3) asm volatile("" ::: "memory"); }
    segtot[seg * 128 + dk] = c;
    __syncthreads();
    float off = 0.f, tot = 0.f;
#pragma unroll
    for (int q = 0; q < 4; ++q) { const float v = segtot[q * 128 + dk]; tot += v; if (q < seg) off += v; }
#pragma unroll
    for (int s = 0; s < 16; ++s) bv[s] += off;
    blast = tot;
}

#define IDS() int tid = threadIdx.x; asm volatile("" : "+v"(tid)); const int lane = tid & 63, wave = __builtin_amdgcn_readfirstlane(tid >> 6); const int gw = bx * 8 + wave, gtid = bx * 512 + tid; (void)lane; (void)gw; (void)gtid;
__global__ void __launch_bounds__(512, 2) fwd_megakernel(Args a) {
    extern __shared__ __attribute__((aligned(16))) unsigned char lds_raw[];
    cg::grid_group grid = cg::this_grid();
    LAS unsigned char* lds = (LAS unsigned char*)lds_raw;
    const int tid = threadIdx.x, lane = tid & 63, wave = __builtin_amdgcn_readfirstlane(tid >> 6);
    const int G = gridDim.x, bx = blockIdx.x;
    const int gw = bx * 8 + wave, NGW = G * 8;
    const int gtid = bx * 512 + tid, NT = G * 512;
    unsigned char* ws = a.ws;
    float* ssq1 = (float*)(ws + WS_SSQ1); float* ssq2 = (float*)(ws + WS_SSQ2); float* ssq3 = (float*)(ws + WS_SSQ3);
    float* glr = (float*)(ws + WS_GLR); float* decb = (float*)(ws + WS_DEC); bf16_t* upd = (bf16_t*)(ws + WS_UPD);
    bf16_t* WgT = (bf16_t*)(ws + WS_WG); bf16_t* WppT = (bf16_t*)(ws + WS_WPP); bf16_t* WinT = (bf16_t*)(ws + WS_WIN); bf16_t* WoutT = (bf16_t*)(ws + WS_WOUT);
    bf16_t* WupT = (bf16_t*)(ws + WS_WUP); bf16_t* WdnT = (bf16_t*)(ws + WS_WDN); bf16_t* WpgT = (bf16_t*)(ws + WS_WPG); bf16_t* pb = (bf16_t*)(ws + WS_PB);
    bf16_t* h0 = (bf16_t*)(ws + WS_H0); bf16_t* projR = (bf16_t*)(ws + WS_PROJ); bf16_t* vT = (bf16_t*)(ws + WS_VT);
    bf16_t* ycat = (bf16_t*)(ws + WS_YCAT); bf16_t* x1b = (bf16_t*)(ws + WS_X1B); bf16_t* gbuf = (bf16_t*)(ws + WS_G);
    float* tailb = (float*)(ws + WS_TAIL); float* headb = (float*)(ws + WS_HEAD); bf16_t* ppb = (bf16_t*)(ws + WS_PP); bf16_t* x2b = (bf16_t*)(ws + WS_X2B);

    {
        LAS float* scr = (LAS float*)(lds + wave * 16384);
        constexpr int I_IN = 32 * 192, I_OUT = 32 * 64, I_UP = 32 * 352, I_DN = 88 * 64, I_PG = 32 * 64, I_PP = 4 * 64;
        constexpr int NITEMS = I_IN + I_OUT + I_UP + I_DN + I_PG + I_PP;
        for (int it = gw; it < NITEMS; it += NGW) {
            int r = it;
            if (r < I_IN) { transpose_item(a.w_in, 2048, 6160, 192, WinT, scr, r, lane, nullptr, 1); continue; } r -= I_IN;
            if (r < I_OUT) { transpose_item(a.w_out, 2048, 2048, 64, WoutT, scr, r, lane, nullptr, 0); continue; } r -= I_OUT;
            if (r < I_UP) { transpose_item(a.w_ffn_up, 2048, 2 * FF, 352, WupT, scr, r, lane, a.norm_ffn_w, 2); continue; } r -= I_UP;
            if (r < I_DN) { transpose_item(a.w_ffn_down, FF, 2048, 64, WdnT, scr, r, lane, nullptr, 0); continue; } r -= I_DN;
            if (r < I_PG) { transpose_item(a.w_ple_gate, 2048, 2048, 64, WpgT, scr, r, lane, a.norm_ple_w, 0); continue; } r -= I_PG;
            transpose_item(a.w_ple_proj, PLE, 2048, 64, WppT, scr, r, lane, nullptr, 0);
        }
        for (int i = gtid; i < 16 * 2048; i += NT) { const int j = i >> 11, k = i & 2047; WgT[i] = (bf16_t)f2bf(a.w_in[(size_t)k * 6160 + 6144 + j]); }
        for (int m = gw; m < T; m += NGW) {
            const f32x4* xr = (const f32x4*)(a.x + (size_t)m * D) + lane; const f32x4* wr4 = (const f32x4*)a.norm_mix_w + lane;
            f32x4 v[8]; float s = 0.f;
#pragma unroll
            for (int j = 0; j < 8; ++j) { v[j] = xr[64 * j]; s += (v[j].x * v[j].x + v[j].y * v[j].y) + (v[j].z * v[j].z + v[j].w * v[j].w); }
            const float rstd = 1.0f / sqrtf(wave_sum(s) * (1.0f / D) + EPS);
            u32x2* o8 = (u32x2*)(h0 + (size_t)m * D) + lane;
#pragma unroll
            for (int j = 0; j < 8; ++j) { const f32x4 w = wr4[64 * j]; u32x2 o; o.x = pk2(v[j].x * rstd * w.x, v[j].y * rstd * w.y); o.y = pk2(v[j].z * rstd * w.z, v[j].w * rstd * w.w); o8[64 * j] = o; }
        }
        for (int i = gtid; i < T * PLE / 4; i += NT) { const f32x4 v = ((const f32x4*)a.p)[i]; u32x2 o; o.x = pk2(v.x, v.y); o.y = pk2(v.z, v.w); ((u32x2*)pb)[i] = o; }
        for (int i = gtid; i < 3 * T; i += NT) ssq1[i] = 0.f;
    }
    grid.sync();

    {
        IDS();
        for (int task = gw; task < T / 16; task += NGW) {
            const int fr = lane & 15, fq = lane >> 4; const int r0 = task * 16;
            const bf16_t* ap = h0 + (size_t)(r0 + fr) * D + 8 * fq; const bf16_t* bp = WgT + (size_t)fr * D + 8 * fq;
            f32x4 acc = {0.f, 0.f, 0.f, 0.f};
#pragma unroll 4
            for (int k0 = 0; k0 < D; k0 += 32) { const bf16x8 av = *(const bf16x8*)(ap + k0), bv = *(const bf16x8*)(bp + k0); acc = __builtin_amdgcn_mfma_f32_16x16x32_bf16(av, bv, acc, 0, 0, 0); }
#pragma unroll
            for (int j = 0; j < 4; ++j) glr[(size_t)(r0 + 4 * fq + j) * 16 + fr] = acc[j];
        }
        __syncthreads();
        { pg8::Gemm g{h0, WinT, T, NR, D}; pg8::StaticOrder S; S.init(T, NR, G, bx); pg8::EpiBf16 E{projR, NR};
          pg8::gemm_phase<pg8::EpiBf16, pg8::StaticOrder, true, true>(lds, g, S, E); }
        { pg8::Gemm g{WinT + (size_t)NR * D, h0, 2048, T, D}; pg8::StaticOrder S; S.init(2048, T, G, bx); pg8::EpiBf16 E{vT, T};
          pg8::gemm_phase<pg8::EpiBf16, pg8::StaticOrder, true, true>(lds, g, S, E); }
    }
    grid.sync();

    {
        IDS();
        LAS float* gL = (LAS float*)lds; LAS float* segtot = (LAS float*)(lds + 4096); LAS bf16_t* kT = (LAS bf16_t*)(lds + 8192);
        const int fr = lane & 15, fq = lane >> 4;
        for (int unit = bx; unit < NCH * 4; unit += G) {
            const int n = unit >> 2, hg = unit & 3; const int dk = tid & 127, seg = tid >> 7, col = hg * 128 + dk;
            float bv[16], blast;
            gla_decay(a, glr, n, hg, tid, gL, segtot, bv, blast);
            unsigned kw[8];
#pragma unroll
            for (int s = 0; s < 16; s += 2) { const size_t t = (size_t)n * 64 + 16 * seg + s;
                const float k0 = bf2f(projR[t * NR + KG + col]) * __expf(blast - bv[s]), k1 = bf2f(projR[(t + 1) * NR + KG + col]) * __expf(blast - bv[s + 1]);
                kw[s >> 1] = pk2(k0, k1); }
            *(LAS u32x4*)(kT + dk * 72 + 16 * seg) = (u32x4){kw[0], kw[1], kw[2], kw[3]}; *(LAS u32x4*)(kT + dk * 72 + 16 * seg + 8) = (u32x4){kw[4], kw[5], kw[6], kw[7]};
            if (seg == 0) decb[(size_t)unit * 128 + dk] = __expf(blast);
            __syncthreads();
            f32x4 acc[8][2];
#pragma unroll
            for (int mt = 0; mt < 8; ++mt) { acc[mt][0] = (f32x4){0.f, 0.f, 0.f, 0.f}; acc[mt][1] = (f32x4){0.f, 0.f, 0.f, 0.f}; }
            bf16x8 vB[2][2];
#pragma unroll
            for (int nt2 = 0; nt2 < 2; ++nt2)
#pragma unroll
                for (int ks = 0; ks < 2; ++ks) vB[nt2][ks] = *(const bf16x8*)(vT + (size_t)(1024 + hg * 256 + 16 * (2 * wave + nt2) + fr) * T + n * 64 + 32 * ks + 8 * fq);
#pragma unroll
            for (int mt = 0; mt < 8; ++mt)
#pragma unroll
                for (int ks = 0; ks < 2; ++ks) { const bf16x8 ak = *(const LAS bf16x8*)(kT + (16 * mt + fr) * 72 + 32 * ks + 8 * fq);
                    acc[mt][0] = __builtin_amdgcn_mfma_f32_16x16x32_bf16(ak, vB[0][ks], acc[mt][0], 0, 0, 0);
                    acc[mt][1] = __builtin_amdgcn_mfma_f32_16x16x32_bf16(ak, vB[1][ks], acc[mt][1], 0, 0, 0); }
#pragma unroll
            for (int mt = 0; mt < 8; ++mt)
#pragma unroll
                for (int nt2 = 0; nt2 < 2; ++nt2) { const int dvv = 16 * (2 * wave + nt2) + fr; u32x2 w; w.x = pk2(acc[mt][nt2][0], acc[mt][nt2][1]); w.y = pk2(acc[mt][nt2][2], acc[mt][nt2][3]);
                    *(u32x2*)(upd + (size_t)unit * 32768 + dvv * 128 + 16 * mt + 4 * fq) = w; }
        }
    }
    grid.sync();

    { IDS();
    for (int g = gtid; g < 4 * 32768; g += NT) {
        const int hg = g >> 15, rem = g & 32767, dk = g & 127;
        bf16_t* p = upd + (size_t)hg * 32768 + rem; const float* dp = decb + hg * 128 + dk;
        float S = 0.f;
        for (int n = 0; n < NCH; n += 8) {
            float uu[8], dd[8];
#pragma unroll
            for (int k = 0; k < 8; ++k) { uu[k] = bf2f(p[(size_t)(n + k) * 131072]); dd[k] = dp[(n + k) * 512]; }
#pragma unroll
            for (int k = 0; k < 8; ++k) { p[(size_t)(n + k) * 131072] = (bf16_t)f2bf(S); S = dd[k] * S + uu[k]; }
        }
    } }
    {
        IDS();
        LAS unsigned char* kvb = lds; LAS float* bt = (LAS float*)(lds + 36864);
        const int fr = lane & 15, fq = lane >> 4, hl = wave >> 2, qt = wave & 3;
        constexpr float LOG2E = 1.4426950408889634f;
        const int prow = (tid >> 3) & 63, pseg = tid & 7, pofs = prow * 144 + pseg * 16;
#define ATT_LOADK(j) do { const int kc_ = (c - 8 + (j)) < 0 ? 0 : (c - 8 + (j)); _Pragma("unroll") for (int r = 0; r < 2; ++r) \
            pre[r] = *(const u32x4*)(projR + (size_t)(kc_ * 64 + prow) * NR + KA + 64 * (2 * hp + r) + 8 * pseg); } while (0)
#define ATT_LOADV(j) do { const int kc_ = (c - 8 + (j)) < 0 ? 0 : (c - 8 + (j)); _Pragma("unroll") for (int r = 0; r < 2; ++r) \
            pre[r] = *(const u32x4*)(vT + (size_t)(64 * (2 * hp + r) + prow) * T + kc_ * 64 + 8 * pseg); } while (0)
#define ATT_WRITE(buf) do { _Pragma("unroll") for (int r = 0; r < 2; ++r) *(LAS u32x4*)(kvb + (buf) * 18432 + r * 9216 + pofs) = pre[r]; } while (0)
        for (int unit = bx; unit < NCH * 8; unit += G) {
            const int c = unit >> 3, hp = unit & 7, h = 2 * hp + hl;
            for (int i = tid; i < 1026; i += 512) { const int hh = i >= 513 ? 1 : 0; bt[hh * 516 + (i - hh * 513)] = a.att_rel_bias[(2 * hp + hh) * 513 + (i - hh * 513)] * LOG2E; }
            bf16x8 qv[2];
#pragma unroll
            for (int ks = 0; ks < 2; ++ks) qv[ks] = *(const bf16x8*)(projR + (size_t)(64 * c + 16 * qt + fr) * NR + QA + 64 * h + 32 * ks + 8 * fq);
            u32x4 pre[2];
            ATT_LOADK(0); ATT_WRITE(0);
            __syncthreads();
            f32x4 S[36];
            const float b512 = bt[hl * 516 + 512];
#pragma unroll
            for (int j = 0; j < 9; ++j) {
                if (j < 8) ATT_LOADK(j + 1); else ATT_LOADV(0);
                const bool dead = (c - 8 + j) < 0;
#pragma unroll
                for (int kt4 = 0; kt4 < 4; ++kt4) { f32x4 acc = {0.f, 0.f, 0.f, 0.f};
#pragma unroll
                    for (int ks = 0; ks < 2; ++ks) { const bf16x8 ak = *(const LAS bf16x8*)(kvb + (j & 1) * 18432 + hl * 9216 + (16 * kt4 + fr) * 144 + (32 * ks + 8 * fq) * 2);
                        acc = __builtin_amdgcn_mfma_f32_16x16x32_bf16(ak, qv[ks], acc, 0, 0, 0); }
#pragma unroll
                    for (int jj = 0; jj < 4; ++jj) { float bias = b512;
                        if (j >= 4) { const int kpos = 64 * j + 16 * kt4 + 4 * fq + jj; int rel = 16 * qt + fr + 512 - kpos; rel = rel > 256 ? 256 : rel; bias = bt[hl * 516 + rel + 256]; }
                        const float sv = acc[jj] * (0.125f * LOG2E) + bias; acc[jj] = dead ? -1e30f : sv; }
                    S[4 * j + kt4] = acc; }
                ATT_WRITE((j + 1) & 1);
                __syncthreads();
            }
            float mx = -1e30f;
#pragma unroll
            for (int i = 0; i < 36; ++i) mx = fmaxf(mx, fmaxf(fmaxf(S[i][0], S[i][1]), fmaxf(S[i][2], S[i][3])));
            mx = fmaxf(mx, __shfl_xor(mx, 16)); mx = fmaxf(mx, __shfl_xor(mx, 32));
            float l = 0.f;
            u32x2 PW[36];
#pragma unroll
            for (int i = 0; i < 36; ++i) { const float p0 = __builtin_amdgcn_exp2f(S[i][0] - mx), p1 = __builtin_amdgcn_exp2f(S[i][1] - mx), p2 = __builtin_amdgcn_exp2f(S[i][2] - mx), p3 = __builtin_amdgcn_exp2f(S[i][3] - mx);
                l += (p0 + p1) + (p2 + p3); PW[i].x = pg8::cvt_pk_bf16(p0, p1); PW[i].y = pg8::cvt_pk_bf16(p2, p3);
                if ((i & 3) == 3) __builtin_amdgcn_sched_barrier(0); }
            l += __shfl_xor(l, 16); l += __shfl_xor(l, 32);
            f32x4 O[4];
#pragma unroll
            for (int dt = 0; dt < 4; ++dt) O[dt] = (f32x4){0.f, 0.f, 0.f, 0.f};
#pragma unroll
            for (int j = 0; j < 9; ++j) {
                if (j < 8) ATT_LOADV(j + 1);
                const int buf = (9 + j) & 1;
#pragma unroll
                for (int a2 = 0; a2 < 2; ++a2) { const u32x4 pw = {PW[4 * j + 2 * a2].x, PW[4 * j + 2 * a2].y, PW[4 * j + 2 * a2 + 1].x, PW[4 * j + 2 * a2 + 1].y};
                    const bf16x8 pa = __builtin_bit_cast(bf16x8, pw);
#pragma unroll
                    for (int dt = 0; dt < 4; ++dt) { const LAS unsigned char* vp = kvb + buf * 18432 + hl * 9216 + (16 * dt + fr) * 144 + (32 * a2 + 4 * fq) * 2;
                        const u32x2 lo = *(const LAS u32x2*)vp, hi = *(const LAS u32x2*)(vp + 32);
                        const u32x4 vw = {lo.x, lo.y, hi.x, hi.y};
                        O[dt] = __builtin_amdgcn_mfma_f32_16x16x32_bf16(pa, __builtin_bit_cast(bf16x8, vw), O[dt], 0, 0, 0); } }
                if (j < 8) ATT_WRITE((9 + j + 1) & 1);
                __syncthreads();
            }
#pragma unroll
            for (int jj = 0; jj < 4; ++jj) { const float linv = 1.0f / __shfl(l, 4 * fq + jj); const size_t t = (size_t)64 * c + 16 * qt + 4 * fq + jj;
#pragma unroll
                for (int dt = 0; dt < 4; ++dt) ycat[t * D + 64 * h + 16 * dt + fr] = (bf16_t)f2bf(O[dt][jj] * linv); }
        }
#undef ATT_LOADK
#undef ATT_LOADV
#undef ATT_WRITE
    }
    grid.sync();

    {
        IDS();
        LAS float* gL = (LAS float*)lds; LAS float* segtot = (LAS float*)(lds + 4096); LAS float* red = (LAS float*)(lds + 6144);
        LAS bf16_t* qd = (LAS bf16_t*)(lds + 8192); LAS bf16_t* ki = (LAS bf16_t*)(lds + 25600); LAS bf16_t* aL = (LAS bf16_t*)(lds + 43008);
        const int fr = lane & 15, fq = lane >> 4;
        for (int unit = bx; unit < NCH * 4; unit += G) {
            const int n = unit >> 2, hg = unit & 3; const int dk = tid & 127, seg = tid >> 7, col = hg * 128 + dk;
            {
                float bv[16], blast;
                gla_decay(a, glr, n, hg, tid, gL, segtot, bv, blast);
#pragma unroll
                for (int s = 0; s < 16; ++s) { const int i = 16 * seg + s; const size_t t = (size_t)n * 64 + i;
                    const float qf = bf2f(projR[t * NR + QG + col]) * 0.08838834764831845f * __expf(bv[s]);
                    const float kf = bf2f(projR[t * NR + KG + col]) * __expf(-bv[s]);
                    qd[i * 136 + dk] = (bf16_t)f2bf(qf); ki[i * 136 + dk] = (bf16_t)f2bf(kf); }
            }
            __syncthreads();
#pragma unroll
            for (int rep = 0; rep < 2; ++rep) { const int idx = wave + 8 * rep, it = idx >> 2, jt = idx & 3;
                f32x4 c = {0.f, 0.f, 0.f, 0.f};
                if (jt <= it) {
#pragma unroll
                    for (int ks = 0; ks < 4; ++ks) { const bf16x8 av = *(const LAS bf16x8*)(qd + (16 * it + fr) * 136 + 32 * ks + 8 * fq), bv8 = *(const LAS bf16x8*)(ki + (16 * jt + fr) * 136 + 32 * ks + 8 * fq);
                        c = __builtin_amdgcn_mfma_f32_16x16x32_bf16(av, bv8, c, 0, 0, 0); } }
#pragma unroll
                for (int jj = 0; jj < 4; ++jj) { const int i = 16 * it + 4 * fq + jj, j = 16 * jt + fr; aL[i * 72 + j] = (bf16_t)f2bf(j <= i ? c[jj] : 0.f); } }
            __syncthreads();
            f32x4 acc[4][2];
#pragma unroll
            for (int mt = 0; mt < 4; ++mt) { acc[mt][0] = (f32x4){0.f, 0.f, 0.f, 0.f}; acc[mt][1] = (f32x4){0.f, 0.f, 0.f, 0.f}; }
#pragma unroll
            for (int nt2 = 0; nt2 < 2; ++nt2) { const int dvv = 16 * (2 * wave + nt2) + fr;
                bf16x8 vB[2], sB[4];
#pragma unroll
                for (int ks = 0; ks < 2; ++ks) vB[ks] = *(const bf16x8*)(vT + (size_t)(1024 + hg * 256 + dvv) * T + n * 64 + 32 * ks + 8 * fq);
#pragma unroll
                for (int ks = 0; ks < 4; ++ks) sB[ks] = *(const bf16x8*)(upd + (size_t)unit * 32768 + dvv * 128 + 32 * ks + 8 * fq);
#pragma unroll
                for (int mt = 0; mt < 4; ++mt) {
#pragma unroll
                    for (int ks = 0; ks < 2; ++ks) acc[mt][nt2] = __builtin_amdgcn_mfma_f32_16x16x32_bf16(*(const LAS bf16x8*)(aL + (16 * mt + fr) * 72 + 32 * ks + 8 * fq), vB[ks], acc[mt][nt2], 0, 0, 0);
#pragma unroll
                    for (int ks = 0; ks < 4; ++ks) acc[mt][nt2] = __builtin_amdgcn_mfma_f32_16x16x32_bf16(*(const LAS bf16x8*)(qd + (16 * mt + fr) * 136 + 32 * ks + 8 * fq), sB[ks], acc[mt][nt2], 0, 0, 0); } }
#pragma unroll
            for (int mt = 0; mt < 4; ++mt)
#pragma unroll
                for (int jj = 0; jj < 4; ++jj) { float p = acc[mt][0][jj] * acc[mt][0][jj] + acc[mt][1][jj] * acc[mt][1][jj];
                    p += __shfl_xor(p, 1); p += __shfl_xor(p, 2); p += __shfl_xor(p, 4); p += __shfl_xor(p, 8);
                    if (fr == 0) red[wave * 64 + 16 * mt + 4 * fq + jj] = p; }
            __syncthreads();
#pragma unroll
            for (int mt = 0; mt < 4; ++mt)
#pragma unroll
                for (int jj = 0; jj < 4; ++jj) { const int i = 16 * mt + 4 * fq + jj; float ss = 0.f;
#pragma unroll
                    for (int w8 = 0; w8 < 8; ++w8) ss += red[w8 * 64 + i];
                    const float rstd = 1.0f / sqrtf(ss * (1.0f / 256.0f) + EPS); const size_t t = (size_t)n * 64 + i;
#pragma unroll
                    for (int nt2 = 0; nt2 < 2; ++nt2) { const int dvv = 16 * (2 * wave + nt2) + fr;
                        const float r = bf2f(projR[t * NR + RG + hg * 256 + dvv]);
                        const float y = acc[mt][nt2][jj] * rstd * a.gla_norm_w[dvv] * (r / (1.0f + __expf(-r)));
                        ycat[t * D + 1024 + hg * 256 + dvv] = (bf16_t)f2bf(y); } }
            __syncthreads();
        }
    }
    grid.sync();

    { pg8::Gemm g{ycat, WoutT, T, D, D}; pg8::StaticOrder S; S.init(T, D, G, bx); pg8::EpiResid E{a.x, a.out, x1b, ssq1};
      pg8::gemm_phase<pg8::EpiResid, pg8::StaticOrder, true, true>(lds, g, S, E); }
    grid.sync();

#ifndef NO_UP
    { pg8::Gemm g{x1b, WupT, T, 2 * FF, D}; pg8::StaticOrder S; S.init(T, 2 * FF, G, bx); pg8::EpiUp E{gbuf, ssq1, a.w_ffn_conv, a.b_ffn_conv, tailb, headb};
      pg8::gemm_phase<pg8::EpiUp, pg8::StaticOrder, true, true>(lds, g, S, E); }
#endif
    grid.sync();

    { IDS();
    for (int i = gtid; i < NCH * 2 * FF; i += NT) {
        const int C = i % FF, gj = i / FF, j = gj & 1, grp = gj >> 1; const int row = grp * 64 + j;
        float ug[3], uv[3];
        const float* tl = tailb + (size_t)(grp - 1) * 2 * (2 * FF); const float* hd = headb + (size_t)grp * 2 * (2 * FF);
        if (j == 0) { ug[0] = grp ? tl[C] : 0.f; uv[0] = grp ? tl[FF + C] : 0.f; ug[1] = grp ? tl[2 * FF + C] : 0.f; uv[1] = grp ? tl[3 * FF + C] : 0.f; ug[2] = hd[C]; uv[2] = hd[FF + C]; }
        else { ug[0] = grp ? tl[2 * FF + C] : 0.f; uv[0] = grp ? tl[3 * FF + C] : 0.f; ug[1] = hd[C]; uv[1] = hd[FF + C]; ug[2] = hd[2 * FF + C]; uv[2] = hd[3 * FF + C]; }
        const float* cw = a.w_ffn_conv; const float* cb = a.b_ffn_conv;
        const float yg = cb[C] + cw[C] * ug[0] + cw[2 * FF + C] * ug[1] + cw[4 * FF + C] * ug[2];
        const float yv = cb[FF + C] + cw[FF + C] * uv[0] + cw[3 * FF + C] * uv[1] + cw[5 * FF + C] * uv[2];
        gbuf[(size_t)row * FF + C] = (bf16_t)f2bf(pg8::gelu_tanh(yg) * yv);
    } }
    grid.sync();

    { pg8::Gemm g{gbuf, WdnT, T, D, FF}; pg8::StaticOrder S; S.init(T, D, G, bx); pg8::EpiResid E{a.out, a.out, x2b, ssq2};
      pg8::gemm_phase<pg8::EpiResid, pg8::StaticOrder, true, true>(lds, g, S, E); }
    { pg8::Gemm g{pb, WppT, T, D, PLE}; pg8::StaticOrder S; S.init(T, D, G, bx); pg8::EpiBf16 E{ppb, D};
      pg8::gemm_phase<pg8::EpiBf16, pg8::StaticOrder, true, true>(lds, g, S, E); }
    grid.sync();

    { pg8::Gemm g{x2b, WpgT, T, D, D}; pg8::StaticOrder S; S.init(T, D, G, bx); pg8::EpiPle E{a.out, ppb, ssq2, ssq3};
      pg8::gemm_phase<pg8::EpiPle, pg8::StaticOrder, true, true>(lds, g, S, E); }
    grid.sync();

    { IDS();
    for (int m = gw; m < T; m += NGW) {
        const float rstd = 1.0f / sqrtf(ssq3[m] * (1.0f / D) + EPS);
        f32x4* xr = (f32x4*)(a.out + (size_t)m * D) + lane; const f32x4* wr4 = (const f32x4*)a.final_norm_w + lane;
#pragma unroll
        for (int j = 0; j < 8; ++j) { f32x4 v = xr[64 * j]; const f32x4 w = wr4[64 * j]; v.x *= rstd * w.x; v.y *= rstd * w.y; v.z *= rstd * w.z; v.w *= rstd * w.w; xr[64 * j] = v; }
    } }
}

extern "C" void kernel_launch(void* const* d_in, const int* in_sizes, int n_in, void* d_out, int out_size, void* d_ws, size_t ws_size, hipStream_t stream) {
    static int grid = 0;
    if (grid == 0) {
        if (n_in != 18 || out_size != T * D || ws_size < WS_END) { fprintf(stderr, "kernel_launch: unexpected problem (n_in %d out %d ws %zu)\n", n_in, out_size, ws_size); grid = -1; return; }
        int dev = 0, cus = 0, per_cu = 0;
        hipGetDevice(&dev); hipDeviceGetAttribute(&cus, hipDeviceAttributeMultiprocessorCount, dev);
        if (hipFuncSetAttribute((const void*)fwd_megakernel, hipFuncAttributeMaxDynamicSharedMemorySize, LDS_BYTES) != hipSuccess) { fprintf(stderr, "kernel_launch: hipFuncSetAttribute failed\n"); grid = -1; return; }
        if (hipOccupancyMaxActiveBlocksPerMultiprocessor(&per_cu, (const void*)fwd_megakernel, 512, LDS_BYTES) != hipSuccess || per_cu < 1) { fprintf(stderr, "kernel_launch: occupancy query says %d\n", per_cu); per_cu = 1; }
        (void)hipGetLastError();
        grid = cus * per_cu;
    }
    if (grid < 0) return;
    Args a{};
    const float** f = (const float**)&a;
    for (int i = 0; i < 18; ++i) f[i] = (const float*)d_in[i];
    a.out = (float*)d_out; a.ws = (unsigned char*)d_ws;
    void* args[] = {&a};
    hipError_t e = hipLaunchCooperativeKernel((const void*)fwd_megakernel, dim3(grid), dim3(512), args, LDS_BYTES, stream);
    if (e != hipSuccess) fprintf(stderr, "cooperative launch failed: %s (grid %d)\n", hipGetErrorString(e), grid);
}
```

```cpp
#include <hip/hip_runtime.h>
#include <hip/hip_cooperative_groups.h>
#include <cstdio>
#include <cstdint>
namespace cg = cooperative_groups;
#ifndef PROBE_DUP
#define PROBE_DUP 0
#endif
#ifndef PROBE_T
#define PROBE_T 0
#endif
#define REPS(k) for (int rep_ = 0; rep_ < (PROBE_DUP == (k) ? 2 : 1); ++rep_)

#define LAS __attribute__((address_space(3)))
typedef unsigned short bf16_t;
typedef short bf16x8 __attribute__((ext_vector_type(8)));
typedef float f32x4 __attribute__((ext_vector_type(4)));
typedef float f32x2 __attribute__((ext_vector_type(2)));
typedef unsigned u32x4 __attribute__((ext_vector_type(4)));
typedef unsigned u32x2 __attribute__((ext_vector_type(2)));

constexpr int T = 16384, D = 2048, FF = 5632, NR = 4096, PLE = 256, NCH = 256;
constexpr int QA = 0, KA = 1024, QG = 2048, KG = 2560, RG = 3072;
constexpr float EPS = 1e-6f;
constexpr size_t MiB = 1u << 20;
constexpr size_t WS_SSQ1 = 0, WS_SSQ2 = 65536, WS_SSQ3 = 131072, WS_GLR = 1 * MiB, WS_WG = 2 * MiB, WS_WPP = 3 * MiB;
constexpr size_t WS_WIN = 4 * MiB, WS_WOUT = 28 * MiB, WS_WUP = 36 * MiB, WS_WDN = 80 * MiB, WS_WPG = 102 * MiB, WS_PB = 110 * MiB;
constexpr size_t WS_H0 = 118 * MiB;
constexpr size_t WS_PROJ = 182 * MiB;
constexpr size_t WS_VT = 310 * MiB;
constexpr size_t WS_X1B = 182 * MiB, WS_G = 246 * MiB, WS_TAIL = 422 * MiB, WS_HEAD = 444 * MiB, WS_PP = 422 * MiB  , WS_X3B = 182 * MiB  , WS_YCAT = WS_H0, WS_X2B = WS_H0;
constexpr size_t WS_DEC = 256 * 1024, WS_UPD = 406 * MiB, WS_BCUM = 374 * MiB;
constexpr size_t WS_BAR = 800 * 1024;
constexpr size_t WS_GLR1 = 470 * MiB;
constexpr size_t WS_RSTD0 = 900 * 1024;
constexpr size_t WS_END = 512 * MiB;
constexpr int LDS_BYTES = 147456;

__device__ __forceinline__ unsigned f2bf(float f) { unsigned u = __builtin_bit_cast(unsigned, f); return (u + 0x7fffu + ((u >> 16) & 1u)) >> 16; }
typedef __bf16 hwbf16x2 __attribute__((ext_vector_type(2)));
__device__ __forceinline__ unsigned pk2(float lo, float hi) { const f32x2 v = {lo, hi}; return __builtin_bit_cast(unsigned, __builtin_convertvector(v, hwbf16x2)); }
__device__ __forceinline__ float frcp(float x) { return __builtin_amdgcn_rcpf(x); }
__device__ __forceinline__ float frsq(float x) { return __builtin_amdgcn_rsqf(x); }
__device__ __forceinline__ float fsigmoid(float x) { return frcp(1.0f + __builtin_amdgcn_exp2f(-1.4426950408889634f * x)); }
__device__ __forceinline__ float bf2f(unsigned short b) { return __builtin_bit_cast(float, (unsigned)b << 16); }
__device__ __forceinline__ float bflo(unsigned w) { return __builtin_bit_cast(float, w << 16); }
__device__ __forceinline__ float bfhi(unsigned w) { return __builtin_bit_cast(float, w & 0xffff0000u); }
__device__ __forceinline__ float wave_sum(float v) {
#pragma unroll
    for (int o = 1; o < 64; o <<= 1) v += __shfl_xor(v, o);
    return v;
}

namespace pg8 {
#define PG8_LAS __attribute__((address_space(3)))
constexpr int BM = 256, BK = 64, HALF = 128, HTB = HALF * BK * 2, STAGE_BYTES = 8 * HTB, NXCD = 8, WGM = 8;
__host__ __device__ __forceinline__ int lds_byte(int r, int c) { const int st = (r >> 4) * 2 + (c >> 5), rr = r & 15, cc = c & 31, ob = rr * 64 + cc * 2; return st * 1024 + (ob ^ (((ob >> 9) & 1) << 5)); }
__host__ __device__ __forceinline__ void stage_rc(int b, int& R, int& C) { const int st = b / 1024, sb = b % 1024, swz = sb ^ (((sb >> 9) & 1) << 5); R = (st >> 1) * 16 + swz / 64; C = (st & 1) * 32 + (swz % 64) / 2; }
__host__ __device__ __forceinline__ int perm32(int rho) { const int n = rho >> 4, i = rho & 15; return 8 * (i >> 2) + 4 * n + (i & 3); }

struct Unit { int pm, pn; };
struct Gemm { const bf16_t* A; const bf16_t* Bt; int M, N, K; };

struct StaticOrder {
    int nM, nN, nwg, G, c;
    __host__ __device__ void init(int M, int N, int G_, int c_) { nM = M / BM; nN = N / BM; nwg = nM * nN; G = G_; c = c_; }
    __host__ __device__ bool next(int i, Unit& u) const {
        const long L = (long)i * G + c; if (L >= nwg) return false;
        int wgid = (int)L; { const int q = nwg / NXCD, r = nwg % NXCD, xcd = wgid % NXCD, off = wgid / NXCD; wgid = (xcd < r ? xcd * (q + 1) : r * (q + 1) + (xcd - r) * q) + off; }
        const int nig = WGM * nN, gid = wgid / nig, fm = gid * WGM, gsz = (nM - fm) < WGM ? (nM - fm) : WGM;
        u.pm = fm + ((wgid % nig) % gsz); u.pn = (wgid % nig) / gsz; return true;
    }
    __device__ __forceinline__ void a_ready(const Unit&) const {}
    __device__ __forceinline__ void done(const Unit&) const {}
};

__device__ __forceinline__ unsigned cvt_pk_bf16(float lo, float hi) { return pk2(lo, hi); }

struct EpiBf16 {
    static constexpr bool PERM = true, AFTER_DRAIN = false;
    bf16_t* O; int ldc; const float* rs; const float* cs;
    __device__ __forceinline__ void operator()(const f32x4 (&acc)[2][2][4][2], const Unit& u, int wr, int wc, int fr, int fq) const {
        const int row0 = u.pm * BM + wr * 64 + fr; const int col0 = u.pn * BM + wc * 32 + 8 * fq;
        f32x4 c0[2], c1[2];
#pragma unroll
        for (int bj = 0; bj < 2; ++bj) { c0[bj] = cs ? *(const f32x4*)(cs + col0 + bj * HALF) : (f32x4){1.f, 1.f, 1.f, 1.f}; c1[bj] = cs ? *(const f32x4*)(cs + col0 + bj * HALF + 4) : (f32x4){1.f, 1.f, 1.f, 1.f}; }
#pragma unroll
        for (int ai = 0; ai < 2; ++ai)
#pragma unroll
            for (int m = 0; m < 4; ++m) { const int row = row0 + ai * HALF + m * 16; bf16_t* rowp = O + (size_t)row * ldc + col0; const float r = rs ? rs[row] : 1.0f;
#pragma unroll
                for (int bj = 0; bj < 2; ++bj) { const f32x4 v0 = acc[ai][bj][m][0] * c0[bj] * r, v1 = acc[ai][bj][m][1] * c1[bj] * r;
                    u32x4 w; w.x = cvt_pk_bf16(v0[0], v0[1]); w.y = cvt_pk_bf16(v0[2], v0[3]); w.z = cvt_pk_bf16(v1[0], v1[1]); w.w = cvt_pk_bf16(v1[2], v1[3]);
                    *(u32x4*)(rowp + bj * HALF) = w; } }
    }
};
template <bool BASE_BF16> struct EpiResid {
    static constexpr bool PERM = true, AFTER_DRAIN = false;
    const void* base; bf16_t* ob; float* ssq;
    __device__ __forceinline__ void operator()(const f32x4 (&acc)[2][2][4][2], const Unit& u, int wr, int wc, int fr, int fq) const {
        const int row0 = u.pm * BM + wr * 64 + fr; const int col0 = u.pn * BM + wc * 32 + 8 * fq;
#pragma unroll
        for (int ai = 0; ai < 2; ++ai)
#pragma unroll
            for (int m = 0; m < 4; ++m) { const int row = row0 + ai * HALF + m * 16; const size_t off = (size_t)row * D + col0; float ss = 0.f;
#pragma unroll
                for (int bj = 0; bj < 2; ++bj) {
                    f32x4 b0, b1;
                    if (BASE_BF16) { const u32x4 pw = *(const u32x4*)((const bf16_t*)base + off + bj * HALF); b0 = (f32x4){bflo(pw.x), bfhi(pw.x), bflo(pw.y), bfhi(pw.y)}; b1 = (f32x4){bflo(pw.z), bfhi(pw.z), bflo(pw.w), bfhi(pw.w)}; }
                    else { b0 = *(const f32x4*)((const float*)base + off + bj * HALF); b1 = *(const f32x4*)((const float*)base + off + bj * HALF + 4); }
                    const f32x4 v0 = acc[ai][bj][m][0] + b0, v1 = acc[ai][bj][m][1] + b1;
                    u32x4 w; w.x = cvt_pk_bf16(v0[0], v0[1]); w.y = cvt_pk_bf16(v0[2], v0[3]); w.z = cvt_pk_bf16(v1[0], v1[1]); w.w = cvt_pk_bf16(v1[2], v1[3]);
                    *(u32x4*)(ob + off + bj * HALF) = w;
                    ss += (v0[0] * v0[0] + v0[1] * v0[1]) + (v0[2] * v0[2] + v0[3] * v0[3]) + (v1[0] * v1[0] + v1[1] * v1[1]) + (v1[2] * v1[2] + v1[3] * v1[3]); }
                ss += __shfl_xor(ss, 16); ss += __shfl_xor(ss, 32);
                if (fq == 0) atomicAdd(ssq + row, ss); }
    }
};
struct EpiPle {
    static constexpr bool PERM = true, AFTER_DRAIN = false;
    const bf16_t* x2; bf16_t* x3; const bf16_t* pp; const float* ssq2; float* ssq3;
    __device__ __forceinline__ void operator()(const f32x4 (&acc)[2][2][4][2], const Unit& u, int wr, int wc, int fr, int fq) const {
        const int row0 = u.pm * BM + wr * 64 + fr; const int col0 = u.pn * BM + wc * 32 + 8 * fq;
#pragma unroll
        for (int ai = 0; ai < 2; ++ai)
#pragma unroll
            for (int m = 0; m < 4; ++m) { const int row = row0 + ai * HALF + m * 16; const size_t off = (size_t)row * D + col0; float ss = 0.f;
                const float rstd = frsq(ssq2[row] * (1.0f / D) + EPS);
#pragma unroll
                for (int bj = 0; bj < 2; ++bj) {
                    const u32x4 xw = *(const u32x4*)(x2 + off + bj * HALF);
                    const u32x4 pw = *(const u32x4*)(pp + off + bj * HALF);
                    const f32x4 b0 = {bflo(xw.x), bfhi(xw.x), bflo(xw.y), bfhi(xw.y)}, b1 = {bflo(xw.z), bfhi(xw.z), bflo(xw.w), bfhi(xw.w)};
                    const f32x4 p0 = {bflo(pw.x), bfhi(pw.x), bflo(pw.y), bfhi(pw.y)}, p1 = {bflo(pw.z), bfhi(pw.z), bflo(pw.w), bfhi(pw.w)};
                    f32x4 v0, v1;
#pragma unroll
                    for (int e = 0; e < 4; ++e) { const float g0 = fsigmoid(acc[ai][bj][m][0][e] * rstd), g1 = fsigmoid(acc[ai][bj][m][1][e] * rstd);
                        v0[e] = b0[e] + g0 * p0[e]; v1[e] = b1[e] + g1 * p1[e]; }
                    u32x4 w; w.x = cvt_pk_bf16(v0[0], v0[1]); w.y = cvt_pk_bf16(v0[2], v0[3]); w.z = cvt_pk_bf16(v1[0], v1[1]); w.w = cvt_pk_bf16(v1[2], v1[3]);
                    *(u32x4*)(x3 + off + bj * HALF) = w;
                    ss += (v0[0] * v0[0] + v0[1] * v0[1]) + (v0[2] * v0[2] + v0[3] * v0[3]) + (v1[0] * v1[0] + v1[1] * v1[1]) + (v1[2] * v1[2] + v1[3] * v1[3]); }
                ss += __shfl_xor(ss, 16); ss += __shfl_xor(ss, 32);
                if (fq == 0) atomicAdd(ssq3 + row, ss); }
    }
};
__device__ __forceinline__ float gelu_tanh(float x) {
    const float t = x * x * (-1.5957691216057308f * 1.4426950408889634f * 0.044715f) + (-1.5957691216057308f * 1.4426950408889634f);
    return x * frcp(1.0f + __builtin_amdgcn_exp2f(t * x));
}
template <int CTRL> __device__ __forceinline__ float dppz(float v) { return __builtin_bit_cast(float, __builtin_amdgcn_update_dpp(0, __builtin_bit_cast(int, v), CTRL, 0xf, 0xf, true)); }
#define FMAC_DPP(acc, src, w, CTRL) asm volatile("s_nop 1\n\tv_fmac_f32_dpp %0, %1, %2 " CTRL " row_mask:0xf bank_mask:0xf bound_ctrl:1" : "+v"(acc) : "v"(src), "v"(w))
struct EpiUp {
    static constexpr bool PERM = true, AFTER_DRAIN = false;
    bf16_t* G; const float* ssq1; const float* cw; const float* cb; float* tail; float* head;
    __device__ __forceinline__ void operator()(const f32x4 (&acc)[2][2][4][2], const Unit& u, int wr, int wc, int fr, int fq) const {
        const int C0 = u.pn * 128 + wc * 32 + 8 * fq;
#pragma unroll
        for (int ai = 0; ai < 2; ++ai) {
            const int rbase = u.pm * BM + ai * HALF + wr * 64; const int grp = rbase >> 6;
            float rstd[4];
#pragma unroll
            for (int m = 0; m < 4; ++m) rstd[m] = frsq(ssq1[rbase + m * 16 + fr] * (1.0f / D) + EPS);
            if (fr < 2) { float* hp = head + ((size_t)grp * 2 + fr) * (2 * FF) + C0;
#pragma unroll
                for (int bj = 0; bj < 2; ++bj) { *(f32x4*)(hp + bj * FF) = acc[ai][bj][0][0] * rstd[0]; *(f32x4*)(hp + bj * FF + 4) = acc[ai][bj][0][1] * rstd[0]; } }
            if (fr >= 14) { float* tp = tail + ((size_t)grp * 2 + (fr - 14)) * (2 * FF) + C0;
#pragma unroll
                for (int bj = 0; bj < 2; ++bj) { *(f32x4*)(tp + bj * FF) = acc[ai][bj][3][0] * rstd[3]; *(f32x4*)(tp + bj * FF + 4) = acc[ai][bj][3][1] * rstd[3]; } }
            __builtin_amdgcn_sched_barrier(0);
#pragma unroll
            for (int n = 0; n < 2; ++n) {
                unsigned outw[4][2];
#pragma unroll
                for (int ep = 0; ep < 2; ++ep) {
                    int C = C0 + 4 * n + 2 * ep; asm volatile("" : "+v"(C));
                    const f32x2 wg0 = *(const f32x2*)(cw + C), wg1 = *(const f32x2*)(cw + 2 * FF + C), wg2 = *(const f32x2*)(cw + 4 * FF + C), bg = *(const f32x2*)(cb + C);
                    const f32x2 wv0 = *(const f32x2*)(cw + FF + C), wv1 = *(const f32x2*)(cw + 3 * FF + C), wv2 = *(const f32x2*)(cw + 5 * FF + C), bv = *(const f32x2*)(cb + FF + C);
                    f32x2 ugp = {0.f, 0.f}, uvp = {0.f, 0.f};
#pragma unroll
                    for (int m = 0; m < 4; ++m) {
                        f32x2 ug = (f32x2){acc[ai][0][m][n][2 * ep], acc[ai][0][m][n][2 * ep + 1]} * rstd[m], uv = (f32x2){acc[ai][1][m][n][2 * ep], acc[ai][1][m][n][2 * ep + 1]} * rstd[m];
                        asm volatile("" : "+v"(ug), "+v"(uv));
                        f32x2 yg = wg2 * ug + bg, yv = wv2 * uv + bv;
#pragma unroll
                        for (int q = 0; q < 2; ++q) {
                            FMAC_DPP(yg[q], ug[q], wg1[q], "row_shr:1"); FMAC_DPP(yv[q], uv[q], wv1[q], "row_shr:1");
                            FMAC_DPP(yg[q], ug[q], wg0[q], "row_shr:2"); FMAC_DPP(yv[q], uv[q], wv0[q], "row_shr:2");
                            if (m > 0) { FMAC_DPP(yg[q], ugp[q], wg1[q], "row_shl:15"); FMAC_DPP(yv[q], uvp[q], wv1[q], "row_shl:15");
                                         FMAC_DPP(yg[q], ugp[q], wg0[q], "row_shl:14"); FMAC_DPP(yv[q], uvp[q], wv0[q], "row_shl:14"); } }
                        f32x2 t = yg * yg * (-1.5957691216057308f * 1.4426950408889634f * 0.044715f) + (-1.5957691216057308f * 1.4426950408889634f);
                        t = t * yg;
                        f32x2 den = {__builtin_amdgcn_exp2f(t[0]), __builtin_amdgcn_exp2f(t[1])}; den = den + 1.0f;
                        const f32x2 rc = {frcp(den[0]), frcp(den[1])};
                        f32x2 o = yg * rc * yv; asm volatile("" : "+v"(o));
                        outw[m][ep] = pk2(o[0], o[1]);
                        ugp = ug; uvp = uv;
                    }
                    __builtin_amdgcn_sched_barrier(0);
                }
#pragma unroll
                for (int m = 0; m < 4; ++m) if (m > 0 || fr >= 2) { u32x2 w = {outw[m][0], outw[m][1]}; *(u32x2*)(G + (size_t)(rbase + m * 16 + fr) * FF + C0 + 4 * n) = w; }
                __builtin_amdgcn_sched_barrier(0);
            }
        }
    }
};

template <class Epi, class Sched, bool ALIGN_EPI = false, bool SP2 = false>
__device__ __forceinline__ void gemm_phase(PG8_LAS unsigned char* lds, const Gemm g, const Sched& S, const Epi& E) {
    int tid_ = threadIdx.x; asm volatile("" : "+v"(tid_));
    const int tid = tid_, wid = __builtin_amdgcn_readfirstlane(tid >> 6), lane = tid & 63, wr = wid >> 2, wc = wid & 3, fr = lane & 15, fq = lane >> 4;
    const int K = g.K, nt = K / BK;
    unsigned voffA[2], voffB[2];
#pragma unroll
    for (int i = 0; i < 2; ++i) { int R, C; stage_rc(tid * 16 + i * 8192, R, C); const int Rb = Epi::PERM ? ((R & ~31) + perm32(R & 31)) : R;
        voffA[i] = (unsigned)(R * K + C) * 2u; voffB[i] = (unsigned)(Rb * K + C) * 2u; }
    const size_t kstep = (size_t)(BK * 2);
    const size_t hstep = (size_t)HALF * K * 2;
    const size_t tstep = 2 * hstep;
    const unsigned ldsw = (unsigned)wid * 1024u;
    const int aoff = lds_byte(wr * 64 + fr, fq * 8), boff = lds_byte(wc * 32 + fr, fq * 8);
#define PG8_SA(b, h) (((b) * 2 + (h)) * HTB)
#define PG8_SB(b, h) ((4 + (b) * 2 + (h)) * HTB)
#define PG8_STAGE(bufoff, gbase, voff) do { _Pragma("unroll") for (int _i = 0; _i < 2; ++_i) \
        __builtin_amdgcn_global_load_lds((const unsigned*)((const char*)(gbase) + (voff)[_i]), (PG8_LAS unsigned*)(lds + (bufoff) + ldsw + _i * 8192), 16, 0, 0); } while (0)
#define PG8_LDA(dst, b, h) do { _Pragma("unroll") for (int m = 0; m < 4; ++m) _Pragma("unroll") for (int k = 0; k < 2; ++k) dst[m][k] = *(const PG8_LAS bf16x8*)(lds + PG8_SA(b, h) + aoff + m * 2048 + k * 1024); } while (0)
#define PG8_LDB(dst, b, h) do { _Pragma("unroll") for (int n = 0; n < 2; ++n) _Pragma("unroll") for (int k = 0; k < 2; ++k) dst[n][k] = *(const PG8_LAS bf16x8*)(lds + PG8_SB(b, h) + boff + n * 2048 + k * 1024); } while (0)
#define PG8_MMA(ai, bj, At, Bt) do { __builtin_amdgcn_s_setprio(1); _Pragma("unroll") for (int m = 0; m < 4; ++m) _Pragma("unroll") for (int n = 0; n < 2; ++n) _Pragma("unroll") for (int k = 0; k < 2; ++k) \
        acc[ai][bj][m][n] = __builtin_amdgcn_mfma_f32_16x16x32_bf16(Bt[n][k], At[m][k], acc[ai][bj][m][n], 0, 0, 0); __builtin_amdgcn_s_setprio(0); } while (0)
#define PG8_WAIT_V(n) asm volatile("s_waitcnt vmcnt(" #n ")" ::: "memory")
#define PG8_WAIT_L(n) asm volatile("s_waitcnt lgkmcnt(" #n ")" ::: "memory")
#define PG8_BAR __builtin_amdgcn_s_barrier()
#define PG8_SCHED __builtin_amdgcn_sched_barrier(0)
    Unit cur, nxt; int ui = 0;
    if (!S.next(0, cur)) return;
    f32x4 acc[2][2][4][2];
#pragma unroll
    for (int a = 0; a < 2; ++a)
#pragma unroll
        for (int b = 0; b < 2; ++b)
#pragma unroll
            for (int m = 0; m < 4; ++m)
#pragma unroll
                for (int n = 0; n < 2; ++n) acc[a][b][m][n] = (f32x4){0.f, 0.f, 0.f, 0.f};
    bf16x8 At[4][2], B0[2][2], B1[2][2];
    const char* cA = (const char*)g.A + (size_t)cur.pm * tstep; const char* cB = (const char*)g.Bt + (size_t)cur.pn * tstep;
    S.a_ready(cur);
    if constexpr (SP2) {
        PG8_STAGE(PG8_SB(0, 0), cB, voffB); PG8_STAGE(PG8_SB(0, 1), cB + hstep, voffB); PG8_STAGE(PG8_SA(0, 0), cA, voffA); PG8_STAGE(PG8_SA(0, 1), cA + hstep, voffA);
        if (wr == 1) PG8_BAR;
        PG8_WAIT_V(2); PG8_BAR;
        PG8_STAGE(PG8_SB(1, 0), cB + kstep, voffB); PG8_STAGE(PG8_SA(1, 0), cA + kstep, voffA); PG8_STAGE(PG8_SB(1, 1), cB + hstep + kstep, voffB);
        PG8_WAIT_V(6); PG8_BAR;
    } else {
        PG8_STAGE(PG8_SB(0, 0), cB, voffB); PG8_STAGE(PG8_SA(0, 0), cA, voffA); PG8_STAGE(PG8_SB(0, 1), cB + hstep, voffB); PG8_STAGE(PG8_SA(0, 1), cA + hstep, voffA);
        if (wr == 1) PG8_BAR;
        PG8_WAIT_V(4); PG8_BAR;
        PG8_STAGE(PG8_SB(1, 0), cB + kstep, voffB); PG8_STAGE(PG8_SA(1, 0), cA + kstep, voffA); PG8_STAGE(PG8_SB(1, 1), cB + hstep + kstep, voffB);
        PG8_WAIT_V(6); PG8_BAR;
    }
    for (;;) {
        const bool has_next = S.next(ui + 1, nxt);
        const char* nA = has_next ? (const char*)g.A + (size_t)nxt.pm * tstep : cA; const char* nB = has_next ? (const char*)g.Bt + (size_t)nxt.pn * tstep : cB;
        for (int t = 0; t < nt; t += 2) {
            const bool last = (t == nt - 2);
            const char* a1 = cA + (size_t)(t + 1) * kstep;
            const char* a2 = last ? nA : cA + (size_t)(t + 2) * kstep; const char* b2 = last ? nB : cB + (size_t)(t + 2) * kstep;
            const char* a3 = a2 + kstep; const char* b3 = b2 + kstep;
            if (last && has_next) S.a_ready(nxt);
            if constexpr (SP2) {
            PG8_LDB(B0, 0, 0); PG8_LDB(B1, 0, 1); PG8_SCHED; PG8_LDA(At, 0, 0); PG8_STAGE(PG8_SA(1, 1), a1 + hstep, voffA);
            PG8_WAIT_V(8); PG8_WAIT_L(0); PG8_BAR; PG8_MMA(0, 0, At, B0); PG8_MMA(0, 1, At, B1); PG8_BAR; PG8_SCHED;
            PG8_LDA(At, 0, 1); PG8_STAGE(PG8_SB(0, 0), b2, voffB); PG8_STAGE(PG8_SB(0, 1), b2 + hstep, voffB); PG8_STAGE(PG8_SA(0, 0), a2, voffA);
            PG8_WAIT_V(8); PG8_WAIT_L(0); PG8_BAR; PG8_MMA(1, 0, At, B0); PG8_MMA(1, 1, At, B1); PG8_BAR; PG8_SCHED;
            PG8_LDB(B0, 1, 0); PG8_LDB(B1, 1, 1); PG8_SCHED; PG8_LDA(At, 1, 0); PG8_STAGE(PG8_SA(0, 1), a2 + hstep, voffA);
            PG8_WAIT_V(8); PG8_WAIT_L(0); PG8_BAR; PG8_MMA(0, 0, At, B0); PG8_MMA(0, 1, At, B1); PG8_BAR; PG8_SCHED;
            PG8_LDA(At, 1, 1); PG8_STAGE(PG8_SB(1, 0), b3, voffB); PG8_STAGE(PG8_SB(1, 1), b3 + hstep, voffB); PG8_STAGE(PG8_SA(1, 0), a3, voffA);
            PG8_WAIT_V(8); PG8_WAIT_L(0); PG8_BAR; PG8_MMA(1, 0, At, B0); PG8_MMA(1, 1, At, B1); PG8_BAR; PG8_SCHED;
            } else {
            PG8_LDB(B0, 0, 0); PG8_SCHED; PG8_LDA(At, 0, 0); PG8_STAGE(PG8_SA(1, 1), a1 + hstep, voffA);
            PG8_WAIT_L(8); PG8_BAR; PG8_WAIT_L(0); PG8_MMA(0, 0, At, B0); PG8_BAR; PG8_SCHED;
            PG8_LDB(B1, 0, 1); PG8_STAGE(PG8_SB(0, 0), b2, voffB);
            PG8_BAR; PG8_WAIT_L(0); PG8_MMA(0, 1, At, B1); PG8_BAR;
            PG8_LDA(At, 0, 1); PG8_STAGE(PG8_SA(0, 0), a2, voffA);
            PG8_BAR; PG8_WAIT_L(0); PG8_MMA(1, 0, At, B0); PG8_BAR; PG8_SCHED;
            PG8_STAGE(PG8_SB(0, 1), b2 + hstep, voffB);
            PG8_WAIT_V(6); PG8_BAR; PG8_MMA(1, 1, At, B1); PG8_BAR;
            PG8_LDB(B0, 1, 0); PG8_SCHED; PG8_LDA(At, 1, 0); PG8_STAGE(PG8_SA(0, 1), a2 + hstep, voffA);
            PG8_WAIT_L(8); PG8_BAR; PG8_WAIT_L(0); PG8_MMA(0, 0, At, B0); PG8_BAR; PG8_SCHED;
            PG8_LDB(B1, 1, 1); PG8_STAGE(PG8_SB(1, 0), b3, voffB);
            PG8_BAR; PG8_WAIT_L(0); PG8_MMA(0, 1, At, B1); PG8_BAR;
            PG8_LDA(At, 1, 1); PG8_STAGE(PG8_SA(1, 0), a3, voffA);
            PG8_BAR; PG8_WAIT_L(0); PG8_MMA(1, 0, At, B0); PG8_BAR; PG8_SCHED;
            PG8_STAGE(PG8_SB(1, 1), b3 + hstep, voffB);
            PG8_WAIT_V(6); PG8_BAR; PG8_MMA(1, 1, At, B1); PG8_BAR;
            }
        }
        if constexpr (ALIGN_EPI) { if (wr == 0) PG8_BAR; }
        if constexpr (!Epi::AFTER_DRAIN) { E(acc, cur, wr, wc, fr, fq); S.done(cur); }
        if (!has_next) break;
#pragma unroll
        for (int a = 0; a < 2; ++a)
#pragma unroll
            for (int b = 0; b < 2; ++b)
#pragma unroll
                for (int m = 0; m < 4; ++m)
#pragma unroll
                    for (int n = 0; n < 2; ++n) acc[a][b][m][n] = (f32x4){0.f, 0.f, 0.f, 0.f};
        cur = nxt; cA = nA; cB = nB; ++ui;
        if constexpr (ALIGN_EPI) { if (wr == 1) PG8_BAR; }
    }
    PG8_WAIT_V(0);
    if constexpr (!ALIGN_EPI) { if (wr == 0) PG8_BAR; }
    PG8_BAR;
#undef PG8_SA
#undef PG8_SB
#undef PG8_STAGE
#undef PG8_LDA
#undef PG8_LDB
#undef PG8_MMA
#undef PG8_WAIT_V
#undef PG8_WAIT_L
#undef PG8_BAR
#undef PG8_SCHED
}
}

struct Args {
    const float *x, *p, *norm_mix_w, *w_in, *att_rel_bias, *w_gla_gate_up, *b_gla_gate, *gla_norm_w, *w_out, *norm_ffn_w, *w_ffn_up, *w_ffn_conv, *b_ffn_conv, *w_ffn_down,
                *norm_ple_w, *w_ple_gate, *w_ple_proj, *final_norm_w;
    float* out; unsigned char* ws;
};

__device__ __forceinline__ int map_row(int mode, int n) {
    if (mode == 1) { if (n < 2048) return n; if (n < 3072) return n + 2048; if (n < 4096) return n - 1024; if (n < 5120) return n + 1024; return n - 2048; }
    if (mode == 2) { const int half = n >= FF ? 1 : 0; const int c = n - half * FF; return (c >> 7) * 256 + half * 128 + (c & 127); }
    return n;
}
__device__ __forceinline__ void transpose_item(const float* W, int K, int ldn, int nblk, bf16_t* WT, LAS float* scr, int item, int lane, const float* kscale, int mode) {
    const int kb = item / nblk, nb = item % nblk, k0 = 32 * kb, n0 = 128 * nb;
    const int c4 = lane & 31, kh = lane >> 5;
    f32x4 v[16];
#pragma unroll
    for (int i = 0; i < 16; ++i) v[i] = *(const f32x4*)(W + (size_t)(k0 + 2 * i + kh) * ldn + n0 + 4 * c4);
#pragma unroll
    for (int i = 0; i < 16; ++i) { f32x4 t = v[i]; if (kscale) t = t * kscale[k0 + 2 * i + kh]; *(LAS f32x4*)(scr + (2 * i + kh) * 132 + 4 * c4) = t; }
    asm volatile("s_waitcnt lgkmcnt(0)" ::: "memory");
    const int c = lane & 3, nl = lane >> 2; const int drow0 = map_row(mode, n0);
#pragma unroll
    for (int j = 0; j < 8; ++j) { const int n = nl + 16 * j; const LAS float* sp = scr + (8 * c) * 132 + n;
        u32x4 o; o.x = pk2(sp[0 * 132], sp[1 * 132]); o.y = pk2(sp[2 * 132], sp[3 * 132]); o.z = pk2(sp[4 * 132], sp[5 * 132]); o.w = pk2(sp[6 * 132], sp[7 * 132]);
        *(u32x4*)(WT + (size_t)(drow0 + n) * K + k0 + 8 * c) = o; }
    asm volatile("s_waitcnt lgkmcnt(0)" ::: "memory");
}

#define XB_TMO      128
#define XB_XCNT(j)  (256  + 64 * (j))
#define XB_XSUB(j)  (1280 + 64 * (j))
#define XB_XGEN(j)  (2304 + 64 * (j))
#define XB_TOP      3328
#define XB_TOPGEN   3392
#define XCD_BAR_WORDS 3456
#define XB_SPIN_CAP (1u << 18)
__device__ __forceinline__ unsigned xb_ld(unsigned* p)              { return __hip_atomic_load(p, __ATOMIC_RELAXED, __HIP_MEMORY_SCOPE_AGENT); }
__device__ __forceinline__ unsigned xb_add(unsigned* p, unsigned v) { return __hip_atomic_fetch_add(p, v, __ATOMIC_RELAXED, __HIP_MEMORY_SCOPE_AGENT); }
__device__ __forceinline__ unsigned xb_xcc_id() { return (unsigned)__builtin_amdgcn_s_getreg((3 << 11) | 20) & 0xFu; }
#define XB_SPIN(cond, bar) do { unsigned _sp = 0; while (cond) { __builtin_amdgcn_s_sleep(1); \
    if ((++_sp & 255u) == 0u) { if (xb_ld(&(bar)[XB_TMO])) break; if (_sp > XB_SPIN_CAP) { atomicAdd(&(bar)[XB_TMO], 1u); break; } } } } while (0)
struct XcdBarrier {
    unsigned* bar; unsigned x;
    volatile LAS unsigned* st;
};
__device__ __forceinline__ XcdBarrier xcd_barrier_post(unsigned* bar, volatile LAS unsigned* st) {
    XcdBarrier b; b.bar = bar; b.x = xb_xcc_id(); b.st = st;
    if (threadIdx.x == 0) (void)xb_add(&bar[XB_XCNT(b.x)], 1u);
    return b;
}
__device__ __forceinline__ void xcd_barrier_complete(unsigned* bar, unsigned x, unsigned& nloc, unsigned& nx) {
    const unsigned G = gridDim.x * gridDim.y * gridDim.z;
    unsigned sum, cnt, mine, sp = 0u;
    for (;;) {
        sum = 0u; cnt = 0u; mine = 0u;
#pragma unroll
        for (unsigned j = 0; j < 16; ++j) { const unsigned c = xb_ld(&bar[XB_XCNT(j)]); sum += c; cnt += (c > 0u) ? 1u : 0u; mine = (j == x) ? c : mine; }
        if (sum == G) break;
        __builtin_amdgcn_s_sleep(1);
        if ((++sp & 255u) == 0u) { if (xb_ld(&bar[XB_TMO])) break; if (sp > XB_SPIN_CAP) { atomicAdd(&bar[XB_TMO], 1u); break; } }
    }
    nloc = mine > 0u ? mine : 1u; nx = cnt > 0u ? cnt : 1u;
}
__device__ __forceinline__ void xcd_barrier(const XcdBarrier& b) {
    asm volatile("s_waitcnt vmcnt(0)" ::: "memory");
    __syncthreads();
    if (threadIdx.x == 0) {
        unsigned* bar = b.bar;
        __builtin_amdgcn_s_waitcnt(0);
        unsigned nloc = b.st[0], nx = b.st[1];
        if (nloc == 0u) { xcd_barrier_complete(bar, b.x, nloc, nx); b.st[0] = nloc; b.st[1] = nx; }
        const unsigned old = xb_add(&bar[XB_XSUB(b.x)], 1u);
        const unsigned gen = old / nloc;
        if (old + 1u == (gen + 1u) * nloc) {
            __builtin_amdgcn_fence(__ATOMIC_RELEASE, "agent");
            asm volatile("s_waitcnt vmcnt(0)" ::: "memory");
            const unsigned og = xb_add(&bar[XB_TOP], 1u);
            const unsigned tg = og / nx;
            if (og + 1u == (tg + 1u) * nx) xb_add(&bar[XB_TOPGEN], 1u);
            else XB_SPIN(xb_ld(&bar[XB_TOPGEN]) == tg, bar);
            __builtin_amdgcn_fence(__ATOMIC_ACQUIRE, "agent");
            xb_add(&bar[XB_XGEN(b.x)], 1u);
            asm volatile("s_waitcnt vmcnt(0)" ::: "memory");
        } else {
            XB_SPIN(xb_ld(&bar[XB_XGEN(b.x)]) == gen, bar);
            __builtin_amdgcn_fence(__ATOMIC_ACQUIRE, "agent");
            asm volatile("s_waitcnt vmcnt(0)" ::: "memory");
        }
    }
    __syncthreads();
}

__device__ __forceinline__ void gla_decay(const Args& a, const float* glr, int n, int hg, int tid, LAS float* gL, LAS float* segtot, float (&bv)[16], float& blast) {
    const int dk = tid & 127, seg = tid >> 7, col = hg * 128 + dk;
    if (tid < 256) ((LAS f32x4*)gL)[tid] = ((const f32x4*)(glr + (size_t)n * 64 * 16))[tid];
    float w[16];
#pragma unroll
    for (int j = 0; j < 16; ++j) w[j] = a.w_gla_gate_up[j * 512 + col];
    const float bias = a.b_gla_gate[col];
    __syncthreads();
    float c = 0.f;
#pragma unroll
    for (int s = 0; s < 16; ++s) { const LAS f32x4* g4 = (const LAS f32x4*)(gL + (16 * seg + s) * 16); float logit = bias;
#pragma unroll
        for (int q = 0; q < 4; ++q) { const f32x4 g = g4[q]; logit += g[0] * w[4 * q] + g[1] * w[4 * q + 1] + g[2] * w[4 * q + 2] + g[3] * w[4 * q + 3]; }
        const float ls = fminf(logit, 0.f) - log1pf(__expf(-fabsf(logit)));
        c += ls * (1.0f / 16.0f); bv[s] = c; if ((s & 3) == 3) asm volatile("" ::: "memory"); }
    segtot[seg * 128 + dk] = c;
    __syncthreads();
    float off = 0.f, tot = 0.f;
#pragma unroll
    for (int q = 0; q < 4; ++q) { const float v = segtot[q * 128 + dk]; tot += v; if (q < seg) off += v; }
#pragma unroll
    for (int s = 0; s < 16; ++s) bv[s] += off;
    blast = tot;
}

#define LBAR() do { asm volatile("s_waitcnt lgkmcnt(0)" ::: "memory"); __builtin_amdgcn_s_barrier(); asm volatile("" ::: "memory"); } while (0)
#define STAMP(k) do { if (PROBE_T != 0 && blockIdx.x == 0 && threadIdx.x == 0) ((unsigned long long*)(a.ws + 200 * 1024))[k] = __builtin_amdgcn_s_memrealtime(); } while (0)
#define IDS() int tid = threadIdx.x; asm volatile("" : "+v"(tid)); const int lane = tid & 63, wave = __builtin_amdgcn_readfirstlane(tid >> 6); const int gw = bx * 8 + wave, gtid = bx * 512 + tid; (void)lane; (void)gw; (void)gtid;
__global__ void __launch_bounds__(512, 2) fwd_megakernel(Args a) {
    extern __shared__ __attribute__((aligned(16))) unsigned char lds_raw[];
    cg::grid_group grid = cg::this_grid();
    LAS unsigned char* lds = (LAS unsigned char*)lds_raw;
    const int tid = threadIdx.x, lane = tid & 63, wave = __builtin_amdgcn_readfirstlane(tid >> 6);
    const int G = gridDim.x, bx = blockIdx.x;
    const int gw = bx * 8 + wave, NGW = G * 8;
    const int gtid = bx * 512 + tid, NT = G * 512;
    unsigned char* ws = a.ws;
    float* ssq1 = (float*)(ws + WS_SSQ1); float* ssq2 = (float*)(ws + WS_SSQ2); float* ssq3 = (float*)(ws + WS_SSQ3);
    float* glr = (float*)(ws + WS_GLR); float* glr1 = (float*)(ws + WS_GLR1); float* decb = (float*)(ws + WS_DEC); float* bcum = (float*)(ws + WS_BCUM); bf16_t* upd = (bf16_t*)(ws + WS_UPD);
    bf16_t* WgT = (bf16_t*)(ws + WS_WG); bf16_t* WppT = (bf16_t*)(ws + WS_WPP); bf16_t* WinT = (bf16_t*)(ws + WS_WIN); bf16_t* WoutT = (bf16_t*)(ws + WS_WOUT);
    bf16_t* WupT = (bf16_t*)(ws + WS_WUP); bf16_t* WdnT = (bf16_t*)(ws + WS_WDN); bf16_t* WpgT = (bf16_t*)(ws + WS_WPG); bf16_t* pb = (bf16_t*)(ws + WS_PB);
    bf16_t* h0 = (bf16_t*)(ws + WS_H0); bf16_t* projR = (bf16_t*)(ws + WS_PROJ); bf16_t* vT = (bf16_t*)(ws + WS_VT);
    bf16_t* ycat = (bf16_t*)a.out;
    float* rstd0 = (float*)(ws + WS_RSTD0); bf16_t* x1b = (bf16_t*)(ws + WS_X1B); bf16_t* gbuf = (bf16_t*)(ws + WS_G);
    float* tailb = (float*)(ws + WS_TAIL); float* headb = (float*)(ws + WS_HEAD); bf16_t* ppb = (bf16_t*)(ws + WS_PP); bf16_t* x2b = (bf16_t*)(ws + WS_X2B); bf16_t* x3b = (bf16_t*)(ws + WS_X3B);

    volatile LAS unsigned* bst = (volatile LAS unsigned*)(lds + LDS_BYTES - 64);
    if (threadIdx.x < 16) bst[threadIdx.x] = 0u;
    unsigned* barw = (unsigned*)(ws + WS_BAR);
    __syncthreads();
    const XcdBarrier xbar = xcd_barrier_post(barw, bst);
    if (a.out == nullptr) grid.sync();
    STAMP(0);
    REPS(1) {
        LAS float* scr = (LAS float*)(lds + wave * 16896);
        constexpr int I_IN = 64 * 48, I_OUT = 64 * 16, I_UP = 64 * 88, I_DN = 176 * 16, I_PG = 64 * 16, I_PP = 8 * 16;
        constexpr int NITEMS = I_IN + I_OUT + I_UP + I_DN + I_PG + I_PP;
        for (int it = gw; it < NITEMS; it += NGW) {
            int r = it;
            if (r < I_IN) { transpose_item(a.w_in, 2048, 6160, 48, WinT, scr, r, lane, a.norm_mix_w, 1); continue; } r -= I_IN;
            if (r < I_OUT) { transpose_item(a.w_out, 2048, 2048, 16, WoutT, scr, r, lane, nullptr, 0); continue; } r -= I_OUT;
            if (r < I_UP) { transpose_item(a.w_ffn_up, 2048, 2 * FF, 88, WupT, scr, r, lane, a.norm_ffn_w, 2); continue; } r -= I_UP;
            if (r < I_DN) { transpose_item(a.w_ffn_down, FF, 2048, 16, WdnT, scr, r, lane, nullptr, 0); continue; } r -= I_DN;
            if (r < I_PG) { transpose_item(a.w_ple_gate, 2048, 2048, 16, WpgT, scr, r, lane, a.norm_ple_w, 0); continue; } r -= I_PG;
            transpose_item(a.w_ple_proj, PLE, 2048, 16, WppT, scr, r, lane, nullptr, 0);
        }
        for (int i = gtid; i < 16 * 2048; i += NT) { const int j = i >> 11, k = i & 2047; WgT[i] = (bf16_t)f2bf(a.w_in[(size_t)k * 6160 + 6144 + j] * a.norm_mix_w[k]); }
        for (int m = gw; m < T; m += 2 * NGW) {
            const int m1 = m + NGW; const bool two = m1 < T;
            const f32x4* xr0 = (const f32x4*)(a.x + (size_t)m * D) + lane; const f32x4* xr1 = (const f32x4*)(a.x + (size_t)(two ? m1 : m) * D) + lane;
            f32x4 v0[8], v1[8]; float s0 = 0.f, s1 = 0.f;
#pragma unroll
            for (int j = 0; j < 8; ++j) { v0[j] = xr0[64 * j]; v1[j] = xr1[64 * j]; }
            u32x2* o0 = (u32x2*)(h0 + (size_t)m * D) + lane; u32x2* o1 = (u32x2*)(h0 + (size_t)m1 * D) + lane;
#pragma unroll
            for (int j = 0; j < 8; ++j) { s0 += (v0[j].x * v0[j].x + v0[j].y * v0[j].y) + (v0[j].z * v0[j].z + v0[j].w * v0[j].w); s1 += (v1[j].x * v1[j].x + v1[j].y * v1[j].y) + (v1[j].z * v1[j].z + v1[j].w * v1[j].w);
                u32x2 o; o.x = pk2(v0[j].x, v0[j].y); o.y = pk2(v0[j].z, v0[j].w); o0[64 * j] = o;
                if (two) { u32x2 q; q.x = pk2(v1[j].x, v1[j].y); q.y = pk2(v1[j].z, v1[j].w); o1[64 * j] = q; } }
            s0 = wave_sum(s0); s1 = wave_sum(s1);
            if (lane == 0) { rstd0[m] = frsq(s0 * (1.0f / D) + EPS); if (two) rstd0[m1] = frsq(s1 * (1.0f / D) + EPS); }
        }
        for (int i = gtid; i < T * PLE / 4; i += NT) { const f32x4 v = ((const f32x4*)a.p)[i]; u32x2 o; o.x = pk2(v.x, v.y); o.y = pk2(v.z, v.w); ((u32x2*)pb)[i] = o; }
        for (int i = gtid; i < 3 * T; i += NT) ssq1[i] = 0.f;
    }
    if (PROBE_T != 0) { asm volatile("s_waitcnt vmcnt(0)" ::: "memory"); }
    xcd_barrier(xbar);
    STAMP(1);

    REPS(2) {
        IDS();
        for (int task = gw; task < 2 * (T / 16); task += NGW) {
            const int fr = lane & 15, fq = lane >> 4; const int r0 = (task >> 1) * 16, kh = (task & 1) * (D / 2);
            const bf16_t* ap = h0 + (size_t)(r0 + fr) * D + kh + 8 * fq; const bf16_t* bp = WgT + (size_t)fr * D + kh + 8 * fq;
            f32x4 acc = {0.f, 0.f, 0.f, 0.f};
#pragma unroll 8
            for (int k0 = 0; k0 < D / 2; k0 += 32) { const bf16x8 av = *(const bf16x8*)(ap + k0), bv = *(const bf16x8*)(bp + k0); acc = __builtin_amdgcn_mfma_f32_16x16x32_bf16(av, bv, acc, 0, 0, 0); }
            float* gp = (task & 1) ? glr1 : glr;
#pragma unroll
            for (int j = 0; j < 4; ++j) gp[(size_t)(r0 + 4 * fq + j) * 16 + fr] = acc[j] * rstd0[r0 + 4 * fq + j];
        }
        __syncthreads();
        { pg8::Gemm g{h0, WinT, T, NR, D}; pg8::StaticOrder S; S.init(T, NR, G, bx); pg8::EpiBf16 E{projR, NR, rstd0, nullptr};
          pg8::gemm_phase<pg8::EpiBf16, pg8::StaticOrder, true, true>(lds, g, S, E); }
        { pg8::Gemm g{WinT + (size_t)NR * D, h0, 2048, T, D}; pg8::StaticOrder S; S.init(2048, T, G, bx); pg8::EpiBf16 E{vT, T, nullptr, rstd0};
          pg8::gemm_phase<pg8::EpiBf16, pg8::StaticOrder, true, true>(lds, g, S, E); }
    }
    xcd_barrier(xbar);
    STAMP(2);

    REPS(3) {
        IDS();
        LAS float* gL = (LAS float*)lds; LAS float* segtot = (LAS float*)(lds + 4096); LAS bf16_t* kT = (LAS bf16_t*)(lds + 8192);
        const int fr = lane & 15, fq = lane >> 4, dk = tid & 127, seg = tid >> 7;
        f32x4 g4r = {0.f, 0.f, 0.f, 0.f}; unsigned short kraw[16]; bf16x8 vB[2][2], vBn[2][2];
#define G1_LOAD(u_, VB) do { const int n_ = (u_) >> 2, hg_ = (u_) & 3; if (tid < 256) g4r = ((const f32x4*)(glr + (size_t)n_ * 64 * 16))[tid] + ((const f32x4*)(glr1 + (size_t)n_ * 64 * 16))[tid]; \
            _Pragma("unroll") for (int s = 0; s < 16; ++s) kraw[s] = projR[((size_t)n_ * 64 + 16 * seg + s) * NR + KG + hg_ * 128 + dk]; \
            _Pragma("unroll") for (int nt2 = 0; nt2 < 2; ++nt2) _Pragma("unroll") for (int ks = 0; ks < 2; ++ks) VB[nt2][ks] = *(const bf16x8*)(vT + (size_t)(1024 + hg_ * 256 + 16 * (2 * wave + nt2) + fr) * T + n_ * 64 + 32 * ks + 8 * fq); } while (0)
        if (bx < NCH * 4) G1_LOAD(bx, vB);
        for (int unit = bx; unit < NCH * 4; unit += G) {
            const int n = unit >> 2, hg = unit & 3, col = hg * 128 + dk;
            float w[16];
#pragma unroll
            for (int j = 0; j < 16; ++j) w[j] = a.w_gla_gate_up[j * 512 + col];
            const float bias = a.b_gla_gate[col];
            if (tid < 256) ((LAS f32x4*)gL)[tid] = g4r;
            LBAR();
            float bv[16]; float c = 0.f;
#pragma unroll
            for (int s = 0; s < 16; ++s) { const LAS f32x4* g4 = (const LAS f32x4*)(gL + (16 * seg + s) * 16); float logit = bias;
#pragma unroll
                for (int q = 0; q < 4; ++q) { const f32x4 g = g4[q]; logit += g[0] * w[4 * q] + g[1] * w[4 * q + 1] + g[2] * w[4 * q + 2] + g[3] * w[4 * q + 3]; }
                const float ls = fminf(logit, 0.f) - __logf(1.0f + __expf(-fabsf(logit)));
                c += ls * (1.0f / 16.0f); bv[s] = c; if ((s & 3) == 3) asm volatile("" ::: "memory"); }
            segtot[seg * 128 + dk] = c;
            LBAR();
            float off = 0.f, blast = 0.f;
#pragma unroll
            for (int q = 0; q < 4; ++q) { const float v = segtot[q * 128 + dk]; blast += v; if (q < seg) off += v; }
            unsigned kw[8];
#pragma unroll
            for (int s = 0; s < 16; s += 2) { const float b0 = bv[s] + off, b1 = bv[s + 1] + off; const size_t t = (size_t)n * 64 + 16 * seg + s;
                bcum[t * 512 + col] = b0; bcum[(t + 1) * 512 + col] = b1;
                kw[s >> 1] = pk2(bf2f(kraw[s]) * __expf(blast - b0), bf2f(kraw[s + 1]) * __expf(blast - b1)); }
            *(LAS u32x4*)(kT + dk * 72 + 16 * seg) = (u32x4){kw[0], kw[1], kw[2], kw[3]}; *(LAS u32x4*)(kT + dk * 72 + 16 * seg + 8) = (u32x4){kw[4], kw[5], kw[6], kw[7]};
            if (seg == 0) decb[(size_t)unit * 128 + dk] = __expf(blast);
            LBAR();
            if (unit + G < NCH * 4) G1_LOAD(unit + G, vBn);
            f32x4 acc[8][2];
#pragma unroll
            for (int mt = 0; mt < 8; ++mt) { acc[mt][0] = (f32x4){0.f, 0.f, 0.f, 0.f}; acc[mt][1] = (f32x4){0.f, 0.f, 0.f, 0.f}; }
#pragma unroll
            for (int mt = 0; mt < 8; ++mt)
#pragma unroll
                for (int ks = 0; ks < 2; ++ks) { const bf16x8 ak = *(const LAS bf16x8*)(kT + (16 * mt + fr) * 72 + 32 * ks + 8 * fq);
                    acc[mt][0] = __builtin_amdgcn_mfma_f32_16x16x32_bf16(ak, vB[0][ks], acc[mt][0], 0, 0, 0);
                    acc[mt][1] = __builtin_amdgcn_mfma_f32_16x16x32_bf16(ak, vB[1][ks], acc[mt][1], 0, 0, 0); }
#pragma unroll
            for (int mt = 0; mt < 8; ++mt)
#pragma unroll
                for (int nt2 = 0; nt2 < 2; ++nt2) { const int dvv = 16 * (2 * wave + nt2) + fr; u32x2 wv; wv.x = pk2(acc[mt][nt2][0], acc[mt][nt2][1]); wv.y = pk2(acc[mt][nt2][2], acc[mt][nt2][3]);
                    *(u32x2*)(upd + (size_t)unit * 32768 + dvv * 128 + 16 * mt + 4 * fq) = wv; }
#pragma unroll
            for (int nt2 = 0; nt2 < 2; ++nt2)
#pragma unroll
                for (int ks = 0; ks < 2; ++ks) vB[nt2][ks] = vBn[nt2][ks];
        }
#undef G1_LOAD
    }
    xcd_barrier(xbar);
    STAMP(3);

    { IDS();
    for (int g2 = bx * 256 + tid; tid < 256 && g2 < 4 * 16384; g2 += G * 256) {
        const int hg = g2 >> 14, rem = (g2 & 16383) * 2, dk = rem & 127;
        unsigned* p = (unsigned*)(upd + (size_t)hg * 32768 + rem); const f32x2* dp = (const f32x2*)(decb + hg * 128 + dk);
        float S0 = 0.f, S1 = 0.f;
        unsigned ua[16], ub[16]; f32x2 da[16], db[16];
#define SCAN_LOAD(U, Dd, n0) do { _Pragma("unroll") for (int k = 0; k < 16; ++k) { U[k] = p[(size_t)((n0) + k) * 65536]; Dd[k] = dp[((n0) + k) * 256]; } } while (0)
#define SCAN_STEP(U, Dd, n0) do { _Pragma("unroll") for (int k = 0; k < 16; ++k) { p[(size_t)((n0) + k) * 65536] = pk2(S0, S1); S0 = Dd[k].x * S0 + bflo(U[k]); S1 = Dd[k].y * S1 + bfhi(U[k]); } } while (0)
        SCAN_LOAD(ua, da, 0);
        for (int n = 0; n < NCH; n += 32) {
            SCAN_LOAD(ub, db, n + 16);
            SCAN_STEP(ua, da, n);
            if (n + 32 < NCH) SCAN_LOAD(ua, da, n + 32);
            SCAN_STEP(ub, db, n + 16);
        }
#undef SCAN_LOAD
#undef SCAN_STEP
    } }
    if (PROBE_T != 0) { asm volatile("s_waitcnt vmcnt(0)" ::: "memory"); grid.sync(); STAMP(12); }
    {
        IDS();
        constexpr int CHB = 18432, BUFB = 3 * CHB;
        LAS unsigned char* kvb = lds; LAS float* bt = (LAS float*)(lds + 2 * BUFB);
        const int fr = lane & 15, fq = lane >> 4, hl = wave >> 2, qt = wave & 3;
        constexpr float LOG2E = 1.4426950408889634f;
        const int prow = (tid >> 3) & 63, pseg = tid & 7, pofs = prow * 144 + pseg * 16;
#define ATT_LOADK(cc, hpp, g) do { _Pragma("unroll") for (int q3 = 0; q3 < 3; ++q3) { const int kc_ = ((cc) - 8 + 3 * (g) + q3) < 0 ? 0 : ((cc) - 8 + 3 * (g) + q3); _Pragma("unroll") for (int r = 0; r < 2; ++r) \
            pre[q3][r] = *(const u32x4*)(projR + (size_t)(kc_ * 64 + prow) * NR + KA + 64 * (2 * (hpp) + r) + 8 * pseg); } } while (0)
#define ATT_LOADV(cc, hpp, g) do { _Pragma("unroll") for (int q3 = 0; q3 < 3; ++q3) { const int kc_ = ((cc) - 8 + 3 * (g) + q3) < 0 ? 0 : ((cc) - 8 + 3 * (g) + q3); _Pragma("unroll") for (int r = 0; r < 2; ++r) \
            pre[q3][r] = *(const u32x4*)(vT + (size_t)(64 * (2 * (hpp) + r) + prow) * T + kc_ * 64 + 8 * pseg); } } while (0)
#define ATT_WRITE(buf) do { _Pragma("unroll") for (int q3 = 0; q3 < 3; ++q3) _Pragma("unroll") for (int r = 0; r < 2; ++r) *(LAS u32x4*)(kvb + (buf) * BUFB + q3 * CHB + r * 9216 + pofs) = pre[q3][r]; } while (0)
#define ATT_LOADQ(cc, hpp) do { _Pragma("unroll") for (int ks = 0; ks < 2; ++ks) qn[ks] = *(const bf16x8*)(projR + (size_t)(64 * (cc) + 16 * qt + fr) * NR + QA + 64 * (2 * (hpp) + hl) + 32 * ks + 8 * fq); } while (0)
        const int NU = NCH * 8 * (PROBE_DUP == 4 ? 2 : 1);
        u32x4 pre[3][2]; bf16x8 qn[2]; int hp_tab = -1;
        if (bx < NU) { const int c0 = (bx >> 3) & (NCH - 1), hp0 = bx & 7; ATT_LOADQ(c0, hp0); ATT_LOADK(c0, hp0, 0); ATT_WRITE(0); }
        for (int unit = bx; unit < NU; unit += G) {
            const int c = (unit >> 3) & (NCH - 1), hp = unit & 7, h = 2 * hp + hl;
            const int un = unit + G, cn = (un >> 3) & (NCH - 1), hpn = un & 7;
            if (hp != hp_tab) { for (int i = tid; i < 1026; i += 512) { const int hh = i >= 513 ? 1 : 0; bt[hh * 516 + (i - hh * 513)] = a.att_rel_bias[(2 * hp + hh) * 513 + (i - hh * 513)] * LOG2E; } hp_tab = hp; }
            const bf16x8 qv0 = qn[0], qv1 = qn[1];
            __syncthreads();
            f32x4 S[36];
            const LAS float* btl = bt + hl * 516 + 256; const int relb = 16 * qt + fr + 512 - 4 * fq;
            const float b512 = btl[256];
#pragma unroll
            for (int g = 0; g < 3; ++g) {
                if (g < 2) ATT_LOADK(c, hp, g + 1); else ATT_LOADV(c, hp, 0);
#pragma unroll
                for (int q3 = 0; q3 < 3; ++q3) { const int j = 3 * g + q3;
#pragma unroll
                    for (int kt4 = 0; kt4 < 4; ++kt4) { f32x4 acc = {0.f, 0.f, 0.f, 0.f};
                        const LAS unsigned char* kp = kvb + (g & 1) * BUFB + q3 * CHB + hl * 9216 + (16 * kt4 + fr) * 144 + 16 * fq;
                        acc = __builtin_amdgcn_mfma_f32_16x16x32_bf16(*(const LAS bf16x8*)kp, qv0, acc, 0, 0, 0);
                        acc = __builtin_amdgcn_mfma_f32_16x16x32_bf16(*(const LAS bf16x8*)(kp + 64), qv1, acc, 0, 0, 0);
#pragma unroll
                        for (int jj = 0; jj < 4; ++jj) { float bias = b512;
                            if (j == 4) { int rel = relb - (64 * j + 16 * kt4 + jj); rel = rel > 256 ? 256 : rel; bias = btl[rel]; }
                            else if (j > 4) bias = btl[relb - (64 * j + 16 * kt4 + jj)];
                            acc[jj] = acc[jj] * (0.125f * LOG2E) + bias; }
                        S[4 * j + kt4] = acc; }
                    __builtin_amdgcn_sched_barrier(0); }
                ATT_WRITE((g + 1) & 1);
                __syncthreads();
            }
            if (c < 8) {
#pragma unroll
                for (int j = 0; j < 8; ++j) if (j < 8 - c) {
#pragma unroll
                    for (int kt4 = 0; kt4 < 4; ++kt4) S[4 * j + kt4] = (f32x4){-1e30f, -1e30f, -1e30f, -1e30f}; } }
            float mx = -1e30f;
#pragma unroll
            for (int i = 0; i < 36; ++i) mx = fmaxf(mx, fmaxf(fmaxf(S[i][0], S[i][1]), fmaxf(S[i][2], S[i][3])));
            mx = fmaxf(mx, __shfl_xor(mx, 16)); mx = fmaxf(mx, __shfl_xor(mx, 32));
            f32x2 l2 = {0.f, 0.f};
            u32x2 PW[36];
#pragma unroll
            for (int i = 0; i < 36; ++i) { const f32x4 d = S[i] - mx; const float p0 = __builtin_amdgcn_exp2f(d[0]), p1 = __builtin_amdgcn_exp2f(d[1]), p2 = __builtin_amdgcn_exp2f(d[2]), p3 = __builtin_amdgcn_exp2f(d[3]);
                l2 = l2 + (f32x2){p0, p1}; l2 = l2 + (f32x2){p2, p3}; PW[i].x = pg8::cvt_pk_bf16(p0, p1); PW[i].y = pg8::cvt_pk_bf16(p2, p3); asm volatile("" : "+v"(PW[i].x), "+v"(PW[i].y));
                if ((i & 3) == 3) __builtin_amdgcn_sched_barrier(0); }
            float l = l2[0] + l2[1];
            l += __shfl_xor(l, 16); l += __shfl_xor(l, 32);
            f32x4 O[4];
#pragma unroll
            for (int dt = 0; dt < 4; ++dt) O[dt] = (f32x4){0.f, 0.f, 0.f, 0.f};
            if (un < NU) ATT_LOADQ(cn, hpn);
#pragma unroll
            for (int g = 0; g < 3; ++g) {
                if (g < 2) ATT_LOADV(c, hp, g + 1); else if (un < NU) ATT_LOADK(cn, hpn, 0);
                const int buf = (3 + g) & 1;
#pragma unroll
                for (int q3 = 0; q3 < 3; ++q3) { const int j = 3 * g + q3;
#pragma unroll
                    for (int a2 = 0; a2 < 2; ++a2) { const u32x4 pw = {PW[4 * j + 2 * a2].x, PW[4 * j + 2 * a2].y, PW[4 * j + 2 * a2 + 1].x, PW[4 * j + 2 * a2 + 1].y};
                        const bf16x8 pa = __builtin_bit_cast(bf16x8, pw);
#pragma unroll
                        for (int dt = 0; dt < 4; ++dt) { const LAS unsigned char* vp = kvb + buf * BUFB + q3 * CHB + hl * 9216 + (16 * dt + fr) * 144 + (32 * a2 + 4 * fq) * 2;
                            const u32x2 lo = *(const LAS u32x2*)vp, hi = *(const LAS u32x2*)(vp + 32);
                            const u32x4 vw = {lo.x, lo.y, hi.x, hi.y};
                            O[dt] = __builtin_amdgcn_mfma_f32_16x16x32_bf16(pa, __builtin_bit_cast(bf16x8, vw), O[dt], 0, 0, 0); } } }
                if (g < 2 || un < NU) ATT_WRITE((3 + g + 1) & 1);
                if (g < 2) __syncthreads();
            }
#pragma unroll
            for (int jj = 0; jj < 4; ++jj) { const float linv = 1.0f / __shfl(l, 4 * fq + jj); const size_t t = (size_t)64 * c + 16 * qt + 4 * fq + jj;
#pragma unroll
                for (int dt = 0; dt < 4; ++dt) ycat[t * D + 64 * h + 16 * dt + fr] = (bf16_t)f2bf(O[dt][jj] * linv); }
        }
#undef ATT_LOADK
#undef ATT_LOADV
#undef ATT_WRITE
#undef ATT_LOADQ
    }
    xcd_barrier(xbar);
    STAMP(4);

    REPS(5) {
        IDS();
        LAS float* red = (LAS float*)(lds + 6144);
        LAS bf16_t* qd = (LAS bf16_t*)(lds + 8192); LAS bf16_t* ki = (LAS bf16_t*)(lds + 25600); LAS bf16_t* aL = (LAS bf16_t*)(lds + 43008);
        const int fr = lane & 15, fq = lane >> 4, dk = tid & 127, seg = tid >> 7;
        f32x4 braw[2][2]; u32x4 qraw[2], kraw[2];
        const int pi = tid >> 4, pg = tid & 15;
#define G3_LOAD(u_) do { const int n_ = (u_) >> 2, hg_ = (u_) & 3; _Pragma("unroll") for (int r = 0; r < 2; ++r) { const size_t t_ = (size_t)n_ * 64 + pi + 32 * r; \
            braw[r][0] = *(const f32x4*)(bcum + t_ * 512 + hg_ * 128 + 8 * pg); braw[r][1] = *(const f32x4*)(bcum + t_ * 512 + hg_ * 128 + 8 * pg + 4); \
            qraw[r] = *(const u32x4*)(projR + t_ * NR + QG + hg_ * 128 + 8 * pg); kraw[r] = *(const u32x4*)(projR + t_ * NR + KG + hg_ * 128 + 8 * pg); } } while (0)
        if (bx < NCH * 4) G3_LOAD(bx);
        for (int unit = bx; unit < NCH * 4; unit += G) {
            const int n = unit >> 2, hg = unit & 3;
            bf16x8 vB[2][2], sB[2][4];
#pragma unroll
            for (int nt2 = 0; nt2 < 2; ++nt2) { const int dvv = 16 * (2 * wave + nt2) + fr;
#pragma unroll
                for (int ks = 0; ks < 2; ++ks) vB[nt2][ks] = *(const bf16x8*)(vT + (size_t)(1024 + hg * 256 + dvv) * T + n * 64 + 32 * ks + 8 * fq);
#pragma unroll
                for (int ks = 0; ks < 4; ++ks) sB[nt2][ks] = *(const bf16x8*)(upd + (size_t)unit * 32768 + dvv * 128 + 32 * ks + 8 * fq); }
#pragma unroll
            for (int r = 0; r < 2; ++r) { const int i = pi + 32 * r; u32x4 qo, ko;
#pragma unroll
                for (int e = 0; e < 4; ++e) { const float b0 = e < 2 ? braw[r][0][2 * e] : braw[r][1][2 * e - 4], b1 = e < 2 ? braw[r][0][2 * e + 1] : braw[r][1][2 * e - 3];
                    qo[e] = pk2(bflo(qraw[r][e]) * 0.08838834764831845f * __expf(b0), bfhi(qraw[r][e]) * 0.08838834764831845f * __expf(b1));
                    ko[e] = pk2(bflo(kraw[r][e]) * __expf(-b0), bfhi(kraw[r][e]) * __expf(-b1)); }
                *(LAS u32x4*)(qd + i * 136 + 8 * pg) = qo; *(LAS u32x4*)(ki + i * 136 + 8 * pg) = ko; }
            LBAR();
            if (unit + G < NCH * 4) G3_LOAD(unit + G);
#pragma unroll
            for (int rep = 0; rep < 2; ++rep) { const int idx = wave + 8 * rep, it = idx >> 2, jt = idx & 3;
                f32x4 c = {0.f, 0.f, 0.f, 0.f};
                if (jt <= it) {
#pragma unroll
                    for (int ks = 0; ks < 4; ++ks) { const bf16x8 av = *(const LAS bf16x8*)(qd + (16 * it + fr) * 136 + 32 * ks + 8 * fq), bv8 = *(const LAS bf16x8*)(ki + (16 * jt + fr) * 136 + 32 * ks + 8 * fq);
                        c = __builtin_amdgcn_mfma_f32_16x16x32_bf16(av, bv8, c, 0, 0, 0); } }
#pragma unroll
                for (int jj = 0; jj < 4; ++jj) { const int i = 16 * it + 4 * fq + jj, j = 16 * jt + fr; aL[i * 72 + j] = (bf16_t)f2bf(j <= i ? c[jj] : 0.f); } }
            LBAR();
            unsigned short rr[4][4][2];
#pragma unroll
            for (int mt = 0; mt < 4; ++mt)
#pragma unroll
                for (int jj = 0; jj < 4; ++jj)
#pragma unroll
                    for (int nt2 = 0; nt2 < 2; ++nt2) rr[mt][jj][nt2] = projR[((size_t)n * 64 + 16 * mt + 4 * fq + jj) * NR + RG + hg * 256 + 16 * (2 * wave + nt2) + fr];
            f32x4 acc[4][2];
#pragma unroll
            for (int mt = 0; mt < 4; ++mt) { acc[mt][0] = (f32x4){0.f, 0.f, 0.f, 0.f}; acc[mt][1] = (f32x4){0.f, 0.f, 0.f, 0.f}; }
#pragma unroll
            for (int nt2 = 0; nt2 < 2; ++nt2)
#pragma unroll
                for (int mt = 0; mt < 4; ++mt) {
#pragma unroll
                    for (int ks = 0; ks < 2; ++ks) acc[mt][nt2] = __builtin_amdgcn_mfma_f32_16x16x32_bf16(*(const LAS bf16x8*)(aL + (16 * mt + fr) * 72 + 32 * ks + 8 * fq), vB[nt2][ks], acc[mt][nt2], 0, 0, 0);
#pragma unroll
                    for (int ks = 0; ks < 4; ++ks) acc[mt][nt2] = __builtin_amdgcn_mfma_f32_16x16x32_bf16(*(const LAS bf16x8*)(qd + (16 * mt + fr) * 136 + 32 * ks + 8 * fq), sB[nt2][ks], acc[mt][nt2], 0, 0, 0); }
#pragma unroll
            for (int mt = 0; mt < 4; ++mt)
#pragma unroll
                for (int jj = 0; jj < 4; ++jj) { float p = acc[mt][0][jj] * acc[mt][0][jj] + acc[mt][1][jj] * acc[mt][1][jj];
                    p += __shfl_xor(p, 1); p += __shfl_xor(p, 2); p += __shfl_xor(p, 4); p += __shfl_xor(p, 8);
                    if (fr == 0) red[wave * 64 + 16 * mt + 4 * fq + jj] = p; }
            LBAR();
            const float gw0 = a.gla_norm_w[16 * (2 * wave) + fr], gw1 = a.gla_norm_w[16 * (2 * wave + 1) + fr];
#pragma unroll
            for (int mt = 0; mt < 4; ++mt)
#pragma unroll
                for (int jj = 0; jj < 4; ++jj) { const int i = 16 * mt + 4 * fq + jj; float ss = 0.f;
#pragma unroll
                    for (int w8 = 0; w8 < 8; ++w8) ss += red[w8 * 64 + i];
                    const float rstd = frsq(ss * (1.0f / 256.0f) + EPS); const size_t t = (size_t)n * 64 + i;
#pragma unroll
                    for (int nt2 = 0; nt2 < 2; ++nt2) { const int dvv = 16 * (2 * wave + nt2) + fr;
                        const float r = bf2f(rr[mt][jj][nt2]);
                        const float y = acc[mt][nt2][jj] * rstd * (nt2 ? gw1 : gw0) * (r * fsigmoid(r));
                        ycat[t * D + 1024 + hg * 256 + dvv] = (bf16_t)f2bf(y); } }
        }
#undef G3_LOAD
    }
    xcd_barrier(xbar);
    STAMP(5);

    { pg8::Gemm g{ycat, WoutT, T, D, D}; pg8::StaticOrder S; S.init(T, D, G, bx); pg8::EpiResid<true> E{h0, x1b, ssq1};
      pg8::gemm_phase<pg8::EpiResid<true>, pg8::StaticOrder, true, true>(lds, g, S, E); }
    xcd_barrier(xbar);
    STAMP(6);

#ifndef NO_UP
    REPS(6) { pg8::Gemm g{x1b, WupT, T, 2 * FF, D}; pg8::StaticOrder S; S.init(T, 2 * FF, G, bx); pg8::EpiUp E{gbuf, ssq1, a.w_ffn_conv, a.b_ffn_conv, tailb, headb};
      pg8::gemm_phase<pg8::EpiUp, pg8::StaticOrder, true, true>(lds, g, S, E); }
#endif
    xcd_barrier(xbar);
    STAMP(7);

    { IDS();
    for (int i = gtid; i < NCH * 2 * (FF / 4); i += NT) {
        const int c4 = i % (FF / 4), gj = i / (FF / 4), j = gj & 1, grp = gj >> 1; const int row = grp * 64 + j, C = 4 * c4;
        const float* tl = tailb + (size_t)(grp - 1) * 2 * (2 * FF); const float* hd = headb + (size_t)grp * 2 * (2 * FF);
        const f32x4 z = {0.f, 0.f, 0.f, 0.f};
        f32x4 ug0, uv0, ug1, uv1, ug2, uv2;
        if (j == 0) { ug0 = grp ? *(const f32x4*)(tl + C) : z; uv0 = grp ? *(const f32x4*)(tl + FF + C) : z; ug1 = grp ? *(const f32x4*)(tl + 2 * FF + C) : z; uv1 = grp ? *(const f32x4*)(tl + 3 * FF + C) : z;
                      ug2 = *(const f32x4*)(hd + C); uv2 = *(const f32x4*)(hd + FF + C); }
        else { ug0 = grp ? *(const f32x4*)(tl + 2 * FF + C) : z; uv0 = grp ? *(const f32x4*)(tl + 3 * FF + C) : z; ug1 = *(const f32x4*)(hd + C); uv1 = *(const f32x4*)(hd + FF + C);
               ug2 = *(const f32x4*)(hd + 2 * FF + C); uv2 = *(const f32x4*)(hd + 3 * FF + C); }
        const float* cw = a.w_ffn_conv; const float* cb = a.b_ffn_conv;
        const f32x4 yg = *(const f32x4*)(cb + C) + *(const f32x4*)(cw + C) * ug0 + *(const f32x4*)(cw + 2 * FF + C) * ug1 + *(const f32x4*)(cw + 4 * FF + C) * ug2;
        const f32x4 yv = *(const f32x4*)(cb + FF + C) + *(const f32x4*)(cw + FF + C) * uv0 + *(const f32x4*)(cw + 3 * FF + C) * uv1 + *(const f32x4*)(cw + 5 * FF + C) * uv2;
        u32x2 o; o.x = pk2(pg8::gelu_tanh(yg[0]) * yv[0], pg8::gelu_tanh(yg[1]) * yv[1]); o.y = pk2(pg8::gelu_tanh(yg[2]) * yv[2], pg8::gelu_tanh(yg[3]) * yv[3]);
        *(u32x2*)(gbuf + (size_t)row * FF + C) = o;
    } }
    xcd_barrier(xbar);
    STAMP(8);

    { pg8::Gemm g{gbuf, WdnT, T, D, FF}; pg8::StaticOrder S; S.init(T, D, G, bx); pg8::EpiResid<true> E{x1b, x2b, ssq2};
      pg8::gemm_phase<pg8::EpiResid<true>, pg8::StaticOrder, true, true>(lds, g, S, E); }
    { pg8::Gemm g{pb, WppT, T, D, PLE}; pg8::StaticOrder S; S.init(T, D, G, bx); pg8::EpiBf16 E{ppb, D, nullptr, nullptr};
      pg8::gemm_phase<pg8::EpiBf16, pg8::StaticOrder, true, true>(lds, g, S, E); }
    xcd_barrier(xbar);
    STAMP(9);

    { pg8::Gemm g{x2b, WpgT, T, D, D}; pg8::StaticOrder S; S.init(T, D, G, bx); pg8::EpiPle E{x2b, x3b, ppb, ssq2, ssq3};
      pg8::gemm_phase<pg8::EpiPle, pg8::StaticOrder, true, true>(lds, g, S, E); }
    xcd_barrier(xbar);
    STAMP(10);

    { IDS();
    for (int m = gw; m < T; m += NGW) {
        const float rstd = frsq(ssq3[m] * (1.0f / D) + EPS);
        const u32x4* xr = (const u32x4*)(x3b + (size_t)m * D) + lane; f32x4* orow = (f32x4*)(a.out + (size_t)m * D); const f32x4* wr4 = (const f32x4*)a.final_norm_w;
#pragma unroll
        for (int j = 0; j < 4; ++j) { const u32x4 xw = xr[64 * j]; const int c4 = (64 * j + lane) * 2; const f32x4 w0 = wr4[c4], w1 = wr4[c4 + 1];
            f32x4 v0 = {bflo(xw.x) * rstd * w0.x, bfhi(xw.x) * rstd * w0.y, bflo(xw.y) * rstd * w0.z, bfhi(xw.y) * rstd * w0.w};
            f32x4 v1 = {bflo(xw.z) * rstd * w1.x, bfhi(xw.z) * rstd * w1.y, bflo(xw.w) * rstd * w1.z, bfhi(xw.w) * rstd * w1.w};
            orow[c4] = v0; orow[c4 + 1] = v1; }
    } }
    if (PROBE_DUP == 7) { for (int i_ = 0; i_ < 20; ++i_) grid.sync(); }
    if (PROBE_T != 0) {
        asm volatile("s_waitcnt vmcnt(0)" ::: "memory"); grid.sync(); STAMP(11); grid.sync();
        unsigned probe_m = 50000u;
        if (PROBE_T != 100) { const unsigned long long* tsb = (const unsigned long long*)(a.ws + 200 * 1024); constexpr int HI_ = PROBE_T == 13 ? 12 : (PROBE_T == 14 ? 4 : (PROBE_T == 15 ? 11 : PROBE_T)), LO_ = PROBE_T == 13 ? 3 : (PROBE_T == 14 ? 12 : (PROBE_T == 15 ? 0 : PROBE_T - 1));
            probe_m = (unsigned)(__hip_atomic_load(tsb + HI_, __ATOMIC_RELAXED, __HIP_MEMORY_SCOPE_AGENT) - __hip_atomic_load(tsb + LO_, __ATOMIC_RELAXED, __HIP_MEMORY_SCOPE_AGENT)); if (PROBE_T == 15) probe_m /= 8; }
        for (unsigned e = blockIdx.x * 512u + threadIdx.x; e < probe_m; e += gridDim.x * 512u) a.out[e] += 0.08f;
    }
}

extern "C" void kernel_launch(void* const* d_in, const int* in_sizes, int n_in, void* d_out, int out_size, void* d_ws, size_t ws_size, hipStream_t stream) {
    static int grid = 0;
    if (grid == 0) {
        if (n_in != 18 || out_size != T * D || ws_size < WS_END) { fprintf(stderr, "kernel_launch: unexpected problem (n_in %d out %d ws %zu)\n", n_in, out_size, ws_size); grid = -1; return; }
        int dev = 0, cus = 0, per_cu = 0;
        hipGetDevice(&dev); hipDeviceGetAttribute(&cus, hipDeviceAttributeMultiprocessorCount, dev);
        if (hipFuncSetAttribute((const void*)fwd_megakernel, hipFuncAttributeMaxDynamicSharedMemorySize, LDS_BYTES) != hipSuccess) { fprintf(stderr, "kernel_launch: hipFuncSetAttribute failed\n"); grid = -1; return; }
        if (hipOccupancyMaxActiveBlocksPerMultiprocessor(&per_cu, (const void*)fwd_megakernel, 512, LDS_BYTES) != hipSuccess || per_cu < 1) { fprintf(stderr, "kernel_launch: occupancy query says %d\n", per_cu); per_cu = 1; }
        (void)hipGetLastError();
        grid = cus * per_cu;
    }
    if (grid < 0) return;
    Args a{};
    const float** f = (const float**)&a;
    for (int i = 0; i < 18; ++i) f[i] = (const float*)d_in[i];
    a.out = (float*)d_out; a.ws = (unsigned char*)d_ws;
    if (hipMemsetAsync((char*)d_ws + WS_BAR, 0, 16384, stream) != hipSuccess) { fprintf(stderr, "kernel_launch: memset of the barrier words failed\n"); return; }
    void* args[] = {&a};
    hipError_t e = hipLaunchCooperativeKernel((const void*)fwd_megakernel, dim3(grid), dim3(512), args, LDS_BYTES, stream);
    if (e != hipSuccess) fprintf(stderr, "cooperative launch failed: %s (grid %d)\n", hipGetErrorString(e), grid);
}
```

```cpp
#include <hip/hip_runtime.h>
#include <hip/hip_cooperative_groups.h>
#include <cstdio>
#include <cstdint>
namespace cg = cooperative_groups;
#ifndef PROBE_DUP
#define PROBE_DUP 0
#endif
#ifndef PROBE_T
#define PROBE_T 0
#endif
#ifndef WGM_P1R
#define WGM_P1R 4
#endif
#ifndef WGM_P1T
#define WGM_P1T 4
#endif
#ifndef WGM_P5
#define WGM_P5 4
#endif
#ifndef WGM_P6
#define WGM_P6 8
#endif
#ifndef WGM_P8
#define WGM_P8 4
#endif
#ifndef WGM_PP
#define WGM_PP 4
#endif
#ifndef WGM_P9
#define WGM_P9 4
#endif
#define REPS(k) for (int rep_ = 0; rep_ < (PROBE_DUP == (k) ? 2 : 1); ++rep_)

#define LAS __attribute__((address_space(3)))
typedef unsigned short bf16_t;
typedef short bf16x8 __attribute__((ext_vector_type(8)));
typedef float f32x4 __attribute__((ext_vector_type(4)));
typedef float f32x2 __attribute__((ext_vector_type(2)));
typedef unsigned u32x4 __attribute__((ext_vector_type(4)));
typedef unsigned u32x2 __attribute__((ext_vector_type(2)));

constexpr int T = 16384, D = 2048, FF = 5632, NR = 4096, PLE = 256, NCH = 256;
constexpr int QA = 0, KA = 1024, QG = 2048, KG = 2560, RG = 3072;
constexpr float EPS = 1e-6f;
constexpr size_t MiB = 1u << 20;
constexpr size_t WS_SSQ1 = 0, WS_SSQ2 = 65536, WS_SSQ3 = 131072, WS_GLR = 1 * MiB, WS_WG = 2 * MiB, WS_WPP = 3 * MiB;
constexpr size_t WS_WIN = 4 * MiB, WS_WOUT = 28 * MiB, WS_WUP = 36 * MiB, WS_WDN = 80 * MiB, WS_WPG = 102 * MiB, WS_PB = 110 * MiB;
constexpr size_t WS_H0 = 118 * MiB;
constexpr size_t WS_PROJ = 182 * MiB;
constexpr size_t WS_VT = 310 * MiB;
constexpr size_t WS_X1B = 182 * MiB, WS_G = 246 * MiB, WS_TAIL = 422 * MiB, WS_HEAD = 444 * MiB, WS_PP = 422 * MiB  , WS_X3B = 182 * MiB  , WS_YCAT = WS_H0, WS_X2B = WS_H0;
constexpr size_t WS_DEC = 256 * 1024, WS_UPD = 406 * MiB, WS_BCUM = 374 * MiB;
constexpr size_t WS_BAR = 800 * 1024;
constexpr size_t WS_GLR1 = 470 * MiB;
constexpr size_t WS_RSTD0 = 900 * 1024;
constexpr size_t WS_END = 512 * MiB;
constexpr int LDS_BYTES = 147456;

__device__ __forceinline__ unsigned f2bf(float f) { unsigned u = __builtin_bit_cast(unsigned, f); return (u + 0x7fffu + ((u >> 16) & 1u)) >> 16; }
typedef __bf16 hwbf16x2 __attribute__((ext_vector_type(2)));
__device__ __forceinline__ unsigned pk2(float lo, float hi) { const f32x2 v = {lo, hi}; return __builtin_bit_cast(unsigned, __builtin_convertvector(v, hwbf16x2)); }
__device__ __forceinline__ float frcp(float x) { return __builtin_amdgcn_rcpf(x); }
__device__ __forceinline__ float frsq(float x) { return __builtin_amdgcn_rsqf(x); }
__device__ __forceinline__ float fsigmoid(float x) { return frcp(1.0f + __builtin_amdgcn_exp2f(-1.4426950408889634f * x)); }
__device__ __forceinline__ float bf2f(unsigned short b) { return __builtin_bit_cast(float, (unsigned)b << 16); }
__device__ __forceinline__ float bflo(unsigned w) { return __builtin_bit_cast(float, w << 16); }
__device__ __forceinline__ float bfhi(unsigned w) { return __builtin_bit_cast(float, w & 0xffff0000u); }
__device__ __forceinline__ float wave_sum(float v) {
#pragma unroll
    for (int o = 1; o < 64; o <<= 1) v += __shfl_xor(v, o);
    return v;
}

namespace pg8 {
#define PG8_LAS __attribute__((address_space(3)))
constexpr int BM = 256, BK = 64, HALF = 128, HTB = HALF * BK * 2, STAGE_BYTES = 8 * HTB, NXCD = 8;
__host__ __device__ __forceinline__ int lds_byte(int r, int c) { const int st = (r >> 4) * 2 + (c >> 5), rr = r & 15, cc = c & 31, ob = rr * 64 + cc * 2; return st * 1024 + (ob ^ (((ob >> 9) & 1) << 5)); }
__host__ __device__ __forceinline__ void stage_rc(int b, int& R, int& C) { const int st = b / 1024, sb = b % 1024, swz = sb ^ (((sb >> 9) & 1) << 5); R = (st >> 1) * 16 + swz / 64; C = (st & 1) * 32 + (swz % 64) / 2; }
__host__ __device__ __forceinline__ int perm32(int rho) { const int n = rho >> 4, i = rho & 15; return 8 * (i >> 2) + 4 * n + (i & 3); }

struct Unit { int pm, pn; };
struct Gemm { const bf16_t* A; const bf16_t* Bt; int M, N, K; };

struct StaticOrder {
    int nM, nN, nwg, G, c, WGM;
    __host__ __device__ void init(int M, int N, int G_, int c_, int wgm) { nM = M / BM; nN = N / BM; nwg = nM * nN; G = G_; c = c_; WGM = wgm; }
    __host__ __device__ bool next(int i, Unit& u) const {
        const long L = (long)i * G + c; if (L >= nwg) return false;
        int wgid = (int)L; { const int q = nwg / NXCD, r = nwg % NXCD, xcd = wgid % NXCD, off = wgid / NXCD; wgid = (xcd < r ? xcd * (q + 1) : r * (q + 1) + (xcd - r) * q) + off; }
        const int nig = WGM * nN, gid = wgid / nig, fm = gid * WGM, gsz = (nM - fm) < WGM ? (nM - fm) : WGM;
        u.pm = fm + ((wgid % nig) % gsz); u.pn = (wgid % nig) / gsz; return true;
    }
    __device__ __forceinline__ void a_ready(const Unit&) const {}
    __device__ __forceinline__ void done(const Unit&) const {}
};

__device__ __forceinline__ unsigned cvt_pk_bf16(float lo, float hi) { return pk2(lo, hi); }

struct EpiBf16 {
    static constexpr bool PERM = true, AFTER_DRAIN = false;
    bf16_t* O; int ldc; const float* rs; const float* cs;
    __device__ __forceinline__ void operator()(const f32x4 (&acc)[2][2][4][2], const Unit& u, int wr, int wc, int fr, int fq) const {
        const int row0 = u.pm * BM + wr * 64 + fr; const int col0 = u.pn * BM + wc * 32 + 8 * fq;
        f32x4 c0[2], c1[2];
#pragma unroll
        for (int bj = 0; bj < 2; ++bj) { c0[bj] = cs ? *(const f32x4*)(cs + col0 + bj * HALF) : (f32x4){1.f, 1.f, 1.f, 1.f}; c1[bj] = cs ? *(const f32x4*)(cs + col0 + bj * HALF + 4) : (f32x4){1.f, 1.f, 1.f, 1.f}; }
#pragma unroll
        for (int ai = 0; ai < 2; ++ai)
#pragma unroll
            for (int m = 0; m < 4; ++m) { const int row = row0 + ai * HALF + m * 16; bf16_t* rowp = O + (size_t)row * ldc + col0; const float r = rs ? rs[row] : 1.0f;
#pragma unroll
                for (int bj = 0; bj < 2; ++bj) { const f32x4 v0 = acc[ai][bj][m][0] * c0[bj] * r, v1 = acc[ai][bj][m][1] * c1[bj] * r;
                    u32x4 w; w.x = cvt_pk_bf16(v0[0], v0[1]); w.y = cvt_pk_bf16(v0[2], v0[3]); w.z = cvt_pk_bf16(v1[0], v1[1]); w.w = cvt_pk_bf16(v1[2], v1[3]);
                    *(u32x4*)(rowp + bj * HALF) = w; } }
    }
};
template <bool BASE_BF16> struct EpiResid {
    static constexpr bool PERM = true, AFTER_DRAIN = false;
    const void* base; bf16_t* ob; float* ssq;
    __device__ __forceinline__ void operator()(const f32x4 (&acc)[2][2][4][2], const Unit& u, int wr, int wc, int fr, int fq) const {
        const int row0 = u.pm * BM + wr * 64 + fr; const int col0 = u.pn * BM + wc * 32 + 8 * fq;
#pragma unroll
        for (int ai = 0; ai < 2; ++ai)
#pragma unroll
            for (int m = 0; m < 4; ++m) { const int row = row0 + ai * HALF + m * 16; const size_t off = (size_t)row * D + col0; float ss = 0.f;
#pragma unroll
                for (int bj = 0; bj < 2; ++bj) {
                    f32x4 b0, b1;
                    if (BASE_BF16) { const u32x4 pw = *(const u32x4*)((const bf16_t*)base + off + bj * HALF); b0 = (f32x4){bflo(pw.x), bfhi(pw.x), bflo(pw.y), bfhi(pw.y)}; b1 = (f32x4){bflo(pw.z), bfhi(pw.z), bflo(pw.w), bfhi(pw.w)}; }
                    else { b0 = *(const f32x4*)((const float*)base + off + bj * HALF); b1 = *(const f32x4*)((const float*)base + off + bj * HALF + 4); }
                    const f32x4 v0 = acc[ai][bj][m][0] + b0, v1 = acc[ai][bj][m][1] + b1;
                    u32x4 w; w.x = cvt_pk_bf16(v0[0], v0[1]); w.y = cvt_pk_bf16(v0[2], v0[3]); w.z = cvt_pk_bf16(v1[0], v1[1]); w.w = cvt_pk_bf16(v1[2], v1[3]);
                    *(u32x4*)(ob + off + bj * HALF) = w;
                    ss += (v0[0] * v0[0] + v0[1] * v0[1]) + (v0[2] * v0[2] + v0[3] * v0[3]) + (v1[0] * v1[0] + v1[1] * v1[1]) + (v1[2] * v1[2] + v1[3] * v1[3]); }
                ss += __shfl_xor(ss, 16); ss += __shfl_xor(ss, 32);
                if (fq == 0) atomicAdd(ssq + row, ss); }
    }
};
struct EpiPle {
    static constexpr bool PERM = true, AFTER_DRAIN = false;
    const bf16_t* x2; bf16_t* x3; const bf16_t* pp; const float* ssq2; float* ssq3;
    __device__ __forceinline__ void operator()(const f32x4 (&acc)[2][2][4][2], const Unit& u, int wr, int wc, int fr, int fq) const {
        const int row0 = u.pm * BM + wr * 64 + fr; const int col0 = u.pn * BM + wc * 32 + 8 * fq;
#pragma unroll
        for (int ai = 0; ai < 2; ++ai)
#pragma unroll
            for (int m = 0; m < 4; ++m) { const int row = row0 + ai * HALF + m * 16; const size_t off = (size_t)row * D + col0; float ss = 0.f;
                const float rstd = frsq(ssq2[row] * (1.0f / D) + EPS);
#pragma unroll
                for (int bj = 0; bj < 2; ++bj) {
                    const u32x4 xw = *(const u32x4*)(x2 + off + bj * HALF);
                    const u32x4 pw = *(const u32x4*)(pp + off + bj * HALF);
                    const f32x4 b0 = {bflo(xw.x), bfhi(xw.x), bflo(xw.y), bfhi(xw.y)}, b1 = {bflo(xw.z), bfhi(xw.z), bflo(xw.w), bfhi(xw.w)};
                    const f32x4 p0 = {bflo(pw.x), bfhi(pw.x), bflo(pw.y), bfhi(pw.y)}, p1 = {bflo(pw.z), bfhi(pw.z), bflo(pw.w), bfhi(pw.w)};
                    f32x4 v0, v1;
#pragma unroll
                    for (int e = 0; e < 4; ++e) { const float g0 = fsigmoid(acc[ai][bj][m][0][e] * rstd), g1 = fsigmoid(acc[ai][bj][m][1][e] * rstd);
                        v0[e] = b0[e] + g0 * p0[e]; v1[e] = b1[e] + g1 * p1[e]; }
                    u32x4 w; w.x = cvt_pk_bf16(v0[0], v0[1]); w.y = cvt_pk_bf16(v0[2], v0[3]); w.z = cvt_pk_bf16(v1[0], v1[1]); w.w = cvt_pk_bf16(v1[2], v1[3]);
                    *(u32x4*)(x3 + off + bj * HALF) = w;
                    ss += (v0[0] * v0[0] + v0[1] * v0[1]) + (v0[2] * v0[2] + v0[3] * v0[3]) + (v1[0] * v1[0] + v1[1] * v1[1]) + (v1[2] * v1[2] + v1[3] * v1[3]); }
                ss += __shfl_xor(ss, 16); ss += __shfl_xor(ss, 32);
                if (fq == 0) atomicAdd(ssq3 + row, ss); }
    }
};
__device__ __forceinline__ float gelu_tanh(float x) {
    const float t = x * x * (-1.5957691216057308f * 1.4426950408889634f * 0.044715f) + (-1.5957691216057308f * 1.4426950408889634f);
    return x * frcp(1.0f + __builtin_amdgcn_exp2f(t * x));
}
template <int CTRL> __device__ __forceinline__ float dppz(float v) { return __builtin_bit_cast(float, __builtin_amdgcn_update_dpp(0, __builtin_bit_cast(int, v), CTRL, 0xf, 0xf, true)); }
#define FMAC_DPP(acc, src, w, CTRL) asm volatile("s_nop 1\n\tv_fmac_f32_dpp %0, %1, %2 " CTRL " row_mask:0xf bank_mask:0xf bound_ctrl:1" : "+v"(acc) : "v"(src), "v"(w))
struct EpiUp {
    static constexpr bool PERM = true, AFTER_DRAIN = false;
    bf16_t* G; const float* ssq1; const float* cw; const float* cb; float* tail; float* head;
    __device__ __forceinline__ void operator()(const f32x4 (&acc)[2][2][4][2], const Unit& u, int wr, int wc, int fr, int fq) const {
        const int C0 = u.pn * 128 + wc * 32 + 8 * fq;
#pragma unroll
        for (int ai = 0; ai < 2; ++ai) {
            const int rbase = u.pm * BM + ai * HALF + wr * 64; const int grp = rbase >> 6;
            float rstd[4];
#pragma unroll
            for (int m = 0; m < 4; ++m) rstd[m] = frsq(ssq1[rbase + m * 16 + fr] * (1.0f / D) + EPS);
            if (fr < 2) { float* hp = head + ((size_t)grp * 2 + fr) * (2 * FF) + C0;
#pragma unroll
                for (int bj = 0; bj < 2; ++bj) { *(f32x4*)(hp + bj * FF) = acc[ai][bj][0][0] * rstd[0]; *(f32x4*)(hp + bj * FF + 4) = acc[ai][bj][0][1] * rstd[0]; } }
            if (fr >= 14) { float* tp = tail + ((size_t)grp * 2 + (fr - 14)) * (2 * FF) + C0;
#pragma unroll
                for (int bj = 0; bj < 2; ++bj) { *(f32x4*)(tp + bj * FF) = acc[ai][bj][3][0] * rstd[3]; *(f32x4*)(tp + bj * FF + 4) = acc[ai][bj][3][1] * rstd[3]; } }
            __builtin_amdgcn_sched_barrier(0);
#pragma unroll
            for (int n = 0; n < 2; ++n) {
                unsigned outw[4][2];
#pragma unroll
                for (int ep = 0; ep < 2; ++ep) {
                    int C = C0 + 4 * n + 2 * ep; asm volatile("" : "+v"(C));
                    const f32x2 wg0 = *(const f32x2*)(cw + C), wg1 = *(const f32x2*)(cw + 2 * FF + C), wg2 = *(const f32x2*)(cw + 4 * FF + C), bg = *(const f32x2*)(cb + C);
                    const f32x2 wv0 = *(const f32x2*)(cw + FF + C), wv1 = *(const f32x2*)(cw + 3 * FF + C), wv2 = *(const f32x2*)(cw + 5 * FF + C), bv = *(const f32x2*)(cb + FF + C);
                    f32x2 ugp = {0.f, 0.f}, uvp = {0.f, 0.f};
#pragma unroll
                    for (int m = 0; m < 4; ++m) {
                        f32x2 ug = (f32x2){acc[ai][0][m][n][2 * ep], acc[ai][0][m][n][2 * ep + 1]} * rstd[m], uv = (f32x2){acc[ai][1][m][n][2 * ep], acc[ai][1][m][n][2 * ep + 1]} * rstd[m];
                        asm volatile("" : "+v"(ug), "+v"(uv));
                        f32x2 yg = wg2 * ug + bg, yv = wv2 * uv + bv;
#pragma unroll
                        for (int q = 0; q < 2; ++q) {
                            FMAC_DPP(yg[q], ug[q], wg1[q], "row_shr:1"); FMAC_DPP(yv[q], uv[q], wv1[q], "row_shr:1");
                            FMAC_DPP(yg[q], ug[q], wg0[q], "row_shr:2"); FMAC_DPP(yv[q], uv[q], wv0[q], "row_shr:2");
                            if (m > 0) { FMAC_DPP(yg[q], ugp[q], wg1[q], "row_shl:15"); FMAC_DPP(yv[q], uvp[q], wv1[q], "row_shl:15");
                                         FMAC_DPP(yg[q], ugp[q], wg0[q], "row_shl:14"); FMAC_DPP(yv[q], uvp[q], wv0[q], "row_shl:14"); } }
                        f32x2 t = yg * yg * (-1.5957691216057308f * 1.4426950408889634f * 0.044715f) + (-1.5957691216057308f * 1.4426950408889634f);
                        t = t * yg;
                        f32x2 den = {__builtin_amdgcn_exp2f(t[0]), __builtin_amdgcn_exp2f(t[1])}; den = den + 1.0f;
                        const f32x2 rc = {frcp(den[0]), frcp(den[1])};
                        f32x2 o = yg * rc * yv; asm volatile("" : "+v"(o));
                        outw[m][ep] = pk2(o[0], o[1]);
                        ugp = ug; uvp = uv;
                    }
                    __builtin_amdgcn_sched_barrier(0);
                }
#pragma unroll
                for (int m = 0; m < 4; ++m) if (m > 0 || fr >= 2) { u32x2 w = {outw[m][0], outw[m][1]}; *(u32x2*)(G + (size_t)(rbase + m * 16 + fr) * FF + C0 + 4 * n) = w; }
                __builtin_amdgcn_sched_barrier(0);
            }
        }
    }
};

template <class Epi, class Sched, bool ALIGN_EPI = false, bool SP2 = false>
__device__ __forceinline__ void gemm_phase(PG8_LAS unsigned char* lds, const Gemm g, const Sched& S, const Epi& E) {
    int tid_ = threadIdx.x; asm volatile("" : "+v"(tid_));
    const int tid = tid_, wid = __builtin_amdgcn_readfirstlane(tid >> 6), lane = tid & 63, wr = wid >> 2, wc = wid & 3, fr = lane & 15, fq = lane >> 4;
    const int K = g.K, nt = K / BK;
    unsigned voffA[2], voffB[2];
#pragma unroll
    for (int i = 0; i < 2; ++i) { int R, C; stage_rc(tid * 16 + i * 8192, R, C); const int Rb = Epi::PERM ? ((R & ~31) + perm32(R & 31)) : R;
        voffA[i] = (unsigned)(R * K + C) * 2u; voffB[i] = (unsigned)(Rb * K + C) * 2u; }
    const size_t kstep = (size_t)(BK * 2);
    const size_t hstep = (size_t)HALF * K * 2;
    const size_t tstep = 2 * hstep;
    const unsigned ldsw = (unsigned)wid * 1024u;
    const int aoff = lds_byte(wr * 64 + fr, fq * 8), boff = lds_byte(wc * 32 + fr, fq * 8);
#define PG8_SA(b, h) (((b) * 2 + (h)) * HTB)
#define PG8_SB(b, h) ((4 + (b) * 2 + (h)) * HTB)
#define PG8_STAGE(bufoff, gbase, voff) do { _Pragma("unroll") for (int _i = 0; _i < 2; ++_i) \
        __builtin_amdgcn_global_load_lds((const unsigned*)((const char*)(gbase) + (voff)[_i]), (PG8_LAS unsigned*)(lds + (bufoff) + ldsw + _i * 8192), 16, 0, 0); } while (0)
#define PG8_LDA(dst, b, h) do { _Pragma("unroll") for (int m = 0; m < 4; ++m) _Pragma("unroll") for (int k = 0; k < 2; ++k) dst[m][k] = *(const PG8_LAS bf16x8*)(lds + PG8_SA(b, h) + aoff + m * 2048 + k * 1024); } while (0)
#define PG8_LDB(dst, b, h) do { _Pragma("unroll") for (int n = 0; n < 2; ++n) _Pragma("unroll") for (int k = 0; k < 2; ++k) dst[n][k] = *(const PG8_LAS bf16x8*)(lds + PG8_SB(b, h) + boff + n * 2048 + k * 1024); } while (0)
#define PG8_MMA(ai, bj, At, Bt) do { __builtin_amdgcn_s_setprio(1); _Pragma("unroll") for (int m = 0; m < 4; ++m) _Pragma("unroll") for (int n = 0; n < 2; ++n) _Pragma("unroll") for (int k = 0; k < 2; ++k) \
        acc[ai][bj][m][n] = __builtin_amdgcn_mfma_f32_16x16x32_bf16(Bt[n][k], At[m][k], acc[ai][bj][m][n], 0, 0, 0); __builtin_amdgcn_s_setprio(0); } while (0)
#define PG8_WAIT_V(n) asm volatile("s_waitcnt vmcnt(" #n ")" ::: "memory")
#define PG8_WAIT_L(n) asm volatile("s_waitcnt lgkmcnt(" #n ")" ::: "memory")
#define PG8_BAR __builtin_amdgcn_s_barrier()
#define PG8_SCHED __builtin_amdgcn_sched_barrier(0)
    Unit cur, nxt; int ui = 0;
    if (!S.next(0, cur)) return;
    f32x4 acc[2][2][4][2];
#pragma unroll
    for (int a = 0; a < 2; ++a)
#pragma unroll
        for (int b = 0; b < 2; ++b)
#pragma unroll
            for (int m = 0; m < 4; ++m)
#pragma unroll
                for (int n = 0; n < 2; ++n) acc[a][b][m][n] = (f32x4){0.f, 0.f, 0.f, 0.f};
    bf16x8 At[4][2], B0[2][2], B1[2][2];
    const char* cA = (const char*)g.A + (size_t)cur.pm * tstep; const char* cB = (const char*)g.Bt + (size_t)cur.pn * tstep;
    S.a_ready(cur);
    if constexpr (SP2) {
        PG8_STAGE(PG8_SB(0, 0), cB, voffB); PG8_STAGE(PG8_SB(0, 1), cB + hstep, voffB); PG8_STAGE(PG8_SA(0, 0), cA, voffA); PG8_STAGE(PG8_SA(0, 1), cA + hstep, voffA);
        if (wr == 1) PG8_BAR;
        PG8_WAIT_V(2); PG8_BAR;
        PG8_STAGE(PG8_SB(1, 0), cB + kstep, voffB); PG8_STAGE(PG8_SA(1, 0), cA + kstep, voffA); PG8_STAGE(PG8_SB(1, 1), cB + hstep + kstep, voffB);
        PG8_WAIT_V(6); PG8_BAR;
    } else {
        PG8_STAGE(PG8_SB(0, 0), cB, voffB); PG8_STAGE(PG8_SA(0, 0), cA, voffA); PG8_STAGE(PG8_SB(0, 1), cB + hstep, voffB); PG8_STAGE(PG8_SA(0, 1), cA + hstep, voffA);
        if (wr == 1) PG8_BAR;
        PG8_WAIT_V(4); PG8_BAR;
        PG8_STAGE(PG8_SB(1, 0), cB + kstep, voffB); PG8_STAGE(PG8_SA(1, 0), cA + kstep, voffA); PG8_STAGE(PG8_SB(1, 1), cB + hstep + kstep, voffB);
        PG8_WAIT_V(6); PG8_BAR;
    }
    for (;;) {
        const bool has_next = S.next(ui + 1, nxt);
        const char* nA = has_next ? (const char*)g.A + (size_t)nxt.pm * tstep : cA; const char* nB = has_next ? (const char*)g.Bt + (size_t)nxt.pn * tstep : cB;
        for (int t = 0; t < nt; t += 2) {
            const bool last = (t == nt - 2);
            const char* a1 = cA + (size_t)(t + 1) * kstep;
            const char* a2 = last ? nA : cA + (size_t)(t + 2) * kstep; const char* b2 = last ? nB : cB + (size_t)(t + 2) * kstep;
            const char* a3 = a2 + kstep; const char* b3 = b2 + kstep;
            if (last && has_next) S.a_ready(nxt);
            if constexpr (SP2) {
            PG8_LDB(B0, 0, 0); PG8_LDB(B1, 0, 1); PG8_SCHED; PG8_LDA(At, 0, 0); PG8_STAGE(PG8_SA(1, 1), a1 + hstep, voffA);
            PG8_WAIT_V(8); PG8_WAIT_L(0); PG8_BAR; PG8_MMA(0, 0, At, B0); PG8_MMA(0, 1, At, B1); PG8_BAR; PG8_SCHED;
            PG8_LDA(At, 0, 1); PG8_STAGE(PG8_SB(0, 0), b2, voffB); PG8_STAGE(PG8_SB(0, 1), b2 + hstep, voffB); PG8_STAGE(PG8_SA(0, 0), a2, voffA);
            PG8_WAIT_V(8); PG8_WAIT_L(0); PG8_BAR; PG8_MMA(1, 0, At, B0); PG8_MMA(1, 1, At, B1); PG8_BAR; PG8_SCHED;
            PG8_LDB(B0, 1, 0); PG8_LDB(B1, 1, 1); PG8_SCHED; PG8_LDA(At, 1, 0); PG8_STAGE(PG8_SA(0, 1), a2 + hstep, voffA);
            PG8_WAIT_V(8); PG8_WAIT_L(0); PG8_BAR; PG8_MMA(0, 0, At, B0); PG8_MMA(0, 1, At, B1); PG8_BAR; PG8_SCHED;
            PG8_LDA(At, 1, 1); PG8_STAGE(PG8_SB(1, 0), b3, voffB); PG8_STAGE(PG8_SB(1, 1), b3 + hstep, voffB); PG8_STAGE(PG8_SA(1, 0), a3, voffA);
            PG8_WAIT_V(8); PG8_WAIT_L(0); PG8_BAR; PG8_MMA(1, 0, At, B0); PG8_MMA(1, 1, At, B1); PG8_BAR; PG8_SCHED;
            } else {
            PG8_LDB(B0, 0, 0); PG8_SCHED; PG8_LDA(At, 0, 0); PG8_STAGE(PG8_SA(1, 1), a1 + hstep, voffA);
            PG8_WAIT_L(8); PG8_BAR; PG8_WAIT_L(0); PG8_MMA(0, 0, At, B0); PG8_BAR; PG8_SCHED;
            PG8_LDB(B1, 0, 1); PG8_STAGE(PG8_SB(0, 0), b2, voffB);
            PG8_BAR; PG8_WAIT_L(0); PG8_MMA(0, 1, At, B1); PG8_BAR;
            PG8_LDA(At, 0, 1); PG8_STAGE(PG8_SA(0, 0), a2, voffA);
            PG8_BAR; PG8_WAIT_L(0); PG8_MMA(1, 0, At, B0); PG8_BAR; PG8_SCHED;
            PG8_STAGE(PG8_SB(0, 1), b2 + hstep, voffB);
            PG8_WAIT_V(6); PG8_BAR; PG8_MMA(1, 1, At, B1); PG8_BAR;
            PG8_LDB(B0, 1, 0); PG8_SCHED; PG8_LDA(At, 1, 0); PG8_STAGE(PG8_SA(0, 1), a2 + hstep, voffA);
            PG8_WAIT_L(8); PG8_BAR; PG8_WAIT_L(0); PG8_MMA(0, 0, At, B0); PG8_BAR; PG8_SCHED;
            PG8_LDB(B1, 1, 1); PG8_STAGE(PG8_SB(1, 0), b3, voffB);
            PG8_BAR; PG8_WAIT_L(0); PG8_MMA(0, 1, At, B1); PG8_BAR;
            PG8_LDA(At, 1, 1); PG8_STAGE(PG8_SA(1, 0), a3, voffA);
            PG8_BAR; PG8_WAIT_L(0); PG8_MMA(1, 0, At, B0); PG8_BAR; PG8_SCHED;
            PG8_STAGE(PG8_SB(1, 1), b3 + hstep, voffB);
            PG8_WAIT_V(6); PG8_BAR; PG8_MMA(1, 1, At, B1); PG8_BAR;
            }
        }
        if constexpr (ALIGN_EPI) { if (wr == 0) PG8_BAR; }
        if constexpr (!Epi::AFTER_DRAIN) { E(acc, cur, wr, wc, fr, fq); S.done(cur); }
        if (!has_next) break;
#pragma unroll
        for (int a = 0; a < 2; ++a)
#pragma unroll
            for (int b = 0; b < 2; ++b)
#pragma unroll
                for (int m = 0; m < 4; ++m)
#pragma unroll
                    for (int n = 0; n < 2; ++n) acc[a][b][m][n] = (f32x4){0.f, 0.f, 0.f, 0.f};
        cur = nxt; cA = nA; cB = nB; ++ui;
        if constexpr (ALIGN_EPI) { if (wr == 1) PG8_BAR; }
    }
    PG8_WAIT_V(0);
    if constexpr (!ALIGN_EPI) { if (wr == 0) PG8_BAR; }
    PG8_BAR;
#undef PG8_SA
#undef PG8_SB
#undef PG8_STAGE
#undef PG8_LDA
#undef PG8_LDB
#undef PG8_MMA
#undef PG8_WAIT_V
#undef PG8_WAIT_L
#undef PG8_BAR
#undef PG8_SCHED
}
}

struct Args {
    const float *x, *p, *norm_mix_w, *w_in, *att_rel_bias, *w_gla_gate_up, *b_gla_gate, *gla_norm_w, *w_out, *norm_ffn_w, *w_ffn_up, *w_ffn_conv, *b_ffn_conv, *w_ffn_down,
                *norm_ple_w, *w_ple_gate, *w_ple_proj, *final_norm_w;
    float* out; unsigned char* ws;
};

__device__ __forceinline__ int map_row(int mode, int n) {
    if (mode == 1) { if (n < 2048) return n; if (n < 3072) return n + 2048; if (n < 4096) return n - 1024; if (n < 5120) return n + 1024; return n - 2048; }
    if (mode == 2) { const int half = n >= FF ? 1 : 0; const int c = n - half * FF; return (c >> 7) * 256 + half * 128 + (c & 127); }
    return n;
}
__device__ __forceinline__ void transpose_item(const float* W, int K, int ldn, int nblk, bf16_t* WT, LAS float* scr, int item, int lane, const float* kscale, int mode) {
    const int kb = item / nblk, nb = item % nblk, k0 = 32 * kb, n0 = 128 * nb;
    const int c4 = lane & 31, kh = lane >> 5;
    f32x4 v[16];
#pragma unroll
    for (int i = 0; i < 16; ++i) v[i] = *(const f32x4*)(W + (size_t)(k0 + 2 * i + kh) * ldn + n0 + 4 * c4);
#pragma unroll
    for (int i = 0; i < 16; ++i) { f32x4 t = v[i]; if (kscale) t = t * kscale[k0 + 2 * i + kh]; *(LAS f32x4*)(scr + (2 * i + kh) * 132 + 4 * c4) = t; }
    asm volatile("s_waitcnt lgkmcnt(0)" ::: "memory");
    const int c = lane & 3, nl = lane >> 2; const int drow0 = map_row(mode, n0);
#pragma unroll
    for (int j = 0; j < 8; ++j) { const int n = nl + 16 * j; const LAS float* sp = scr + (8 * c) * 132 + n;
        u32x4 o; o.x = pk2(sp[0 * 132], sp[1 * 132]); o.y = pk2(sp[2 * 132], sp[3 * 132]); o.z = pk2(sp[4 * 132], sp[5 * 132]); o.w = pk2(sp[6 * 132], sp[7 * 132]);
        *(u32x4*)(WT + (size_t)(drow0 + n) * K + k0 + 8 * c) = o; }
    asm volatile("s_waitcnt lgkmcnt(0)" ::: "memory");
}

#define XB_TMO      128
#define XB_XCNT(j)  (256  + 64 * (j))
#define XB_XSUB(j)  (1280 + 64 * (j))
#define XB_XGEN(j)  (2304 + 64 * (j))
#define XB_TOP      3328
#define XB_TOPGEN   3392
#define XCD_BAR_WORDS 3456
#define XB_SPIN_CAP (1u << 18)
__device__ __forceinline__ unsigned xb_ld(unsigned* p)              { return __hip_atomic_load(p, __ATOMIC_RELAXED, __HIP_MEMORY_SCOPE_AGENT); }
__device__ __forceinline__ unsigned xb_add(unsigned* p, unsigned v) { return __hip_atomic_fetch_add(p, v, __ATOMIC_RELAXED, __HIP_MEMORY_SCOPE_AGENT); }
__device__ __forceinline__ unsigned xb_xcc_id() { return (unsigned)__builtin_amdgcn_s_getreg((3 << 11) | 20) & 0xFu; }
#define XB_SPIN(cond, bar) do { unsigned _sp = 0; while (cond) { __builtin_amdgcn_s_sleep(1); \
    if ((++_sp & 255u) == 0u) { if (xb_ld(&(bar)[XB_TMO])) break; if (_sp > XB_SPIN_CAP) { atomicAdd(&(bar)[XB_TMO], 1u); break; } } } } while (0)
struct XcdBarrier {
    unsigned* bar; unsigned x;
    volatile LAS unsigned* st;
};
__device__ __forceinline__ XcdBarrier xcd_barrier_post(unsigned* bar, volatile LAS unsigned* st) {
    XcdBarrier b; b.bar = bar; b.x = xb_xcc_id(); b.st = st;
    if (threadIdx.x == 0) (void)xb_add(&bar[XB_XCNT(b.x)], 1u);
    return b;
}
__device__ __forceinline__ void xcd_barrier_complete(unsigned* bar, unsigned x, unsigned& nloc, unsigned& nx) {
    const unsigned G = gridDim.x * gridDim.y * gridDim.z;
    unsigned sum, cnt, mine, sp = 0u;
    for (;;) {
        sum = 0u; cnt = 0u; mine = 0u;
#pragma unroll
        for (unsigned j = 0; j < 16; ++j) { const unsigned c = xb_ld(&bar[XB_XCNT(j)]); sum += c; cnt += (c > 0u) ? 1u : 0u; mine = (j == x) ? c : mine; }
        if (sum == G) break;
        __builtin_amdgcn_s_sleep(1);
        if ((++sp & 255u) == 0u) { if (xb_ld(&bar[XB_TMO])) break; if (sp > XB_SPIN_CAP) { atomicAdd(&bar[XB_TMO], 1u); break; } }
    }
    nloc = mine > 0u ? mine : 1u; nx = cnt > 0u ? cnt : 1u;
}
__device__ __forceinline__ void xcd_barrier(const XcdBarrier& b) {
    asm volatile("s_waitcnt vmcnt(0)" ::: "memory");
    __syncthreads();
    if (threadIdx.x == 0) {
        unsigned* bar = b.bar;
        __builtin_amdgcn_s_waitcnt(0);
        unsigned nloc = b.st[0], nx = b.st[1];
        if (nloc == 0u) { xcd_barrier_complete(bar, b.x, nloc, nx); b.st[0] = nloc; b.st[1] = nx; }
        const unsigned old = xb_add(&bar[XB_XSUB(b.x)], 1u);
        const unsigned gen = old / nloc;
        if (old + 1u == (gen + 1u) * nloc) {
            __builtin_amdgcn_fence(__ATOMIC_RELEASE, "agent");
            asm volatile("s_waitcnt vmcnt(0)" ::: "memory");
            const unsigned og = xb_add(&bar[XB_TOP], 1u);
            const unsigned tg = og / nx;
            if (og + 1u == (tg + 1u) * nx) xb_add(&bar[XB_TOPGEN], 1u);
            else XB_SPIN(xb_ld(&bar[XB_TOPGEN]) == tg, bar);
            __builtin_amdgcn_fence(__ATOMIC_ACQUIRE, "agent");
            xb_add(&bar[XB_XGEN(b.x)], 1u);
            asm volatile("s_waitcnt vmcnt(0)" ::: "memory");
        } else {
            XB_SPIN(xb_ld(&bar[XB_XGEN(b.x)]) == gen, bar);
            __builtin_amdgcn_fence(__ATOMIC_ACQUIRE, "agent");
            asm volatile("s_waitcnt vmcnt(0)" ::: "memory");
        }
    }
    __syncthreads();
}

__device__ __forceinline__ void gla_decay(const Args& a, const float* glr, int n, int hg, int tid, LAS float* gL, LAS float* segtot, float (&bv)[16], float& blast) {
    const int dk = tid & 127, seg = tid >> 7, col = hg * 128 + dk;
    if (tid < 256) ((LAS f32x4*)gL)[tid] = ((const f32x4*)(glr + (size_t)n * 64 * 16))[tid];
    float w[16];
#pragma unroll
    for (int j = 0; j < 16; ++j) w[j] = a.w_gla_gate_up[j * 512 + col];
    const float bias = a.b_gla_gate[col];
    __syncthreads();
    float c = 0.f;
#pragma unroll
    for (int s = 0; s < 16; ++s) { const LAS f32x4* g4 = (const LAS f32x4*)(gL + (16 * seg + s) * 16); float logit = bias;
#pragma unroll
        for (int q = 0; q < 4; ++q) { const f32x4 g = g4[q]; logit += g[0] * w[4 * q] + g[1] * w[4 * q + 1] + g[2] * w[4 * q + 2] + g[3] * w[4 * q + 3]; }
        const float ls = fminf(logit, 0.f) - log1pf(__expf(-fabsf(logit)));
        c += ls * (1.0f / 16.0f); bv[s] = c; if ((s & 3) == 3) asm volatile("" ::: "memory"); }
    segtot[seg * 128 + dk] = c;
    __syncthreads();
    float off = 0.f, tot = 0.f;
#pragma unroll
    for (int q = 0; q < 4; ++q) { const float v = segtot[q * 128 + dk]; tot += v; if (q < seg) off += v; }
#pragma unroll
    for (int s = 0; s < 16; ++s) bv[s] += off;
    blast = tot;
}

#define LBAR() do { asm volatile("s_waitcnt lgkmcnt(0)" ::: "memory"); __builtin_amdgcn_s_barrier(); asm volatile("" ::: "memory"); } while (0)
#define STAMP(k) do { if (PROBE_T != 0 && blockIdx.x == 0 && threadIdx.x == 0) ((unsigned long long*)(a.ws + 200 * 1024))[k] = __builtin_amdgcn_s_memrealtime(); } while (0)
#define IDS() int tid = threadIdx.x; asm volatile("" : "+v"(tid)); const int lane = tid & 63, wave = __builtin_amdgcn_readfirstlane(tid >> 6); const int gw = bx * 8 + wave, gtid = bx * 512 + tid; (void)lane; (void)gw; (void)gtid;
__global__ void __launch_bounds__(512, 2) fwd_megakernel(Args a) {
    extern __shared__ __attribute__((aligned(16))) unsigned char lds_raw[];
    cg::grid_group grid = cg::this_grid();
    LAS unsigned char* lds = (LAS unsigned char*)lds_raw;
    const int tid = threadIdx.x, lane = tid & 63, wave = __builtin_amdgcn_readfirstlane(tid >> 6);
    const int G = gridDim.x, bx = blockIdx.x;
    const int gw = bx * 8 + wave, NGW = G * 8;
    const int gtid = bx * 512 + tid, NT = G * 512;
    unsigned char* ws = a.ws;
    float* ssq1 = (float*)(ws + WS_SSQ1); float* ssq2 = (float*)(ws + WS_SSQ2); float* ssq3 = (float*)(ws + WS_SSQ3);
    float* glr = (float*)(ws + WS_GLR); float* glr1 = (float*)(ws + WS_GLR1); float* decb = (float*)(ws + WS_DEC); float* bcum = (float*)(ws + WS_BCUM); bf16_t* upd = (bf16_t*)(ws + WS_UPD);
    bf16_t* WgT = (bf16_t*)(ws + WS_WG); bf16_t* WppT = (bf16_t*)(ws + WS_WPP); bf16_t* WinT = (bf16_t*)(ws + WS_WIN); bf16_t* WoutT = (bf16_t*)(ws + WS_WOUT);
    bf16_t* WupT = (bf16_t*)(ws + WS_WUP); bf16_t* WdnT = (bf16_t*)(ws + WS_WDN); bf16_t* WpgT = (bf16_t*)(ws + WS_WPG); bf16_t* pb = (bf16_t*)(ws + WS_PB);
    bf16_t* h0 = (bf16_t*)(ws + WS_H0); bf16_t* projR = (bf16_t*)(ws + WS_PROJ); bf16_t* vT = (bf16_t*)(ws + WS_VT);
    bf16_t* ycat = (bf16_t*)a.out;
    float* rstd0 = (float*)(ws + WS_RSTD0); bf16_t* x1b = (bf16_t*)(ws + WS_X1B); bf16_t* gbuf = (bf16_t*)(ws + WS_G);
    float* tailb = (float*)(ws + WS_TAIL); float* headb = (float*)(ws + WS_HEAD); bf16_t* ppb = (bf16_t*)(ws + WS_PP); bf16_t* x2b = (bf16_t*)(ws + WS_X2B); bf16_t* x3b = (bf16_t*)(ws + WS_X3B);

    volatile LAS unsigned* bst = (volatile LAS unsigned*)(lds + LDS_BYTES - 64);
    if (threadIdx.x < 16) bst[threadIdx.x] = 0u;
    unsigned* barw = (unsigned*)(ws + WS_BAR);
    __syncthreads();
    const XcdBarrier xbar = xcd_barrier_post(barw, bst);
    if (a.out == nullptr) grid.sync();
    STAMP(0);
    REPS(1) {
        LAS float* scr = (LAS float*)(lds + wave * 16896);
        constexpr int I_IN = 64 * 48, I_OUT = 64 * 16, I_UP = 64 * 88, I_DN = 176 * 16, I_PG = 64 * 16, I_PP = 8 * 16;
        constexpr int NITEMS = I_IN + I_OUT + I_UP + I_DN + I_PG + I_PP;
        for (int it = gw; it < NITEMS; it += NGW) {
            int r = it;
            if (r < I_IN) { transpose_item(a.w_in, 2048, 6160, 48, WinT, scr, r, lane, a.norm_mix_w, 1); continue; } r -= I_IN;
            if (r < I_OUT) { transpose_item(a.w_out, 2048, 2048, 16, WoutT, scr, r, lane, nullptr, 0); continue; } r -= I_OUT;
            if (r < I_UP) { transpose_item(a.w_ffn_up, 2048, 2 * FF, 88, WupT, scr, r, lane, a.norm_ffn_w, 2); continue; } r -= I_UP;
            if (r < I_DN) { transpose_item(a.w_ffn_down, FF, 2048, 16, WdnT, scr, r, lane, nullptr, 0); continue; } r -= I_DN;
            if (r < I_PG) { transpose_item(a.w_ple_gate, 2048, 2048, 16, WpgT, scr, r, lane, a.norm_ple_w, 0); continue; } r -= I_PG;
            transpose_item(a.w_ple_proj, PLE, 2048, 16, WppT, scr, r, lane, nullptr, 0);
        }
        for (int i = gtid; i < 16 * 2048; i += NT) { const int j = i >> 11, k = i & 2047; WgT[i] = (bf16_t)f2bf(a.w_in[(size_t)k * 6160 + 6144 + j] * a.norm_mix_w[k]); }
        for (int m = gw; m < T; m += 2 * NGW) {
            const int m1 = m + NGW; const bool two = m1 < T;
            const f32x4* xr0 = (const f32x4*)(a.x + (size_t)m * D) + lane; const f32x4* xr1 = (const f32x4*)(a.x + (size_t)(two ? m1 : m) * D) + lane;
            f32x4 v0[8], v1[8]; float s0 = 0.f, s1 = 0.f;
#pragma unroll
            for (int j = 0; j < 8; ++j) { v0[j] = xr0[64 * j]; v1[j] = xr1[64 * j]; }
            u32x2* o0 = (u32x2*)(h0 + (size_t)m * D) + lane; u32x2* o1 = (u32x2*)(h0 + (size_t)m1 * D) + lane;
#pragma unroll
            for (int j = 0; j < 8; ++j) { s0 += (v0[j].x * v0[j].x + v0[j].y * v0[j].y) + (v0[j].z * v0[j].z + v0[j].w * v0[j].w); s1 += (v1[j].x * v1[j].x + v1[j].y * v1[j].y) + (v1[j].z * v1[j].z + v1[j].w * v1[j].w);
                u32x2 o; o.x = pk2(v0[j].x, v0[j].y); o.y = pk2(v0[j].z, v0[j].w); o0[64 * j] = o;
                if (two) { u32x2 q; q.x = pk2(v1[j].x, v1[j].y); q.y = pk2(v1[j].z, v1[j].w); o1[64 * j] = q; } }
            s0 = wave_sum(s0); s1 = wave_sum(s1);
            if (lane == 0) { rstd0[m] = frsq(s0 * (1.0f / D) + EPS); if (two) rstd0[m1] = frsq(s1 * (1.0f / D) + EPS); }
        }
        for (int i = gtid; i < T * PLE / 4; i += NT) { const f32x4 v = ((const f32x4*)a.p)[i]; u32x2 o; o.x = pk2(v.x, v.y); o.y = pk2(v.z, v.w); ((u32x2*)pb)[i] = o; }
        for (int i = gtid; i < 3 * T; i += NT) ssq1[i] = 0.f;
    }
    if (PROBE_T != 0) { asm volatile("s_waitcnt vmcnt(0)" ::: "memory"); }
    xcd_barrier(xbar);
    STAMP(1);

    REPS(2) {
        IDS();
        for (int task = gw; task < 2 * (T / 16); task += NGW) {
            const int fr = lane & 15, fq = lane >> 4; const int r0 = (task >> 1) * 16, kh = (task & 1) * (D / 2);
            const bf16_t* ap = h0 + (size_t)(r0 + fr) * D + kh + 8 * fq; const bf16_t* bp = WgT + (size_t)fr * D + kh + 8 * fq;
            f32x4 acc = {0.f, 0.f, 0.f, 0.f};
#pragma unroll 8
            for (int k0 = 0; k0 < D / 2; k0 += 32) { const bf16x8 av = *(const bf16x8*)(ap + k0), bv = *(const bf16x8*)(bp + k0); acc = __builtin_amdgcn_mfma_f32_16x16x32_bf16(av, bv, acc, 0, 0, 0); }
            float* gp = (task & 1) ? glr1 : glr;
#pragma unroll
            for (int j = 0; j < 4; ++j) gp[(size_t)(r0 + 4 * fq + j) * 16 + fr] = acc[j] * rstd0[r0 + 4 * fq + j];
        }
        __syncthreads();
        { pg8::Gemm g{h0, WinT, T, NR, D}; pg8::StaticOrder S; S.init(T, NR, G, bx, WGM_P1R); pg8::EpiBf16 E{projR, NR, rstd0, nullptr};
          pg8::gemm_phase<pg8::EpiBf16, pg8::StaticOrder, true, true>(lds, g, S, E); }
        { pg8::Gemm g{WinT + (size_t)NR * D, h0, 2048, T, D}; pg8::StaticOrder S; S.init(2048, T, G, bx, WGM_P1T); pg8::EpiBf16 E{vT, T, nullptr, rstd0};
          pg8::gemm_phase<pg8::EpiBf16, pg8::StaticOrder, true, true>(lds, g, S, E); }
    }
    xcd_barrier(xbar);
    STAMP(2);

    REPS(3) {
        IDS();
        LAS float* gL = (LAS float*)lds; LAS float* segtot = (LAS float*)(lds + 4096); LAS bf16_t* kT = (LAS bf16_t*)(lds + 8192);
        const int fr = lane & 15, fq = lane >> 4, dk = tid & 127, seg = tid >> 7;
        f32x4 g4r = {0.f, 0.f, 0.f, 0.f}; unsigned short kraw[16]; bf16x8 vB[2][2], vBn[2][2];
#define G1_LOAD(u_, VB) do { const int n_ = (u_) >> 2, hg_ = (u_) & 3; if (tid < 256) g4r = ((const f32x4*)(glr + (size_t)n_ * 64 * 16))[tid] + ((const f32x4*)(glr1 + (size_t)n_ * 64 * 16))[tid]; \
            _Pragma("unroll") for (int s = 0; s < 16; ++s) kraw[s] = projR[((size_t)n_ * 64 + 16 * seg + s) * NR + KG + hg_ * 128 + dk]; \
            _Pragma("unroll") for (int nt2 = 0; nt2 < 2; ++nt2) _Pragma("unroll") for (int ks = 0; ks < 2; ++ks) VB[nt2][ks] = *(const bf16x8*)(vT + (size_t)(1024 + hg_ * 256 + 16 * (2 * wave + nt2) + fr) * T + n_ * 64 + 32 * ks + 8 * fq); } while (0)
        if (bx < NCH * 4) G1_LOAD(bx, vB);
        for (int unit = bx; unit < NCH * 4; unit += G) {
            const int n = unit >> 2, hg = unit & 3, col = hg * 128 + dk;
            float w[16];
#pragma unroll
            for (int j = 0; j < 16; ++j) w[j] = a.w_gla_gate_up[j * 512 + col];
            const float bias = a.b_gla_gate[col];
            if (tid < 256) ((LAS f32x4*)gL)[tid] = g4r;
            LBAR();
            float bv[16]; float c = 0.f;
#pragma unroll
            for (int s = 0; s < 16; ++s) { const LAS f32x4* g4 = (const LAS f32x4*)(gL + (16 * seg + s) * 16); float logit = bias;
#pragma unroll
                for (int q = 0; q < 4; ++q) { const f32x4 g = g4[q]; logit += g[0] * w[4 * q] + g[1] * w[4 * q + 1] + g[2] * w[4 * q + 2] + g[3] * w[4 * q + 3]; }
                const float ls = fminf(logit, 0.f) - __logf(1.0f + __expf(-fabsf(logit)));
                c += ls * (1.0f / 16.0f); bv[s] = c; if ((s & 3) == 3) asm volatile("" ::: "memory"); }
            segtot[seg * 128 + dk] = c;
            LBAR();
            float off = 0.f, blast = 0.f;
#pragma unroll
            for (int q = 0; q < 4; ++q) { const float v = segtot[q * 128 + dk]; blast += v; if (q < seg) off += v; }
            unsigned kw[8];
#pragma unroll
            for (int s = 0; s < 16; s += 2) { const float b0 = bv[s] + off, b1 = bv[s + 1] + off; const size_t t = (size_t)n * 64 + 16 * seg + s;
                bcum[t * 512 + col] = b0; bcum[(t + 1) * 512 + col] = b1;
                kw[s >> 1] = pk2(bf2f(kraw[s]) * __expf(blast - b0), bf2f(kraw[s + 1]) * __expf(blast - b1)); }
            *(LAS u32x4*)(kT + dk * 72 + 16 * seg) = (u32x4){kw[0], kw[1], kw[2], kw[3]}; *(LAS u32x4*)(kT + dk * 72 + 16 * seg + 8) = (u32x4){kw[4], kw[5], kw[6], kw[7]};
            if (seg == 0) decb[(size_t)unit * 128 + dk] = __expf(blast);
            LBAR();
            if (unit + G < NCH * 4) G1_LOAD(unit + G, vBn);
            f32x4 acc[8][2];
#pragma unroll
            for (int mt = 0; mt < 8; ++mt) { acc[mt][0] = (f32x4){0.f, 0.f, 0.f, 0.f}; acc[mt][1] = (f32x4){0.f, 0.f, 0.f, 0.f}; }
#pragma unroll
            for (int mt = 0; mt < 8; ++mt)
#pragma unroll
                for (int ks = 0; ks < 2; ++ks) { const bf16x8 ak = *(const LAS bf16x8*)(kT + (16 * mt + fr) * 72 + 32 * ks + 8 * fq);
                    acc[mt][0] = __builtin_amdgcn_mfma_f32_16x16x32_bf16(ak, vB[0][ks], acc[mt][0], 0, 0, 0);
                    acc[mt][1] = __builtin_amdgcn_mfma_f32_16x16x32_bf16(ak, vB[1][ks], acc[mt][1], 0, 0, 0); }
#pragma unroll
            for (int mt = 0; mt < 8; ++mt)
#pragma unroll
                for (int nt2 = 0; nt2 < 2; ++nt2) { const int dvv = 16 * (2 * wave + nt2) + fr; u32x2 wv; wv.x = pk2(acc[mt][nt2][0], acc[mt][nt2][1]); wv.y = pk2(acc[mt][nt2][2], acc[mt][nt2][3]);
                    *(u32x2*)(upd + (size_t)unit * 32768 + dvv * 128 + 16 * mt + 4 * fq) = wv; }
#pragma unroll
            for (int nt2 = 0; nt2 < 2; ++nt2)
#pragma unroll
                for (int ks = 0; ks < 2; ++ks) vB[nt2][ks] = vBn[nt2][ks];
        }
#undef G1_LOAD
    }
    xcd_barrier(xbar);
    STAMP(3);

    { IDS();
    for (int g2 = bx * 256 + tid; tid < 256 && g2 < 4 * 16384; g2 += G * 256) {
        const int hg = g2 >> 14, rem = (g2 & 16383) * 2, dk = rem & 127;
        unsigned* p = (unsigned*)(upd + (size_t)hg * 32768 + rem); const f32x2* dp = (const f32x2*)(decb + hg * 128 + dk);
        float S0 = 0.f, S1 = 0.f;
        unsigned ua[16], ub[16]; f32x2 da[16], db[16];
#define SCAN_LOAD(U, Dd, n0) do { _Pragma("unroll") for (int k = 0; k < 16; ++k) { U[k] = p[(size_t)((n0) + k) * 65536]; Dd[k] = dp[((n0) + k) * 256]; } } while (0)
#define SCAN_STEP(U, Dd, n0) do { _Pragma("unroll") for (int k = 0; k < 16; ++k) { p[(size_t)((n0) + k) * 65536] = pk2(S0, S1); S0 = Dd[k].x * S0 + bflo(U[k]); S1 = Dd[k].y * S1 + bfhi(U[k]); } } while (0)
        SCAN_LOAD(ua, da, 0);
        for (int n = 0; n < NCH; n += 32) {
            SCAN_LOAD(ub, db, n + 16);
            SCAN_STEP(ua, da, n);
            if (n + 32 < NCH) SCAN_LOAD(ua, da, n + 32);
            SCAN_STEP(ub, db, n + 16);
        }
#undef SCAN_LOAD
#undef SCAN_STEP
    } }
    if (PROBE_T != 0) { asm volatile("s_waitcnt vmcnt(0)" ::: "memory"); grid.sync(); STAMP(12); }
    {
        IDS();
        constexpr int CHB = 18432, BUFB = 3 * CHB;
        LAS unsigned char* kvb = lds; LAS float* bt = (LAS float*)(lds + 2 * BUFB);
        const int fr = lane & 15, fq = lane >> 4, hl = wave >> 2, qt = wave & 3;
        constexpr float LOG2E = 1.4426950408889634f;
        const int prow = (tid >> 3) & 63, pseg = tid & 7, pofs = prow * 144 + pseg * 16;
#define ATT_LOADK(cc, hpp, g) do { _Pragma("unroll") for (int q3 = 0; q3 < 3; ++q3) { const int kc_ = ((cc) - 8 + 3 * (g) + q3) < 0 ? 0 : ((cc) - 8 + 3 * (g) + q3); _Pragma("unroll") for (int r = 0; r < 2; ++r) \
            pre[q3][r] = *(const u32x4*)(projR + (size_t)(kc_ * 64 + prow) * NR + KA + 64 * (2 * (hpp) + r) + 8 * pseg); } } while (0)
#define ATT_LOADV(cc, hpp, g) do { _Pragma("unroll") for (int q3 = 0; q3 < 3; ++q3) { const int kc_ = ((cc) - 8 + 3 * (g) + q3) < 0 ? 0 : ((cc) - 8 + 3 * (g) + q3); _Pragma("unroll") for (int r = 0; r < 2; ++r) \
            pre[q3][r] = *(const u32x4*)(vT + (size_t)(64 * (2 * (hpp) + r) + prow) * T + kc_ * 64 + 8 * pseg); } } while (0)
#define ATT_WRITE(buf) do { _Pragma("unroll") for (int q3 = 0; q3 < 3; ++q3) _Pragma("unroll") for (int r = 0; r < 2; ++r) *(LAS u32x4*)(kvb + (buf) * BUFB + q3 * CHB + r * 9216 + pofs) = pre[q3][r]; } while (0)
#define ATT_LOADQ(cc, hpp) do { _Pragma("unroll") for (int ks = 0; ks < 2; ++ks) qn[ks] = *(const bf16x8*)(projR + (size_t)(64 * (cc) + 16 * qt + fr) * NR + QA + 64 * (2 * (hpp) + hl) + 32 * ks + 8 * fq); } while (0)
        const int NU = NCH * 8 * (PROBE_DUP == 4 ? 2 : 1);
        u32x4 pre[3][2]; bf16x8 qn[2]; int hp_tab = -1;
        if (bx < NU) { const int c0 = (bx >> 3) & (NCH - 1), hp0 = bx & 7; ATT_LOADQ(c0, hp0); ATT_LOADK(c0, hp0, 0); ATT_WRITE(0); }
        for (int unit = bx; unit < NU; unit += G) {
            const int c = (unit >> 3) & (NCH - 1), hp = unit & 7, h = 2 * hp + hl;
            const int un = unit + G, cn = (un >> 3) & (NCH - 1), hpn = un & 7;
            if (hp != hp_tab) { for (int i = tid; i < 1026; i += 512) { const int hh = i >= 513 ? 1 : 0; bt[hh * 516 + (i - hh * 513)] = a.att_rel_bias[(2 * hp + hh) * 513 + (i - hh * 513)] * LOG2E; } hp_tab = hp; }
            const bf16x8 qv0 = qn[0], qv1 = qn[1];
            __syncthreads();
            f32x4 S[36];
            const LAS float* btl = bt + hl * 516 + 256; const int relb = 16 * qt + fr + 512 - 4 * fq;
            const float b512 = btl[256];
#pragma unroll
            for (int g = 0; g < 3; ++g) {
                if (g < 2) ATT_LOADK(c, hp, g + 1); else ATT_LOADV(c, hp, 0);
#pragma unroll
                for (int q3 = 0; q3 < 3; ++q3) { const int j = 3 * g + q3;
#pragma unroll
                    for (int kt4 = 0; kt4 < 4; ++kt4) { f32x4 acc = {0.f, 0.f, 0.f, 0.f};
                        const LAS unsigned char* kp = kvb + (g & 1) * BUFB + q3 * CHB + hl * 9216 + (16 * kt4 + fr) * 144 + 16 * fq;
                        acc = __builtin_amdgcn_mfma_f32_16x16x32_bf16(*(const LAS bf16x8*)kp, qv0, acc, 0, 0, 0);
                        acc = __builtin_amdgcn_mfma_f32_16x16x32_bf16(*(const LAS bf16x8*)(kp + 64), qv1, acc, 0, 0, 0);
#pragma unroll
                        for (int jj = 0; jj < 4; ++jj) { float bias = b512;
                            if (j == 4) { int rel = relb - (64 * j + 16 * kt4 + jj); rel = rel > 256 ? 256 : rel; bias = btl[rel]; }
                            else if (j > 4) bias = btl[relb - (64 * j + 16 * kt4 + jj)];
                            acc[jj] = acc[jj] * (0.125f * LOG2E) + bias; }
                        S[4 * j + kt4] = acc; }
                    __builtin_amdgcn_sched_barrier(0); }
                ATT_WRITE((g + 1) & 1);
                __syncthreads();
            }
            if (c < 8) {
#pragma unroll
                for (int j = 0; j < 8; ++j) if (j < 8 - c) {
#pragma unroll
                    for (int kt4 = 0; kt4 < 4; ++kt4) S[4 * j + kt4] = (f32x4){-1e30f, -1e30f, -1e30f, -1e30f}; } }
            float mx = -1e30f;
#pragma unroll
            for (int i = 0; i < 36; ++i) mx = fmaxf(mx, fmaxf(fmaxf(S[i][0], S[i][1]), fmaxf(S[i][2], S[i][3])));
            mx = fmaxf(mx, __shfl_xor(mx, 16)); mx = fmaxf(mx, __shfl_xor(mx, 32));
            f32x2 l2 = {0.f, 0.f};
            u32x2 PW[36];
#pragma unroll
            for (int i = 0; i < 36; ++i) { const f32x4 d = S[i] - mx; const float p0 = __builtin_amdgcn_exp2f(d[0]), p1 = __builtin_amdgcn_exp2f(d[1]), p2 = __builtin_amdgcn_exp2f(d[2]), p3 = __builtin_amdgcn_exp2f(d[3]);
                l2 = l2 + (f32x2){p0, p1}; l2 = l2 + (f32x2){p2, p3}; PW[i].x = pg8::cvt_pk_bf16(p0, p1); PW[i].y = pg8::cvt_pk_bf16(p2, p3); asm volatile("" : "+v"(PW[i].x), "+v"(PW[i].y));
                if ((i & 3) == 3) __builtin_amdgcn_sched_barrier(0); }
            float l = l2[0] + l2[1];
            l += __shfl_xor(l, 16); l += __shfl_xor(l, 32);
            f32x4 O[4];
#pragma unroll
            for (int dt = 0; dt < 4; ++dt) O[dt] = (f32x4){0.f, 0.f, 0.f, 0.f};
            if (un < NU) ATT_LOADQ(cn, hpn);
#pragma unroll
            for (int g = 0; g < 3; ++g) {
                if (g < 2) ATT_LOADV(c, hp, g + 1); else if (un < NU) ATT_LOADK(cn, hpn, 0);
                const int buf = (3 + g) & 1;
#pragma unroll
                for (int q3 = 0; q3 < 3; ++q3) { const int j = 3 * g + q3;
#pragma unroll
                    for (int a2 = 0; a2 < 2; ++a2) { const u32x4 pw = {PW[4 * j + 2 * a2].x, PW[4 * j + 2 * a2].y, PW[4 * j + 2 * a2 + 1].x, PW[4 * j + 2 * a2 + 1].y};
                        const bf16x8 pa = __builtin_bit_cast(bf16x8, pw);
#pragma unroll
                        for (int dt = 0; dt < 4; ++dt) { const LAS unsigned char* vp = kvb + buf * BUFB + q3 * CHB + hl * 9216 + (16 * dt + fr) * 144 + (32 * a2 + 4 * fq) * 2;
                            const u32x2 lo = *(const LAS u32x2*)vp, hi = *(const LAS u32x2*)(vp + 32);
                            const u32x4 vw = {lo.x, lo.y, hi.x, hi.y};
                            O[dt] = __builtin_amdgcn_mfma_f32_16x16x32_bf16(pa, __builtin_bit_cast(bf16x8, vw), O[dt], 0, 0, 0); } } }
                if (g < 2 || un < NU) ATT_WRITE((3 + g + 1) & 1);
                if (g < 2) __syncthreads();
            }
#pragma unroll
            for (int jj = 0; jj < 4; ++jj) { const float linv = 1.0f / __shfl(l, 4 * fq + jj); const size_t t = (size_t)64 * c + 16 * qt + 4 * fq + jj;
#pragma unroll
                for (int dt = 0; dt < 4; ++dt) ycat[t * D + 64 * h + 16 * dt + fr] = (bf16_t)f2bf(O[dt][jj] * linv); }
        }
#undef ATT_LOADK
#undef ATT_LOADV
#undef ATT_WRITE
#undef ATT_LOADQ
    }
    xcd_barrier(xbar);
    STAMP(4);

    REPS(5) {
        IDS();
        LAS float* red = (LAS float*)(lds + 6144);
        LAS bf16_t* qd = (LAS bf16_t*)(lds + 8192); LAS bf16_t* ki = (LAS bf16_t*)(lds + 25600); LAS bf16_t* aL = (LAS bf16_t*)(lds + 43008);
        const int fr = lane & 15, fq = lane >> 4, dk = tid & 127, seg = tid >> 7;
        f32x4 braw[2][2]; u32x4 qraw[2], kraw[2];
        const int pi = tid >> 4, pg = tid & 15;
#define G3_LOAD(u_) do { const int n_ = (u_) >> 2, hg_ = (u_) & 3; _Pragma("unroll") for (int r = 0; r < 2; ++r) { const size_t t_ = (size_t)n_ * 64 + pi + 32 * r; \
            braw[r][0] = *(const f32x4*)(bcum + t_ * 512 + hg_ * 128 + 8 * pg); braw[r][1] = *(const f32x4*)(bcum + t_ * 512 + hg_ * 128 + 8 * pg + 4); \
            qraw[r] = *(const u32x4*)(projR + t_ * NR + QG + hg_ * 128 + 8 * pg); kraw[r] = *(const u32x4*)(projR + t_ * NR + KG + hg_ * 128 + 8 * pg); } } while (0)
        if (bx < NCH * 4) G3_LOAD(bx);
        for (int unit = bx; unit < NCH * 4; unit += G) {
            const int n = unit >> 2, hg = unit & 3;
            bf16x8 vB[2][2], sB[2][4];
#pragma unroll
            for (int nt2 = 0; nt2 < 2; ++nt2) { const int dvv = 16 * (2 * wave + nt2) + fr;
#pragma unroll
                for (int ks = 0; ks < 2; ++ks) vB[nt2][ks] = *(const bf16x8*)(vT + (size_t)(1024 + hg * 256 + dvv) * T + n * 64 + 32 * ks + 8 * fq);
#pragma unroll
                for (int ks = 0; ks < 4; ++ks) sB[nt2][ks] = *(const bf16x8*)(upd + (size_t)unit * 32768 + dvv * 128 + 32 * ks + 8 * fq); }
#pragma unroll
            for (int r = 0; r < 2; ++r) { const int i = pi + 32 * r; u32x4 qo, ko;
#pragma unroll
                for (int e = 0; e < 4; ++e) { const float b0 = e < 2 ? braw[r][0][2 * e] : braw[r][1][2 * e - 4], b1 = e < 2 ? braw[r][0][2 * e + 1] : braw[r][1][2 * e - 3];
                    qo[e] = pk2(bflo(qraw[r][e]) * 0.08838834764831845f * __expf(b0), bfhi(qraw[r][e]) * 0.08838834764831845f * __expf(b1));
                    ko[e] = pk2(bflo(kraw[r][e]) * __expf(-b0), bfhi(kraw[r][e]) * __expf(-b1)); }
                *(LAS u32x4*)(qd + i * 136 + 8 * pg) = qo; *(LAS u32x4*)(ki + i * 136 + 8 * pg) = ko; }
            LBAR();
            if (unit + G < NCH * 4) G3_LOAD(unit + G);
#pragma unroll
            for (int rep = 0; rep < 2; ++rep) { const int idx = wave + 8 * rep, it = idx >> 2, jt = idx & 3;
                f32x4 c = {0.f, 0.f, 0.f, 0.f};
                if (jt <= it) {
#pragma unroll
                    for (int ks = 0; ks < 4; ++ks) { const bf16x8 av = *(const LAS bf16x8*)(qd + (16 * it + fr) * 136 + 32 * ks + 8 * fq), bv8 = *(const LAS bf16x8*)(ki + (16 * jt + fr) * 136 + 32 * ks + 8 * fq);
                        c = __builtin_amdgcn_mfma_f32_16x16x32_bf16(av, bv8, c, 0, 0, 0); } }
#pragma unroll
                for (int jj = 0; jj < 4; ++jj) { const int i = 16 * it + 4 * fq + jj, j = 16 * jt + fr; aL[i * 72 + j] = (bf16_t)f2bf(j <= i ? c[jj] : 0.f); } }
            LBAR();
            unsigned short rr[4][4][2];
#pragma unroll
            for (int mt = 0; mt < 4; ++mt)
#pragma unroll
                for (int jj = 0; jj < 4; ++jj)
#pragma unroll
                    for (int nt2 = 0; nt2 < 2; ++nt2) rr[mt][jj][nt2] = projR[((size_t)n * 64 + 16 * mt + 4 * fq + jj) * NR + RG + hg * 256 + 16 * (2 * wave + nt2) + fr];
            f32x4 acc[4][2];
#pragma unroll
            for (int mt = 0; mt < 4; ++mt) { acc[mt][0] = (f32x4){0.f, 0.f, 0.f, 0.f}; acc[mt][1] = (f32x4){0.f, 0.f, 0.f, 0.f}; }
#pragma unroll
            for (int nt2 = 0; nt2 < 2; ++nt2)
#pragma unroll
                for (int mt = 0; mt < 4; ++mt) {
#pragma unroll
                    for (int ks = 0; ks < 2; ++ks) acc[mt][nt2] = __builtin_amdgcn_mfma_f32_16x16x32_bf16(*(const LAS bf16x8*)(aL + (16 * mt + fr) * 72 + 32 * ks + 8 * fq), vB[nt2][ks], acc[mt][nt2], 0, 0, 0);
#pragma unroll
                    for (int ks = 0; ks < 4; ++ks) acc[mt][nt2] = __builtin_amdgcn_mfma_f32_16x16x32_bf16(*(const LAS bf16x8*)(qd + (16 * mt + fr) * 136 + 32 * ks + 8 * fq), sB[nt2][ks], acc[mt][nt2], 0, 0, 0); }
#pragma unroll
            for (int mt = 0; mt < 4; ++mt)
#pragma unroll
                for (int jj = 0; jj < 4; ++jj) { float p = acc[mt][0][jj] * acc[mt][0][jj] + acc[mt][1][jj] * acc[mt][1][jj];
                    p += __shfl_xor(p, 1); p += __shfl_xor(p, 2); p += __shfl_xor(p, 4); p += __shfl_xor(p, 8);
                    if (fr == 0) red[wave * 64 + 16 * mt + 4 * fq + jj] = p; }
            LBAR();
            const float gw0 = a.gla_norm_w[16 * (2 * wave) + fr], gw1 = a.gla_norm_w[16 * (2 * wave + 1) + fr];
#pragma unroll
            for (int mt = 0; mt < 4; ++mt)
#pragma unroll
                for (int jj = 0; jj < 4; ++jj) { const int i = 16 * mt + 4 * fq + jj; float ss = 0.f;
#pragma unroll
                    for (int w8 = 0; w8 < 8; ++w8) ss += red[w8 * 64 + i];
                    const float rstd = frsq(ss * (1.0f / 256.0f) + EPS); const size_t t = (size_t)n * 64 + i;
#pragma unroll
                    for (int nt2 = 0; nt2 < 2; ++nt2) { const int dvv = 16 * (2 * wave + nt2) + fr;
                        const float r = bf2f(rr[mt][jj][nt2]);
                        const float y = acc[mt][nt2][jj] * rstd * (nt2 ? gw1 : gw0) * (r * fsigmoid(r));
                        ycat[t * D + 1024 + hg * 256 + dvv] = (bf16_t)f2bf(y); } }
        }
#undef G3_LOAD
    }
    xcd_barrier(xbar);
    STAMP(5);

    { pg8::Gemm g{ycat, WoutT, T, D, D}; pg8::StaticOrder S; S.init(T, D, G, bx, WGM_P5); pg8::EpiResid<true> E{h0, x1b, ssq1};
      pg8::gemm_phase<pg8::EpiResid<true>, pg8::StaticOrder, true, true>(lds, g, S, E); }
    xcd_barrier(xbar);
    STAMP(6);

#ifndef NO_UP
    REPS(6) { pg8::Gemm g{x1b, WupT, T, 2 * FF, D}; pg8::StaticOrder S; S.init(T, 2 * FF, G, bx, WGM_P6); pg8::EpiUp E{gbuf, ssq1, a.w_ffn_conv, a.b_ffn_conv, tailb, headb};
      pg8::gemm_phase<pg8::EpiUp, pg8::StaticOrder, true, true>(lds, g, S, E); }
#endif
    xcd_barrier(xbar);
    STAMP(7);

    { IDS();
    for (int i = gtid; i < NCH * 2 * (FF / 4); i += NT) {
        const int c4 = i % (FF / 4), gj = i / (FF / 4), j = gj & 1, grp = gj >> 1; const int row = grp * 64 + j, C = 4 * c4;
        const float* tl = tailb + (size_t)(grp - 1) * 2 * (2 * FF); const float* hd = headb + (size_t)grp * 2 * (2 * FF);
        const f32x4 z = {0.f, 0.f, 0.f, 0.f};
        f32x4 ug0, uv0, ug1, uv1, ug2, uv2;
        if (j == 0) { ug0 = grp ? *(const f32x4*)(tl + C) : z; uv0 = grp ? *(const f32x4*)(tl + FF + C) : z; ug1 = grp ? *(const f32x4*)(tl + 2 * FF + C) : z; uv1 = grp ? *(const f32x4*)(tl + 3 * FF + C) : z;
                      ug2 = *(const f32x4*)(hd + C); uv2 = *(const f32x4*)(hd + FF + C); }
        else { ug0 = grp ? *(const f32x4*)(tl + 2 * FF + C) : z; uv0 = grp ? *(const f32x4*)(tl + 3 * FF + C) : z; ug1 = *(const f32x4*)(hd + C); uv1 = *(const f32x4*)(hd + FF + C);
               ug2 = *(const f32x4*)(hd + 2 * FF + C); uv2 = *(const f32x4*)(hd + 3 * FF + C); }
        const float* cw = a.w_ffn_conv; const float* cb = a.b_ffn_conv;
        const f32x4 yg = *(const f32x4*)(cb + C) + *(const f32x4*)(cw + C) * ug0 + *(const f32x4*)(cw + 2 * FF + C) * ug1 + *(const f32x4*)(cw + 4 * FF + C) * ug2;
        const f32x4 yv = *(const f32x4*)(cb + FF + C) + *(const f32x4*)(cw + FF + C) * uv0 + *(const f32x4*)(cw + 3 * FF + C) * uv1 + *(const f32x4*)(cw + 5 * FF + C) * uv2;
        u32x2 o; o.x = pk2(pg8::gelu_tanh(yg[0]) * yv[0], pg8::gelu_tanh(yg[1]) * yv[1]); o.y = pk2(pg8::gelu_tanh(yg[2]) * yv[2], pg8::gelu_tanh(yg[3]) * yv[3]);
        *(u32x2*)(gbuf + (size_t)row * FF + C) = o;
    } }
    xcd_barrier(xbar);
    STAMP(8);

    { pg8::Gemm g{gbuf, WdnT, T, D, FF}; pg8::StaticOrder S; S.init(T, D, G, bx, WGM_P8); pg8::EpiResid<true> E{x1b, x2b, ssq2};
      pg8::gemm_phase<pg8::EpiResid<true>, pg8::StaticOrder, true, true>(lds, g, S, E); }
    { pg8::Gemm g{pb, WppT, T, D, PLE}; pg8::StaticOrder S; S.init(T, D, G, bx, WGM_PP); pg8::EpiBf16 E{ppb, D, nullptr, nullptr};
      pg8::gemm_phase<pg8::EpiBf16, pg8::StaticOrder, true, true>(lds, g, S, E); }
    xcd_barrier(xbar);
    STAMP(9);

    { pg8::Gemm g{x2b, WpgT, T, D, D}; pg8::StaticOrder S; S.init(T, D, G, bx, WGM_P9); pg8::EpiPle E{x2b, x3b, ppb, ssq2, ssq3};
      pg8::gemm_phase<pg8::EpiPle, pg8::StaticOrder, true, true>(lds, g, S, E); }
    xcd_barrier(xbar);
    STAMP(10);

    { IDS();
    for (int m = gw; m < T; m += NGW) {
        const float rstd = frsq(ssq3[m] * (1.0f / D) + EPS);
        const u32x4* xr = (const u32x4*)(x3b + (size_t)m * D) + lane; f32x4* orow = (f32x4*)(a.out + (size_t)m * D); const f32x4* wr4 = (const f32x4*)a.final_norm_w;
#pragma unroll
        for (int j = 0; j < 4; ++j) { const u32x4 xw = xr[64 * j]; const int c4 = (64 * j + lane) * 2; const f32x4 w0 = wr4[c4], w1 = wr4[c4 + 1];
            f32x4 v0 = {bflo(xw.x) * rstd * w0.x, bfhi(xw.x) * rstd * w0.y, bflo(xw.y) * rstd * w0.z, bfhi(xw.y) * rstd * w0.w};
            f32x4 v1 = {bflo(xw.z) * rstd * w1.x, bfhi(xw.z) * rstd * w1.y, bflo(xw.w) * rstd * w1.z, bfhi(xw.w) * rstd * w1.w};
            orow[c4] = v0; orow[c4 + 1] = v1; }
    } }
    if (PROBE_DUP == 7) { for (int i_ = 0; i_ < 20; ++i_) grid.sync(); }
    if (PROBE_T != 0) {
        asm volatile("s_waitcnt vmcnt(0)" ::: "memory"); grid.sync(); STAMP(11); grid.sync();
        unsigned probe_m = 50000u;
        if (PROBE_T != 100) { const unsigned long long* tsb = (const unsigned long long*)(a.ws + 200 * 1024); constexpr int HI_ = PROBE_T == 13 ? 12 : (PROBE_T == 14 ? 4 : (PROBE_T == 15 ? 11 : PROBE_T)), LO_ = PROBE_T == 13 ? 3 : (PROBE_T == 14 ? 12 : (PROBE_T == 15 ? 0 : PROBE_T - 1));
            probe_m = (unsigned)(__hip_atomic_load(tsb + HI_, __ATOMIC_RELAXED, __HIP_MEMORY_SCOPE_AGENT) - __hip_atomic_load(tsb + LO_, __ATOMIC_RELAXED, __HIP_MEMORY_SCOPE_AGENT)); if (PROBE_T == 15) probe_m /= 8; }
        for (unsigned e = blockIdx.x * 512u + threadIdx.x; e < probe_m; e += gridDim.x * 512u) a.out[e] += 0.08f;
    }
}

extern "C" void kernel_launch(void* const* d_in, const int* in_sizes, int n_in, void* d_out, int out_size, void* d_ws, size_t ws_size, hipStream_t stream) {
    static int grid = 0;
    if (grid == 0) {
        if (n_in != 18 || out_size != T * D || ws_size < WS_END) { fprintf(stderr, "kernel_launch: unexpected problem (n_in %d out %d ws %zu)\n", n_in, out_size, ws_size); grid = -1; return; }
        int dev = 0, cus = 0, per_cu = 0;
        hipGetDevice(&dev); hipDeviceGetAttribute(&cus, hipDeviceAttributeMultiprocessorCount, dev);
        if (hipFuncSetAttribute((const void*)fwd_megakernel, hipFuncAttributeMaxDynamicSharedMemorySize, LDS_BYTES) != hipSuccess) { fprintf(stderr, "kernel_launch: hipFuncSetAttribute failed\n"); grid = -1; return; }
        if (hipOccupancyMaxActiveBlocksPerMultiprocessor(&per_cu, (const void*)fwd_megakernel, 512, LDS_BYTES) != hipSuccess || per_cu < 1) { fprintf(stderr, "kernel_launch: occupancy query says %d\n", per_cu); per_cu = 1; }
        (void)hipGetLastError();
        grid = cus * per_cu;
    }
    if (grid < 0) return;
    Args a{};
    const float** f = (const float**)&a;
    for (int i = 0; i < 18; ++i) f[i] = (const float*)d_in[i];
    a.out = (float*)d_out; a.ws = (unsigned char*)d_ws;
    if (hipMemsetAsync((char*)d_ws + WS_BAR, 0, 16384, stream) != hipSuccess) { fprintf(stderr, "kernel_launch: memset of the barrier words failed\n"); return; }
    void* args[] = {&a};
    hipError_t e = hipLaunchCooperativeKernel((const void*)fwd_megakernel, dim3(grid), dim3(512), args, LDS_BYTES, stream);
    if (e != hipSuccess) fprintf(stderr, "cooperative launch failed: %s (grid %d)\n", hipGetErrorString(e), grid);
}
```

```cpp
#include <hip/hip_runtime.h>
#include <hip/hip_cooperative_groups.h>
#include <cstdio>
#include <cstdint>
namespace cg = cooperative_groups;
#ifndef PROBE_DUP
#define PROBE_DUP 0
#endif
#ifndef PROBE_T
#define PROBE_T 0
#endif
#ifndef WGM_P1R
#define WGM_P1R 4
#endif
#ifndef WGM_P1T
#define WGM_P1T 4
#endif
#ifndef WGM_P5
#define WGM_P5 4
#endif
#ifndef WGM_P6
#define WGM_P6 8
#endif
#ifndef WGM_P8
#define WGM_P8 4
#endif
#ifndef WGM_PP
#define WGM_PP 4
#endif
#ifndef WGM_P9
#define WGM_P9 4
#endif
#define REPS(k) for (int rep_ = 0; rep_ < (PROBE_DUP == (k) ? 2 : 1); ++rep_)

#define LAS __attribute__((address_space(3)))
typedef unsigned short bf16_t;
typedef short bf16x8 __attribute__((ext_vector_type(8)));
typedef float f32x4 __attribute__((ext_vector_type(4)));
typedef float f32x2 __attribute__((ext_vector_type(2)));
typedef unsigned u32x4 __attribute__((ext_vector_type(4)));
typedef unsigned u32x2 __attribute__((ext_vector_type(2)));

constexpr int T = 16384, D = 2048, FF = 5632, NR = 4096, PLE = 256, NCH = 256;
constexpr int QA = 0, KA = 1024, QG = 2048, KG = 2560, RG = 3072;
constexpr float EPS = 1e-6f;
constexpr size_t MiB = 1u << 20;
constexpr size_t WS_SSQ1 = 0, WS_SSQ2 = 65536, WS_SSQ3 = 131072, WS_GLR = 1 * MiB, WS_WG = 2 * MiB, WS_WPP = 3 * MiB;
constexpr size_t WS_WIN = 4 * MiB, WS_WOUT = 28 * MiB, WS_WUP = 36 * MiB, WS_WDN = 80 * MiB, WS_WPG = 102 * MiB, WS_PB = 110 * MiB;
constexpr size_t WS_H0 = 118 * MiB;
constexpr size_t WS_PROJ = 182 * MiB;
constexpr size_t WS_VT = 310 * MiB;
constexpr size_t WS_X1B = 182 * MiB, WS_G = 246 * MiB, WS_TAIL = 422 * MiB, WS_HEAD = 444 * MiB, WS_PP = 422 * MiB  , WS_X3B = 182 * MiB  , WS_YCAT = WS_H0, WS_X2B = WS_H0;
constexpr size_t WS_DEC = 256 * 1024, WS_UPD = 406 * MiB, WS_BCUM = 374 * MiB;
constexpr size_t WS_BAR = 800 * 1024;
constexpr size_t WS_GLR1 = 470 * MiB;
constexpr size_t WS_RSTD0 = 900 * 1024;
constexpr size_t WS_END = 512 * MiB;
constexpr int LDS_BYTES = 147456;

__device__ __forceinline__ unsigned f2bf(float f) { unsigned u = __builtin_bit_cast(unsigned, f); return (u + 0x7fffu + ((u >> 16) & 1u)) >> 16; }
typedef __bf16 hwbf16x2 __attribute__((ext_vector_type(2)));
__device__ __forceinline__ unsigned pk2(float lo, float hi) { const f32x2 v = {lo, hi}; return __builtin_bit_cast(unsigned, __builtin_convertvector(v, hwbf16x2)); }
__device__ __forceinline__ float frcp(float x) { return __builtin_amdgcn_rcpf(x); }
__device__ __forceinline__ float frsq(float x) { return __builtin_amdgcn_rsqf(x); }
__device__ __forceinline__ float fsigmoid(float x) { return frcp(1.0f + __builtin_amdgcn_exp2f(-1.4426950408889634f * x)); }
__device__ __forceinline__ float bf2f(unsigned short b) { return __builtin_bit_cast(float, (unsigned)b << 16); }
__device__ __forceinline__ float bflo(unsigned w) { return __builtin_bit_cast(float, w << 16); }
__device__ __forceinline__ float bfhi(unsigned w) { return __builtin_bit_cast(float, w & 0xffff0000u); }
__device__ __forceinline__ float wave_sum(float v) {
#pragma unroll
    for (int o = 1; o < 64; o <<= 1) v += __shfl_xor(v, o);
    return v;
}

namespace pg8 {
#define PG8_LAS __attribute__((address_space(3)))
constexpr int BM = 256, BK = 64, HALF = 128, HTB = HALF * BK * 2, STAGE_BYTES = 8 * HTB, NXCD = 8;
__host__ __device__ __forceinline__ int lds_byte(int r, int c) { const int st = (r >> 4) * 2 + (c >> 5), rr = r & 15, cc = c & 31, ob = rr * 64 + cc * 2; return st * 1024 + (ob ^ (((ob >> 9) & 1) << 5)); }
__host__ __device__ __forceinline__ void stage_rc(int b, int& R, int& C) { const int st = b / 1024, sb = b % 1024, swz = sb ^ (((sb >> 9) & 1) << 5); R = (st >> 1) * 16 + swz / 64; C = (st & 1) * 32 + (swz % 64) / 2; }
__host__ __device__ __forceinline__ int perm32(int rho) { const int n = rho >> 4, i = rho & 15; return 8 * (i >> 2) + 4 * n + (i & 3); }

struct Unit { int pm, pn; };
struct Gemm { const bf16_t* A; const bf16_t* Bt; int M, N, K; };

struct StaticOrder {
    int nM, nN, nwg, G, c, WGM;
    __host__ __device__ void init(int M, int N, int G_, int c_, int wgm) { nM = M / BM; nN = N / BM; nwg = nM * nN; G = G_; c = c_; WGM = wgm; }
    __host__ __device__ bool next(int i, Unit& u) const {
        const long L = (long)i * G + c; if (L >= nwg) return false;
        int wgid = (int)L; { const int q = nwg / NXCD, r = nwg % NXCD, xcd = wgid % NXCD, off = wgid / NXCD; wgid = (xcd < r ? xcd * (q + 1) : r * (q + 1) + (xcd - r) * q) + off; }
        const int nig = WGM * nN, gid = wgid / nig, fm = gid * WGM, gsz = (nM - fm) < WGM ? (nM - fm) : WGM;
        u.pm = fm + ((wgid % nig) % gsz); u.pn = (wgid % nig) / gsz; return true;
    }
    __device__ __forceinline__ void a_ready(const Unit&) const {}
    __device__ __forceinline__ void done(const Unit&) const {}
};

__device__ __forceinline__ unsigned cvt_pk_bf16(float lo, float hi) { return pk2(lo, hi); }

struct EpiBf16 {
    static constexpr bool PERM = true, AFTER_DRAIN = false;
    bf16_t* O; int ldc; const float* rs; const float* cs;
    __device__ __forceinline__ void operator()(const f32x4 (&acc)[2][2][4][2], const Unit& u, int wr, int wc, int fr, int fq) const {
        const int row0 = u.pm * BM + wr * 64 + fr; const int col0 = u.pn * BM + wc * 32 + 8 * fq;
        f32x4 c0[2], c1[2];
#pragma unroll
        for (int bj = 0; bj < 2; ++bj) { c0[bj] = cs ? *(const f32x4*)(cs + col0 + bj * HALF) : (f32x4){1.f, 1.f, 1.f, 1.f}; c1[bj] = cs ? *(const f32x4*)(cs + col0 + bj * HALF + 4) : (f32x4){1.f, 1.f, 1.f, 1.f}; }
#pragma unroll
        for (int ai = 0; ai < 2; ++ai)
#pragma unroll
            for (int m = 0; m < 4; ++m) { const int row = row0 + ai * HALF + m * 16; bf16_t* rowp = O + (size_t)row * ldc + col0; const float r = rs ? rs[row] : 1.0f;
#pragma unroll
                for (int bj = 0; bj < 2; ++bj) { const f32x4 v0 = acc[ai][bj][m][0] * c0[bj] * r, v1 = acc[ai][bj][m][1] * c1[bj] * r;
                    u32x4 w; w.x = cvt_pk_bf16(v0[0], v0[1]); w.y = cvt_pk_bf16(v0[2], v0[3]); w.z = cvt_pk_bf16(v1[0], v1[1]); w.w = cvt_pk_bf16(v1[2], v1[3]);
                    *(u32x4*)(rowp + bj * HALF) = w; } }
    }
};
template <bool BASE_BF16> struct EpiResid {
    static constexpr bool PERM = true, AFTER_DRAIN = false;
    const void* base; bf16_t* ob; float* ssq;
    __device__ __forceinline__ void operator()(const f32x4 (&acc)[2][2][4][2], const Unit& u, int wr, int wc, int fr, int fq) const {
        const int row0 = u.pm * BM + wr * 64 + fr; const int col0 = u.pn * BM + wc * 32 + 8 * fq;
#pragma unroll
        for (int ai = 0; ai < 2; ++ai)
#pragma unroll
            for (int m = 0; m < 4; ++m) { const int row = row0 + ai * HALF + m * 16; const size_t off = (size_t)row * D + col0; float ss = 0.f;
#pragma unroll
                for (int bj = 0; bj < 2; ++bj) {
                    f32x4 b0, b1;
                    if (BASE_BF16) { const u32x4 pw = *(const u32x4*)((const bf16_t*)base + off + bj * HALF); b0 = (f32x4){bflo(pw.x), bfhi(pw.x), bflo(pw.y), bfhi(pw.y)}; b1 = (f32x4){bflo(pw.z), bfhi(pw.z), bflo(pw.w), bfhi(pw.w)}; }
                    else { b0 = *(const f32x4*)((const float*)base + off + bj * HALF); b1 = *(const f32x4*)((const float*)base + off + bj * HALF + 4); }
                    const f32x4 v0 = acc[ai][bj][m][0] + b0, v1 = acc[ai][bj][m][1] + b1;
                    u32x4 w; w.x = cvt_pk_bf16(v0[0], v0[1]); w.y = cvt_pk_bf16(v0[2], v0[3]); w.z = cvt_pk_bf16(v1[0], v1[1]); w.w = cvt_pk_bf16(v1[2], v1[3]);
                    *(u32x4*)(ob + off + bj * HALF) = w;
                    ss += (v0[0] * v0[0] + v0[1] * v0[1]) + (v0[2] * v0[2] + v0[3] * v0[3]) + (v1[0] * v1[0] + v1[1] * v1[1]) + (v1[2] * v1[2] + v1[3] * v1[3]); }
                ss += __shfl_xor(ss, 16); ss += __shfl_xor(ss, 32);
                if (fq == 0) atomicAdd(ssq + row, ss); }
    }
};
struct EpiPle {
    static constexpr bool PERM = true, AFTER_DRAIN = false;
    const bf16_t* x2; bf16_t* x3; const bf16_t* pp; const float* ssq2; float* ssq3;
    __device__ __forceinline__ void operator()(const f32x4 (&acc)[2][2][4][2], const Unit& u, int wr, int wc, int fr, int fq) const {
        const int row0 = u.pm * BM + wr * 64 + fr; const int col0 = u.pn * BM + wc * 32 + 8 * fq;
#pragma unroll
        for (int ai = 0; ai < 2; ++ai)
#pragma unroll
            for (int m = 0; m < 4; ++m) { const int row = row0 + ai * HALF + m * 16; const size_t off = (size_t)row * D + col0; float ss = 0.f;
                const float rstd = frsq(ssq2[row] * (1.0f / D) + EPS);
#pragma unroll
                for (int bj = 0; bj < 2; ++bj) {
                    const u32x4 xw = *(const u32x4*)(x2 + off + bj * HALF);
                    const u32x4 pw = *(const u32x4*)(pp + off + bj * HALF);
                    const f32x4 b0 = {bflo(xw.x), bfhi(xw.x), bflo(xw.y), bfhi(xw.y)}, b1 = {bflo(xw.z), bfhi(xw.z), bflo(xw.w), bfhi(xw.w)};
                    const f32x4 p0 = {bflo(pw.x), bfhi(pw.x), bflo(pw.y), bfhi(pw.y)}, p1 = {bflo(pw.z), bfhi(pw.z), bflo(pw.w), bfhi(pw.w)};
                    f32x4 v0, v1;
#pragma unroll
                    for (int e = 0; e < 4; ++e) { const float g0 = fsigmoid(acc[ai][bj][m][0][e] * rstd), g1 = fsigmoid(acc[ai][bj][m][1][e] * rstd);
                        v0[e] = b0[e] + g0 * p0[e]; v1[e] = b1[e] + g1 * p1[e]; }
                    u32x4 w; w.x = cvt_pk_bf16(v0[0], v0[1]); w.y = cvt_pk_bf16(v0[2], v0[3]); w.z = cvt_pk_bf16(v1[0], v1[1]); w.w = cvt_pk_bf16(v1[2], v1[3]);
                    *(u32x4*)(x3 + off + bj * HALF) = w;
                    ss += (v0[0] * v0[0] + v0[1] * v0[1]) + (v0[2] * v0[2] + v0[3] * v0[3]) + (v1[0] * v1[0] + v1[1] * v1[1]) + (v1[2] * v1[2] + v1[3] * v1[3]); }
                ss += __shfl_xor(ss, 16); ss += __shfl_xor(ss, 32);
                if (fq == 0) atomicAdd(ssq3 + row, ss); }
    }
};
__device__ __forceinline__ float gelu_tanh(float x) {
    const float t = x * x * (-1.5957691216057308f * 1.4426950408889634f * 0.044715f) + (-1.5957691216057308f * 1.4426950408889634f);
    return x * frcp(1.0f + __builtin_amdgcn_exp2f(t * x));
}
template <int CTRL> __device__ __forceinline__ float dppz(float v) { return __builtin_bit_cast(float, __builtin_amdgcn_update_dpp(0, __builtin_bit_cast(int, v), CTRL, 0xf, 0xf, true)); }
#define FMAC_DPP(acc, src, w, CTRL) asm volatile("s_nop 1\n\tv_fmac_f32_dpp %0, %1, %2 " CTRL " row_mask:0xf bank_mask:0xf bound_ctrl:1" : "+v"(acc) : "v"(src), "v"(w))
struct EpiUp {
    static constexpr bool PERM = true, AFTER_DRAIN = false;
    bf16_t* G; const float* ssq1; const float* cw; const float* cb; float* tail; float* head;
    __device__ __forceinline__ void operator()(const f32x4 (&acc)[2][2][4][2], const Unit& u, int wr, int wc, int fr, int fq) const {
        const int C0 = u.pn * 128 + wc * 32 + 8 * fq;
#pragma unroll
        for (int ai = 0; ai < 2; ++ai) {
            const int rbase = u.pm * BM + ai * HALF + wr * 64; const int grp = rbase >> 6;
            float rstd[4];
#pragma unroll
            for (int m = 0; m < 4; ++m) rstd[m] = frsq(ssq1[rbase + m * 16 + fr] * (1.0f / D) + EPS);
            if (fr < 2) { float* hp = head + ((size_t)grp * 2 + fr) * (2 * FF) + C0;
#pragma unroll
                for (int bj = 0; bj < 2; ++bj) { *(f32x4*)(hp + bj * FF) = acc[ai][bj][0][0] * rstd[0]; *(f32x4*)(hp + bj * FF + 4) = acc[ai][bj][0][1] * rstd[0]; } }
            if (fr >= 14) { float* tp = tail + ((size_t)grp * 2 + (fr - 14)) * (2 * FF) + C0;
#pragma unroll
                for (int bj = 0; bj < 2; ++bj) { *(f32x4*)(tp + bj * FF) = acc[ai][bj][3][0] * rstd[3]; *(f32x4*)(tp + bj * FF + 4) = acc[ai][bj][3][1] * rstd[3]; } }
            __builtin_amdgcn_sched_barrier(0);
#pragma unroll
            for (int n = 0; n < 2; ++n) {
                unsigned outw[4][2];
#pragma unroll
                for (int ep = 0; ep < 2; ++ep) {
                    int C = C0 + 4 * n + 2 * ep; asm volatile("" : "+v"(C));
                    const f32x2 wg0 = *(const f32x2*)(cw + C), wg1 = *(const f32x2*)(cw + 2 * FF + C), wg2 = *(const f32x2*)(cw + 4 * FF + C), bg = *(const f32x2*)(cb + C);
                    const f32x2 wv0 = *(const f32x2*)(cw + FF + C), wv1 = *(const f32x2*)(cw + 3 * FF + C), wv2 = *(const f32x2*)(cw + 5 * FF + C), bv = *(const f32x2*)(cb + FF + C);
                    f32x2 ugp = {0.f, 0.f}, uvp = {0.f, 0.f};
#pragma unroll
                    for (int m = 0; m < 4; ++m) {
                        f32x2 ug = (f32x2){acc[ai][0][m][n][2 * ep], acc[ai][0][m][n][2 * ep + 1]} * rstd[m], uv = (f32x2){acc[ai][1][m][n][2 * ep], acc[ai][1][m][n][2 * ep + 1]} * rstd[m];
                        asm volatile("" : "+v"(ug), "+v"(uv));
                        f32x2 yg = wg2 * ug + bg, yv = wv2 * uv + bv;
#pragma unroll
                        for (int q = 0; q < 2; ++q) {
                            FMAC_DPP(yg[q], ug[q], wg1[q], "row_shr:1"); FMAC_DPP(yv[q], uv[q], wv1[q], "row_shr:1");
                            FMAC_DPP(yg[q], ug[q], wg0[q], "row_shr:2"); FMAC_DPP(yv[q], uv[q], wv0[q], "row_shr:2");
                            if (m > 0) { FMAC_DPP(yg[q], ugp[q], wg1[q], "row_shl:15"); FMAC_DPP(yv[q], uvp[q], wv1[q], "row_shl:15");
                                         FMAC_DPP(yg[q], ugp[q], wg0[q], "row_shl:14"); FMAC_DPP(yv[q], uvp[q], wv0[q], "row_shl:14"); } }
                        f32x2 t = yg * yg * (-1.5957691216057308f * 1.4426950408889634f * 0.044715f) + (-1.5957691216057308f * 1.4426950408889634f);
                        t = t * yg;
                        f32x2 den = {__builtin_amdgcn_exp2f(t[0]), __builtin_amdgcn_exp2f(t[1])}; den = den + 1.0f;
                        const f32x2 rc = {frcp(den[0]), frcp(den[1])};
                        f32x2 o = yg * rc * yv; asm volatile("" : "+v"(o));
                        outw[m][ep] = pk2(o[0], o[1]);
                        ugp = ug; uvp = uv;
                    }
                    __builtin_amdgcn_sched_barrier(0);
                }
#pragma unroll
                for (int m = 0; m < 4; ++m) if (m > 0 || fr >= 2) { u32x2 w = {outw[m][0], outw[m][1]}; *(u32x2*)(G + (size_t)(rbase + m * 16 + fr) * FF + C0 + 4 * n) = w; }
                __builtin_amdgcn_sched_barrier(0);
            }
        }
    }
};

template <class Epi, class Sched, bool ALIGN_EPI = false, bool SP2 = false>
__device__ __forceinline__ void gemm_phase(PG8_LAS unsigned char* lds, const Gemm g, const Sched& S, const Epi& E) {
    int tid_ = threadIdx.x; asm volatile("" : "+v"(tid_));
    const int tid = tid_, wid = __builtin_amdgcn_readfirstlane(tid >> 6), lane = tid & 63, wr = wid >> 2, wc = wid & 3, fr = lane & 15, fq = lane >> 4;
    const int K = g.K, nt = K / BK;
    unsigned voffA[2], voffB[2];
#pragma unroll
    for (int i = 0; i < 2; ++i) { int R, C; stage_rc(tid * 16 + i * 8192, R, C); const int Rb = Epi::PERM ? ((R & ~31) + perm32(R & 31)) : R;
        voffA[i] = (unsigned)(R * K + C) * 2u; voffB[i] = (unsigned)(Rb * K + C) * 2u; }
    const size_t kstep = (size_t)(BK * 2);
    const size_t hstep = (size_t)HALF * K * 2;
    const size_t tstep = 2 * hstep;
    const unsigned ldsw = (unsigned)wid * 1024u;
    const int aoff = lds_byte(wr * 64 + fr, fq * 8), boff = lds_byte(wc * 32 + fr, fq * 8);
#define PG8_SA(b, h) (((b) * 2 + (h)) * HTB)
#define PG8_SB(b, h) ((4 + (b) * 2 + (h)) * HTB)
#define PG8_STAGE(bufoff, gbase, voff) do { _Pragma("unroll") for (int _i = 0; _i < 2; ++_i) \
        __builtin_amdgcn_global_load_lds((const unsigned*)((const char*)(gbase) + (voff)[_i]), (PG8_LAS unsigned*)(lds + (bufoff) + ldsw + _i * 8192), 16, 0, 0); } while (0)
#define PG8_LDA(dst, b, h) do { _Pragma("unroll") for (int m = 0; m < 4; ++m) _Pragma("unroll") for (int k = 0; k < 2; ++k) dst[m][k] = *(const PG8_LAS bf16x8*)(lds + PG8_SA(b, h) + aoff + m * 2048 + k * 1024); } while (0)
#define PG8_LDB(dst, b, h) do { _Pragma("unroll") for (int n = 0; n < 2; ++n) _Pragma("unroll") for (int k = 0; k < 2; ++k) dst[n][k] = *(const PG8_LAS bf16x8*)(lds + PG8_SB(b, h) + boff + n * 2048 + k * 1024); } while (0)
#define PG8_MMA(ai, bj, At, Bt) do { __builtin_amdgcn_s_setprio(1); _Pragma("unroll") for (int m = 0; m < 4; ++m) _Pragma("unroll") for (int n = 0; n < 2; ++n) _Pragma("unroll") for (int k = 0; k < 2; ++k) \
        acc[ai][bj][m][n] = __builtin_amdgcn_mfma_f32_16x16x32_bf16(Bt[n][k], At[m][k], acc[ai][bj][m][n], 0, 0, 0); __builtin_amdgcn_s_setprio(0); } while (0)
#define PG8_WAIT_V(n) asm volatile("s_waitcnt vmcnt(" #n ")" ::: "memory")
#define PG8_WAIT_L(n) asm volatile("s_waitcnt lgkmcnt(" #n ")" ::: "memory")
#define PG8_BAR __builtin_amdgcn_s_barrier()
#define PG8_SCHED __builtin_amdgcn_sched_barrier(0)
    Unit cur, nxt; int ui = 0;
    if (!S.next(0, cur)) return;
    f32x4 acc[2][2][4][2];
#pragma unroll
    for (int a = 0; a < 2; ++a)
#pragma unroll
        for (int b = 0; b < 2; ++b)
#pragma unroll
            for (int m = 0; m < 4; ++m)
#pragma unroll
                for (int n = 0; n < 2; ++n) acc[a][b][m][n] = (f32x4){0.f, 0.f, 0.f, 0.f};
    bf16x8 At[4][2], B0[2][2], B1[2][2];
    const char* cA = (const char*)g.A + (size_t)cur.pm * tstep; const char* cB = (const char*)g.Bt + (size_t)cur.pn * tstep;
    S.a_ready(cur);
    if constexpr (SP2) {
        PG8_STAGE(PG8_SB(0, 0), cB, voffB); PG8_STAGE(PG8_SB(0, 1), cB + hstep, voffB); PG8_STAGE(PG8_SA(0, 0), cA, voffA); PG8_STAGE(PG8_SA(0, 1), cA + hstep, voffA);
        if (wr == 1) PG8_BAR;
        PG8_WAIT_V(2); PG8_BAR;
        PG8_STAGE(PG8_SB(1, 0), cB + kstep, voffB); PG8_STAGE(PG8_SA(1, 0), cA + kstep, voffA); PG8_STAGE(PG8_SB(1, 1), cB + hstep + kstep, voffB);
        PG8_WAIT_V(6); PG8_BAR;
    } else {
        PG8_STAGE(PG8_SB(0, 0), cB, voffB); PG8_STAGE(PG8_SA(0, 0), cA, voffA); PG8_STAGE(PG8_SB(0, 1), cB + hstep, voffB); PG8_STAGE(PG8_SA(0, 1), cA + hstep, voffA);
        if (wr == 1) PG8_BAR;
        PG8_WAIT_V(4); PG8_BAR;
        PG8_STAGE(PG8_SB(1, 0), cB + kstep, voffB); PG8_STAGE(PG8_SA(1, 0), cA + kstep, voffA); PG8_STAGE(PG8_SB(1, 1), cB + hstep + kstep, voffB);
        PG8_WAIT_V(6); PG8_BAR;
    }
    for (;;) {
        const bool has_next = S.next(ui + 1, nxt);
        const char* nA = has_next ? (const char*)g.A + (size_t)nxt.pm * tstep : cA; const char* nB = has_next ? (const char*)g.Bt + (size_t)nxt.pn * tstep : cB;
        for (int t = 0; t < nt; t += 2) {
            const bool last = (t == nt - 2);
            const char* a1 = cA + (size_t)(t + 1) * kstep;
            const char* a2 = last ? nA : cA + (size_t)(t + 2) * kstep; const char* b2 = last ? nB : cB + (size_t)(t + 2) * kstep;
            const char* a3 = a2 + kstep; const char* b3 = b2 + kstep;
            if (last && has_next) S.a_ready(nxt);
            if constexpr (SP2) {
            PG8_LDB(B0, 0, 0); PG8_LDB(B1, 0, 1); PG8_SCHED; PG8_LDA(At, 0, 0); PG8_STAGE(PG8_SA(1, 1), a1 + hstep, voffA);
            PG8_WAIT_V(8); PG8_WAIT_L(0); PG8_BAR; PG8_MMA(0, 0, At, B0); PG8_MMA(0, 1, At, B1); PG8_BAR; PG8_SCHED;
            PG8_LDA(At, 0, 1); PG8_STAGE(PG8_SB(0, 0), b2, voffB); PG8_STAGE(PG8_SB(0, 1), b2 + hstep, voffB); PG8_STAGE(PG8_SA(0, 0), a2, voffA);
            PG8_WAIT_V(8); PG8_WAIT_L(0); PG8_BAR; PG8_MMA(1, 0, At, B0); PG8_MMA(1, 1, At, B1); PG8_BAR; PG8_SCHED;
            PG8_LDB(B0, 1, 0); PG8_LDB(B1, 1, 1); PG8_SCHED; PG8_LDA(At, 1, 0); PG8_STAGE(PG8_SA(0, 1), a2 + hstep, voffA);
            PG8_WAIT_V(8); PG8_WAIT_L(0); PG8_BAR; PG8_MMA(0, 0, At, B0); PG8_MMA(0, 1, At, B1); PG8_BAR; PG8_SCHED;
            PG8_LDA(At, 1, 1); PG8_STAGE(PG8_SB(1, 0), b3, voffB); PG8_STAGE(PG8_SB(1, 1), b3 + hstep, voffB); PG8_STAGE(PG8_SA(1, 0), a3, voffA);
            PG8_WAIT_V(8); PG8_WAIT_L(0); PG8_BAR; PG8_MMA(1, 0, At, B0); PG8_MMA(1, 1, At, B1); PG8_BAR; PG8_SCHED;
            } else {
            PG8_LDB(B0, 0, 0); PG8_SCHED; PG8_LDA(At, 0, 0); PG8_STAGE(PG8_SA(1, 1), a1 + hstep, voffA);
            PG8_WAIT_L(8); PG8_BAR; PG8_WAIT_L(0); PG8_MMA(0, 0, At, B0); PG8_BAR; PG8_SCHED;
            PG8_LDB(B1, 0, 1); PG8_STAGE(PG8_SB(0, 0), b2, voffB);
            PG8_BAR; PG8_WAIT_L(0); PG8_MMA(0, 1, At, B1); PG8_BAR;
            PG8_LDA(At, 0, 1); PG8_STAGE(PG8_SA(0, 0), a2, voffA);
            PG8_BAR; PG8_WAIT_L(0); PG8_MMA(1, 0, At, B0); PG8_BAR; PG8_SCHED;
            PG8_STAGE(PG8_SB(0, 1), b2 + hstep, voffB);
            PG8_WAIT_V(6); PG8_BAR; PG8_MMA(1, 1, At, B1); PG8_BAR;
            PG8_LDB(B0, 1, 0); PG8_SCHED; PG8_LDA(At, 1, 0); PG8_STAGE(PG8_SA(0, 1), a2 + hstep, voffA);
            PG8_WAIT_L(8); PG8_BAR; PG8_WAIT_L(0); PG8_MMA(0, 0, At, B0); PG8_BAR; PG8_SCHED;
            PG8_LDB(B1, 1, 1); PG8_STAGE(PG8_SB(1, 0), b3, voffB);
            PG8_BAR; PG8_WAIT_L(0); PG8_MMA(0, 1, At, B1); PG8_BAR;
            PG8_LDA(At, 1, 1); PG8_STAGE(PG8_SA(1, 0), a3, voffA);
            PG8_BAR; PG8_WAIT_L(0); PG8_MMA(1, 0, At, B0); PG8_BAR; PG8_SCHED;
            PG8_STAGE(PG8_SB(1, 1), b3 + hstep, voffB);
            PG8_WAIT_V(6); PG8_BAR; PG8_MMA(1, 1, At, B1); PG8_BAR;
            }
        }
        if constexpr (ALIGN_EPI) { if (wr == 0) PG8_BAR; }
        if constexpr (!Epi::AFTER_DRAIN) { E(acc, cur, wr, wc, fr, fq); S.done(cur); }
        if (!has_next) break;
#pragma unroll
        for (int a = 0; a < 2; ++a)
#pragma unroll
            for (int b = 0; b < 2; ++b)
#pragma unroll
                for (int m = 0; m < 4; ++m)
#pragma unroll
                    for (int n = 0; n < 2; ++n) acc[a][b][m][n] = (f32x4){0.f, 0.f, 0.f, 0.f};
        cur = nxt; cA = nA; cB = nB; ++ui;
        if constexpr (ALIGN_EPI) { if (wr == 1) PG8_BAR; }
    }
    PG8_WAIT_V(0);
    if constexpr (!ALIGN_EPI) { if (wr == 0) PG8_BAR; }
    PG8_BAR;
#undef PG8_SA
#undef PG8_SB
#undef PG8_STAGE
#undef PG8_LDA
#undef PG8_LDB
#undef PG8_MMA
#undef PG8_WAIT_V
#undef PG8_WAIT_L
#undef PG8_BAR
#undef PG8_SCHED
}
}

struct Args {
    const float *x, *p, *norm_mix_w, *w_in, *att_rel_bias, *w_gla_gate_up, *b_gla_gate, *gla_norm_w, *w_out, *norm_ffn_w, *w_ffn_up, *w_ffn_conv, *b_ffn_conv, *w_ffn_down,
                *norm_ple_w, *w_ple_gate, *w_ple_proj, *final_norm_w;
    float* out; unsigned char* ws;
};

__device__ __forceinline__ int map_row(int mode, int n) {
    if (mode == 1) { if (n < 2048) return n; if (n < 3072) return n + 2048; if (n < 4096) return n - 1024; if (n < 5120) return n + 1024; return n - 2048; }
    if (mode == 2) { const int half = n >= FF ? 1 : 0; const int c = n - half * FF; return (c >> 7) * 256 + half * 128 + (c & 127); }
    return n;
}
__device__ __forceinline__ void transpose_item(const float* W, int K, int ldn, int nblk, bf16_t* WT, LAS float* scr, int item, int lane, const float* kscale, int mode) {
    const int kb = item / nblk, nb = item % nblk, k0 = 32 * kb, n0 = 128 * nb;
    const int c4 = lane & 31, kh = lane >> 5;
    f32x4 v[16];
#pragma unroll
    for (int i = 0; i < 16; ++i) v[i] = __builtin_nontemporal_load((const f32x4*)(W + (size_t)(k0 + 2 * i + kh) * ldn + n0 + 4 * c4));
#pragma unroll
    for (int i = 0; i < 16; ++i) { f32x4 t = v[i]; if (kscale) t = t * kscale[k0 + 2 * i + kh]; *(LAS f32x4*)(scr + (2 * i + kh) * 132 + 4 * c4) = t; }
    asm volatile("s_waitcnt lgkmcnt(0)" ::: "memory");
    const int c = lane & 3, nl = lane >> 2; const int drow0 = map_row(mode, n0);
#pragma unroll
    for (int j = 0; j < 8; ++j) { const int n = nl + 16 * j; const LAS float* sp = scr + (8 * c) * 132 + n;
        u32x4 o; o.x = pk2(sp[0 * 132], sp[1 * 132]); o.y = pk2(sp[2 * 132], sp[3 * 132]); o.z = pk2(sp[4 * 132], sp[5 * 132]); o.w = pk2(sp[6 * 132], sp[7 * 132]);
        *(u32x4*)(WT + (size_t)(drow0 + n) * K + k0 + 8 * c) = o; }
    asm volatile("s_waitcnt lgkmcnt(0)" ::: "memory");
}

#define XB_TMO      128
#define XB_XCNT(j)  (256  + 64 * (j))
#define XB_XSUB(j)  (1280 + 64 * (j))
#define XB_XGEN(j)  (2304 + 64 * (j))
#define XB_TOP      3328
#define XB_TOPGEN   3392
#define XCD_BAR_WORDS 3456
#define XB_SPIN_CAP (1u << 18)
__device__ __forceinline__ unsigned xb_ld(unsigned* p)              { return __hip_atomic_load(p, __ATOMIC_RELAXED, __HIP_MEMORY_SCOPE_AGENT); }
__device__ __forceinline__ unsigned xb_add(unsigned* p, unsigned v) { return __hip_atomic_fetch_add(p, v, __ATOMIC_RELAXED, __HIP_MEMORY_SCOPE_AGENT); }
__device__ __forceinline__ unsigned xb_xcc_id() { return (unsigned)__builtin_amdgcn_s_getreg((3 << 11) | 20) & 0xFu; }
#define XB_SPIN(cond, bar) do { unsigned _sp = 0; while (cond) { __builtin_amdgcn_s_sleep(1); \
    if ((++_sp & 255u) == 0u) { if (xb_ld(&(bar)[XB_TMO])) break; if (_sp > XB_SPIN_CAP) { atomicAdd(&(bar)[XB_TMO], 1u); break; } } } } while (0)
struct XcdBarrier {
    unsigned* bar; unsigned x;
    volatile LAS unsigned* st;
};
__device__ __forceinline__ XcdBarrier xcd_barrier_post(unsigned* bar, volatile LAS unsigned* st) {
    XcdBarrier b; b.bar = bar; b.x = xb_xcc_id(); b.st = st;
    if (threadIdx.x == 0) (void)xb_add(&bar[XB_XCNT(b.x)], 1u);
    return b;
}
__device__ __forceinline__ void xcd_barrier_complete(unsigned* bar, unsigned x, unsigned& nloc, unsigned& nx) {
    const unsigned G = gridDim.x * gridDim.y * gridDim.z;
    unsigned sum, cnt, mine, sp = 0u;
    for (;;) {
        sum = 0u; cnt = 0u; mine = 0u;
#pragma unroll
        for (unsigned j = 0; j < 16; ++j) { const unsigned c = xb_ld(&bar[XB_XCNT(j)]); sum += c; cnt += (c > 0u) ? 1u : 0u; mine = (j == x) ? c : mine; }
        if (sum == G) break;
        __builtin_amdgcn_s_sleep(1);
        if ((++sp & 255u) == 0u) { if (xb_ld(&bar[XB_TMO])) break; if (sp > XB_SPIN_CAP) { atomicAdd(&bar[XB_TMO], 1u); break; } }
    }
    nloc = mine > 0u ? mine : 1u; nx = cnt > 0u ? cnt : 1u;
}
__device__ __forceinline__ void xcd_barrier(const XcdBarrier& b) {
    asm volatile("s_waitcnt vmcnt(0)" ::: "memory");
    __syncthreads();
    if (threadIdx.x == 0) {
        unsigned* bar = b.bar;
        __builtin_amdgcn_s_waitcnt(0);
        unsigned nloc = b.st[0], nx = b.st[1];
        if (nloc == 0u) { xcd_barrier_complete(bar, b.x, nloc, nx); b.st[0] = nloc; b.st[1] = nx; }
        const unsigned old = xb_add(&bar[XB_XSUB(b.x)], 1u);
        const unsigned gen = old / nloc;
        if (old + 1u == (gen + 1u) * nloc) {
            __builtin_amdgcn_fence(__ATOMIC_RELEASE, "agent");
            asm volatile("s_waitcnt vmcnt(0)" ::: "memory");
            const unsigned og = xb_add(&bar[XB_TOP], 1u);
            const unsigned tg = og / nx;
            if (og + 1u == (tg + 1u) * nx) xb_add(&bar[XB_TOPGEN], 1u);
            else XB_SPIN(xb_ld(&bar[XB_TOPGEN]) == tg, bar);
            __builtin_amdgcn_fence(__ATOMIC_ACQUIRE, "agent");
            xb_add(&bar[XB_XGEN(b.x)], 1u);
            asm volatile("s_waitcnt vmcnt(0)" ::: "memory");
        } else {
            XB_SPIN(xb_ld(&bar[XB_XGEN(b.x)]) == gen, bar);
            __builtin_amdgcn_fence(__ATOMIC_ACQUIRE, "agent");
            asm volatile("s_waitcnt vmcnt(0)" ::: "memory");
        }
    }
    __syncthreads();
}

__device__ __forceinline__ void gla_decay(const Args& a, const float* glr, int n, int hg, int tid, LAS float* gL, LAS float* segtot, float (&bv)[16], float& blast) {
    const int dk = tid & 127, seg = tid >> 7, col = hg * 128 + dk;
    if (tid < 256) ((LAS f32x4*)gL)[tid] = ((const f32x4*)(glr + (size_t)n * 64 * 16))[tid];
    float w[16];
#pragma unroll
    for (int j = 0; j < 16; ++j) w[j] = a.w_gla_gate_up[j * 512 + col];
    const float bias = a.b_gla_gate[col];
    __syncthreads();
    float c = 0.f;
#pragma unroll
    for (int s = 0; s < 16; ++s) { const LAS f32x4* g4 = (const LAS f32x4*)(gL + (16 * seg + s) * 16); float logit = bias;
#pragma unroll
        for (int q = 0; q < 4; ++q) { const f32x4 g = g4[q]; logit += g[0] * w[4 * q] + g[1] * w[4 * q + 1] + g[2] * w[4 * q + 2] + g[3] * w[4 * q + 3]; }
        const float ls = fminf(logit, 0.f) - log1pf(__expf(-fabsf(logit)));
        c += ls * (1.0f / 16.0f); bv[s] = c; if ((s & 3) == 3) asm volatile("" ::: "memory"); }
    segtot[seg * 128 + dk] = c;
    __syncthreads();
    float off = 0.f, tot = 0.f;
#pragma unroll
    for (int q = 0; q < 4; ++q) { const float v = segtot[q * 128 + dk]; tot += v; if (q < seg) off += v; }
#pragma unroll
    for (int s = 0; s < 16; ++s) bv[s] += off;
    blast = tot;
}

#define LBAR() do { asm volatile("s_waitcnt lgkmcnt(0)" ::: "memory"); __builtin_amdgcn_s_barrier(); asm volatile("" ::: "memory"); } while (0)
#define STAMP(k) do { if (PROBE_T != 0 && blockIdx.x == 0 && threadIdx.x == 0) ((unsigned long long*)(a.ws + 200 * 1024))[k] = __builtin_amdgcn_s_memrealtime(); } while (0)
#define IDS() int tid = threadIdx.x; asm volatile("" : "+v"(tid)); const int lane = tid & 63, wave = __builtin_amdgcn_readfirstlane(tid >> 6); const int gw = bx * 8 + wave, gtid = bx * 512 + tid; (void)lane; (void)gw; (void)gtid;
__global__ void __launch_bounds__(512, 2) fwd_megakernel(Args a) {
    extern __shared__ __attribute__((aligned(16))) unsigned char lds_raw[];
    cg::grid_group grid = cg::this_grid();
    LAS unsigned char* lds = (LAS unsigned char*)lds_raw;
    const int tid = threadIdx.x, lane = tid & 63, wave = __builtin_amdgcn_readfirstlane(tid >> 6);
    const int G = gridDim.x, bx = blockIdx.x;
    const int gw = bx * 8 + wave, NGW = G * 8;
    const int gtid = bx * 512 + tid, NT = G * 512;
    unsigned char* ws = a.ws;
    float* ssq1 = (float*)(ws + WS_SSQ1); float* ssq2 = (float*)(ws + WS_SSQ2); float* ssq3 = (float*)(ws + WS_SSQ3);
    float* glr = (float*)(ws + WS_GLR); float* glr1 = (float*)(ws + WS_GLR1); float* decb = (float*)(ws + WS_DEC); float* bcum = (float*)(ws + WS_BCUM); bf16_t* upd = (bf16_t*)(ws + WS_UPD);
    bf16_t* WgT = (bf16_t*)(ws + WS_WG); bf16_t* WppT = (bf16_t*)(ws + WS_WPP); bf16_t* WinT = (bf16_t*)(ws + WS_WIN); bf16_t* WoutT = (bf16_t*)(ws + WS_WOUT);
    bf16_t* WupT = (bf16_t*)(ws + WS_WUP); bf16_t* WdnT = (bf16_t*)(ws + WS_WDN); bf16_t* WpgT = (bf16_t*)(ws + WS_WPG); bf16_t* pb = (bf16_t*)(ws + WS_PB);
    bf16_t* h0 = (bf16_t*)(ws + WS_H0); bf16_t* projR = (bf16_t*)(ws + WS_PROJ); bf16_t* vT = (bf16_t*)(ws + WS_VT);
    bf16_t* ycat = (bf16_t*)a.out;
    float* rstd0 = (float*)(ws + WS_RSTD0); bf16_t* x1b = (bf16_t*)(ws + WS_X1B); bf16_t* gbuf = (bf16_t*)(ws + WS_G);
    float* tailb = (float*)(ws + WS_TAIL); float* headb = (float*)(ws + WS_HEAD); bf16_t* ppb = (bf16_t*)(ws + WS_PP); bf16_t* x2b = (bf16_t*)(ws + WS_X2B); bf16_t* x3b = (bf16_t*)(ws + WS_X3B);

    volatile LAS unsigned* bst = (volatile LAS unsigned*)(lds + LDS_BYTES - 64);
    if (threadIdx.x < 16) bst[threadIdx.x] = 0u;
    unsigned* barw = (unsigned*)(ws + WS_BAR);
    __syncthreads();
    const XcdBarrier xbar = xcd_barrier_post(barw, bst);
    if (a.out == nullptr) grid.sync();
    STAMP(0);
    REPS(1) {
        LAS float* scr = (LAS float*)(lds + wave * 16896);
        constexpr int I_IN = 64 * 48, I_OUT = 64 * 16, I_UP = 64 * 88, I_DN = 176 * 16, I_PG = 64 * 16, I_PP = 8 * 16;
        constexpr int NITEMS = I_IN + I_OUT + I_UP + I_DN + I_PG + I_PP;
        for (int it = gw; it < NITEMS; it += NGW) {
            int r = it;
            if (r < I_IN) { transpose_item(a.w_in, 2048, 6160, 48, WinT, scr, r, lane, a.norm_mix_w, 1); continue; } r -= I_IN;
            if (r < I_OUT) { transpose_item(a.w_out, 2048, 2048, 16, WoutT, scr, r, lane, nullptr, 0); continue; } r -= I_OUT;
            if (r < I_UP) { transpose_item(a.w_ffn_up, 2048, 2 * FF, 88, WupT, scr, r, lane, a.norm_ffn_w, 2); continue; } r -= I_UP;
            if (r < I_DN) { transpose_item(a.w_ffn_down, FF, 2048, 16, WdnT, scr, r, lane, nullptr, 0); continue; } r -= I_DN;
            if (r < I_PG) { transpose_item(a.w_ple_gate, 2048, 2048, 16, WpgT, scr, r, lane, a.norm_ple_w, 0); continue; } r -= I_PG;
            transpose_item(a.w_ple_proj, PLE, 2048, 16, WppT, scr, r, lane, nullptr, 0);
        }
        for (int i = gtid; i < 16 * 2048; i += NT) { const int j = i >> 11, k = i & 2047; WgT[i] = (bf16_t)f2bf(a.w_in[(size_t)k * 6160 + 6144 + j] * a.norm_mix_w[k]); }
        for (int m = gw; m < T; m += 2 * NGW) {
            const int m1 = m + NGW; const bool two = m1 < T;
            const f32x4* xr0 = (const f32x4*)(a.x + (size_t)m * D) + lane; const f32x4* xr1 = (const f32x4*)(a.x + (size_t)(two ? m1 : m) * D) + lane;
            f32x4 v0[8], v1[8]; float s0 = 0.f, s1 = 0.f;
#pragma unroll
            for (int j = 0; j < 8; ++j) { v0[j] = __builtin_nontemporal_load(xr0 + 64 * j); v1[j] = __builtin_nontemporal_load(xr1 + 64 * j); }
            u32x2* o0 = (u32x2*)(h0 + (size_t)m * D) + lane; u32x2* o1 = (u32x2*)(h0 + (size_t)m1 * D) + lane;
#pragma unroll
            for (int j = 0; j < 8; ++j) { s0 += (v0[j].x * v0[j].x + v0[j].y * v0[j].y) + (v0[j].z * v0[j].z + v0[j].w * v0[j].w); s1 += (v1[j].x * v1[j].x + v1[j].y * v1[j].y) + (v1[j].z * v1[j].z + v1[j].w * v1[j].w);
                u32x2 o; o.x = pk2(v0[j].x, v0[j].y); o.y = pk2(v0[j].z, v0[j].w); o0[64 * j] = o;
                if (two) { u32x2 q; q.x = pk2(v1[j].x, v1[j].y); q.y = pk2(v1[j].z, v1[j].w); o1[64 * j] = q; } }
            s0 = wave_sum(s0); s1 = wave_sum(s1);
            if (lane == 0) { rstd0[m] = frsq(s0 * (1.0f / D) + EPS); if (two) rstd0[m1] = frsq(s1 * (1.0f / D) + EPS); }
        }
        for (int i = gtid; i < T * PLE / 4; i += NT) { const f32x4 v = __builtin_nontemporal_load((const f32x4*)a.p + i); u32x2 o; o.x = pk2(v.x, v.y); o.y = pk2(v.z, v.w); ((u32x2*)pb)[i] = o; }
        for (int i = gtid; i < 3 * T; i += NT) ssq1[i] = 0.f;
    }
    if (PROBE_T != 0) { asm volatile("s_waitcnt vmcnt(0)" ::: "memory"); }
    xcd_barrier(xbar);
    STAMP(1);

    REPS(2) {
        IDS();
        for (int task = gw; task < 2 * (T / 16); task += NGW) {
            const int fr = lane & 15, fq = lane >> 4; const int r0 = (task >> 1) * 16, kh = (task & 1) * (D / 2);
            const bf16_t* ap = h0 + (size_t)(r0 + fr) * D + kh + 8 * fq; const bf16_t* bp = WgT + (size_t)fr * D + kh + 8 * fq;
            f32x4 acc = {0.f, 0.f, 0.f, 0.f};
#pragma unroll 8
            for (int k0 = 0; k0 < D / 2; k0 += 32) { const bf16x8 av = *(const bf16x8*)(ap + k0), bv = *(const bf16x8*)(bp + k0); acc = __builtin_amdgcn_mfma_f32_16x16x32_bf16(av, bv, acc, 0, 0, 0); }
            float* gp = (task & 1) ? glr1 : glr;
#pragma unroll
            for (int j = 0; j < 4; ++j) gp[(size_t)(r0 + 4 * fq + j) * 16 + fr] = acc[j] * rstd0[r0 + 4 * fq + j];
        }
        __syncthreads();
        { pg8::Gemm g{h0, WinT, T, NR, D}; pg8::StaticOrder S; S.init(T, NR, G, bx, WGM_P1R); pg8::EpiBf16 E{projR, NR, rstd0, nullptr};
          pg8::gemm_phase<pg8::EpiBf16, pg8::StaticOrder, true, true>(lds, g, S, E); }
        { pg8::Gemm g{WinT + (size_t)NR * D, h0, 2048, T, D}; pg8::StaticOrder S; S.init(2048, T, G, bx, WGM_P1T); pg8::EpiBf16 E{vT, T, nullptr, rstd0};
          pg8::gemm_phase<pg8::EpiBf16, pg8::StaticOrder, true, true>(lds, g, S, E); }
    }
    xcd_barrier(xbar);
    STAMP(2);

    REPS(3) {
        IDS();
        LAS float* gL = (LAS float*)lds; LAS float* segtot = (LAS float*)(lds + 4096); LAS bf16_t* kT = (LAS bf16_t*)(lds + 8192);
        const int fr = lane & 15, fq = lane >> 4, dk = tid & 127, seg = tid >> 7;
        f32x4 g4r = {0.f, 0.f, 0.f, 0.f}; unsigned short kraw[16]; bf16x8 vB[2][2], vBn[2][2];
#define G1_LOAD(u_, VB) do { const int n_ = (u_) >> 2, hg_ = (u_) & 3; if (tid < 256) g4r = ((const f32x4*)(glr + (size_t)n_ * 64 * 16))[tid] + ((const f32x4*)(glr1 + (size_t)n_ * 64 * 16))[tid]; \
            _Pragma("unroll") for (int s = 0; s < 16; ++s) kraw[s] = projR[((size_t)n_ * 64 + 16 * seg + s) * NR + KG + hg_ * 128 + dk]; \
            _Pragma("unroll") for (int nt2 = 0; nt2 < 2; ++nt2) _Pragma("unroll") for (int ks = 0; ks < 2; ++ks) VB[nt2][ks] = *(const bf16x8*)(vT + (size_t)(1024 + hg_ * 256 + 16 * (2 * wave + nt2) + fr) * T + n_ * 64 + 32 * ks + 8 * fq); } while (0)
        if (bx < NCH * 4) G1_LOAD(bx, vB);
        for (int unit = bx; unit < NCH * 4; unit += G) {
            const int n = unit >> 2, hg = unit & 3, col = hg * 128 + dk;
            float w[16];
#pragma unroll
            for (int j = 0; j < 16; ++j) w[j] = a.w_gla_gate_up[j * 512 + col];
            const float bias = a.b_gla_gate[col];
            if (tid < 256) ((LAS f32x4*)gL)[tid] = g4r;
            LBAR();
            float bv[16]; float c = 0.f;
#pragma unroll
            for (int s = 0; s < 16; ++s) { const LAS f32x4* g4 = (const LAS f32x4*)(gL + (16 * seg + s) * 16); float logit = bias;
#pragma unroll
                for (int q = 0; q < 4; ++q) { const f32x4 g = g4[q]; logit += g[0] * w[4 * q] + g[1] * w[4 * q + 1] + g[2] * w[4 * q + 2] + g[3] * w[4 * q + 3]; }
                const float ls = fminf(logit, 0.f) - __logf(1.0f + __expf(-fabsf(logit)));
                c += ls * (1.0f / 16.0f); bv[s] = c; if ((s & 3) == 3) asm volatile("" ::: "memory"); }
            segtot[seg * 128 + dk] = c;
            LBAR();
            float off = 0.f, blast = 0.f;
#pragma unroll
            for (int q = 0; q < 4; ++q) { const float v = segtot[q * 128 + dk]; blast += v; if (q < seg) off += v; }
            unsigned kw[8];
#pragma unroll
            for (int s = 0; s < 16; s += 2) { const float b0 = bv[s] + off, b1 = bv[s + 1] + off; const size_t t = (size_t)n * 64 + 16 * seg + s;
                bcum[t * 512 + col] = b0; bcum[(t + 1) * 512 + col] = b1;
                kw[s >> 1] = pk2(bf2f(kraw[s]) * __expf(blast - b0), bf2f(kraw[s + 1]) * __expf(blast - b1)); }
            *(LAS u32x4*)(kT + dk * 72 + 16 * seg) = (u32x4){kw[0], kw[1], kw[2], kw[3]}; *(LAS u32x4*)(kT + dk * 72 + 16 * seg + 8) = (u32x4){kw[4], kw[5], kw[6], kw[7]};
            if (seg == 0) decb[(size_t)unit * 128 + dk] = __expf(blast);
            LBAR();
            if (unit + G < NCH * 4) G1_LOAD(unit + G, vBn);
            f32x4 acc[8][2];
#pragma unroll
            for (int mt = 0; mt < 8; ++mt) { acc[mt][0] = (f32x4){0.f, 0.f, 0.f, 0.f}; acc[mt][1] = (f32x4){0.f, 0.f, 0.f, 0.f}; }
#pragma unroll
            for (int mt = 0; mt < 8; ++mt)
#pragma unroll
                for (int ks = 0; ks < 2; ++ks) { const bf16x8 ak = *(const LAS bf16x8*)(kT + (16 * mt + fr) * 72 + 32 * ks + 8 * fq);
                    acc[mt][0] = __builtin_amdgcn_mfma_f32_16x16x32_bf16(ak, vB[0][ks], acc[mt][0], 0, 0, 0);
                    acc[mt][1] = __builtin_amdgcn_mfma_f32_16x16x32_bf16(ak, vB[1][ks], acc[mt][1], 0, 0, 0); }
#pragma unroll
            for (int mt = 0; mt < 8; ++mt)
#pragma unroll
                for (int nt2 = 0; nt2 < 2; ++nt2) { const int dvv = 16 * (2 * wave + nt2) + fr; u32x2 wv; wv.x = pk2(acc[mt][nt2][0], acc[mt][nt2][1]); wv.y = pk2(acc[mt][nt2][2], acc[mt][nt2][3]);
                    *(u32x2*)(upd + (size_t)unit * 32768 + dvv * 128 + 16 * mt + 4 * fq) = wv; }
#pragma unroll
            for (int nt2 = 0; nt2 < 2; ++nt2)
#pragma unroll
                for (int ks = 0; ks < 2; ++ks) vB[nt2][ks] = vBn[nt2][ks];
        }
#undef G1_LOAD
    }
    xcd_barrier(xbar);
    STAMP(3);

    { IDS();
    for (int g2 = bx * 256 + tid; tid < 256 && g2 < 4 * 16384; g2 += G * 256) {
        const int hg = g2 >> 14, rem = (g2 & 16383) * 2, dk = rem & 127;
        unsigned* p = (unsigned*)(upd + (size_t)hg * 32768 + rem); const f32x2* dp = (const f32x2*)(decb + hg * 128 + dk);
        float S0 = 0.f, S1 = 0.f;
        unsigned ua[16], ub[16]; f32x2 da[16], db[16];
#define SCAN_LOAD(U, Dd, n0) do { _Pragma("unroll") for (int k = 0; k < 16; ++k) { U[k] = p[(size_t)((n0) + k) * 65536]; Dd[k] = dp[((n0) + k) * 256]; } } while (0)
#define SCAN_STEP(U, Dd, n0) do { _Pragma("unroll") for (int k = 0; k < 16; ++k) { p[(size_t)((n0) + k) * 65536] = pk2(S0, S1); S0 = Dd[k].x * S0 + bflo(U[k]); S1 = Dd[k].y * S1 + bfhi(U[k]); } } while (0)
        SCAN_LOAD(ua, da, 0);
        for (int n = 0; n < NCH; n += 32) {
            SCAN_LOAD(ub, db, n + 16);
            SCAN_STEP(ua, da, n);
            if (n + 32 < NCH) SCAN_LOAD(ua, da, n + 32);
            SCAN_STEP(ub, db, n + 16);
        }
#undef SCAN_LOAD
#undef SCAN_STEP
    } }
    if (PROBE_T != 0) { asm volatile("s_waitcnt vmcnt(0)" ::: "memory"); grid.sync(); STAMP(12); }
    {
        IDS();
        constexpr int CHB = 18432, BUFB = 3 * CHB;
        LAS unsigned char* kvb = lds; LAS float* bt = (LAS float*)(lds + 2 * BUFB);
        const int fr = lane & 15, fq = lane >> 4, hl = wave >> 2, qt = wave & 3;
        constexpr float LOG2E = 1.4426950408889634f;
        const int prow = (tid >> 3) & 63, pseg = tid & 7, pofs = prow * 144 + pseg * 16;
#define ATT_LOADK(cc, hpp, g) do { _Pragma("unroll") for (int q3 = 0; q3 < 3; ++q3) { const int kc_ = ((cc) - 8 + 3 * (g) + q3) < 0 ? 0 : ((cc) - 8 + 3 * (g) + q3); _Pragma("unroll") for (int r = 0; r < 2; ++r) \
            pre[q3][r] = *(const u32x4*)(projR + (size_t)(kc_ * 64 + prow) * NR + KA + 64 * (2 * (hpp) + r) + 8 * pseg); } } while (0)
#define ATT_LOADV(cc, hpp, g) do { _Pragma("unroll") for (int q3 = 0; q3 < 3; ++q3) { const int kc_ = ((cc) - 8 + 3 * (g) + q3) < 0 ? 0 : ((cc) - 8 + 3 * (g) + q3); _Pragma("unroll") for (int r = 0; r < 2; ++r) \
            pre[q3][r] = *(const u32x4*)(vT + (size_t)(64 * (2 * (hpp) + r) + prow) * T + kc_ * 64 + 8 * pseg); } } while (0)
#define ATT_WRITE(buf) do { _Pragma("unroll") for (int q3 = 0; q3 < 3; ++q3) _Pragma("unroll") for (int r = 0; r < 2; ++r) *(LAS u32x4*)(kvb + (buf) * BUFB + q3 * CHB + r * 9216 + pofs) = pre[q3][r]; } while (0)
#define ATT_LOADQ(cc, hpp) do { _Pragma("unroll") for (int ks = 0; ks < 2; ++ks) qn[ks] = *(const bf16x8*)(projR + (size_t)(64 * (cc) + 16 * qt + fr) * NR + QA + 64 * (2 * (hpp) + hl) + 32 * ks + 8 * fq); } while (0)
        const int NU = NCH * 8 * (PROBE_DUP == 4 ? 2 : 1);
        u32x4 pre[3][2]; bf16x8 qn[2]; int hp_tab = -1;
        if (bx < NU) { const int c0 = (bx >> 3) & (NCH - 1), hp0 = bx & 7; ATT_LOADQ(c0, hp0); ATT_LOADK(c0, hp0, 0); ATT_WRITE(0); }
        for (int unit = bx; unit < NU; unit += G) {
            const int c = (unit >> 3) & (NCH - 1), hp = unit & 7, h = 2 * hp + hl;
            const int un = unit + G, cn = (un >> 3) & (NCH - 1), hpn = un & 7;
            if (hp != hp_tab) { for (int i = tid; i < 1026; i += 512) { const int hh = i >= 513 ? 1 : 0; bt[hh * 516 + (i - hh * 513)] = a.att_rel_bias[(2 * hp + hh) * 513 + (i - hh * 513)] * LOG2E; } hp_tab = hp; }
            const bf16x8 qv0 = qn[0], qv1 = qn[1];
            __syncthreads();
            f32x4 S[36];
            const LAS float* btl = bt + hl * 516 + 256; const int relb = 16 * qt + fr + 512 - 4 * fq;
            const float b512 = btl[256];
#pragma unroll
            for (int g = 0; g < 3; ++g) {
                if (g < 2) ATT_LOADK(c, hp, g + 1); else ATT_LOADV(c, hp, 0);
#pragma unroll
                for (int q3 = 0; q3 < 3; ++q3) { const int j = 3 * g + q3;
#pragma unroll
                    for (int kt4 = 0; kt4 < 4; ++kt4) { f32x4 acc = {0.f, 0.f, 0.f, 0.f};
                        const LAS unsigned char* kp = kvb + (g & 1) * BUFB + q3 * CHB + hl * 9216 + (16 * kt4 + fr) * 144 + 16 * fq;
                        acc = __builtin_amdgcn_mfma_f32_16x16x32_bf16(*(const LAS bf16x8*)kp, qv0, acc, 0, 0, 0);
                        acc = __builtin_amdgcn_mfma_f32_16x16x32_bf16(*(const LAS bf16x8*)(kp + 64), qv1, acc, 0, 0, 0);
#pragma unroll
                        for (int jj = 0; jj < 4; ++jj) { float bias = b512;
                            if (j == 4) { int rel = relb - (64 * j + 16 * kt4 + jj); rel = rel > 256 ? 256 : rel; bias = btl[rel]; }
                            else if (j > 4) bias = btl[relb - (64 * j + 16 * kt4 + jj)];
                            acc[jj] = acc[jj] * (0.125f * LOG2E) + bias; }
                        S[4 * j + kt4] = acc; }
                    __builtin_amdgcn_sched_barrier(0); }
                ATT_WRITE((g + 1) & 1);
                __syncthreads();
            }
            if (c < 8) {
#pragma unroll
                for (int j = 0; j < 8; ++j) if (j < 8 - c) {
#pragma unroll
                    for (int kt4 = 0; kt4 < 4; ++kt4) S[4 * j + kt4] = (f32x4){-1e30f, -1e30f, -1e30f, -1e30f}; } }
            float mx = -1e30f;
#pragma unroll
            for (int i = 0; i < 36; ++i) mx = fmaxf(mx, fmaxf(fmaxf(S[i][0], S[i][1]), fmaxf(S[i][2], S[i][3])));
            mx = fmaxf(mx, __shfl_xor(mx, 16)); mx = fmaxf(mx, __shfl_xor(mx, 32));
            f32x2 l2 = {0.f, 0.f};
            u32x2 PW[36];
#pragma unroll
            for (int i = 0; i < 36; ++i) { const f32x4 d = S[i] - mx; const float p0 = __builtin_amdgcn_exp2f(d[0]), p1 = __builtin_amdgcn_exp2f(d[1]), p2 = __builtin_amdgcn_exp2f(d[2]), p3 = __builtin_amdgcn_exp2f(d[3]);
                l2 = l2 + (f32x2){p0, p1}; l2 = l2 + (f32x2){p2, p3}; PW[i].x = pg8::cvt_pk_bf16(p0, p1); PW[i].y = pg8::cvt_pk_bf16(p2, p3); asm volatile("" : "+v"(PW[i].x), "+v"(PW[i].y));
                if ((i & 3) == 3) __builtin_amdgcn_sched_barrier(0); }
            float l = l2[0] + l2[1];
            l += __shfl_xor(l, 16); l += __shfl_xor(l, 32);
            f32x4 O[4];
#pragma unroll
            for (int dt = 0; dt < 4; ++dt) O[dt] = (f32x4){0.f, 0.f, 0.f, 0.f};
            if (un < NU) ATT_LOADQ(cn, hpn);
#pragma unroll
            for (int g = 0; g < 3; ++g) {
                if (g < 2) ATT_LOADV(c, hp, g + 1); else if (un < NU) ATT_LOADK(cn, hpn, 0);
                const int buf = (3 + g) & 1;
#pragma unroll
                for (int q3 = 0; q3 < 3; ++q3) { const int j = 3 * g + q3;
#pragma unroll
                    for (int a2 = 0; a2 < 2; ++a2) { const u32x4 pw = {PW[4 * j + 2 * a2].x, PW[4 * j + 2 * a2].y, PW[4 * j + 2 * a2 + 1].x, PW[4 * j + 2 * a2 + 1].y};
                        const bf16x8 pa = __builtin_bit_cast(bf16x8, pw);
#pragma unroll
                        for (int dt = 0; dt < 4; ++dt) { const LAS unsigned char* vp = kvb + buf * BUFB + q3 * CHB + hl * 9216 + (16 * dt + fr) * 144 + (32 * a2 + 4 * fq) * 2;
                            const u32x2 lo = *(const LAS u32x2*)vp, hi = *(const LAS u32x2*)(vp + 32);
                            const u32x4 vw = {lo.x, lo.y, hi.x, hi.y};
                            O[dt] = __builtin_amdgcn_mfma_f32_16x16x32_bf16(pa, __builtin_bit_cast(bf16x8, vw), O[dt], 0, 0, 0); } } }
                if (g < 2 || un < NU) ATT_WRITE((3 + g + 1) & 1);
                if (g < 2) __syncthreads();
            }
#pragma unroll
            for (int jj = 0; jj < 4; ++jj) { const float linv = 1.0f / __shfl(l, 4 * fq + jj); const size_t t = (size_t)64 * c + 16 * qt + 4 * fq + jj;
#pragma unroll
                for (int dt = 0; dt < 4; ++dt) ycat[t * D + 64 * h + 16 * dt + fr] = (bf16_t)f2bf(O[dt][jj] * linv); }
        }
#undef ATT_LOADK
#undef ATT_LOADV
#undef ATT_WRITE
#undef ATT_LOADQ
    }
    xcd_barrier(xbar);
    STAMP(4);

    REPS(5) {
        IDS();
        LAS float* red = (LAS float*)(lds + 6144);
        LAS bf16_t* qd = (LAS bf16_t*)(lds + 8192); LAS bf16_t* ki = (LAS bf16_t*)(lds + 25600); LAS bf16_t* aL = (LAS bf16_t*)(lds + 43008);
        const int fr = lane & 15, fq = lane >> 4, dk = tid & 127, seg = tid >> 7;
        f32x4 braw[2][2]; u32x4 qraw[2], kraw[2];
        const int pi = tid >> 4, pg = tid & 15;
#define G3_LOAD(u_) do { const int n_ = (u_) >> 2, hg_ = (u_) & 3; _Pragma("unroll") for (int r = 0; r < 2; ++r) { const size_t t_ = (size_t)n_ * 64 + pi + 32 * r; \
            braw[r][0] = *(const f32x4*)(bcum + t_ * 512 + hg_ * 128 + 8 * pg); braw[r][1] = *(const f32x4*)(bcum + t_ * 512 + hg_ * 128 + 8 * pg + 4); \
            qraw[r] = *(const u32x4*)(projR + t_ * NR + QG + hg_ * 128 + 8 * pg); kraw[r] = *(const u32x4*)(projR + t_ * NR + KG + hg_ * 128 + 8 * pg); } } while (0)
        if (bx < NCH * 4) G3_LOAD(bx);
        for (int unit = bx; unit < NCH * 4; unit += G) {
            const int n = unit >> 2, hg = unit & 3;
            bf16x8 vB[2][2], sB[2][4];
#pragma unroll
            for (int nt2 = 0; nt2 < 2; ++nt2) { const int dvv = 16 * (2 * wave + nt2) + fr;
#pragma unroll
                for (int ks = 0; ks < 2; ++ks) vB[nt2][ks] = *(const bf16x8*)(vT + (size_t)(1024 + hg * 256 + dvv) * T + n * 64 + 32 * ks + 8 * fq);
#pragma unroll
                for (int ks = 0; ks < 4; ++ks) sB[nt2][ks] = *(const bf16x8*)(upd + (size_t)unit * 32768 + dvv * 128 + 32 * ks + 8 * fq); }
#pragma unroll
            for (int r = 0; r < 2; ++r) { const int i = pi + 32 * r; u32x4 qo, ko;
#pragma unroll
                for (int e = 0; e < 4; ++e) { const float b0 = e < 2 ? braw[r][0][2 * e] : braw[r][1][2 * e - 4], b1 = e < 2 ? braw[r][0][2 * e + 1] : braw[r][1][2 * e - 3];
                    qo[e] = pk2(bflo(qraw[r][e]) * 0.08838834764831845f * __expf(b0), bfhi(qraw[r][e]) * 0.08838834764831845f * __expf(b1));
                    ko[e] = pk2(bflo(kraw[r][e]) * __expf(-b0), bfhi(kraw[r][e]) * __expf(-b1)); }
                *(LAS u32x4*)(qd + i * 136 + 8 * pg) = qo; *(LAS u32x4*)(ki + i * 136 + 8 * pg) = ko; }
            LBAR();
            if (unit + G < NCH * 4) G3_LOAD(unit + G);
#pragma unroll
            for (int rep = 0; rep < 2; ++rep) { const int idx = wave + 8 * rep, it = idx >> 2, jt = idx & 3;
                f32x4 c = {0.f, 0.f, 0.f, 0.f};
                if (jt <= it) {
#pragma unroll
                    for (int ks = 0; ks < 4; ++ks) { const bf16x8 av = *(const LAS bf16x8*)(qd + (16 * it + fr) * 136 + 32 * ks + 8 * fq), bv8 = *(const LAS bf16x8*)(ki + (16 * jt + fr) * 136 + 32 * ks + 8 * fq);
                        c = __builtin_amdgcn_mfma_f32_16x16x32_bf16(av, bv8, c, 0, 0, 0); } }
#pragma unroll
                for (int jj = 0; jj < 4; ++jj) { const int i = 16 * it + 4 * fq + jj, j = 16 * jt + fr; aL[i * 72 + j] = (bf16_t)f2bf(j <= i ? c[jj] : 0.f); } }
            LBAR();
            unsigned short rr[4][4][2];
#pragma unroll
            for (int mt = 0; mt < 4; ++mt)
#pragma unroll
                for (int jj = 0; jj < 4; ++jj)
#pragma unroll
                    for (int nt2 = 0; nt2 < 2; ++nt2) rr[mt][jj][nt2] = projR[((size_t)n * 64 + 16 * mt + 4 * fq + jj) * NR + RG + hg * 256 + 16 * (2 * wave + nt2) + fr];
            f32x4 acc[4][2];
#pragma unroll
            for (int mt = 0; mt < 4; ++mt) { acc[mt][0] = (f32x4){0.f, 0.f, 0.f, 0.f}; acc[mt][1] = (f32x4){0.f, 0.f, 0.f, 0.f}; }
#pragma unroll
            for (int nt2 = 0; nt2 < 2; ++nt2)
#pragma unroll
                for (int mt = 0; mt < 4; ++mt) {
#pragma unroll
                    for (int ks = 0; ks < 2; ++ks) acc[mt][nt2] = __builtin_amdgcn_mfma_f32_16x16x32_bf16(*(const LAS bf16x8*)(aL + (16 * mt + fr) * 72 + 32 * ks + 8 * fq), vB[nt2][ks], acc[mt][nt2], 0, 0, 0);
#pragma unroll
                    for (int ks = 0; ks < 4; ++ks) acc[mt][nt2] = __builtin_amdgcn_mfma_f32_16x16x32_bf16(*(const LAS bf16x8*)(qd + (16 * mt + fr) * 136 + 32 * ks + 8 * fq), sB[nt2][ks], acc[mt][nt2], 0, 0, 0); }
#pragma unroll
            for (int mt = 0; mt < 4; ++mt)
#pragma unroll
                for (int jj = 0; jj < 4; ++jj) { float p = acc[mt][0][jj] * acc[mt][0][jj] + acc[mt][1][jj] * acc[mt][1][jj];
                    p += __shfl_xor(p, 1); p += __shfl_xor(p, 2); p += __shfl_xor(p, 4); p += __shfl_xor(p, 8);
                    if (fr == 0) red[wave * 64 + 16 * mt + 4 * fq + jj] = p; }
            LBAR();
            const float gw0 = a.gla_norm_w[16 * (2 * wave) + fr], gw1 = a.gla_norm_w[16 * (2 * wave + 1) + fr];
#pragma unroll
            for (int mt = 0; mt < 4; ++mt)
#pragma unroll
                for (int jj = 0; jj < 4; ++jj) { const int i = 16 * mt + 4 * fq + jj; float ss = 0.f;
#pragma unroll
                    for (int w8 = 0; w8 < 8; ++w8) ss += red[w8 * 64 + i];
                    const float rstd = frsq(ss * (1.0f / 256.0f) + EPS); const size_t t = (size_t)n * 64 + i;
#pragma unroll
                    for (int nt2 = 0; nt2 < 2; ++nt2) { const int dvv = 16 * (2 * wave + nt2) + fr;
                        const float r = bf2f(rr[mt][jj][nt2]);
                        const float y = acc[mt][nt2][jj] * rstd * (nt2 ? gw1 : gw0) * (r * fsigmoid(r));
                        ycat[t * D + 1024 + hg * 256 + dvv] = (bf16_t)f2bf(y); } }
        }
#undef G3_LOAD
    }
    xcd_barrier(xbar);
    STAMP(5);

    { pg8::Gemm g{ycat, WoutT, T, D, D}; pg8::StaticOrder S; S.init(T, D, G, bx, WGM_P5); pg8::EpiResid<true> E{h0, x1b, ssq1};
      pg8::gemm_phase<pg8::EpiResid<true>, pg8::StaticOrder, true, true>(lds, g, S, E); }
    xcd_barrier(xbar);
    STAMP(6);

#ifndef NO_UP
    REPS(6) { pg8::Gemm g{x1b, WupT, T, 2 * FF, D}; pg8::StaticOrder S; S.init(T, 2 * FF, G, bx, WGM_P6); pg8::EpiUp E{gbuf, ssq1, a.w_ffn_conv, a.b_ffn_conv, tailb, headb};
      pg8::gemm_phase<pg8::EpiUp, pg8::StaticOrder, true, true>(lds, g, S, E); }
#endif
    xcd_barrier(xbar);
    STAMP(7);

    { IDS();
    for (int i = gtid; i < NCH * 2 * (FF / 4); i += NT) {
        const int c4 = i % (FF / 4), gj = i / (FF / 4), j = gj & 1, grp = gj >> 1; const int row = grp * 64 + j, C = 4 * c4;
        const float* tl = tailb + (size_t)(grp - 1) * 2 * (2 * FF); const float* hd = headb + (size_t)grp * 2 * (2 * FF);
        const f32x4 z = {0.f, 0.f, 0.f, 0.f};
        f32x4 ug0, uv0, ug1, uv1, ug2, uv2;
        if (j == 0) { ug0 = grp ? *(const f32x4*)(tl + C) : z; uv0 = grp ? *(const f32x4*)(tl + FF + C) : z; ug1 = grp ? *(const f32x4*)(tl + 2 * FF + C) : z; uv1 = grp ? *(const f32x4*)(tl + 3 * FF + C) : z;
                      ug2 = *(const f32x4*)(hd + C); uv2 = *(const f32x4*)(hd + FF + C); }
        else { ug0 = grp ? *(const f32x4*)(tl + 2 * FF + C) : z; uv0 = grp ? *(const f32x4*)(tl + 3 * FF + C) : z; ug1 = *(const f32x4*)(hd + C); uv1 = *(const f32x4*)(hd + FF + C);
               ug2 = *(const f32x4*)(hd + 2 * FF + C); uv2 = *(const f32x4*)(hd + 3 * FF + C); }
        const float* cw = a.w_ffn_conv; const float* cb = a.b_ffn_conv;
        const f32x4 yg = *(const f32x4*)(cb + C) + *(const f32x4*)(cw + C) * ug0 + *(const f32x4*)(cw + 2 * FF + C) * ug1 + *(const f32x4*)(cw + 4 * FF + C) * ug2;
        const f32x4 yv = *(const f32x4*)(cb + FF + C) + *(const f32x4*)(cw + FF + C) * uv0 + *(const f32x4*)(cw + 3 * FF + C) * uv1 + *(const f32x4*)(cw + 5 * FF + C) * uv2;
        u32x2 o; o.x = pk2(pg8::gelu_tanh(yg[0]) * yv[0], pg8::gelu_tanh(yg[1]) * yv[1]); o.y = pk2(pg8::gelu_tanh(yg[2]) * yv[2], pg8::gelu_tanh(yg[3]) * yv[3]);
        *(u32x2*)(gbuf + (size_t)row * FF + C) = o;
    } }
    xcd_barrier(xbar);
    STAMP(8);

    { pg8::Gemm g{gbuf, WdnT, T, D, FF}; pg8::StaticOrder S; S.init(T, D, G, bx, WGM_P8); pg8::EpiResid<true> E{x1b, x2b, ssq2};
      pg8::gemm_phase<pg8::EpiResid<true>, pg8::StaticOrder, true, true>(lds, g, S, E); }
    { pg8::Gemm g{pb, WppT, T, D, PLE}; pg8::StaticOrder S; S.init(T, D, G, bx, WGM_PP); pg8::EpiBf16 E{ppb, D, nullptr, nullptr};
      pg8::gemm_phase<pg8::EpiBf16, pg8::StaticOrder, true, true>(lds, g, S, E); }
    xcd_barrier(xbar);
    STAMP(9);

    { pg8::Gemm g{x2b, WpgT, T, D, D}; pg8::StaticOrder S; S.init(T, D, G, bx, WGM_P9); pg8::EpiPle E{x2b, x3b, ppb, ssq2, ssq3};
      pg8::gemm_phase<pg8::EpiPle, pg8::StaticOrder, true, true>(lds, g, S, E); }
    xcd_barrier(xbar);
    STAMP(10);

    { IDS();
    for (int m = gw; m < T; m += NGW) {
        const float rstd = frsq(ssq3[m] * (1.0f / D) + EPS);
        const u32x4* xr = (const u32x4*)(x3b + (size_t)m * D) + lane; f32x4* orow = (f32x4*)(a.out + (size_t)m * D); const f32x4* wr4 = (const f32x4*)a.final_norm_w;
#pragma unroll
        for (int j = 0; j < 4; ++j) { const u32x4 xw = xr[64 * j]; const int c4 = (64 * j + lane) * 2; const f32x4 w0 = wr4[c4], w1 = wr4[c4 + 1];
            f32x4 v0 = {bflo(xw.x) * rstd * w0.x, bfhi(xw.x) * rstd * w0.y, bflo(xw.y) * rstd * w0.z, bfhi(xw.y) * rstd * w0.w};
            f32x4 v1 = {bflo(xw.z) * rstd * w1.x, bfhi(xw.z) * rstd * w1.y, bflo(xw.w) * rstd * w1.z, bfhi(xw.w) * rstd * w1.w};
            __builtin_nontemporal_store(v0, orow + c4); __builtin_nontemporal_store(v1, orow + c4 + 1); }
    } }
    if (PROBE_DUP == 7) { for (int i_ = 0; i_ < 20; ++i_) grid.sync(); }
    if (PROBE_T != 0) {
        asm volatile("s_waitcnt vmcnt(0)" ::: "memory"); grid.sync(); STAMP(11); grid.sync();
        unsigned probe_m = 50000u;
        if (PROBE_T != 100) { const unsigned long long* tsb = (const unsigned long long*)(a.ws + 200 * 1024); constexpr int HI_ = PROBE_T == 13 ? 12 : (PROBE_T == 14 ? 4 : (PROBE_T == 15 ? 11 : PROBE_T)), LO_ = PROBE_T == 13 ? 3 : (PROBE_T == 14 ? 12 : (PROBE_T == 15 ? 0 : PROBE_T - 1));
            probe_m = (unsigned)(__hip_atomic_load(tsb + HI_, __ATOMIC_RELAXED, __HIP_MEMORY_SCOPE_AGENT) - __hip_atomic_load(tsb + LO_, __ATOMIC_RELAXED, __HIP_MEMORY_SCOPE_AGENT)); if (PROBE_T == 15) probe_m /= 8; }
        for (unsigned e = blockIdx.x * 512u + threadIdx.x; e < probe_m; e += gridDim.x * 512u) a.out[e] += 0.08f;
    }
}

extern "C" void kernel_launch(void* const* d_in, const int* in_sizes, int n_in, void* d_out, int out_size, void* d_ws, size_t ws_size, hipStream_t stream) {
    static int grid = 0;
    if (grid == 0) {
        if (n_in != 18 || out_size != T * D || ws_size < WS_END) { fprintf(stderr, "kernel_launch: unexpected problem (n_in %d out %d ws %zu)\n", n_in, out_size, ws_size); grid = -1; return; }
        int dev = 0, cus = 0, per_cu = 0;
        hipGetDevice(&dev); hipDeviceGetAttribute(&cus, hipDeviceAttributeMultiprocessorCount, dev);
        if (hipFuncSetAttribute((const void*)fwd_megakernel, hipFuncAttributeMaxDynamicSharedMemorySize, LDS_BYTES) != hipSuccess) { fprintf(stderr, "kernel_launch: hipFuncSetAttribute failed\n"); grid = -1; return; }
        if (hipOccupancyMaxActiveBlocksPerMultiprocessor(&per_cu, (const void*)fwd_megakernel, 512, LDS_BYTES) != hipSuccess || per_cu < 1) { fprintf(stderr, "kernel_launch: occupancy query says %d\n", per_cu); per_cu = 1; }
        (void)hipGetLastError();
        grid = cus * per_cu;
    }
    if (grid < 0) return;
    Args a{};
    const float** f = (const float**)&a;
    for (int i = 0; i < 18; ++i) f[i] = (const float*)d_in[i];
    a.out = (float*)d_out; a.ws = (unsigned char*)d_ws;
    if (hipMemsetAsync((char*)d_ws + WS_BAR, 0, 16384, stream) != hipSuccess) { fprintf(stderr, "kernel_launch: memset of the barrier words failed\n"); return; }
    void* args[] = {&a};
    hipError_t e = hipLaunchCooperativeKernel((const void*)fwd_megakernel, dim3(grid), dim3(512), args, LDS_BYTES, stream);
    if (e != hipSuccess) fprintf(stderr, "cooperative launch failed: %s (grid %d)\n", hipGetErrorString(e), grid);
}
```

```cpp
#include <hip/hip_runtime.h>
#include <hip/hip_cooperative_groups.h>
#include <cstdio>
#include <cstdint>
namespace cg = cooperative_groups;
#ifndef PROBE_DUP
#define PROBE_DUP 0
#endif
#ifndef PROBE_T
#define PROBE_T 0
#endif
#ifndef WGM_P1R
#define WGM_P1R 4
#endif
#ifndef WGM_P1T
#define WGM_P1T 4
#endif
#ifndef WGM_P5
#define WGM_P5 4
#endif
#ifndef WGM_P6
#define WGM_P6 8
#endif
#ifndef WGM_P8
#define WGM_P8 4
#endif
#ifndef WGM_PP
#define WGM_PP 4
#endif
#ifndef WGM_P9
#define WGM_P9 4
#endif
#define REPS(k) for (int rep_ = 0; rep_ < (PROBE_DUP == (k) ? 2 : 1); ++rep_)

#define LAS __attribute__((address_space(3)))
typedef unsigned short bf16_t;
typedef short bf16x8 __attribute__((ext_vector_type(8)));
typedef float f32x4 __attribute__((ext_vector_type(4)));
typedef float f32x2 __attribute__((ext_vector_type(2)));
typedef unsigned u32x4 __attribute__((ext_vector_type(4)));
typedef unsigned u32x2 __attribute__((ext_vector_type(2)));

constexpr int T = 16384, D = 2048, FF = 5632, NR = 4096, PLE = 256, NCH = 256;
constexpr int QA = 0, KA = 1024, QG = 2048, KG = 2560, RG = 3072;
constexpr float EPS = 1e-6f;
constexpr size_t MiB = 1u << 20;
constexpr size_t WS_SSQ1 = 0, WS_SSQ2 = 65536, WS_SSQ3 = 131072, WS_GLR = 1 * MiB, WS_WG = 2 * MiB, WS_WPP = 3 * MiB;
constexpr size_t WS_WIN = 4 * MiB, WS_WOUT = 28 * MiB, WS_WUP = 36 * MiB, WS_WDN = 80 * MiB, WS_WPG = 102 * MiB, WS_PB = 110 * MiB;
constexpr size_t WS_H0 = 118 * MiB;
constexpr size_t WS_PROJ = 182 * MiB;
constexpr size_t WS_VT = 310 * MiB;
constexpr size_t WS_X1B = 182 * MiB, WS_G = 246 * MiB, WS_TAIL = 422 * MiB, WS_HEAD = 444 * MiB, WS_PP = 422 * MiB  , WS_X3B = 182 * MiB  , WS_YCAT = WS_H0, WS_X2B = WS_H0;
constexpr size_t WS_DEC = 256 * 1024, WS_UPD = 406 * MiB, WS_BCUM = 374 * MiB;
constexpr size_t WS_BAR = 800 * 1024;
constexpr size_t WS_GLR1 = 470 * MiB;
constexpr size_t WS_RSTD0 = 900 * 1024;
constexpr size_t WS_END = 512 * MiB;
constexpr int LDS_BYTES = 147456;

__device__ __forceinline__ unsigned f2bf(float f) { unsigned u = __builtin_bit_cast(unsigned, f); return (u + 0x7fffu + ((u >> 16) & 1u)) >> 16; }
typedef __bf16 hwbf16x2 __attribute__((ext_vector_type(2)));
__device__ __forceinline__ unsigned pk2(float lo, float hi) { const f32x2 v = {lo, hi}; return __builtin_bit_cast(unsigned, __builtin_convertvector(v, hwbf16x2)); }
__device__ __forceinline__ float frcp(float x) { return __builtin_amdgcn_rcpf(x); }
__device__ __forceinline__ float frsq(float x) { return __builtin_amdgcn_rsqf(x); }
__device__ __forceinline__ float fsigmoid(float x) { return frcp(1.0f + __builtin_amdgcn_exp2f(-1.4426950408889634f * x)); }
__device__ __forceinline__ float bf2f(unsigned short b) { return __builtin_bit_cast(float, (unsigned)b << 16); }
__device__ __forceinline__ float bflo(unsigned w) { return __builtin_bit_cast(float, w << 16); }
__device__ __forceinline__ float bfhi(unsigned w) { return __builtin_bit_cast(float, w & 0xffff0000u); }
__device__ __forceinline__ float wave_sum(float v) {
#pragma unroll
    for (int o = 1; o < 64; o <<= 1) v += __shfl_xor(v, o);
    return v;
}

namespace pg8 {
#define PG8_LAS __attribute__((address_space(3)))
constexpr int BM = 256, BK = 64, HALF = 128, HTB = HALF * BK * 2, STAGE_BYTES = 8 * HTB, NXCD = 8;
__host__ __device__ __forceinline__ int lds_byte(int r, int c) { const int st = (r >> 4) * 2 + (c >> 5), rr = r & 15, cc = c & 31, ob = rr * 64 + cc * 2; return st * 1024 + (ob ^ (((ob >> 9) & 1) << 5)); }
__host__ __device__ __forceinline__ void stage_rc(int b, int& R, int& C) { const int st = b / 1024, sb = b % 1024, swz = sb ^ (((sb >> 9) & 1) << 5); R = (st >> 1) * 16 + swz / 64; C = (st & 1) * 32 + (swz % 64) / 2; }
__host__ __device__ __forceinline__ int perm32(int rho) { const int n = rho >> 4, i = rho & 15; return 8 * (i >> 2) + 4 * n + (i & 3); }

struct Unit { int pm, pn; };
struct Gemm { const bf16_t* A; const bf16_t* Bt; int M, N, K; };

struct StaticOrder {
    int nM, nN, nwg, G, c, WGM;
    __host__ __device__ void init(int M, int N, int G_, int c_, int wgm) { nM = M / BM; nN = N / BM; nwg = nM * nN; G = G_; c = c_; WGM = wgm; }
    __host__ __device__ bool next(int i, Unit& u) const {
        const long L = (long)i * G + c; if (L >= nwg) return false;
        int wgid = (int)L; { const int q = nwg / NXCD, r = nwg % NXCD, xcd = wgid % NXCD, off = wgid / NXCD; wgid = (xcd < r ? xcd * (q + 1) : r * (q + 1) + (xcd - r) * q) + off; }
        const int nig = WGM * nN, gid = wgid / nig, fm = gid * WGM, gsz = (nM - fm) < WGM ? (nM - fm) : WGM;
        u.pm = fm + ((wgid % nig) % gsz); u.pn = (wgid % nig) / gsz; return true;
    }
    __device__ __forceinline__ void a_ready(const Unit&) const {}
    __device__ __forceinline__ void done(const Unit&) const {}
};

__device__ __forceinline__ unsigned cvt_pk_bf16(float lo, float hi) { return pk2(lo, hi); }

struct EpiBf16 {
    static constexpr bool PERM = true, AFTER_DRAIN = false;
    bf16_t* O; int ldc; const float* rs; const float* cs;
    __device__ __forceinline__ void operator()(const f32x4 (&acc)[2][2][4][2], const Unit& u, int wr, int wc, int fr, int fq) const {
        const int row0 = u.pm * BM + wr * 64 + fr; const int col0 = u.pn * BM + wc * 32 + 8 * fq;
        f32x4 c0[2], c1[2];
#pragma unroll
        for (int bj = 0; bj < 2; ++bj) { c0[bj] = cs ? *(const f32x4*)(cs + col0 + bj * HALF) : (f32x4){1.f, 1.f, 1.f, 1.f}; c1[bj] = cs ? *(const f32x4*)(cs + col0 + bj * HALF + 4) : (f32x4){1.f, 1.f, 1.f, 1.f}; }
#pragma unroll
        for (int ai = 0; ai < 2; ++ai)
#pragma unroll
            for (int m = 0; m < 4; ++m) { const int row = row0 + ai * HALF + m * 16; bf16_t* rowp = O + (size_t)row * ldc + col0; const float r = rs ? rs[row] : 1.0f;
#pragma unroll
                for (int bj = 0; bj < 2; ++bj) { const f32x4 v0 = acc[ai][bj][m][0] * c0[bj] * r, v1 = acc[ai][bj][m][1] * c1[bj] * r;
                    u32x4 w; w.x = cvt_pk_bf16(v0[0], v0[1]); w.y = cvt_pk_bf16(v0[2], v0[3]); w.z = cvt_pk_bf16(v1[0], v1[1]); w.w = cvt_pk_bf16(v1[2], v1[3]);
                    *(u32x4*)(rowp + bj * HALF) = w; } }
    }
};
template <bool BASE_BF16> struct EpiResid {
    static constexpr bool PERM = true, AFTER_DRAIN = false;
    const void* base; bf16_t* ob; float* ssq;
    __device__ __forceinline__ void operator()(const f32x4 (&acc)[2][2][4][2], const Unit& u, int wr, int wc, int fr, int fq) const {
        const int row0 = u.pm * BM + wr * 64 + fr; const int col0 = u.pn * BM + wc * 32 + 8 * fq;
#pragma unroll
        for (int ai = 0; ai < 2; ++ai)
#pragma unroll
            for (int m = 0; m < 4; ++m) { const int row = row0 + ai * HALF + m * 16; const size_t off = (size_t)row * D + col0; float ss = 0.f;
#pragma unroll
                for (int bj = 0; bj < 2; ++bj) {
                    f32x4 b0, b1;
                    if (BASE_BF16) { const u32x4 pw = *(const u32x4*)((const bf16_t*)base + off + bj * HALF); b0 = (f32x4){bflo(pw.x), bfhi(pw.x), bflo(pw.y), bfhi(pw.y)}; b1 = (f32x4){bflo(pw.z), bfhi(pw.z), bflo(pw.w), bfhi(pw.w)}; }
                    else { b0 = *(const f32x4*)((const float*)base + off + bj * HALF); b1 = *(const f32x4*)((const float*)base + off + bj * HALF + 4); }
                    const f32x4 v0 = acc[ai][bj][m][0] + b0, v1 = acc[ai][bj][m][1] + b1;
                    u32x4 w; w.x = cvt_pk_bf16(v0[0], v0[1]); w.y = cvt_pk_bf16(v0[2], v0[3]); w.z = cvt_pk_bf16(v1[0], v1[1]); w.w = cvt_pk_bf16(v1[2], v1[3]);
                    *(u32x4*)(ob + off + bj * HALF) = w;
                    ss += (v0[0] * v0[0] + v0[1] * v0[1]) + (v0[2] * v0[2] + v0[3] * v0[3]) + (v1[0] * v1[0] + v1[1] * v1[1]) + (v1[2] * v1[2] + v1[3] * v1[3]); }
                ss += __shfl_xor(ss, 16); ss += __shfl_xor(ss, 32);
                if (fq == 0) atomicAdd(ssq + row, ss); }
    }
};
struct EpiPle {
    static constexpr bool PERM = true, AFTER_DRAIN = false;
    const bf16_t* x2; bf16_t* x3; const bf16_t* pp; const float* ssq2; float* ssq3;
    __device__ __forceinline__ void operator()(const f32x4 (&acc)[2][2][4][2], const Unit& u, int wr, int wc, int fr, int fq) const {
        const int row0 = u.pm * BM + wr * 64 + fr; const int col0 = u.pn * BM + wc * 32 + 8 * fq;
#pragma unroll
        for (int ai = 0; ai < 2; ++ai)
#pragma unroll
            for (int m = 0; m < 4; ++m) { const int row = row0 + ai * HALF + m * 16; const size_t off = (size_t)row * D + col0; float ss = 0.f;
                const float rstd = frsq(ssq2[row] * (1.0f / D) + EPS);
#pragma unroll
                for (int bj = 0; bj < 2; ++bj) {
                    const u32x4 xw = *(const u32x4*)(x2 + off + bj * HALF);
                    const u32x4 pw = *(const u32x4*)(pp + off + bj * HALF);
                    const f32x4 b0 = {bflo(xw.x), bfhi(xw.x), bflo(xw.y), bfhi(xw.y)}, b1 = {bflo(xw.z), bfhi(xw.z), bflo(xw.w), bfhi(xw.w)};
                    const f32x4 p0 = {bflo(pw.x), bfhi(pw.x), bflo(pw.y), bfhi(pw.y)}, p1 = {bflo(pw.z), bfhi(pw.z), bflo(pw.w), bfhi(pw.w)};
                    f32x4 v0, v1;
#pragma unroll
                    for (int e = 0; e < 4; ++e) { const float g0 = fsigmoid(acc[ai][bj][m][0][e] * rstd), g1 = fsigmoid(acc[ai][bj][m][1][e] * rstd);
                        v0[e] = b0[e] + g0 * p0[e]; v1[e] = b1[e] + g1 * p1[e]; }
                    u32x4 w; w.x = cvt_pk_bf16(v0[0], v0[1]); w.y = cvt_pk_bf16(v0[2], v0[3]); w.z = cvt_pk_bf16(v1[0], v1[1]); w.w = cvt_pk_bf16(v1[2], v1[3]);
                    *(u32x4*)(x3 + off + bj * HALF) = w;
                    ss += (v0[0] * v0[0] + v0[1] * v0[1]) + (v0[2] * v0[2] + v0[3] * v0[3]) + (v1[0] * v1[0] + v1[1] * v1[1]) + (v1[2] * v1[2] + v1[3] * v1[3]); }
                ss += __shfl_xor(ss, 16); ss += __shfl_xor(ss, 32);
                if (fq == 0) atomicAdd(ssq3 + row, ss); }
    }
};
__device__ __forceinline__ float gelu_tanh(float x) {
    const float t = x * x * (-1.5957691216057308f * 1.4426950408889634f * 0.044715f) + (-1.5957691216057308f * 1.4426950408889634f);
    return x * frcp(1.0f + __builtin_amdgcn_exp2f(t * x));
}
template <int CTRL> __device__ __forceinline__ float dppz(float v) { return __builtin_bit_cast(float, __builtin_amdgcn_update_dpp(0, __builtin_bit_cast(int, v), CTRL, 0xf, 0xf, true)); }
#define FMAC_DPP(acc, src, w, CTRL) asm volatile("s_nop 1\n\tv_fmac_f32_dpp %0, %1, %2 " CTRL " row_mask:0xf bank_mask:0xf bound_ctrl:1" : "+v"(acc) : "v"(src), "v"(w))
struct EpiUp {
    static constexpr bool PERM = true, AFTER_DRAIN = false;
    bf16_t* G; const float* ssq1; const float* cw; const float* cb; float* tail; float* head;
    __device__ __forceinline__ void operator()(const f32x4 (&acc)[2][2][4][2], const Unit& u, int wr, int wc, int fr, int fq) const {
        const int C0 = u.pn * 128 + wc * 32 + 8 * fq;
#pragma unroll
        for (int ai = 0; ai < 2; ++ai) {
            const int rbase = u.pm * BM + ai * HALF + wr * 64; const int grp = rbase >> 6;
            float rstd[4];
#pragma unroll
            for (int m = 0; m < 4; ++m) rstd[m] = frsq(ssq1[rbase + m * 16 + fr] * (1.0f / D) + EPS);
            if (fr < 2) { float* hp = head + ((size_t)grp * 2 + fr) * (2 * FF) + C0;
#pragma unroll
                for (int bj = 0; bj < 2; ++bj) { *(f32x4*)(hp + bj * FF) = acc[ai][bj][0][0] * rstd[0]; *(f32x4*)(hp + bj * FF + 4) = acc[ai][bj][0][1] * rstd[0]; } }
            if (fr >= 14) { float* tp = tail + ((size_t)grp * 2 + (fr - 14)) * (2 * FF) + C0;
#pragma unroll
                for (int bj = 0; bj < 2; ++bj) { *(f32x4*)(tp + bj * FF) = acc[ai][bj][3][0] * rstd[3]; *(f32x4*)(tp + bj * FF + 4) = acc[ai][bj][3][1] * rstd[3]; } }
            __builtin_amdgcn_sched_barrier(0);
            unsigned outw[4][4];
#pragma unroll
            for (int n = 0; n < 2; ++n) {
#pragma unroll
                for (int ep = 0; ep < 2; ++ep) {
                    int C = C0 + 4 * n + 2 * ep; asm volatile("" : "+v"(C));
                    const f32x2 wg0 = *(const f32x2*)(cw + C), wg1 = *(const f32x2*)(cw + 2 * FF + C), wg2 = *(const f32x2*)(cw + 4 * FF + C), bg = *(const f32x2*)(cb + C);
                    const f32x2 wv0 = *(const f32x2*)(cw + FF + C), wv1 = *(const f32x2*)(cw + 3 * FF + C), wv2 = *(const f32x2*)(cw + 5 * FF + C), bv = *(const f32x2*)(cb + FF + C);
                    f32x2 ugp = {0.f, 0.f}, uvp = {0.f, 0.f};
#pragma unroll
                    for (int m = 0; m < 4; ++m) {
                        f32x2 ug = (f32x2){acc[ai][0][m][n][2 * ep], acc[ai][0][m][n][2 * ep + 1]} * rstd[m], uv = (f32x2){acc[ai][1][m][n][2 * ep], acc[ai][1][m][n][2 * ep + 1]} * rstd[m];
                        asm volatile("" : "+v"(ug), "+v"(uv));
                        f32x2 yg = wg2 * ug + bg, yv = wv2 * uv + bv;
#pragma unroll
                        for (int q = 0; q < 2; ++q) {
                            FMAC_DPP(yg[q], ug[q], wg1[q], "row_shr:1"); FMAC_DPP(yv[q], uv[q], wv1[q], "row_shr:1");
                            FMAC_DPP(yg[q], ug[q], wg0[q], "row_shr:2"); FMAC_DPP(yv[q], uv[q], wv0[q], "row_shr:2");
                            if (m > 0) { FMAC_DPP(yg[q], ugp[q], wg1[q], "row_shl:15"); FMAC_DPP(yv[q], uvp[q], wv1[q], "row_shl:15");
                                         FMAC_DPP(yg[q], ugp[q], wg0[q], "row_shl:14"); FMAC_DPP(yv[q], uvp[q], wv0[q], "row_shl:14"); } }
                        f32x2 t = yg * yg * (-1.5957691216057308f * 1.4426950408889634f * 0.044715f) + (-1.5957691216057308f * 1.4426950408889634f);
                        t = t * yg;
                        f32x2 den = {__builtin_amdgcn_exp2f(t[0]), __builtin_amdgcn_exp2f(t[1])}; den = den + 1.0f;
                        const f32x2 rc = {frcp(den[0]), frcp(den[1])};
                        f32x2 o = yg * rc * yv; asm volatile("" : "+v"(o));
                        outw[m][2 * n + ep] = pk2(o[0], o[1]);
                        ugp = ug; uvp = uv;
                    }
                    __builtin_amdgcn_sched_barrier(0);
                }
                __builtin_amdgcn_sched_barrier(0);
            }
#pragma unroll
            for (int m = 0; m < 4; ++m) if (m > 0 || fr >= 2) { u32x4 w = {outw[m][0], outw[m][1], outw[m][2], outw[m][3]}; *(u32x4*)(G + (size_t)(rbase + m * 16 + fr) * FF + C0) = w; }
            __builtin_amdgcn_sched_barrier(0);
        }
    }
};

template <class Epi, class Sched, bool ALIGN_EPI = false, bool SP2 = false>
__device__ __forceinline__ void gemm_phase(PG8_LAS unsigned char* lds, const Gemm g, const Sched& S, const Epi& E) {
    int tid_ = threadIdx.x; asm volatile("" : "+v"(tid_));
    const int tid = tid_, wid = __builtin_amdgcn_readfirstlane(tid >> 6), lane = tid & 63, wr = wid >> 2, wc = wid & 3, fr = lane & 15, fq = lane >> 4;
    const int K = g.K, nt = K / BK;
    unsigned voffA[2], voffB[2];
#pragma unroll
    for (int i = 0; i < 2; ++i) { int R, C; stage_rc(tid * 16 + i * 8192, R, C); const int Rb = Epi::PERM ? ((R & ~31) + perm32(R & 31)) : R;
        voffA[i] = (unsigned)(R * K + C) * 2u; voffB[i] = (unsigned)(Rb * K + C) * 2u; }
    const size_t kstep = (size_t)(BK * 2);
    const size_t hstep = (size_t)HALF * K * 2;
    const size_t tstep = 2 * hstep;
    const unsigned ldsw = (unsigned)wid * 1024u;
    const int aoff = lds_byte(wr * 64 + fr, fq * 8), boff = lds_byte(wc * 32 + fr, fq * 8);
#define PG8_SA(b, h) (((b) * 2 + (h)) * HTB)
#define PG8_SB(b, h) ((4 + (b) * 2 + (h)) * HTB)
#define PG8_STAGE(bufoff, gbase, voff) do { _Pragma("unroll") for (int _i = 0; _i < 2; ++_i) \
        __builtin_amdgcn_global_load_lds((const unsigned*)((const char*)(gbase) + (voff)[_i]), (PG8_LAS unsigned*)(lds + (bufoff) + ldsw + _i * 8192), 16, 0, 0); } while (0)
#define PG8_LDA(dst, b, h) do { _Pragma("unroll") for (int m = 0; m < 4; ++m) _Pragma("unroll") for (int k = 0; k < 2; ++k) dst[m][k] = *(const PG8_LAS bf16x8*)(lds + PG8_SA(b, h) + aoff + m * 2048 + k * 1024); } while (0)
#define PG8_LDB(dst, b, h) do { _Pragma("unroll") for (int n = 0; n < 2; ++n) _Pragma("unroll") for (int k = 0; k < 2; ++k) dst[n][k] = *(const PG8_LAS bf16x8*)(lds + PG8_SB(b, h) + boff + n * 2048 + k * 1024); } while (0)
#define PG8_MMA(ai, bj, At, Bt) do { __builtin_amdgcn_s_setprio(1); _Pragma("unroll") for (int m = 0; m < 4; ++m) _Pragma("unroll") for (int n = 0; n < 2; ++n) _Pragma("unroll") for (int k = 0; k < 2; ++k) \
        acc[ai][bj][m][n] = __builtin_amdgcn_mfma_f32_16x16x32_bf16(Bt[n][k], At[m][k], acc[ai][bj][m][n], 0, 0, 0); __builtin_amdgcn_s_setprio(0); } while (0)
#define PG8_WAIT_V(n) asm volatile("s_waitcnt vmcnt(" #n ")" ::: "memory")
#define PG8_WAIT_L(n) asm volatile("s_waitcnt lgkmcnt(" #n ")" ::: "memory")
#define PG8_BAR __builtin_amdgcn_s_barrier()
#define PG8_SCHED __builtin_amdgcn_sched_barrier(0)
    Unit cur, nxt; int ui = 0;
    if (!S.next(0, cur)) return;
    f32x4 acc[2][2][4][2];
#pragma unroll
    for (int a = 0; a < 2; ++a)
#pragma unroll
        for (int b = 0; b < 2; ++b)
#pragma unroll
            for (int m = 0; m < 4; ++m)
#pragma unroll
                for (int n = 0; n < 2; ++n) acc[a][b][m][n] = (f32x4){0.f, 0.f, 0.f, 0.f};
    bf16x8 At[4][2], B0[2][2], B1[2][2];
    const char* cA = (const char*)g.A + (size_t)cur.pm * tstep; const char* cB = (const char*)g.Bt + (size_t)cur.pn * tstep;
    S.a_ready(cur);
    if constexpr (SP2) {
        PG8_STAGE(PG8_SB(0, 0), cB, voffB); PG8_STAGE(PG8_SB(0, 1), cB + hstep, voffB); PG8_STAGE(PG8_SA(0, 0), cA, voffA); PG8_STAGE(PG8_SA(0, 1), cA + hstep, voffA);
        if (wr == 1) PG8_BAR;
        PG8_WAIT_V(2); PG8_BAR;
        PG8_STAGE(PG8_SB(1, 0), cB + kstep, voffB); PG8_STAGE(PG8_SA(1, 0), cA + kstep, voffA); PG8_STAGE(PG8_SB(1, 1), cB + hstep + kstep, voffB);
        PG8_WAIT_V(6); PG8_BAR;
    } else {
        PG8_STAGE(PG8_SB(0, 0), cB, voffB); PG8_STAGE(PG8_SA(0, 0), cA, voffA); PG8_STAGE(PG8_SB(0, 1), cB + hstep, voffB); PG8_STAGE(PG8_SA(0, 1), cA + hstep, voffA);
        if (wr == 1) PG8_BAR;
        PG8_WAIT_V(4); PG8_BAR;
        PG8_STAGE(PG8_SB(1, 0), cB + kstep, voffB); PG8_STAGE(PG8_SA(1, 0), cA + kstep, voffA); PG8_STAGE(PG8_SB(1, 1), cB + hstep + kstep, voffB);
        PG8_WAIT_V(6); PG8_BAR;
    }
    for (;;) {
        const bool has_next = S.next(ui + 1, nxt);
        const char* nA = has_next ? (const char*)g.A + (size_t)nxt.pm * tstep : cA; const char* nB = has_next ? (const char*)g.Bt + (size_t)nxt.pn * tstep : cB;
        for (int t = 0; t < nt; t += 2) {
            const bool last = (t == nt - 2);
            const char* a1 = cA + (size_t)(t + 1) * kstep;
            const char* a2 = last ? nA : cA + (size_t)(t + 2) * kstep; const char* b2 = last ? nB : cB + (size_t)(t + 2) * kstep;
            const char* a3 = a2 + kstep; const char* b3 = b2 + kstep;
            if (last && has_next) S.a_ready(nxt);
            if constexpr (SP2) {
            PG8_LDB(B0, 0, 0); PG8_LDB(B1, 0, 1); PG8_SCHED; PG8_LDA(At, 0, 0); PG8_STAGE(PG8_SA(1, 1), a1 + hstep, voffA);
            PG8_WAIT_V(8); PG8_WAIT_L(0); PG8_BAR; PG8_MMA(0, 0, At, B0); PG8_MMA(0, 1, At, B1); PG8_BAR; PG8_SCHED;
            PG8_LDA(At, 0, 1); PG8_STAGE(PG8_SB(0, 0), b2, voffB); PG8_STAGE(PG8_SB(0, 1), b2 + hstep, voffB); PG8_STAGE(PG8_SA(0, 0), a2, voffA);
            PG8_WAIT_V(8); PG8_WAIT_L(0); PG8_BAR; PG8_MMA(1, 0, At, B0); PG8_MMA(1, 1, At, B1); PG8_BAR; PG8_SCHED;
            PG8_LDB(B0, 1, 0); PG8_LDB(B1, 1, 1); PG8_SCHED; PG8_LDA(At, 1, 0); PG8_STAGE(PG8_SA(0, 1), a2 + hstep, voffA);
            PG8_WAIT_V(8); PG8_WAIT_L(0); PG8_BAR; PG8_MMA(0, 0, At, B0); PG8_MMA(0, 1, At, B1); PG8_BAR; PG8_SCHED;
            PG8_LDA(At, 1, 1); PG8_STAGE(PG8_SB(1, 0), b3, voffB); PG8_STAGE(PG8_SB(1, 1), b3 + hstep, voffB); PG8_STAGE(PG8_SA(1, 0), a3, voffA);
            PG8_WAIT_V(8); PG8_WAIT_L(0); PG8_BAR; PG8_MMA(1, 0, At, B0); PG8_MMA(1, 1, At, B1); PG8_BAR; PG8_SCHED;
            } else {
            PG8_LDB(B0, 0, 0); PG8_SCHED; PG8_LDA(At, 0, 0); PG8_STAGE(PG8_SA(1, 1), a1 + hstep, voffA);
            PG8_WAIT_L(8); PG8_BAR; PG8_WAIT_L(0); PG8_MMA(0, 0, At, B0); PG8_BAR; PG8_SCHED;
            PG8_LDB(B1, 0, 1); PG8_STAGE(PG8_SB(0, 0), b2, voffB);
            PG8_BAR; PG8_WAIT_L(0); PG8_MMA(0, 1, At, B1); PG8_BAR;
            PG8_LDA(At, 0, 1); PG8_STAGE(PG8_SA(0, 0), a2, voffA);
            PG8_BAR; PG8_WAIT_L(0); PG8_MMA(1, 0, At, B0); PG8_BAR; PG8_SCHED;
            PG8_STAGE(PG8_SB(0, 1), b2 + hstep, voffB);
            PG8_WAIT_V(6); PG8_BAR; PG8_MMA(1, 1, At, B1); PG8_BAR;
            PG8_LDB(B0, 1, 0); PG8_SCHED; PG8_LDA(At, 1, 0); PG8_STAGE(PG8_SA(0, 1), a2 + hstep, voffA);
            PG8_WAIT_L(8); PG8_BAR; PG8_WAIT_L(0); PG8_MMA(0, 0, At, B0); PG8_BAR; PG8_SCHED;
            PG8_LDB(B1, 1, 1); PG8_STAGE(PG8_SB(1, 0), b3, voffB);
            PG8_BAR; PG8_WAIT_L(0); PG8_MMA(0, 1, At, B1); PG8_BAR;
            PG8_LDA(At, 1, 1); PG8_STAGE(PG8_SA(1, 0), a3, voffA);
            PG8_BAR; PG8_WAIT_L(0); PG8_MMA(1, 0, At, B0); PG8_BAR; PG8_SCHED;
            PG8_STAGE(PG8_SB(1, 1), b3 + hstep, voffB);
            PG8_WAIT_V(6); PG8_BAR; PG8_MMA(1, 1, At, B1); PG8_BAR;
            }
        }
        if constexpr (ALIGN_EPI) { if (wr == 0) PG8_BAR; }
        if constexpr (!Epi::AFTER_DRAIN) { E(acc, cur, wr, wc, fr, fq); S.done(cur); }
        if (!has_next) break;
#pragma unroll
        for (int a = 0; a < 2; ++a)
#pragma unroll
            for (int b = 0; b < 2; ++b)
#pragma unroll
                for (int m = 0; m < 4; ++m)
#pragma unroll
                    for (int n = 0; n < 2; ++n) acc[a][b][m][n] = (f32x4){0.f, 0.f, 0.f, 0.f};
        cur = nxt; cA = nA; cB = nB; ++ui;
        if constexpr (ALIGN_EPI) { if (wr == 1) PG8_BAR; }
    }
    PG8_WAIT_V(0);
    if constexpr (!ALIGN_EPI) { if (wr == 0) PG8_BAR; }
    PG8_BAR;
#undef PG8_SA
#undef PG8_SB
#undef PG8_STAGE
#undef PG8_LDA
#undef PG8_LDB
#undef PG8_MMA
#undef PG8_WAIT_V
#undef PG8_WAIT_L
#undef PG8_BAR
#undef PG8_SCHED
}
}

struct Args {
    const float *x, *p, *norm_mix_w, *w_in, *att_rel_bias, *w_gla_gate_up, *b_gla_gate, *gla_norm_w, *w_out, *norm_ffn_w, *w_ffn_up, *w_ffn_conv, *b_ffn_conv, *w_ffn_down,
                *norm_ple_w, *w_ple_gate, *w_ple_proj, *final_norm_w;
    float* out; unsigned char* ws;
};

__device__ __forceinline__ int map_row(int mode, int n) {
    if (mode == 1) { if (n < 2048) return n; if (n < 3072) return n + 2048; if (n < 4096) return n - 1024; if (n < 5120) return n + 1024; return n - 2048; }
    if (mode == 2) { const int half = n >= FF ? 1 : 0; const int c = n - half * FF; return (c >> 7) * 256 + half * 128 + (c & 127); }
    return n;
}
__device__ __forceinline__ void transpose_item(const float* W, int K, int ldn, int nblk, bf16_t* WT, LAS float* scr, int item, int lane, const float* kscale, int mode) {
    const int kb = item / nblk, nb = item % nblk, k0 = 32 * kb, n0 = 128 * nb;
    const int c4 = lane & 31, kh = lane >> 5;
    f32x4 v[16];
#pragma unroll
    for (int i = 0; i < 16; ++i) v[i] = __builtin_nontemporal_load((const f32x4*)(W + (size_t)(k0 + 2 * i + kh) * ldn + n0 + 4 * c4));
#pragma unroll
    for (int i = 0; i < 16; ++i) { f32x4 t = v[i]; if (kscale) t = t * kscale[k0 + 2 * i + kh]; *(LAS f32x4*)(scr + (2 * i + kh) * 132 + 4 * c4) = t; }
    asm volatile("s_waitcnt lgkmcnt(0)" ::: "memory");
    const int c = lane & 3, nl = lane >> 2; const int drow0 = map_row(mode, n0);
#pragma unroll
    for (int j = 0; j < 8; ++j) { const int n = nl + 16 * j; const LAS float* sp = scr + (8 * c) * 132 + n;
        u32x4 o; o.x = pk2(sp[0 * 132], sp[1 * 132]); o.y = pk2(sp[2 * 132], sp[3 * 132]); o.z = pk2(sp[4 * 132], sp[5 * 132]); o.w = pk2(sp[6 * 132], sp[7 * 132]);
        *(u32x4*)(WT + (size_t)(drow0 + n) * K + k0 + 8 * c) = o; }
    asm volatile("s_waitcnt lgkmcnt(0)" ::: "memory");
}

#define XB_TMO      128
#define XB_XCNT(j)  (256  + 64 * (j))
#define XB_XSUB(j)  (1280 + 64 * (j))
#define XB_XGEN(j)  (2304 + 64 * (j))
#define XB_TOP      3328
#define XB_TOPGEN   3392
#define XCD_BAR_WORDS 3456
#define XB_SPIN_CAP (1u << 18)
__device__ __forceinline__ unsigned xb_ld(unsigned* p)              { return __hip_atomic_load(p, __ATOMIC_RELAXED, __HIP_MEMORY_SCOPE_AGENT); }
__device__ __forceinline__ unsigned xb_add(unsigned* p, unsigned v) { return __hip_atomic_fetch_add(p, v, __ATOMIC_RELAXED, __HIP_MEMORY_SCOPE_AGENT); }
__device__ __forceinline__ unsigned xb_xcc_id() { return (unsigned)__builtin_amdgcn_s_getreg((3 << 11) | 20) & 0xFu; }
#define XB_SPIN(cond, bar) do { unsigned _sp = 0; while (cond) { __builtin_amdgcn_s_sleep(1); \
    if ((++_sp & 255u) == 0u) { if (xb_ld(&(bar)[XB_TMO])) break; if (_sp > XB_SPIN_CAP) { atomicAdd(&(bar)[XB_TMO], 1u); break; } } } } while (0)
struct XcdBarrier {
    unsigned* bar; unsigned x;
    volatile LAS unsigned* st;
};
__device__ __forceinline__ XcdBarrier xcd_barrier_post(unsigned* bar, volatile LAS unsigned* st) {
    XcdBarrier b; b.bar = bar; b.x = xb_xcc_id(); b.st = st;
    if (threadIdx.x == 0) (void)xb_add(&bar[XB_XCNT(b.x)], 1u);
    return b;
}
__device__ __forceinline__ void xcd_barrier_complete(unsigned* bar, unsigned x, unsigned& nloc, unsigned& nx) {
    const unsigned G = gridDim.x * gridDim.y * gridDim.z;
    unsigned sum, cnt, mine, sp = 0u;
    for (;;) {
        sum = 0u; cnt = 0u; mine = 0u;
#pragma unroll
        for (unsigned j = 0; j < 16; ++j) { const unsigned c = xb_ld(&bar[XB_XCNT(j)]); sum += c; cnt += (c > 0u) ? 1u : 0u; mine = (j == x) ? c : mine; }
        if (sum == G) break;
        __builtin_amdgcn_s_sleep(1);
        if ((++sp & 255u) == 0u) { if (xb_ld(&bar[XB_TMO])) break; if (sp > XB_SPIN_CAP) { atomicAdd(&bar[XB_TMO], 1u); break; } }
    }
    nloc = mine > 0u ? mine : 1u; nx = cnt > 0u ? cnt : 1u;
}
__device__ __forceinline__ void xcd_barrier(const XcdBarrier& b) {
    asm volatile("s_waitcnt vmcnt(0)" ::: "memory");
    __syncthreads();
    if (threadIdx.x == 0) {
        unsigned* bar = b.bar;
        __builtin_amdgcn_s_waitcnt(0);
        unsigned nloc = b.st[0], nx = b.st[1];
        if (nloc == 0u) { xcd_barrier_complete(bar, b.x, nloc, nx); b.st[0] = nloc; b.st[1] = nx; }
        const unsigned old = xb_add(&bar[XB_XSUB(b.x)], 1u);
        const unsigned gen = old / nloc;
        if (old + 1u == (gen + 1u) * nloc) {
            __builtin_amdgcn_fence(__ATOMIC_RELEASE, "agent");
            asm volatile("s_waitcnt vmcnt(0)" ::: "memory");
            const unsigned og = xb_add(&bar[XB_TOP], 1u);
            const unsigned tg = og / nx;
            if (og + 1u == (tg + 1u) * nx) xb_add(&bar[XB_TOPGEN], 1u);
            else XB_SPIN(xb_ld(&bar[XB_TOPGEN]) == tg, bar);
            __builtin_amdgcn_fence(__ATOMIC_ACQUIRE, "agent");
            xb_add(&bar[XB_XGEN(b.x)], 1u);
            asm volatile("s_waitcnt vmcnt(0)" ::: "memory");
        } else {
            XB_SPIN(xb_ld(&bar[XB_XGEN(b.x)]) == gen, bar);
            __builtin_amdgcn_fence(__ATOMIC_ACQUIRE, "agent");
            asm volatile("s_waitcnt vmcnt(0)" ::: "memory");
        }
    }
    __syncthreads();
}

__device__ __forceinline__ void gla_decay(const Args& a, const float* glr, int n, int hg, int tid, LAS float* gL, LAS float* segtot, float (&bv)[16], float& blast) {
    const int dk = tid & 127, seg = tid >> 7, col = hg * 128 + dk;
    if (tid < 256) ((LAS f32x4*)gL)[tid] = ((const f32x4*)(glr + (size_t)n * 64 * 16))[tid];
    float w[16];
#pragma unroll
    for (int j = 0; j < 16; ++j) w[j] = a.w_gla_gate_up[j * 512 + col];
    const float bias = a.b_gla_gate[col];
    __syncthreads();
    float c = 0.f;
#pragma unroll
    for (int s = 0; s < 16; ++s) { const LAS f32x4* g4 = (const LAS f32x4*)(gL + (16 * seg + s) * 16); float logit = bias;
#pragma unroll
        for (int q = 0; q < 4; ++q) { const f32x4 g = g4[q]; logit += g[0] * w[4 * q] + g[1] * w[4 * q + 1] + g[2] * w[4 * q + 2] + g[3] * w[4 * q + 3]; }
        const float ls = fminf(logit, 0.f) - log1pf(__expf(-fabsf(logit)));
        c += ls * (1.0f / 16.0f); bv[s] = c; if ((s & 3) == 3) asm volatile("" ::: "memory"); }
    segtot[seg * 128 + dk] = c;
    __syncthreads();
    float off = 0.f, tot = 0.f;
#pragma unroll
    for (int q = 0; q < 4; ++q) { const float v = segtot[q * 128 + dk]; tot += v; if (q < seg) off += v; }
#pragma unroll
    for (int s = 0; s < 16; ++s) bv[s] += off;
    blast = tot;
}

#define LBAR() do { asm volatile("s_waitcnt lgkmcnt(0)" ::: "memory"); __builtin_amdgcn_s_barrier(); asm volatile("" ::: "memory"); } while (0)
#define STAMP(k) do { if (PROBE_T != 0 && blockIdx.x == 0 && threadIdx.x == 0) ((unsigned long long*)(a.ws + 200 * 1024))[k] = __builtin_amdgcn_s_memrealtime(); } while (0)
#define IDS() int tid = threadIdx.x; asm volatile("" : "+v"(tid)); const int lane = tid & 63, wave = __builtin_amdgcn_readfirstlane(tid >> 6); const int gw = bx * 8 + wave, gtid = bx * 512 + tid; (void)lane; (void)gw; (void)gtid;
__global__ void __launch_bounds__(512, 2) fwd_megakernel(Args a) {
    extern __shared__ __attribute__((aligned(16))) unsigned char lds_raw[];
    cg::grid_group grid = cg::this_grid();
    LAS unsigned char* lds = (LAS unsigned char*)lds_raw;
    const int tid = threadIdx.x, lane = tid & 63, wave = __builtin_amdgcn_readfirstlane(tid >> 6);
    const int G = gridDim.x, bx = blockIdx.x;
    const int gw = bx * 8 + wave, NGW = G * 8;
    const int gtid = bx * 512 + tid, NT = G * 512;
    unsigned char* ws = a.ws;
    float* ssq1 = (float*)(ws + WS_SSQ1); float* ssq2 = (float*)(ws + WS_SSQ2); float* ssq3 = (float*)(ws + WS_SSQ3);
    float* glr = (float*)(ws + WS_GLR); float* glr1 = (float*)(ws + WS_GLR1); float* decb = (float*)(ws + WS_DEC); float* bcum = (float*)(ws + WS_BCUM); bf16_t* upd = (bf16_t*)(ws + WS_UPD);
    bf16_t* WgT = (bf16_t*)(ws + WS_WG); bf16_t* WppT = (bf16_t*)(ws + WS_WPP); bf16_t* WinT = (bf16_t*)(ws + WS_WIN); bf16_t* WoutT = (bf16_t*)(ws + WS_WOUT);
    bf16_t* WupT = (bf16_t*)(ws + WS_WUP); bf16_t* WdnT = (bf16_t*)(ws + WS_WDN); bf16_t* WpgT = (bf16_t*)(ws + WS_WPG); bf16_t* pb = (bf16_t*)(ws + WS_PB);
    bf16_t* h0 = (bf16_t*)(ws + WS_H0); bf16_t* projR = (bf16_t*)(ws + WS_PROJ); bf16_t* vT = (bf16_t*)(ws + WS_VT);
    bf16_t* ycat = (bf16_t*)a.out;
    float* rstd0 = (float*)(ws + WS_RSTD0); bf16_t* x1b = (bf16_t*)(ws + WS_X1B); bf16_t* gbuf = (bf16_t*)(ws + WS_G);
    float* tailb = (float*)(ws + WS_TAIL); float* headb = (float*)(ws + WS_HEAD); bf16_t* ppb = (bf16_t*)(ws + WS_PP); bf16_t* x2b = (bf16_t*)(ws + WS_X2B); bf16_t* x3b = (bf16_t*)(ws + WS_X3B);

    volatile LAS unsigned* bst = (volatile LAS unsigned*)(lds + LDS_BYTES - 64);
    if (threadIdx.x < 16) bst[threadIdx.x] = 0u;
    unsigned* barw = (unsigned*)(ws + WS_BAR);
    __syncthreads();
    const XcdBarrier xbar = xcd_barrier_post(barw, bst);
    if (a.out == nullptr) grid.sync();
    STAMP(0);
    REPS(1) {
        LAS float* scr = (LAS float*)(lds + wave * 16896);
        constexpr int I_IN = 64 * 48, I_OUT = 64 * 16, I_UP = 64 * 88, I_DN = 176 * 16, I_PG = 64 * 16, I_PP = 8 * 16;
        constexpr int NITEMS = I_IN + I_OUT + I_UP + I_DN + I_PG + I_PP;
        for (int it = gw; it < NITEMS; it += NGW) {
            int r = it;
            if (r < I_IN) { transpose_item(a.w_in, 2048, 6160, 48, WinT, scr, r, lane, a.norm_mix_w, 1); continue; } r -= I_IN;
            if (r < I_OUT) { transpose_item(a.w_out, 2048, 2048, 16, WoutT, scr, r, lane, nullptr, 0); continue; } r -= I_OUT;
            if (r < I_UP) { transpose_item(a.w_ffn_up, 2048, 2 * FF, 88, WupT, scr, r, lane, a.norm_ffn_w, 2); continue; } r -= I_UP;
            if (r < I_DN) { transpose_item(a.w_ffn_down, FF, 2048, 16, WdnT, scr, r, lane, nullptr, 0); continue; } r -= I_DN;
            if (r < I_PG) { transpose_item(a.w_ple_gate, 2048, 2048, 16, WpgT, scr, r, lane, a.norm_ple_w, 0); continue; } r -= I_PG;
            transpose_item(a.w_ple_proj, PLE, 2048, 16, WppT, scr, r, lane, nullptr, 0);
        }
        for (int i = gtid; i < 16 * 2048; i += NT) { const int j = i >> 11, k = i & 2047; WgT[i] = (bf16_t)f2bf(a.w_in[(size_t)k * 6160 + 6144 + j] * a.norm_mix_w[k]); }
        for (int m = gw; m < T; m += 2 * NGW) {
            const int m1 = m + NGW; const bool two = m1 < T;
            const f32x4* xr0 = (const f32x4*)(a.x + (size_t)m * D) + lane; const f32x4* xr1 = (const f32x4*)(a.x + (size_t)(two ? m1 : m) * D) + lane;
            f32x4 v0[8], v1[8]; float s0 = 0.f, s1 = 0.f;
#pragma unroll
            for (int j = 0; j < 8; ++j) { v0[j] = __builtin_nontemporal_load(xr0 + 64 * j); v1[j] = __builtin_nontemporal_load(xr1 + 64 * j); }
            u32x2* o0 = (u32x2*)(h0 + (size_t)m * D) + lane; u32x2* o1 = (u32x2*)(h0 + (size_t)m1 * D) + lane;
#pragma unroll
            for (int j = 0; j < 8; ++j) { s0 += (v0[j].x * v0[j].x + v0[j].y * v0[j].y) + (v0[j].z * v0[j].z + v0[j].w * v0[j].w); s1 += (v1[j].x * v1[j].x + v1[j].y * v1[j].y) + (v1[j].z * v1[j].z + v1[j].w * v1[j].w);
                u32x2 o; o.x = pk2(v0[j].x, v0[j].y); o.y = pk2(v0[j].z, v0[j].w); o0[64 * j] = o;
                if (two) { u32x2 q; q.x = pk2(v1[j].x, v1[j].y); q.y = pk2(v1[j].z, v1[j].w); o1[64 * j] = q; } }
            s0 = wave_sum(s0); s1 = wave_sum(s1);
            if (lane == 0) { rstd0[m] = frsq(s0 * (1.0f / D) + EPS); if (two) rstd0[m1] = frsq(s1 * (1.0f / D) + EPS); }
        }
        for (int i = gtid; i < T * PLE / 4; i += NT) { const f32x4 v = __builtin_nontemporal_load((const f32x4*)a.p + i); u32x2 o; o.x = pk2(v.x, v.y); o.y = pk2(v.z, v.w); ((u32x2*)pb)[i] = o; }
        for (int i = gtid; i < 3 * T; i += NT) ssq1[i] = 0.f;
    }
    if (PROBE_T != 0) { asm volatile("s_waitcnt vmcnt(0)" ::: "memory"); }
    xcd_barrier(xbar);
    STAMP(1);

    REPS(2) {
        IDS();
        for (int task = gw; task < 2 * (T / 16); task += NGW) {
            const int fr = lane & 15, fq = lane >> 4; const int r0 = (task >> 1) * 16, kh = (task & 1) * (D / 2);
            const bf16_t* ap = h0 + (size_t)(r0 + fr) * D + kh + 8 * fq; const bf16_t* bp = WgT + (size_t)fr * D + kh + 8 * fq;
            f32x4 acc = {0.f, 0.f, 0.f, 0.f};
#pragma unroll 8
            for (int k0 = 0; k0 < D / 2; k0 += 32) { const bf16x8 av = *(const bf16x8*)(ap + k0), bv = *(const bf16x8*)(bp + k0); acc = __builtin_amdgcn_mfma_f32_16x16x32_bf16(av, bv, acc, 0, 0, 0); }
            float* gp = (task & 1) ? glr1 : glr;
#pragma unroll
            for (int j = 0; j < 4; ++j) gp[(size_t)(r0 + 4 * fq + j) * 16 + fr] = acc[j] * rstd0[r0 + 4 * fq + j];
        }
        __syncthreads();
        { pg8::Gemm g{h0, WinT, T, NR, D}; pg8::StaticOrder S; S.init(T, NR, G, bx, WGM_P1R); pg8::EpiBf16 E{projR, NR, rstd0, nullptr};
          pg8::gemm_phase<pg8::EpiBf16, pg8::StaticOrder, true, true>(lds, g, S, E); }
        { pg8::Gemm g{WinT + (size_t)NR * D, h0, 2048, T, D}; pg8::StaticOrder S; S.init(2048, T, G, bx, WGM_P1T); pg8::EpiBf16 E{vT, T, nullptr, rstd0};
          pg8::gemm_phase<pg8::EpiBf16, pg8::StaticOrder, true, true>(lds, g, S, E); }
    }
    xcd_barrier(xbar);
    STAMP(2);

    REPS(3) {
        IDS();
        LAS float* gL = (LAS float*)lds; LAS float* segtot = (LAS float*)(lds + 4096); LAS bf16_t* kT = (LAS bf16_t*)(lds + 8192);
        const int fr = lane & 15, fq = lane >> 4, dk = tid & 127, seg = tid >> 7;
        f32x4 g4r = {0.f, 0.f, 0.f, 0.f}; unsigned short kraw[16]; bf16x8 vB[2][2], vBn[2][2];
#define G1_LOAD(u_, VB) do { const int n_ = (u_) >> 2, hg_ = (u_) & 3; if (tid < 256) g4r = ((const f32x4*)(glr + (size_t)n_ * 64 * 16))[tid] + ((const f32x4*)(glr1 + (size_t)n_ * 64 * 16))[tid]; \
            _Pragma("unroll") for (int s = 0; s < 16; ++s) kraw[s] = projR[((size_t)n_ * 64 + 16 * seg + s) * NR + KG + hg_ * 128 + dk]; \
            _Pragma("unroll") for (int nt2 = 0; nt2 < 2; ++nt2) _Pragma("unroll") for (int ks = 0; ks < 2; ++ks) VB[nt2][ks] = *(const bf16x8*)(vT + (size_t)(1024 + hg_ * 256 + 16 * (2 * wave + nt2) + fr) * T + n_ * 64 + 32 * ks + 8 * fq); } while (0)
        if (bx < NCH * 4) G1_LOAD(bx, vB);
        for (int unit = bx; unit < NCH * 4; unit += G) {
            const int n = unit >> 2, hg = unit & 3, col = hg * 128 + dk;
            float w[16];
#pragma unroll
            for (int j = 0; j < 16; ++j) w[j] = a.w_gla_gate_up[j * 512 + col];
            const float bias = a.b_gla_gate[col];
            if (tid < 256) ((LAS f32x4*)gL)[tid] = g4r;
            LBAR();
            float bv[16]; float c = 0.f;
#pragma unroll
            for (int s = 0; s < 16; ++s) { const LAS f32x4* g4 = (const LAS f32x4*)(gL + (16 * seg + s) * 16); float logit = bias;
#pragma unroll
                for (int q = 0; q < 4; ++q) { const f32x4 g = g4[q]; logit += g[0] * w[4 * q] + g[1] * w[4 * q + 1] + g[2] * w[4 * q + 2] + g[3] * w[4 * q + 3]; }
                const float ls = fminf(logit, 0.f) - __logf(1.0f + __expf(-fabsf(logit)));
                c += ls * (1.0f / 16.0f); bv[s] = c; if ((s & 3) == 3) asm volatile("" ::: "memory"); }
            segtot[seg * 128 + dk] = c;
            LBAR();
            float off = 0.f, blast = 0.f;
#pragma unroll
            for (int q = 0; q < 4; ++q) { const float v = segtot[q * 128 + dk]; blast += v; if (q < seg) off += v; }
            unsigned kw[8];
#pragma unroll
            for (int s = 0; s < 16; s += 2) { const float b0 = bv[s] + off, b1 = bv[s + 1] + off; const size_t t = (size_t)n * 64 + 16 * seg + s;
                bcum[t * 512 + col] = b0; bcum[(t + 1) * 512 + col] = b1;
                kw[s >> 1] = pk2(bf2f(kraw[s]) * __expf(blast - b0), bf2f(kraw[s + 1]) * __expf(blast - b1)); }
            *(LAS u32x4*)(kT + dk * 72 + 16 * seg) = (u32x4){kw[0], kw[1], kw[2], kw[3]}; *(LAS u32x4*)(kT + dk * 72 + 16 * seg + 8) = (u32x4){kw[4], kw[5], kw[6], kw[7]};
            if (seg == 0) decb[(size_t)unit * 128 + dk] = __expf(blast);
            LBAR();
            if (unit + G < NCH * 4) G1_LOAD(unit + G, vBn);
            f32x4 acc[8][2];
#pragma unroll
            for (int mt = 0; mt < 8; ++mt) { acc[mt][0] = (f32x4){0.f, 0.f, 0.f, 0.f}; acc[mt][1] = (f32x4){0.f, 0.f, 0.f, 0.f}; }
#pragma unroll
            for (int mt = 0; mt < 8; ++mt)
#pragma unroll
                for (int ks = 0; ks < 2; ++ks) { const bf16x8 ak = *(const LAS bf16x8*)(kT + (16 * mt + fr) * 72 + 32 * ks + 8 * fq);
                    acc[mt][0] = __builtin_amdgcn_mfma_f32_16x16x32_bf16(ak, vB[0][ks], acc[mt][0], 0, 0, 0);
                    acc[mt][1] = __builtin_amdgcn_mfma_f32_16x16x32_bf16(ak, vB[1][ks], acc[mt][1], 0, 0, 0); }
#pragma unroll
            for (int mt = 0; mt < 8; ++mt)
#pragma unroll
                for (int nt2 = 0; nt2 < 2; ++nt2) { const int dvv = 16 * (2 * wave + nt2) + fr; u32x2 wv; wv.x = pk2(acc[mt][nt2][0], acc[mt][nt2][1]); wv.y = pk2(acc[mt][nt2][2], acc[mt][nt2][3]);
                    *(u32x2*)(upd + (size_t)unit * 32768 + dvv * 128 + 16 * mt + 4 * fq) = wv; }
#pragma unroll
            for (int nt2 = 0; nt2 < 2; ++nt2)
#pragma unroll
                for (int ks = 0; ks < 2; ++ks) vB[nt2][ks] = vBn[nt2][ks];
        }
#undef G1_LOAD
    }
    xcd_barrier(xbar);
    STAMP(3);

    { IDS();
    for (int g2 = bx * 256 + tid; tid < 256 && g2 < 4 * 16384; g2 += G * 256) {
        const int hg = g2 >> 14, rem = (g2 & 16383) * 2, dk = rem & 127;
        unsigned* p = (unsigned*)(upd + (size_t)hg * 32768 + rem); const f32x2* dp = (const f32x2*)(decb + hg * 128 + dk);
        float S0 = 0.f, S1 = 0.f;
        unsigned ua[16], ub[16]; f32x2 da[16], db[16];
#define SCAN_LOAD(U, Dd, n0) do { _Pragma("unroll") for (int k = 0; k < 16; ++k) { U[k] = p[(size_t)((n0) + k) * 65536]; Dd[k] = dp[((n0) + k) * 256]; } } while (0)
#define SCAN_STEP(U, Dd, n0) do { _Pragma("unroll") for (int k = 0; k < 16; ++k) { p[(size_t)((n0) + k) * 65536] = pk2(S0, S1); S0 = Dd[k].x * S0 + bflo(U[k]); S1 = Dd[k].y * S1 + bfhi(U[k]); } } while (0)
        SCAN_LOAD(ua, da, 0);
        for (int n = 0; n < NCH; n += 32) {
            SCAN_LOAD(ub, db, n + 16);
            SCAN_STEP(ua, da, n);
            if (n + 32 < NCH) SCAN_LOAD(ua, da, n + 32);
            SCAN_STEP(ub, db, n + 16);
        }
#undef SCAN_LOAD
#undef SCAN_STEP
    } }
    if (PROBE_T != 0) { asm volatile("s_waitcnt vmcnt(0)" ::: "memory"); grid.sync(); STAMP(12); }
    {
        IDS();
        constexpr int CHB = 18432, BUFB = 3 * CHB;
        LAS unsigned char* kvb = lds; LAS float* bt = (LAS float*)(lds + 2 * BUFB);
        const int fr = lane & 15, fq = lane >> 4, hl = wave >> 2, qt = wave & 3;
        constexpr float LOG2E = 1.4426950408889634f;
        const int prow = (tid >> 3) & 63, pseg = tid & 7, pofs = prow * 144 + pseg * 16;
#define ATT_LOADK(cc, hpp, g) do { _Pragma("unroll") for (int q3 = 0; q3 < 3; ++q3) { const int kc_ = ((cc) - 8 + 3 * (g) + q3) < 0 ? 0 : ((cc) - 8 + 3 * (g) + q3); _Pragma("unroll") for (int r = 0; r < 2; ++r) \
            pre[q3][r] = *(const u32x4*)(projR + (size_t)(kc_ * 64 + prow) * NR + KA + 64 * (2 * (hpp) + r) + 8 * pseg); } } while (0)
#define ATT_LOADV(cc, hpp, g) do { _Pragma("unroll") for (int q3 = 0; q3 < 3; ++q3) { const int kc_ = ((cc) - 8 + 3 * (g) + q3) < 0 ? 0 : ((cc) - 8 + 3 * (g) + q3); _Pragma("unroll") for (int r = 0; r < 2; ++r) \
            pre[q3][r] = *(const u32x4*)(vT + (size_t)(64 * (2 * (hpp) + r) + prow) * T + kc_ * 64 + 8 * pseg); } } while (0)
#define ATT_WRITE(buf) do { _Pragma("unroll") for (int q3 = 0; q3 < 3; ++q3) _Pragma("unroll") for (int r = 0; r < 2; ++r) *(LAS u32x4*)(kvb + (buf) * BUFB + q3 * CHB + r * 9216 + pofs) = pre[q3][r]; } while (0)
#define ATT_LOADQ(cc, hpp) do { _Pragma("unroll") for (int ks = 0; ks < 2; ++ks) qn[ks] = *(const bf16x8*)(projR + (size_t)(64 * (cc) + 16 * qt + fr) * NR + QA + 64 * (2 * (hpp) + hl) + 32 * ks + 8 * fq); } while (0)
        const int NU = NCH * 8 * (PROBE_DUP == 4 ? 2 : 1);
        u32x4 pre[3][2]; bf16x8 qn[2]; int hp_tab = -1;
        if (bx < NU) { const int c0 = (bx >> 3) & (NCH - 1), hp0 = bx & 7; ATT_LOADQ(c0, hp0); ATT_LOADK(c0, hp0, 0); ATT_WRITE(0); }
        for (int unit = bx; unit < NU; unit += G) {
            const int c = (unit >> 3) & (NCH - 1), hp = unit & 7, h = 2 * hp + hl;
            const int un = unit + G, cn = (un >> 3) & (NCH - 1), hpn = un & 7;
            if (hp != hp_tab) { for (int i = tid; i < 1026; i += 512) { const int hh = i >= 513 ? 1 : 0; bt[hh * 516 + (i - hh * 513)] = a.att_rel_bias[(2 * hp + hh) * 513 + (i - hh * 513)] * LOG2E; } hp_tab = hp; }
            const bf16x8 qv0 = qn[0], qv1 = qn[1];
            __syncthreads();
            f32x4 S[36];
            const LAS float* btl = bt + hl * 516 + 256; const int relb = 16 * qt + fr + 512 - 4 * fq;
            const float b512 = btl[256];
#pragma unroll
            for (int g = 0; g < 3; ++g) {
                if (g < 2) ATT_LOADK(c, hp, g + 1); else ATT_LOADV(c, hp, 0);
#pragma unroll
                for (int q3 = 0; q3 < 3; ++q3) { const int j = 3 * g + q3;
#pragma unroll
                    for (int kt4 = 0; kt4 < 4; ++kt4) { f32x4 acc = {0.f, 0.f, 0.f, 0.f};
                        const LAS unsigned char* kp = kvb + (g & 1) * BUFB + q3 * CHB + hl * 9216 + (16 * kt4 + fr) * 144 + 16 * fq;
                        acc = __builtin_amdgcn_mfma_f32_16x16x32_bf16(*(const LAS bf16x8*)kp, qv0, acc, 0, 0, 0);
                        acc = __builtin_amdgcn_mfma_f32_16x16x32_bf16(*(const LAS bf16x8*)(kp + 64), qv1, acc, 0, 0, 0);
#pragma unroll
                        for (int jj = 0; jj < 4; ++jj) { float bias = b512;
                            if (j == 4) { int rel = relb - (64 * j + 16 * kt4 + jj); rel = rel > 256 ? 256 : rel; bias = btl[rel]; }
                            else if (j > 4) bias = btl[relb - (64 * j + 16 * kt4 + jj)];
                            acc[jj] = acc[jj] * (0.125f * LOG2E) + bias; }
                        S[4 * j + kt4] = acc; }
                    __builtin_amdgcn_sched_barrier(0); }
                ATT_WRITE((g + 1) & 1);
                __syncthreads();
            }
            if (c < 8) {
#pragma unroll
                for (int j = 0; j < 8; ++j) if (j < 8 - c) {
#pragma unroll
                    for (int kt4 = 0; kt4 < 4; ++kt4) S[4 * j + kt4] = (f32x4){-1e30f, -1e30f, -1e30f, -1e30f}; } }
            float mx = -1e30f;
#pragma unroll
            for (int i = 0; i < 36; ++i) mx = fmaxf(mx, fmaxf(fmaxf(S[i][0], S[i][1]), fmaxf(S[i][2], S[i][3])));
            mx = fmaxf(mx, __shfl_xor(mx, 16)); mx = fmaxf(mx, __shfl_xor(mx, 32));
            f32x2 l2 = {0.f, 0.f};
            u32x2 PW[36];
#pragma unroll
            for (int i = 0; i < 36; ++i) { const f32x4 d = S[i] - mx; const float p0 = __builtin_amdgcn_exp2f(d[0]), p1 = __builtin_amdgcn_exp2f(d[1]), p2 = __builtin_amdgcn_exp2f(d[2]), p3 = __builtin_amdgcn_exp2f(d[3]);
                l2 = l2 + (f32x2){p0, p1}; l2 = l2 + (f32x2){p2, p3}; PW[i].x = pg8::cvt_pk_bf16(p0, p1); PW[i].y = pg8::cvt_pk_bf16(p2, p3); asm volatile("" : "+v"(PW[i].x), "+v"(PW[i].y));
                if ((i & 3) == 3) __builtin_amdgcn_sched_barrier(0); }
            float l = l2[0] + l2[1];
            l += __shfl_xor(l, 16); l += __shfl_xor(l, 32);
            f32x4 O[4];
#pragma unroll
            for (int dt = 0; dt < 4; ++dt) O[dt] = (f32x4){0.f, 0.f, 0.f, 0.f};
            if (un < NU) ATT_LOADQ(cn, hpn);
#pragma unroll
            for (int g = 0; g < 3; ++g) {
                if (g < 2) ATT_LOADV(c, hp, g + 1); else if (un < NU) ATT_LOADK(cn, hpn, 0);
                const int buf = (3 + g) & 1;
#pragma unroll
                for (int q3 = 0; q3 < 3; ++q3) { const int j = 3 * g + q3;
#pragma unroll
                    for (int a2 = 0; a2 < 2; ++a2) { const u32x4 pw = {PW[4 * j + 2 * a2].x, PW[4 * j + 2 * a2].y, PW[4 * j + 2 * a2 + 1].x, PW[4 * j + 2 * a2 + 1].y};
                        const bf16x8 pa = __builtin_bit_cast(bf16x8, pw);
#pragma unroll
                        for (int dt = 0; dt < 4; ++dt) { const LAS unsigned char* vp = kvb + buf * BUFB + q3 * CHB + hl * 9216 + (16 * dt + fr) * 144 + (32 * a2 + 4 * fq) * 2;
                            const u32x2 lo = *(const LAS u32x2*)vp, hi = *(const LAS u32x2*)(vp + 32);
                            const u32x4 vw = {lo.x, lo.y, hi.x, hi.y};
                            O[dt] = __builtin_amdgcn_mfma_f32_16x16x32_bf16(pa, __builtin_bit_cast(bf16x8, vw), O[dt], 0, 0, 0); } } }
                if (g < 2 || un < NU) ATT_WRITE((3 + g + 1) & 1);
                if (g < 2) __syncthreads();
            }
#pragma unroll
            for (int jj = 0; jj < 4; ++jj) { const float linv = 1.0f / __shfl(l, 4 * fq + jj); const size_t t = (size_t)64 * c + 16 * qt + 4 * fq + jj;
#pragma unroll
                for (int dt = 0; dt < 4; ++dt) ycat[t * D + 64 * h + 16 * dt + fr] = (bf16_t)f2bf(O[dt][jj] * linv); }
        }
#undef ATT_LOADK
#undef ATT_LOADV
#undef ATT_WRITE
#undef ATT_LOADQ
    }
    xcd_barrier(xbar);
    STAMP(4);

    REPS(5) {
        IDS();
        LAS float* red = (LAS float*)(lds + 6144);
        LAS bf16_t* qd = (LAS bf16_t*)(lds + 8192); LAS bf16_t* ki = (LAS bf16_t*)(lds + 25600); LAS bf16_t* aL = (LAS bf16_t*)(lds + 43008);
        const int fr = lane & 15, fq = lane >> 4, dk = tid & 127, seg = tid >> 7;
        f32x4 braw[2][2]; u32x4 qraw[2], kraw[2];
        const int pi = tid >> 4, pg = tid & 15;
#define G3_LOAD(u_) do { const int n_ = (u_) >> 2, hg_ = (u_) & 3; _Pragma("unroll") for (int r = 0; r < 2; ++r) { const size_t t_ = (size_t)n_ * 64 + pi + 32 * r; \
            braw[r][0] = *(const f32x4*)(bcum + t_ * 512 + hg_ * 128 + 8 * pg); braw[r][1] = *(const f32x4*)(bcum + t_ * 512 + hg_ * 128 + 8 * pg + 4); \
            qraw[r] = *(const u32x4*)(projR + t_ * NR + QG + hg_ * 128 + 8 * pg); kraw[r] = *(const u32x4*)(projR + t_ * NR + KG + hg_ * 128 + 8 * pg); } } while (0)
        if (bx < NCH * 4) G3_LOAD(bx);
        for (int unit = bx; unit < NCH * 4; unit += G) {
            const int n = unit >> 2, hg = unit & 3;
            bf16x8 vB[2][2], sB[2][4];
#pragma unroll
            for (int nt2 = 0; nt2 < 2; ++nt2) { const int dvv = 16 * (2 * wave + nt2) + fr;
#pragma unroll
                for (int ks = 0; ks < 2; ++ks) vB[nt2][ks] = *(const bf16x8*)(vT + (size_t)(1024 + hg * 256 + dvv) * T + n * 64 + 32 * ks + 8 * fq);
#pragma unroll
                for (int ks = 0; ks < 4; ++ks) sB[nt2][ks] = *(const bf16x8*)(upd + (size_t)unit * 32768 + dvv * 128 + 32 * ks + 8 * fq); }
#pragma unroll
            for (int r = 0; r < 2; ++r) { const int i = pi + 32 * r; u32x4 qo, ko;
#pragma unroll
                for (int e = 0; e < 4; ++e) { const float b0 = e < 2 ? braw[r][0][2 * e] : braw[r][1][2 * e - 4], b1 = e < 2 ? braw[r][0][2 * e + 1] : braw[r][1][2 * e - 3];
                    qo[e] = pk2(bflo(qraw[r][e]) * 0.08838834764831845f * __expf(b0), bfhi(qraw[r][e]) * 0.08838834764831845f * __expf(b1));
                    ko[e] = pk2(bflo(kraw[r][e]) * __expf(-b0), bfhi(kraw[r][e]) * __expf(-b1)); }
                *(LAS u32x4*)(qd + i * 136 + 8 * pg) = qo; *(LAS u32x4*)(ki + i * 136 + 8 * pg) = ko; }
            LBAR();
            if (unit + G < NCH * 4) G3_LOAD(unit + G);
#pragma unroll
            for (int rep = 0; rep < 2; ++rep) { const int idx = wave + 8 * rep, it = idx >> 2, jt = idx & 3;
                f32x4 c = {0.f, 0.f, 0.f, 0.f};
                if (jt <= it) {
#pragma unroll
                    for (int ks = 0; ks < 4; ++ks) { const bf16x8 av = *(const LAS bf16x8*)(qd + (16 * it + fr) * 136 + 32 * ks + 8 * fq), bv8 = *(const LAS bf16x8*)(ki + (16 * jt + fr) * 136 + 32 * ks + 8 * fq);
                        c = __builtin_amdgcn_mfma_f32_16x16x32_bf16(av, bv8, c, 0, 0, 0); } }
#pragma unroll
                for (int jj = 0; jj < 4; ++jj) { const int i = 16 * it + 4 * fq + jj, j = 16 * jt + fr; aL[i * 72 + j] = (bf16_t)f2bf(j <= i ? c[jj] : 0.f); } }
            LBAR();
            unsigned short rr[4][4][2];
#pragma unroll
            for (int mt = 0; mt < 4; ++mt)
#pragma unroll
                for (int jj = 0; jj < 4; ++jj)
#pragma unroll
                    for (int nt2 = 0; nt2 < 2; ++nt2) rr[mt][jj][nt2] = projR[((size_t)n * 64 + 16 * mt + 4 * fq + jj) * NR + RG + hg * 256 + 16 * (2 * wave + nt2) + fr];
            f32x4 acc[4][2];
#pragma unroll
            for (int mt = 0; mt < 4; ++mt) { acc[mt][0] = (f32x4){0.f, 0.f, 0.f, 0.f}; acc[mt][1] = (f32x4){0.f, 0.f, 0.f, 0.f}; }
#pragma unroll
            for (int nt2 = 0; nt2 < 2; ++nt2)
#pragma unroll
                for (int mt = 0; mt < 4; ++mt) {
#pragma unroll
                    for (int ks = 0; ks < 2; ++ks) acc[mt][nt2] = __builtin_amdgcn_mfma_f32_16x16x32_bf16(*(const LAS bf16x8*)(aL + (16 * mt + fr) * 72 + 32 * ks + 8 * fq), vB[nt2][ks], acc[mt][nt2], 0, 0, 0);
#pragma unroll
                    for (int ks = 0; ks < 4; ++ks) acc[mt][nt2] = __builtin_amdgcn_mfma_f32_16x16x32_bf16(*(const LAS bf16x8*)(qd + (16 * mt + fr) * 136 + 32 * ks + 8 * fq), sB[nt2][ks], acc[mt][nt2], 0, 0, 0); }
#pragma unroll
            for (int mt = 0; mt < 4; ++mt)
#pragma unroll
                for (int jj = 0; jj < 4; ++jj) { float p = acc[mt][0][jj] * acc[mt][0][jj] + acc[mt][1][jj] * acc[mt][1][jj];
                    p += __shfl_xor(p, 1); p += __shfl_xor(p, 2); p += __shfl_xor(p, 4); p += __shfl_xor(p, 8);
                    if (fr == 0) red[wave * 64 + 16 * mt + 4 * fq + jj] = p; }
            LBAR();
            const float gw0 = a.gla_norm_w[16 * (2 * wave) + fr], gw1 = a.gla_norm_w[16 * (2 * wave + 1) + fr];
#pragma unroll
            for (int mt = 0; mt < 4; ++mt)
#pragma unroll
                for (int jj = 0; jj < 4; ++jj) { const int i = 16 * mt + 4 * fq + jj; float ss = 0.f;
#pragma unroll
                    for (int w8 = 0; w8 < 8; ++w8) ss += red[w8 * 64 + i];
                    const float rstd = frsq(ss * (1.0f / 256.0f) + EPS); const size_t t = (size_t)n * 64 + i;
#pragma unroll
                    for (int nt2 = 0; nt2 < 2; ++nt2) { const int dvv = 16 * (2 * wave + nt2) + fr;
                        const float r = bf2f(rr[mt][jj][nt2]);
                        const float y = acc[mt][nt2][jj] * rstd * (nt2 ? gw1 : gw0) * (r * fsigmoid(r));
                        ycat[t * D + 1024 + hg * 256 + dvv] = (bf16_t)f2bf(y); } }
        }
#undef G3_LOAD
    }
    xcd_barrier(xbar);
    STAMP(5);

    { pg8::Gemm g{ycat, WoutT, T, D, D}; pg8::StaticOrder S; S.init(T, D, G, bx, WGM_P5); pg8::EpiResid<true> E{h0, x1b, ssq1};
      pg8::gemm_phase<pg8::EpiResid<true>, pg8::StaticOrder, true, true>(lds, g, S, E); }
    xcd_barrier(xbar);
    STAMP(6);

#ifndef NO_UP
    REPS(6) { pg8::Gemm g{x1b, WupT, T, 2 * FF, D}; pg8::StaticOrder S; S.init(T, 2 * FF, G, bx, WGM_P6); pg8::EpiUp E{gbuf, ssq1, a.w_ffn_conv, a.b_ffn_conv, tailb, headb};
      pg8::gemm_phase<pg8::EpiUp, pg8::StaticOrder, true, true>(lds, g, S, E); }
#endif
    xcd_barrier(xbar);
    STAMP(7);

    { IDS();
    for (int i = gtid; i < NCH * 2 * (FF / 4); i += NT) {
        const int c4 = i % (FF / 4), gj = i / (FF / 4), j = gj & 1, grp = gj >> 1; const int row = grp * 64 + j, C = 4 * c4;
        const float* tl = tailb + (size_t)(grp - 1) * 2 * (2 * FF); const float* hd = headb + (size_t)grp * 2 * (2 * FF);
        const f32x4 z = {0.f, 0.f, 0.f, 0.f};
        f32x4 ug0, uv0, ug1, uv1, ug2, uv2;
        if (j == 0) { ug0 = grp ? *(const f32x4*)(tl + C) : z; uv0 = grp ? *(const f32x4*)(tl + FF + C) : z; ug1 = grp ? *(const f32x4*)(tl + 2 * FF + C) : z; uv1 = grp ? *(const f32x4*)(tl + 3 * FF + C) : z;
                      ug2 = *(const f32x4*)(hd + C); uv2 = *(const f32x4*)(hd + FF + C); }
        else { ug0 = grp ? *(const f32x4*)(tl + 2 * FF + C) : z; uv0 = grp ? *(const f32x4*)(tl + 3 * FF + C) : z; ug1 = *(const f32x4*)(hd + C); uv1 = *(const f32x4*)(hd + FF + C);
               ug2 = *(const f32x4*)(hd + 2 * FF + C); uv2 = *(const f32x4*)(hd + 3 * FF + C); }
        const float* cw = a.w_ffn_conv; const float* cb = a.b_ffn_conv;
        const f32x4 yg = *(const f32x4*)(cb + C) + *(const f32x4*)(cw + C) * ug0 + *(const f32x4*)(cw + 2 * FF + C) * ug1 + *(const f32x4*)(cw + 4 * FF + C) * ug2;
        const f32x4 yv = *(const f32x4*)(cb + FF + C) + *(const f32x4*)(cw + FF + C) * uv0 + *(const f32x4*)(cw + 3 * FF + C) * uv1 + *(const f32x4*)(cw + 5 * FF + C) * uv2;
        u32x2 o; o.x = pk2(pg8::gelu_tanh(yg[0]) * yv[0], pg8::gelu_tanh(yg[1]) * yv[1]); o.y = pk2(pg8::gelu_tanh(yg[2]) * yv[2], pg8::gelu_tanh(yg[3]) * yv[3]);
        *(u32x2*)(gbuf + (size_t)row * FF + C) = o;
    } }
    xcd_barrier(xbar);
    STAMP(8);

    { pg8::Gemm g{gbuf, WdnT, T, D, FF}; pg8::StaticOrder S; S.init(T, D, G, bx, WGM_P8); pg8::EpiResid<true> E{x1b, x2b, ssq2};
      pg8::gemm_phase<pg8::EpiResid<true>, pg8::StaticOrder, true, true>(lds, g, S, E); }
    { pg8::Gemm g{pb, WppT, T, D, PLE}; pg8::StaticOrder S; S.init(T, D, G, bx, WGM_PP); pg8::EpiBf16 E{ppb, D, nullptr, nullptr};
      pg8::gemm_phase<pg8::EpiBf16, pg8::StaticOrder, true, true>(lds, g, S, E); }
    xcd_barrier(xbar);
    STAMP(9);

    { pg8::Gemm g{x2b, WpgT, T, D, D}; pg8::StaticOrder S; S.init(T, D, G, bx, WGM_P9); pg8::EpiPle E{x2b, x3b, ppb, ssq2, ssq3};
      pg8::gemm_phase<pg8::EpiPle, pg8::StaticOrder, true, true>(lds, g, S, E); }
    xcd_barrier(xbar);
    STAMP(10);

    { IDS();
    for (int m = gw; m < T; m += NGW) {
        const float rstd = frsq(ssq3[m] * (1.0f / D) + EPS);
        const u32x4* xr = (const u32x4*)(x3b + (size_t)m * D) + lane; f32x4* orow = (f32x4*)(a.out + (size_t)m * D); const f32x4* wr4 = (const f32x4*)a.final_norm_w;
#pragma unroll
        for (int j = 0; j < 4; ++j) { const u32x4 xw = xr[64 * j]; const int c4 = (64 * j + lane) * 2; const f32x4 w0 = wr4[c4], w1 = wr4[c4 + 1];
            f32x4 v0 = {bflo(xw.x) * rstd * w0.x, bfhi(xw.x) * rstd * w0.y, bflo(xw.y) * rstd * w0.z, bfhi(xw.y) * rstd * w0.w};
            f32x4 v1 = {bflo(xw.z) * rstd * w1.x, bfhi(xw.z) * rstd * w1.y, bflo(xw.w) * rstd * w1.z, bfhi(xw.w) * rstd * w1.w};
            __builtin_nontemporal_store(v0, orow + c4); __builtin_nontemporal_store(v1, orow + c4 + 1); }
    } }
    if (PROBE_DUP == 7) { for (int i_ = 0; i_ < 20; ++i_) grid.sync(); }
    if (PROBE_T != 0) {
        asm volatile("s_waitcnt vmcnt(0)" ::: "memory"); grid.sync(); STAMP(11); grid.sync();
        unsigned probe_m = 50000u;
        if (PROBE_T != 100) { const unsigned long long* tsb = (const unsigned long long*)(a.ws + 200 * 1024); constexpr int HI_ = PROBE_T == 13 ? 12 : (PROBE_T == 14 ? 4 : (PROBE_T == 15 ? 11 : PROBE_T)), LO_ = PROBE_T == 13 ? 3 : (PROBE_T == 14 ? 12 : (PROBE_T == 15 ? 0 : PROBE_T - 1));
            probe_m = (unsigned)(__hip_atomic_load(tsb + HI_, __ATOMIC_RELAXED, __HIP_MEMORY_SCOPE_AGENT) - __hip_atomic_load(tsb + LO_, __ATOMIC_RELAXED, __HIP_MEMORY_SCOPE_AGENT)); if (PROBE_T == 15) probe_m /= 8; }
        for (unsigned e = blockIdx.x * 512u + threadIdx.x; e < probe_m; e += gridDim.x * 512u) a.out[e] += 0.08f;
    }
}

extern "C" void kernel_launch(void* const* d_in, const int* in_sizes, int n_in, void* d_out, int out_size, void* d_ws, size_t ws_size, hipStream_t stream) {
    static int grid = 0;
    if (grid == 0) {
        if (n_in != 18 || out_size != T * D || ws_size < WS_END) { fprintf(stderr, "kernel_launch: unexpected problem (n_in %d out %d ws %zu)\n", n_in, out_size, ws_size); grid = -1; return; }
        int dev = 0, cus = 0, per_cu = 0;
        hipGetDevice(&dev); hipDeviceGetAttribute(&cus, hipDeviceAttributeMultiprocessorCount, dev);
        if (hipFuncSetAttribute((const void*)fwd_megakernel, hipFuncAttributeMaxDynamicSharedMemorySize, LDS_BYTES) != hipSuccess) { fprintf(stderr, "kernel_launch: hipFuncSetAttribute failed\n"); grid = -1; return; }
        if (hipOccupancyMaxActiveBlocksPerMultiprocessor(&per_cu, (const void*)fwd_megakernel, 512, LDS_BYTES) != hipSuccess || per_cu < 1) { fprintf(stderr, "kernel_launch: occupancy query says %d\n", per_cu); per_cu = 1; }
        (void)hipGetLastError();
        grid = cus * per_cu;
    }
    if (grid < 0) return;
    Args a{};
    const float** f = (const float**)&a;
    for (int i = 0; i < 18; ++i) f[i] = (const float*)d_in[i];
    a.out = (float*)d_out; a.ws = (unsigned char*)d_ws;
    if (hipMemsetAsync((char*)d_ws + WS_BAR, 0, 16384, stream) != hipSuccess) { fprintf(stderr, "kernel_launch: memset of the barrier words failed\n"); return; }
    void* args[] = {&a};
    hipError_t e = hipLaunchCooperativeKernel((const void*)fwd_megakernel, dim3(grid), dim3(512), args, LDS_BYTES, stream);
    if (e != hipSuccess) fprintf(stderr, "cooperative launch failed: %s (grid %d)\n", hipGetErrorString(e), grid);
}
```

```cpp
#include <hip/hip_runtime.h>
#include <hip/hip_cooperative_groups.h>
#include <cstdio>
#include <cstdint>
namespace cg = cooperative_groups;
#ifndef PROBE_DUP
#define PROBE_DUP 0
#endif
#ifndef PROBE_T
#define PROBE_T 0
#endif
#ifndef WGM_P1R
#define WGM_P1R 4
#endif
#ifndef WGM_P1T
#define WGM_P1T 4
#endif
#ifndef WGM_P5
#define WGM_P5 4
#endif
#ifndef WGM_P6
#define WGM_P6 8
#endif
#ifndef WGM_P8
#define WGM_P8 4
#endif
#ifndef WGM_PP
#define WGM_PP 4
#endif
#ifndef WGM_P9
#define WGM_P9 4
#endif
#define REPS(k) for (int rep_ = 0; rep_ < (PROBE_DUP == (k) ? 2 : 1); ++rep_)

#define LAS __attribute__((address_space(3)))
typedef unsigned short bf16_t;
typedef short bf16x8 __attribute__((ext_vector_type(8)));
typedef float f32x4 __attribute__((ext_vector_type(4)));
typedef float f32x2 __attribute__((ext_vector_type(2)));
typedef unsigned u32x4 __attribute__((ext_vector_type(4)));
typedef unsigned u32x2 __attribute__((ext_vector_type(2)));

constexpr int T = 16384, D = 2048, FF = 5632, NR = 4096, PLE = 256, NCH = 256;
constexpr int QA = 0, KA = 1024, QG = 2048, KG = 2560, RG = 3072;
constexpr float EPS = 1e-6f;
constexpr size_t MiB = 1u << 20;
constexpr size_t WS_SSQ1 = 0, WS_SSQ2 = 65536, WS_SSQ3 = 131072, WS_GLR = 1 * MiB, WS_WG = 2 * MiB, WS_WPP = 3 * MiB;
constexpr size_t WS_WIN = 4 * MiB, WS_WOUT = 28 * MiB, WS_WUP = 36 * MiB, WS_WDN = 80 * MiB, WS_WPG = 102 * MiB, WS_PB = 110 * MiB;
constexpr size_t WS_H0 = 118 * MiB;
constexpr size_t WS_PROJ = 182 * MiB;
constexpr size_t WS_VT = 310 * MiB;
constexpr size_t WS_X1B = 182 * MiB, WS_G = 246 * MiB, WS_TAIL = 422 * MiB, WS_HEAD = 444 * MiB, WS_PP = 422 * MiB  , WS_X3B = 182 * MiB  , WS_YCAT = WS_H0, WS_X2B = WS_H0;
constexpr size_t WS_DEC = 256 * 1024, WS_UPD = 406 * MiB, WS_BCUM = 374 * MiB;
constexpr size_t WS_BAR = 800 * 1024;
constexpr size_t WS_GLR1 = 470 * MiB;
constexpr size_t WS_RSTD0 = 900 * 1024;
constexpr size_t WS_END = 512 * MiB;
constexpr int LDS_BYTES = 147456;

__device__ __forceinline__ unsigned f2bf(float f) { unsigned u = __builtin_bit_cast(unsigned, f); return (u + 0x7fffu + ((u >> 16) & 1u)) >> 16; }
typedef __bf16 hwbf16x2 __attribute__((ext_vector_type(2)));
__device__ __forceinline__ unsigned pk2(float lo, float hi) { const f32x2 v = {lo, hi}; return __builtin_bit_cast(unsigned, __builtin_convertvector(v, hwbf16x2)); }
__device__ __forceinline__ float frcp(float x) { return __builtin_amdgcn_rcpf(x); }
__device__ __forceinline__ float frsq(float x) { return __builtin_amdgcn_rsqf(x); }
__device__ __forceinline__ float fsigmoid(float x) { return frcp(1.0f + __builtin_amdgcn_exp2f(-1.4426950408889634f * x)); }
__device__ __forceinline__ float bf2f(unsigned short b) { return __builtin_bit_cast(float, (unsigned)b << 16); }
__device__ __forceinline__ float bflo(unsigned w) { return __builtin_bit_cast(float, w << 16); }
__device__ __forceinline__ float bfhi(unsigned w) { return __builtin_bit_cast(float, w & 0xffff0000u); }
__device__ __forceinline__ float wave_sum(float v) {
#pragma unroll
    for (int o = 1; o < 64; o <<= 1) v += __shfl_xor(v, o);
    return v;
}

namespace pg8 {
#define PG8_LAS __attribute__((address_space(3)))
constexpr int BM = 256, BK = 64, HALF = 128, HTB = HALF * BK * 2, STAGE_BYTES = 8 * HTB, NXCD = 8;
__host__ __device__ __forceinline__ int lds_byte(int r, int c) { const int st = (r >> 4) * 2 + (c >> 5), rr = r & 15, cc = c & 31, ob = rr * 64 + cc * 2; return st * 1024 + (ob ^ (((ob >> 9) & 1) << 5)); }
__host__ __device__ __forceinline__ void stage_rc(int b, int& R, int& C) { const int st = b / 1024, sb = b % 1024, swz = sb ^ (((sb >> 9) & 1) << 5); R = (st >> 1) * 16 + swz / 64; C = (st & 1) * 32 + (swz % 64) / 2; }
__host__ __device__ __forceinline__ int perm32(int rho) { const int n = rho >> 4, i = rho & 15; return 8 * (i >> 2) + 4 * n + (i & 3); }

struct Unit { int pm, pn; };
struct Gemm { const bf16_t* A; const bf16_t* Bt; int M, N, K; };

struct StaticOrder {
    int nM, nN, nwg, G, c, WGM;
    __host__ __device__ void init(int M, int N, int G_, int c_, int wgm) { nM = M / BM; nN = N / BM; nwg = nM * nN; G = G_; c = c_; WGM = wgm; }
    __host__ __device__ bool next(int i, Unit& u) const {
        const long L = (long)i * G + c; if (L >= nwg) return false;
        int wgid = (int)L; { const int q = nwg / NXCD, r = nwg % NXCD, xcd = wgid % NXCD, off = wgid / NXCD; wgid = (xcd < r ? xcd * (q + 1) : r * (q + 1) + (xcd - r) * q) + off; }
        const int nig = WGM * nN, gid = wgid / nig, fm = gid * WGM, gsz = (nM - fm) < WGM ? (nM - fm) : WGM;
        u.pm = fm + ((wgid % nig) % gsz); u.pn = (wgid % nig) / gsz; return true;
    }
    __device__ __forceinline__ void a_ready(const Unit&) const {}
    __device__ __forceinline__ void done(const Unit&) const {}
};

__device__ __forceinline__ unsigned cvt_pk_bf16(float lo, float hi) { return pk2(lo, hi); }

struct EpiBf16 {
    static constexpr bool PERM = true, AFTER_DRAIN = false;
    bf16_t* O; int ldc; const float* rs; const float* cs;
    __device__ __forceinline__ void operator()(const f32x4 (&acc)[2][2][4][2], const Unit& u, int wr, int wc, int fr, int fq) const {
        const int row0 = u.pm * BM + wr * 64 + fr; const int col0 = u.pn * BM + wc * 32 + 8 * fq;
        f32x4 c0[2], c1[2];
#pragma unroll
        for (int bj = 0; bj < 2; ++bj) { c0[bj] = cs ? *(const f32x4*)(cs + col0 + bj * HALF) : (f32x4){1.f, 1.f, 1.f, 1.f}; c1[bj] = cs ? *(const f32x4*)(cs + col0 + bj * HALF + 4) : (f32x4){1.f, 1.f, 1.f, 1.f}; }
#pragma unroll
        for (int ai = 0; ai < 2; ++ai)
#pragma unroll
            for (int m = 0; m < 4; ++m) { const int row = row0 + ai * HALF + m * 16; bf16_t* rowp = O + (size_t)row * ldc + col0; const float r = rs ? rs[row] : 1.0f;
#pragma unroll
                for (int bj = 0; bj < 2; ++bj) { const f32x4 v0 = acc[ai][bj][m][0] * c0[bj] * r, v1 = acc[ai][bj][m][1] * c1[bj] * r;
                    u32x4 w; w.x = cvt_pk_bf16(v0[0], v0[1]); w.y = cvt_pk_bf16(v0[2], v0[3]); w.z = cvt_pk_bf16(v1[0], v1[1]); w.w = cvt_pk_bf16(v1[2], v1[3]);
                    *(u32x4*)(rowp + bj * HALF) = w; } }
    }
};
template <bool BASE_BF16> struct EpiResid {
    static constexpr bool PERM = true, AFTER_DRAIN = false;
    const void* base; bf16_t* ob; float* ssq;
    __device__ __forceinline__ void operator()(const f32x4 (&acc)[2][2][4][2], const Unit& u, int wr, int wc, int fr, int fq) const {
        const int row0 = u.pm * BM + wr * 64 + fr; const int col0 = u.pn * BM + wc * 32 + 8 * fq;
#pragma unroll
        for (int ai = 0; ai < 2; ++ai)
#pragma unroll
            for (int m = 0; m < 4; ++m) { const int row = row0 + ai * HALF + m * 16; const size_t off = (size_t)row * D + col0; float ss = 0.f;
#pragma unroll
                for (int bj = 0; bj < 2; ++bj) {
                    f32x4 b0, b1;
                    if (BASE_BF16) { const u32x4 pw = *(const u32x4*)((const bf16_t*)base + off + bj * HALF); b0 = (f32x4){bflo(pw.x), bfhi(pw.x), bflo(pw.y), bfhi(pw.y)}; b1 = (f32x4){bflo(pw.z), bfhi(pw.z), bflo(pw.w), bfhi(pw.w)}; }
                    else { b0 = *(const f32x4*)((const float*)base + off + bj * HALF); b1 = *(const f32x4*)((const float*)base + off + bj * HALF + 4); }
                    const f32x4 v0 = acc[ai][bj][m][0] + b0, v1 = acc[ai][bj][m][1] + b1;
                    u32x4 w; w.x = cvt_pk_bf16(v0[0], v0[1]); w.y = cvt_pk_bf16(v0[2], v0[3]); w.z = cvt_pk_bf16(v1[0], v1[1]); w.w = cvt_pk_bf16(v1[2], v1[3]);
                    *(u32x4*)(ob + off + bj * HALF) = w;
                    ss += (v0[0] * v0[0] + v0[1] * v0[1]) + (v0[2] * v0[2] + v0[3] * v0[3]) + (v1[0] * v1[0] + v1[1] * v1[1]) + (v1[2] * v1[2] + v1[3] * v1[3]); }
                ss += __shfl_xor(ss, 16); ss += __shfl_xor(ss, 32);
                if (fq == 0) atomicAdd(ssq + row, ss); }
    }
};
struct EpiPle {
    static constexpr bool PERM = true, AFTER_DRAIN = false;
    const bf16_t* x2; bf16_t* x3; const bf16_t* pp; const float* ssq2; float* ssq3;
    __device__ __forceinline__ void operator()(const f32x4 (&acc)[2][2][4][2], const Unit& u, int wr, int wc, int fr, int fq) const {
        const int row0 = u.pm * BM + wr * 64 + fr; const int col0 = u.pn * BM + wc * 32 + 8 * fq;
#pragma unroll
        for (int ai = 0; ai < 2; ++ai)
#pragma unroll
            for (int m = 0; m < 4; ++m) { const int row = row0 + ai * HALF + m * 16; const size_t off = (size_t)row * D + col0; float ss = 0.f;
                const float rstd = frsq(ssq2[row] * (1.0f / D) + EPS);
#pragma unroll
                for (int bj = 0; bj < 2; ++bj) {
                    const u32x4 xw = *(const u32x4*)(x2 + off + bj * HALF);
                    const u32x4 pw = *(const u32x4*)(pp + off + bj * HALF);
                    const f32x4 b0 = {bflo(xw.x), bfhi(xw.x), bflo(xw.y), bfhi(xw.y)}, b1 = {bflo(xw.z), bfhi(xw.z), bflo(xw.w), bfhi(xw.w)};
                    const f32x4 p0 = {bflo(pw.x), bfhi(pw.x), bflo(pw.y), bfhi(pw.y)}, p1 = {bflo(pw.z), bfhi(pw.z), bflo(pw.w), bfhi(pw.w)};
                    f32x4 v0, v1;
#pragma unroll
                    for (int e = 0; e < 4; ++e) { const float g0 = fsigmoid(acc[ai][bj][m][0][e] * rstd), g1 = fsigmoid(acc[ai][bj][m][1][e] * rstd);
                        v0[e] = b0[e] + g0 * p0[e]; v1[e] = b1[e] + g1 * p1[e]; }
                    u32x4 w; w.x = cvt_pk_bf16(v0[0], v0[1]); w.y = cvt_pk_bf16(v0[2], v0[3]); w.z = cvt_pk_bf16(v1[0], v1[1]); w.w = cvt_pk_bf16(v1[2], v1[3]);
                    *(u32x4*)(x3 + off + bj * HALF) = w;
                    ss += (v0[0] * v0[0] + v0[1] * v0[1]) + (v0[2] * v0[2] + v0[3] * v0[3]) + (v1[0] * v1[0] + v1[1] * v1[1]) + (v1[2] * v1[2] + v1[3] * v1[3]); }
                ss += __shfl_xor(ss, 16); ss += __shfl_xor(ss, 32);
                if (fq == 0) atomicAdd(ssq3 + row, ss); }
    }
};
__device__ __forceinline__ float gelu_tanh(float x) {
    const float t = x * x * (-1.5957691216057308f * 1.4426950408889634f * 0.044715f) + (-1.5957691216057308f * 1.4426950408889634f);
    return x * frcp(1.0f + __builtin_amdgcn_exp2f(t * x));
}
template <int CTRL> __device__ __forceinline__ float dppz(float v) { return __builtin_bit_cast(float, __builtin_amdgcn_update_dpp(0, __builtin_bit_cast(int, v), CTRL, 0xf, 0xf, true)); }
#define FMAC_DPP(acc, src, w, CTRL) asm volatile("s_nop 1\n\tv_fmac_f32_dpp %0, %1, %2 " CTRL " row_mask:0xf bank_mask:0xf bound_ctrl:1" : "+v"(acc) : "v"(src), "v"(w))
struct EpiUp {
    static constexpr bool PERM = true, AFTER_DRAIN = false;
    bf16_t* G; const float* ssq1; const float* cw; const float* cb; float* tail; float* head;
    __device__ __forceinline__ void operator()(const f32x4 (&acc)[2][2][4][2], const Unit& u, int wr, int wc, int fr, int fq) const {
        const int C0 = u.pn * 128 + wc * 32 + 8 * fq;
#pragma unroll
        for (int ai = 0; ai < 2; ++ai) {
            const int rbase = u.pm * BM + ai * HALF + wr * 64; const int grp = rbase >> 6;
            float rstd[4];
#pragma unroll
            for (int m = 0; m < 4; ++m) rstd[m] = frsq(ssq1[rbase + m * 16 + fr] * (1.0f / D) + EPS);
            if (fr < 2) { float* hp = head + ((size_t)grp * 2 + fr) * (2 * FF) + C0;
#pragma unroll
                for (int bj = 0; bj < 2; ++bj) { *(f32x4*)(hp + bj * FF) = acc[ai][bj][0][0] * rstd[0]; *(f32x4*)(hp + bj * FF + 4) = acc[ai][bj][0][1] * rstd[0]; } }
            if (fr >= 14) { float* tp = tail + ((size_t)grp * 2 + (fr - 14)) * (2 * FF) + C0;
#pragma unroll
                for (int bj = 0; bj < 2; ++bj) { *(f32x4*)(tp + bj * FF) = acc[ai][bj][3][0] * rstd[3]; *(f32x4*)(tp + bj * FF + 4) = acc[ai][bj][3][1] * rstd[3]; } }
            __builtin_amdgcn_sched_barrier(0);
            unsigned outw[4][4];
#pragma unroll
            for (int n = 0; n < 2; ++n) {
#pragma unroll
                for (int ep = 0; ep < 2; ++ep) {
                    int C = C0 + 4 * n + 2 * ep; asm volatile("" : "+v"(C));
                    const f32x2 wg0 = *(const f32x2*)(cw + C), wg1 = *(const f32x2*)(cw + 2 * FF + C), wg2 = *(const f32x2*)(cw + 4 * FF + C), bg = *(const f32x2*)(cb + C);
                    const f32x2 wv0 = *(const f32x2*)(cw + FF + C), wv1 = *(const f32x2*)(cw + 3 * FF + C), wv2 = *(const f32x2*)(cw + 5 * FF + C), bv = *(const f32x2*)(cb + FF + C);
                    f32x2 ugp = {0.f, 0.f}, uvp = {0.f, 0.f};
#pragma unroll
                    for (int m = 0; m < 4; ++m) {
                        f32x2 ug = (f32x2){acc[ai][0][m][n][2 * ep], acc[ai][0][m][n][2 * ep + 1]} * rstd[m], uv = (f32x2){acc[ai][1][m][n][2 * ep], acc[ai][1][m][n][2 * ep + 1]} * rstd[m];
                        asm volatile("" : "+v"(ug), "+v"(uv));
                        f32x2 yg = wg2 * ug + bg, yv = wv2 * uv + bv;
#pragma unroll
                        for (int q = 0; q < 2; ++q) {
                            FMAC_DPP(yg[q], ug[q], wg1[q], "row_shr:1"); FMAC_DPP(yv[q], uv[q], wv1[q], "row_shr:1");
                            FMAC_DPP(yg[q], ug[q], wg0[q], "row_shr:2"); FMAC_DPP(yv[q], uv[q], wv0[q], "row_shr:2");
                            if (m > 0) { FMAC_DPP(yg[q], ugp[q], wg1[q], "row_shl:15"); FMAC_DPP(yv[q], uvp[q], wv1[q], "row_shl:15");
                                         FMAC_DPP(yg[q], ugp[q], wg0[q], "row_shl:14"); FMAC_DPP(yv[q], uvp[q], wv0[q], "row_shl:14"); } }
                        f32x2 t = yg * yg * (-1.5957691216057308f * 1.4426950408889634f * 0.044715f) + (-1.5957691216057308f * 1.4426950408889634f);
                        t = t * yg;
                        f32x2 den = {__builtin_amdgcn_exp2f(t[0]), __builtin_amdgcn_exp2f(t[1])}; den = den + 1.0f;
                        const f32x2 rc = {frcp(den[0]), frcp(den[1])};
                        f32x2 o = yg * rc * yv; asm volatile("" : "+v"(o));
                        outw[m][2 * n + ep] = pk2(o[0], o[1]);
                        ugp = ug; uvp = uv;
                    }
                    __builtin_amdgcn_sched_barrier(0);
                }
                __builtin_amdgcn_sched_barrier(0);
            }
#pragma unroll
            for (int m = 0; m < 4; ++m) if (m > 0 || fr >= 2) { u32x4 w = {outw[m][0], outw[m][1], outw[m][2], outw[m][3]}; *(u32x4*)(G + (size_t)(rbase + m * 16 + fr) * FF + C0) = w; }
            __builtin_amdgcn_sched_barrier(0);
        }
    }
};

template <class Epi, class Sched, bool ALIGN_EPI = false, bool SP2 = false>
__device__ __forceinline__ void gemm_phase(PG8_LAS unsigned char* lds, const Gemm g, const Sched& S, const Epi& E) {
    int tid_ = threadIdx.x; asm volatile("" : "+v"(tid_));
    const int tid = tid_, wid = __builtin_amdgcn_readfirstlane(tid >> 6), lane = tid & 63, wr = wid >> 2, wc = wid & 3, fr = lane & 15, fq = lane >> 4;
    const int K = g.K, nt = K / BK;
    unsigned voffA[2], voffB[2];
#pragma unroll
    for (int i = 0; i < 2; ++i) { int R, C; stage_rc(tid * 16 + i * 8192, R, C); const int Rb = Epi::PERM ? ((R & ~31) + perm32(R & 31)) : R;
        voffA[i] = (unsigned)(R * K + C) * 2u; voffB[i] = (unsigned)(Rb * K + C) * 2u; }
    const size_t kstep = (size_t)(BK * 2);
    const size_t hstep = (size_t)HALF * K * 2;
    const size_t tstep = 2 * hstep;
    const unsigned ldsw = (unsigned)wid * 1024u;
    const int aoff = lds_byte(wr * 64 + fr, fq * 8), boff = lds_byte(wc * 32 + fr, fq * 8);
#define PG8_SA(b, h) (((b) * 2 + (h)) * HTB)
#define PG8_SB(b, h) ((4 + (b) * 2 + (h)) * HTB)
#define PG8_STAGE(bufoff, gbase, voff) do { _Pragma("unroll") for (int _i = 0; _i < 2; ++_i) \
        __builtin_amdgcn_global_load_lds((const unsigned*)((const char*)(gbase) + (voff)[_i]), (PG8_LAS unsigned*)(lds + (bufoff) + ldsw + _i * 8192), 16, 0, 0); } while (0)
#define PG8_LDA(dst, b, h) do { _Pragma("unroll") for (int m = 0; m < 4; ++m) _Pragma("unroll") for (int k = 0; k < 2; ++k) dst[m][k] = *(const PG8_LAS bf16x8*)(lds + PG8_SA(b, h) + aoff + m * 2048 + k * 1024); } while (0)
#define PG8_LDB(dst, b, h) do { _Pragma("unroll") for (int n = 0; n < 2; ++n) _Pragma("unroll") for (int k = 0; k < 2; ++k) dst[n][k] = *(const PG8_LAS bf16x8*)(lds + PG8_SB(b, h) + boff + n * 2048 + k * 1024); } while (0)
#define PG8_MMA(ai, bj, At, Bt) do { __builtin_amdgcn_s_setprio(1); _Pragma("unroll") for (int m = 0; m < 4; ++m) _Pragma("unroll") for (int n = 0; n < 2; ++n) _Pragma("unroll") for (int k = 0; k < 2; ++k) \
        acc[ai][bj][m][n] = __builtin_amdgcn_mfma_f32_16x16x32_bf16(Bt[n][k], At[m][k], acc[ai][bj][m][n], 0, 0, 0); __builtin_amdgcn_s_setprio(0); } while (0)
#define PG8_WAIT_V(n) asm volatile("s_waitcnt vmcnt(" #n ")" ::: "memory")
#define PG8_WAIT_L(n) asm volatile("s_waitcnt lgkmcnt(" #n ")" ::: "memory")
#define PG8_BAR __builtin_amdgcn_s_barrier()
#define PG8_SCHED __builtin_amdgcn_sched_barrier(0)
    Unit cur, nxt; int ui = 0;
    if (!S.next(0, cur)) return;
    f32x4 acc[2][2][4][2];
#pragma unroll
    for (int a = 0; a < 2; ++a)
#pragma unroll
        for (int b = 0; b < 2; ++b)
#pragma unroll
            for (int m = 0; m < 4; ++m)
#pragma unroll
                for (int n = 0; n < 2; ++n) acc[a][b][m][n] = (f32x4){0.f, 0.f, 0.f, 0.f};
    bf16x8 At[4][2], B0[2][2], B1[2][2];
    const char* cA = (const char*)g.A + (size_t)cur.pm * tstep; const char* cB = (const char*)g.Bt + (size_t)cur.pn * tstep;
    S.a_ready(cur);
    if constexpr (SP2) {
        PG8_STAGE(PG8_SB(0, 0), cB, voffB); PG8_STAGE(PG8_SB(0, 1), cB + hstep, voffB); PG8_STAGE(PG8_SA(0, 0), cA, voffA); PG8_STAGE(PG8_SA(0, 1), cA + hstep, voffA);
        if (wr == 1) PG8_BAR;
        PG8_WAIT_V(2); PG8_BAR;
        PG8_STAGE(PG8_SB(1, 0), cB + kstep, voffB); PG8_STAGE(PG8_SA(1, 0), cA + kstep, voffA); PG8_STAGE(PG8_SB(1, 1), cB + hstep + kstep, voffB);
        PG8_WAIT_V(6); PG8_BAR;
    } else {
        PG8_STAGE(PG8_SB(0, 0), cB, voffB); PG8_STAGE(PG8_SA(0, 0), cA, voffA); PG8_STAGE(PG8_SB(0, 1), cB + hstep, voffB); PG8_STAGE(PG8_SA(0, 1), cA + hstep, voffA);
        if (wr == 1) PG8_BAR;
        PG8_WAIT_V(4); PG8_BAR;
        PG8_STAGE(PG8_SB(1, 0), cB + kstep, voffB); PG8_STAGE(PG8_SA(1, 0), cA + kstep, voffA); PG8_STAGE(PG8_SB(1, 1), cB + hstep + kstep, voffB);
        PG8_WAIT_V(6); PG8_BAR;
    }
    for (;;) {
        const bool has_next = S.next(ui + 1, nxt);
        const char* nA = has_next ? (const char*)g.A + (size_t)nxt.pm * tstep : cA; const char* nB = has_next ? (const char*)g.Bt + (size_t)nxt.pn * tstep : cB;
        for (int t = 0; t < nt; t += 2) {
            const bool last = (t == nt - 2);
            const char* a1 = cA + (size_t)(t + 1) * kstep;
            const char* a2 = last ? nA : cA + (size_t)(t + 2) * kstep; const char* b2 = last ? nB : cB + (size_t)(t + 2) * kstep;
            const char* a3 = a2 + kstep; const char* b3 = b2 + kstep;
            if (last && has_next) S.a_ready(nxt);
            if constexpr (SP2) {
            PG8_LDB(B0, 0, 0); PG8_LDB(B1, 0, 1); PG8_SCHED; PG8_LDA(At, 0, 0); PG8_STAGE(PG8_SA(1, 1), a1 + hstep, voffA);
            PG8_WAIT_V(8); PG8_WAIT_L(0); PG8_BAR; PG8_MMA(0, 0, At, B0); PG8_MMA(0, 1, At, B1); PG8_BAR; PG8_SCHED;
            PG8_LDA(At, 0, 1); PG8_STAGE(PG8_SB(0, 0), b2, voffB); PG8_STAGE(PG8_SB(0, 1), b2 + hstep, voffB); PG8_STAGE(PG8_SA(0, 0), a2, voffA);
            PG8_WAIT_V(8); PG8_WAIT_L(0); PG8_BAR; PG8_MMA(1, 0, At, B0); PG8_MMA(1, 1, At, B1); PG8_BAR; PG8_SCHED;
            PG8_LDB(B0, 1, 0); PG8_LDB(B1, 1, 1); PG8_SCHED; PG8_LDA(At, 1, 0); PG8_STAGE(PG8_SA(0, 1), a2 + hstep, voffA);
            PG8_WAIT_V(8); PG8_WAIT_L(0); PG8_BAR; PG8_MMA(0, 0, At, B0); PG8_MMA(0, 1, At, B1); PG8_BAR; PG8_SCHED;
            PG8_LDA(At, 1, 1); PG8_STAGE(PG8_SB(1, 0), b3, voffB); PG8_STAGE(PG8_SB(1, 1), b3 + hstep, voffB); PG8_STAGE(PG8_SA(1, 0), a3, voffA);
            PG8_WAIT_V(8); PG8_WAIT_L(0); PG8_BAR; PG8_MMA(1, 0, At, B0); PG8_MMA(1, 1, At, B1); PG8_BAR; PG8_SCHED;
            } else {
            PG8_LDB(B0, 0, 0); PG8_SCHED; PG8_LDA(At, 0, 0); PG8_STAGE(PG8_SA(1, 1), a1 + hstep, voffA);
            PG8_WAIT_L(8); PG8_BAR; PG8_WAIT_L(0); PG8_MMA(0, 0, At, B0); PG8_BAR; PG8_SCHED;
            PG8_LDB(B1, 0, 1); PG8_STAGE(PG8_SB(0, 0), b2, voffB);
            PG8_BAR; PG8_WAIT_L(0); PG8_MMA(0, 1, At, B1); PG8_BAR;
            PG8_LDA(At, 0, 1); PG8_STAGE(PG8_SA(0, 0), a2, voffA);
            PG8_BAR; PG8_WAIT_L(0); PG8_MMA(1, 0, At, B0); PG8_BAR; PG8_SCHED;
            PG8_STAGE(PG8_SB(0, 1), b2 + hstep, voffB);
            PG8_WAIT_V(6); PG8_BAR; PG8_MMA(1, 1, At, B1); PG8_BAR;
            PG8_LDB(B0, 1, 0); PG8_SCHED; PG8_LDA(At, 1, 0); PG8_STAGE(PG8_SA(0, 1), a2 + hstep, voffA);
            PG8_WAIT_L(8); PG8_BAR; PG8_WAIT_L(0); PG8_MMA(0, 0, At, B0); PG8_BAR; PG8_SCHED;
            PG8_LDB(B1, 1, 1); PG8_STAGE(PG8_SB(1, 0), b3, voffB);
            PG8_BAR; PG8_WAIT_L(0); PG8_MMA(0, 1, At, B1); PG8_BAR;
            PG8_LDA(At, 1, 1); PG8_STAGE(PG8_SA(1, 0), a3, voffA);
            PG8_BAR; PG8_WAIT_L(0); PG8_MMA(1, 0, At, B0); PG8_BAR; PG8_SCHED;
            PG8_STAGE(PG8_SB(1, 1), b3 + hstep, voffB);
            PG8_WAIT_V(6); PG8_BAR; PG8_MMA(1, 1, At, B1); PG8_BAR;
            }
        }
        if constexpr (ALIGN_EPI) { if (wr == 0) PG8_BAR; }
        if constexpr (!Epi::AFTER_DRAIN) { E(acc, cur, wr, wc, fr, fq); S.done(cur); }
        if (!has_next) break;
#pragma unroll
        for (int a = 0; a < 2; ++a)
#pragma unroll
            for (int b = 0; b < 2; ++b)
#pragma unroll
                for (int m = 0; m < 4; ++m)
#pragma unroll
                    for (int n = 0; n < 2; ++n) acc[a][b][m][n] = (f32x4){0.f, 0.f, 0.f, 0.f};
        cur = nxt; cA = nA; cB = nB; ++ui;
        if constexpr (ALIGN_EPI) { if (wr == 1) PG8_BAR; }
    }
    PG8_WAIT_V(0);
    if constexpr (!ALIGN_EPI) { if (wr == 0) PG8_BAR; }
    PG8_BAR;
#undef PG8_SA
#undef PG8_SB
#undef PG8_STAGE
#undef PG8_LDA
#undef PG8_LDB
#undef PG8_MMA
#undef PG8_WAIT_V
#undef PG8_WAIT_L
#undef PG8_BAR
#undef PG8_SCHED
}
}

struct Args {
    const float *x, *p, *norm_mix_w, *w_in, *att_rel_bias, *w_gla_gate_up, *b_gla_gate, *gla_norm_w, *w_out, *norm_ffn_w, *w_ffn_up, *w_ffn_conv, *b_ffn_conv, *w_ffn_down,
                *norm_ple_w, *w_ple_gate, *w_ple_proj, *final_norm_w;
    float* out; unsigned char* ws;
};

__device__ __forceinline__ int map_row(int mode, int n) {
    if (mode == 1) { if (n < 2048) return n; if (n < 3072) return n + 2048; if (n < 4096) return n - 1024; if (n < 5120) return n + 1024; return n - 2048; }
    if (mode == 2) { const int half = n >= FF ? 1 : 0; const int c = n - half * FF; return (c >> 7) * 256 + half * 128 + (c & 127); }
    return n;
}
__device__ __forceinline__ void transpose_item(const float* W, int K, int ldn, int nblk, bf16_t* WT, LAS float* scr, int item, int lane, const float* kscale, int mode) {
    const int kb = item / nblk, nb = item % nblk, k0 = 32 * kb, n0 = 128 * nb;
    const int c4 = lane & 31, kh = lane >> 5;
    f32x4 v[16];
#pragma unroll
    for (int i = 0; i < 16; ++i) v[i] = __builtin_nontemporal_load((const f32x4*)(W + (size_t)(k0 + 2 * i + kh) * ldn + n0 + 4 * c4));
#pragma unroll
    for (int i = 0; i < 16; ++i) { f32x4 t = v[i]; if (kscale) t = t * kscale[k0 + 2 * i + kh]; *(LAS f32x4*)(scr + (2 * i + kh) * 132 + 4 * c4) = t; }
    asm volatile("s_waitcnt lgkmcnt(0)" ::: "memory");
    const int c = lane & 3, nl = lane >> 2; const int drow0 = map_row(mode, n0);
#pragma unroll
    for (int j = 0; j < 8; ++j) { const int n = nl + 16 * j; const LAS float* sp = scr + (8 * c) * 132 + n;
        u32x4 o; o.x = pk2(sp[0 * 132], sp[1 * 132]); o.y = pk2(sp[2 * 132], sp[3 * 132]); o.z = pk2(sp[4 * 132], sp[5 * 132]); o.w = pk2(sp[6 * 132], sp[7 * 132]);
        *(u32x4*)(WT + (size_t)(drow0 + n) * K + k0 + 8 * c) = o; }
    asm volatile("s_waitcnt lgkmcnt(0)" ::: "memory");
}

#define XB_TMO      128
#define XB_XCNT(j)  (256  + 64 * (j))
#define XB_XSUB(j)  (1280 + 64 * (j))
#define XB_XGEN(j)  (2304 + 64 * (j))
#define XB_TOP      3328
#define XB_TOPGEN   3392
#define XCD_BAR_WORDS 3456
#define XB_SPIN_CAP (1u << 18)
__device__ __forceinline__ unsigned xb_ld(unsigned* p)              { return __hip_atomic_load(p, __ATOMIC_RELAXED, __HIP_MEMORY_SCOPE_AGENT); }
__device__ __forceinline__ unsigned xb_add(unsigned* p, unsigned v) { return __hip_atomic_fetch_add(p, v, __ATOMIC_RELAXED, __HIP_MEMORY_SCOPE_AGENT); }
__device__ __forceinline__ unsigned xb_xcc_id() { return (unsigned)__builtin_amdgcn_s_getreg((3 << 11) | 20) & 0xFu; }
#define XB_SPIN(cond, bar) do { unsigned _sp = 0; while (cond) { __builtin_amdgcn_s_sleep(1); \
    if ((++_sp & 255u) == 0u) { if (xb_ld(&(bar)[XB_TMO])) break; if (_sp > XB_SPIN_CAP) { atomicAdd(&(bar)[XB_TMO], 1u); break; } } } } while (0)
struct XcdBarrier {
    unsigned* bar; unsigned x;
    volatile LAS unsigned* st;
};
__device__ __forceinline__ XcdBarrier xcd_barrier_post(unsigned* bar, volatile LAS unsigned* st) {
    XcdBarrier b; b.bar = bar; b.x = xb_xcc_id(); b.st = st;
    if (threadIdx.x == 0) (void)xb_add(&bar[XB_XCNT(b.x)], 1u);
    return b;
}
__device__ __forceinline__ void xcd_barrier_complete(unsigned* bar, unsigned x, unsigned& nloc, unsigned& nx) {
    const unsigned G = gridDim.x * gridDim.y * gridDim.z;
    unsigned sum, cnt, mine, sp = 0u;
    for (;;) {
        sum = 0u; cnt = 0u; mine = 0u;
#pragma unroll
        for (unsigned j = 0; j < 16; ++j) { const unsigned c = xb_ld(&bar[XB_XCNT(j)]); sum += c; cnt += (c > 0u) ? 1u : 0u; mine = (j == x) ? c : mine; }
        if (sum == G) break;
        __builtin_amdgcn_s_sleep(1);
        if ((++sp & 255u) == 0u) { if (xb_ld(&bar[XB_TMO])) break; if (sp > XB_SPIN_CAP) { atomicAdd(&bar[XB_TMO], 1u); break; } }
    }
    nloc = mine > 0u ? mine : 1u; nx = cnt > 0u ? cnt : 1u;
}
__device__ __forceinline__ void xcd_barrier(const XcdBarrier& b) {
    asm volatile("s_waitcnt vmcnt(0)" ::: "memory");
    __syncthreads();
    if (threadIdx.x == 0) {
        unsigned* bar = b.bar;
        __builtin_amdgcn_s_waitcnt(0);
        unsigned nloc = b.st[0], nx = b.st[1];
        if (nloc == 0u) { xcd_barrier_complete(bar, b.x, nloc, nx); b.st[0] = nloc; b.st[1] = nx; }
        const unsigned old = xb_add(&bar[XB_XSUB(b.x)], 1u);
        const unsigned gen = old / nloc;
        if (old + 1u == (gen + 1u) * nloc) {
            __builtin_amdgcn_fence(__ATOMIC_RELEASE, "agent");
            asm volatile("s_waitcnt vmcnt(0)" ::: "memory");
            const unsigned og = xb_add(&bar[XB_TOP], 1u);
            const unsigned tg = og / nx;
            if (og + 1u == (tg + 1u) * nx) xb_add(&bar[XB_TOPGEN], 1u);
            else XB_SPIN(xb_ld(&bar[XB_TOPGEN]) == tg, bar);
            __builtin_amdgcn_fence(__ATOMIC_ACQUIRE, "agent");
            xb_add(&bar[XB_XGEN(b.x)], 1u);
            asm volatile("s_waitcnt vmcnt(0)" ::: "memory");
        } else {
            XB_SPIN(xb_ld(&bar[XB_XGEN(b.x)]) == gen, bar);
            __builtin_amdgcn_fence(__ATOMIC_ACQUIRE, "agent");
            asm volatile("s_waitcnt vmcnt(0)" ::: "memory");
        }
    }
    __syncthreads();
}

__device__ __forceinline__ void gla_decay(const Args& a, const float* glr, int n, int hg, int tid, LAS float* gL, LAS float* segtot, float (&bv)[16], float& blast) {
    const int dk = tid & 127, seg = tid >> 7, col = hg * 128 + dk;
    if (tid < 256) ((LAS f32x4*)gL)[tid] = ((const f32x4*)(glr + (size_t)n * 64 * 16))[tid];
    float w[16];
#pragma unroll
    for (int j = 0; j < 16; ++j) w[j] = a.w_gla_gate_up[j * 512 + col];
    const float bias = a.b_gla_gate[col];
    __syncthreads();
    float c = 0.f;
#pragma unroll
    for (int s = 0; s < 16; ++s) { const LAS f32x4* g4 = (const LAS f32x4*)(gL + (16 * seg + s) * 16); float logit = bias;
#pragma unroll
        for (int q = 0; q < 4; ++q) { const f32x4 g = g4[q]; logit += g[0] * w[4 * q] + g[1] * w[4 * q + 1] + g[2] * w[4 * q + 2] + g[3] * w[4 * q + 3]; }
        const float ls = fminf(logit, 0.f) - log1pf(__expf(-fabsf(logit)));
        c += ls * (1.0f / 16.0f); bv[s] = c; if ((s & 3) == 3) asm volatile("" ::: "memory"); }
    segtot[seg * 128 + dk] = c;
    __syncthreads();
    float off = 0.f, tot = 0.f;
#pragma unroll
    for (int q = 0; q < 4; ++q) { const float v = segtot[q * 128 + dk]; tot += v; if (q < seg) off += v; }
#pragma unroll
    for (int s = 0; s < 16; ++s) bv[s] += off;
    blast = tot;
}

#define LBAR() do { asm volatile("s_waitcnt lgkmcnt(0)" ::: "memory"); __builtin_amdgcn_s_barrier(); asm volatile("" ::: "memory"); } while (0)
#define STAMP(k) do { if (PROBE_T != 0 && blockIdx.x == 0 && threadIdx.x == 0) ((unsigned long long*)(a.ws + 200 * 1024))[k] = __builtin_amdgcn_s_memrealtime(); } while (0)
#define IDS() int tid = threadIdx.x; asm volatile("" : "+v"(tid)); const int lane = tid & 63, wave = __builtin_amdgcn_readfirstlane(tid >> 6); const int gw = bx * 8 + wave, gtid = bx * 512 + tid; (void)lane; (void)gw; (void)gtid;
__global__ void __launch_bounds__(512, 2) fwd_megakernel(Args a) {
    extern __shared__ __attribute__((aligned(16))) unsigned char lds_raw[];
    cg::grid_group grid = cg::this_grid();
    LAS unsigned char* lds = (LAS unsigned char*)lds_raw;
    const int tid = threadIdx.x, lane = tid & 63, wave = __builtin_amdgcn_readfirstlane(tid >> 6);
    const int G = gridDim.x, bx = blockIdx.x;
    const int gw = bx * 8 + wave, NGW = G * 8;
    const int gtid = bx * 512 + tid, NT = G * 512;
    unsigned char* ws = a.ws;
    float* ssq1 = (float*)(ws + WS_SSQ1); float* ssq2 = (float*)(ws + WS_SSQ2); float* ssq3 = (float*)(ws + WS_SSQ3);
    float* glr = (float*)(ws + WS_GLR); float* glr1 = (float*)(ws + WS_GLR1); float* decb = (float*)(ws + WS_DEC); float* bcum = (float*)(ws + WS_BCUM); bf16_t* upd = (bf16_t*)(ws + WS_UPD);
    bf16_t* WgT = (bf16_t*)(ws + WS_WG); bf16_t* WppT = (bf16_t*)(ws + WS_WPP); bf16_t* WinT = (bf16_t*)(ws + WS_WIN); bf16_t* WoutT = (bf16_t*)(ws + WS_WOUT);
    bf16_t* WupT = (bf16_t*)(ws + WS_WUP); bf16_t* WdnT = (bf16_t*)(ws + WS_WDN); bf16_t* WpgT = (bf16_t*)(ws + WS_WPG); bf16_t* pb = (bf16_t*)(ws + WS_PB);
    bf16_t* h0 = (bf16_t*)(ws + WS_H0); bf16_t* projR = (bf16_t*)(ws + WS_PROJ); bf16_t* vT = (bf16_t*)(ws + WS_VT);
    bf16_t* ycat = (bf16_t*)a.out;
    float* rstd0 = (float*)(ws + WS_RSTD0); bf16_t* x1b = (bf16_t*)(ws + WS_X1B); bf16_t* gbuf = (bf16_t*)(ws + WS_G);
    float* tailb = (float*)(ws + WS_TAIL); float* headb = (float*)(ws + WS_HEAD); bf16_t* ppb = (bf16_t*)(ws + WS_PP); bf16_t* x2b = (bf16_t*)(ws + WS_X2B); bf16_t* x3b = (bf16_t*)(ws + WS_X3B);

    volatile LAS unsigned* bst = (volatile LAS unsigned*)(lds + LDS_BYTES - 64);
    if (threadIdx.x < 16) bst[threadIdx.x] = 0u;
    unsigned* barw = (unsigned*)(ws + WS_BAR);
    __syncthreads();
    const XcdBarrier xbar = xcd_barrier_post(barw, bst);
    if (a.out == nullptr) grid.sync();
    STAMP(0);
    REPS(1) {
        LAS float* scr = (LAS float*)(lds + wave * 16896);
        constexpr int I_IN = 64 * 48, I_OUT = 64 * 16, I_UP = 64 * 88, I_DN = 176 * 16, I_PG = 64 * 16, I_PP = 8 * 16;
        constexpr int NITEMS = I_IN + I_OUT + I_UP + I_DN + I_PG + I_PP;
        for (int it = gw; it < NITEMS; it += NGW) {
            int r = it;
            if (r < I_IN) { transpose_item(a.w_in, 2048, 6160, 48, WinT, scr, r, lane, a.norm_mix_w, 1); continue; } r -= I_IN;
            if (r < I_OUT) { transpose_item(a.w_out, 2048, 2048, 16, WoutT, scr, r, lane, nullptr, 0); continue; } r -= I_OUT;
            if (r < I_UP) { transpose_item(a.w_ffn_up, 2048, 2 * FF, 88, WupT, scr, r, lane, a.norm_ffn_w, 2); continue; } r -= I_UP;
            if (r < I_DN) { transpose_item(a.w_ffn_down, FF, 2048, 16, WdnT, scr, r, lane, nullptr, 0); continue; } r -= I_DN;
            if (r < I_PG) { transpose_item(a.w_ple_gate, 2048, 2048, 16, WpgT, scr, r, lane, a.norm_ple_w, 0); continue; } r -= I_PG;
            transpose_item(a.w_ple_proj, PLE, 2048, 16, WppT, scr, r, lane, nullptr, 0);
        }
        for (int i = gtid; i < 16 * 2048; i += NT) { const int j = i >> 11, k = i & 2047; WgT[i] = (bf16_t)f2bf(a.w_in[(size_t)k * 6160 + 6144 + j] * a.norm_mix_w[k]); }
        for (int m = gw; m < T; m += 2 * NGW) {
            const int m1 = m + NGW; const bool two = m1 < T;
            const f32x4* xr0 = (const f32x4*)(a.x + (size_t)m * D) + lane; const f32x4* xr1 = (const f32x4*)(a.x + (size_t)(two ? m1 : m) * D) + lane;
            f32x4 v0[8], v1[8]; float s0 = 0.f, s1 = 0.f;
#pragma unroll
            for (int j = 0; j < 8; ++j) { v0[j] = __builtin_nontemporal_load(xr0 + 64 * j); v1[j] = __builtin_nontemporal_load(xr1 + 64 * j); }
            u32x2* o0 = (u32x2*)(h0 + (size_t)m * D) + lane; u32x2* o1 = (u32x2*)(h0 + (size_t)m1 * D) + lane;
#pragma unroll
            for (int j = 0; j < 8; ++j) { s0 += (v0[j].x * v0[j].x + v0[j].y * v0[j].y) + (v0[j].z * v0[j].z + v0[j].w * v0[j].w); s1 += (v1[j].x * v1[j].x + v1[j].y * v1[j].y) + (v1[j].z * v1[j].z + v1[j].w * v1[j].w);
                u32x2 o; o.x = pk2(v0[j].x, v0[j].y); o.y = pk2(v0[j].z, v0[j].w); o0[64 * j] = o;
                if (two) { u32x2 q; q.x = pk2(v1[j].x, v1[j].y); q.y = pk2(v1[j].z, v1[j].w); o1[64 * j] = q; } }
            s0 = wave_sum(s0); s1 = wave_sum(s1);
            if (lane == 0) { rstd0[m] = frsq(s0 * (1.0f / D) + EPS); if (two) rstd0[m1] = frsq(s1 * (1.0f / D) + EPS); }
        }
        for (int i = gtid; i < T * PLE / 4; i += NT) { const f32x4 v = __builtin_nontemporal_load((const f32x4*)a.p + i); u32x2 o; o.x = pk2(v.x, v.y); o.y = pk2(v.z, v.w); ((u32x2*)pb)[i] = o; }
        for (int i = gtid; i < 3 * T; i += NT) ssq1[i] = 0.f;
    }
    if (PROBE_T != 0) { asm volatile("s_waitcnt vmcnt(0)" ::: "memory"); }
    xcd_barrier(xbar);
    STAMP(1);

    REPS(2) {
        IDS();
        for (int task = gw; task < 2 * (T / 16); task += NGW) {
            const int fr = lane & 15, fq = lane >> 4; const int r0 = (task >> 1) * 16, kh = (task & 1) * (D / 2);
            const bf16_t* ap = h0 + (size_t)(r0 + fr) * D + kh + 8 * fq; const bf16_t* bp = WgT + (size_t)fr * D + kh + 8 * fq;
            f32x4 acc = {0.f, 0.f, 0.f, 0.f};
#pragma unroll 8
            for (int k0 = 0; k0 < D / 2; k0 += 32) { const bf16x8 av = *(const bf16x8*)(ap + k0), bv = *(const bf16x8*)(bp + k0); acc = __builtin_amdgcn_mfma_f32_16x16x32_bf16(av, bv, acc, 0, 0, 0); }
            float* gp = (task & 1) ? glr1 : glr;
#pragma unroll
            for (int j = 0; j < 4; ++j) gp[(size_t)(r0 + 4 * fq + j) * 16 + fr] = acc[j] * rstd0[r0 + 4 * fq + j];
        }
        __syncthreads();
        { pg8::Gemm g{h0, WinT, T, NR, D}; pg8::StaticOrder S; S.init(T, NR, G, bx, WGM_P1R); pg8::EpiBf16 E{projR, NR, rstd0, nullptr};
          pg8::gemm_phase<pg8::EpiBf16, pg8::StaticOrder, true, true>(lds, g, S, E); }
        { pg8::Gemm g{WinT + (size_t)NR * D, h0, 2048, T, D}; pg8::StaticOrder S; S.init(2048, T, G, bx, WGM_P1T); pg8::EpiBf16 E{vT, T, nullptr, rstd0};
          pg8::gemm_phase<pg8::EpiBf16, pg8::StaticOrder, true, true>(lds, g, S, E); }
    }
    xcd_barrier(xbar);
    STAMP(2);

    REPS(3) {
        IDS();
        LAS float* gL = (LAS float*)lds; LAS float* segtot = (LAS float*)(lds + 4096); LAS bf16_t* kT = (LAS bf16_t*)(lds + 8192);
        const int fr = lane & 15, fq = lane >> 4, dk = tid & 127, seg = tid >> 7;
        f32x4 g4r = {0.f, 0.f, 0.f, 0.f}; unsigned short kraw[16]; bf16x8 vB[2][2], vBn[2][2];
#define G1_LOAD(u_, VB) do { const int n_ = (u_) >> 2, hg_ = (u_) & 3; if (tid < 256) g4r = ((const f32x4*)(glr + (size_t)n_ * 64 * 16))[tid] + ((const f32x4*)(glr1 + (size_t)n_ * 64 * 16))[tid]; \
            _Pragma("unroll") for (int s = 0; s < 16; ++s) kraw[s] = projR[((size_t)n_ * 64 + 16 * seg + s) * NR + KG + hg_ * 128 + dk]; \
            _Pragma("unroll") for (int nt2 = 0; nt2 < 2; ++nt2) _Pragma("unroll") for (int ks = 0; ks < 2; ++ks) VB[nt2][ks] = *(const bf16x8*)(vT + (size_t)(1024 + hg_ * 256 + 16 * (2 * wave + nt2) + fr) * T + n_ * 64 + 32 * ks + 8 * fq); } while (0)
        if (bx < NCH * 4) G1_LOAD(bx, vB);
        for (int unit = bx; unit < NCH * 4; unit += G) {
            const int n = unit >> 2, hg = unit & 3, col = hg * 128 + dk;
            float w[16];
#pragma unroll
            for (int j = 0; j < 16; ++j) w[j] = a.w_gla_gate_up[j * 512 + col];
            const float bias = a.b_gla_gate[col];
            if (tid < 256) ((LAS f32x4*)gL)[tid] = g4r;
            LBAR();
            float bv[16]; float c = 0.f;
#pragma unroll
            for (int s = 0; s < 16; ++s) { const LAS f32x4* g4 = (const LAS f32x4*)(gL + (16 * seg + s) * 16); float logit = bias;
#pragma unroll
                for (int q = 0; q < 4; ++q) { const f32x4 g = g4[q]; logit += g[0] * w[4 * q] + g[1] * w[4 * q + 1] + g[2] * w[4 * q + 2] + g[3] * w[4 * q + 3]; }
                const float ls = fminf(logit, 0.f) - __logf(1.0f + __expf(-fabsf(logit)));
                c += ls * (1.0f / 16.0f); bv[s] = c; if ((s & 3) == 3) asm volatile("" ::: "memory"); }
            segtot[seg * 128 + dk] = c;
            LBAR();
            float off = 0.f, blast = 0.f;
#pragma unroll
            for (int q = 0; q < 4; ++q) { const float v = segtot[q * 128 + dk]; blast += v; if (q < seg) off += v; }
            unsigned kw[8];
#pragma unroll
            for (int s = 0; s < 16; s += 2) { const float b0 = bv[s] + off, b1 = bv[s + 1] + off; const size_t t = (size_t)n * 64 + 16 * seg + s;
                bcum[t * 512 + col] = b0; bcum[(t + 1) * 512 + col] = b1;
                kw[s >> 1] = pk2(bf2f(kraw[s]) * __expf(blast - b0), bf2f(kraw[s + 1]) * __expf(blast - b1)); }
            *(LAS u32x4*)(kT + dk * 72 + 16 * seg) = (u32x4){kw[0], kw[1], kw[2], kw[3]}; *(LAS u32x4*)(kT + dk * 72 + 16 * seg + 8) = (u32x4){kw[4], kw[5], kw[6], kw[7]};
            if (seg == 0) decb[(size_t)unit * 128 + dk] = __expf(blast);
            LBAR();
            if (unit + G < NCH * 4) G1_LOAD(unit + G, vBn);
            f32x4 acc[8][2];
#pragma unroll
            for (int mt = 0; mt < 8; ++mt) { acc[mt][0] = (f32x4){0.f, 0.f, 0.f, 0.f}; acc[mt][1] = (f32x4){0.f, 0.f, 0.f, 0.f}; }
#pragma unroll
            for (int mt = 0; mt < 8; ++mt)
#pragma unroll
                for (int ks = 0; ks < 2; ++ks) { const bf16x8 ak = *(const LAS bf16x8*)(kT + (16 * mt + fr) * 72 + 32 * ks + 8 * fq);
                    acc[mt][0] = __builtin_amdgcn_mfma_f32_16x16x32_bf16(ak, vB[0][ks], acc[mt][0], 0, 0, 0);
                    acc[mt][1] = __builtin_amdgcn_mfma_f32_16x16x32_bf16(ak, vB[1][ks], acc[mt][1], 0, 0, 0); }
#pragma unroll
            for (int mt = 0; mt < 8; ++mt)
#pragma unroll
                for (int nt2 = 0; nt2 < 2; ++nt2) { const int dvv = 16 * (2 * wave + nt2) + fr; u32x2 wv; wv.x = pk2(acc[mt][nt2][0], acc[mt][nt2][1]); wv.y = pk2(acc[mt][nt2][2], acc[mt][nt2][3]);
                    *(u32x2*)(upd + (size_t)unit * 32768 + dvv * 128 + 16 * mt + 4 * fq) = wv; }
#pragma unroll
            for (int nt2 = 0; nt2 < 2; ++nt2)
#pragma unroll
                for (int ks = 0; ks < 2; ++ks) vB[nt2][ks] = vBn[nt2][ks];
        }
#undef G1_LOAD
    }
    xcd_barrier(xbar);
    STAMP(3);

    { IDS();
    for (int g2 = bx * 256 + tid; tid < 256 && g2 < 4 * 16384; g2 += G * 256) {
        const int hg = g2 >> 14, rem = (g2 & 16383) * 2, dk = rem & 127;
        unsigned* p = (unsigned*)(upd + (size_t)hg * 32768 + rem); const f32x2* dp = (const f32x2*)(decb + hg * 128 + dk);
        float S0 = 0.f, S1 = 0.f;
        unsigned ua[16], ub[16]; f32x2 da[16], db[16];
#define SCAN_LOAD(U, Dd, n0) do { _Pragma("unroll") for (int k = 0; k < 16; ++k) { U[k] = p[(size_t)((n0) + k) * 65536]; Dd[k] = dp[((n0) + k) * 256]; } } while (0)
#define SCAN_STEP(U, Dd, n0) do { _Pragma("unroll") for (int k = 0; k < 16; ++k) { p[(size_t)((n0) + k) * 65536] = pk2(S0, S1); S0 = Dd[k].x * S0 + bflo(U[k]); S1 = Dd[k].y * S1 + bfhi(U[k]); } } while (0)
        SCAN_LOAD(ua, da, 0);
        for (int n = 0; n < NCH; n += 32) {
            SCAN_LOAD(ub, db, n + 16);
            SCAN_STEP(ua, da, n);
            if (n + 32 < NCH) SCAN_LOAD(ua, da, n + 32);
            SCAN_STEP(ub, db, n + 16);
        }
#undef SCAN_LOAD
#undef SCAN_STEP
    } }
    if (PROBE_T != 0) { asm volatile("s_waitcnt vmcnt(0)" ::: "memory"); grid.sync(); STAMP(12); }
    {
        IDS();
        constexpr int CHB = 18432, BUFB = 3 * CHB;
        LAS unsigned char* kvb = lds; LAS float* bt = (LAS float*)(lds + 2 * BUFB);
        const int fr = lane & 15, fq = lane >> 4, hl = wave >> 2, qt = wave & 3;
        constexpr float LOG2E = 1.4426950408889634f;
        const int prow = (tid >> 3) & 63, pseg = tid & 7, pofs = prow * 144 + pseg * 16;
#define ATT_LOADK(cc, hpp, g) do { _Pragma("unroll") for (int q3 = 0; q3 < 3; ++q3) { const int kc_ = ((cc) - 8 + 3 * (g) + q3) < 0 ? 0 : ((cc) - 8 + 3 * (g) + q3); _Pragma("unroll") for (int r = 0; r < 2; ++r) \
            pre[q3][r] = *(const u32x4*)(projR + (size_t)(kc_ * 64 + prow) * NR + KA + 64 * (2 * (hpp) + r) + 8 * pseg); } } while (0)
#define ATT_LOADV(cc, hpp, g) do { _Pragma("unroll") for (int q3 = 0; q3 < 3; ++q3) { const int kc_ = ((cc) - 8 + 3 * (g) + q3) < 0 ? 0 : ((cc) - 8 + 3 * (g) + q3); _Pragma("unroll") for (int r = 0; r < 2; ++r) \
            pre[q3][r] = *(const u32x4*)(vT + (size_t)(64 * (2 * (hpp) + r) + prow) * T + kc_ * 64 + 8 * pseg); } } while (0)
#define ATT_WRITE(buf) do { _Pragma("unroll") for (int q3 = 0; q3 < 3; ++q3) _Pragma("unroll") for (int r = 0; r < 2; ++r) *(LAS u32x4*)(kvb + (buf) * BUFB + q3 * CHB + r * 9216 + pofs) = pre[q3][r]; } while (0)
#define ATT_LOADQ(cc, hpp) do { _Pragma("unroll") for (int ks = 0; ks < 2; ++ks) qn[ks] = *(const bf16x8*)(projR + (size_t)(64 * (cc) + 16 * qt + fr) * NR + QA + 64 * (2 * (hpp) + hl) + 32 * ks + 8 * fq); } while (0)
        const int NU = NCH * 8 * (PROBE_DUP == 4 ? 2 : 1);
        u32x4 pre[3][2]; bf16x8 qn[2]; int hp_tab = -1;
        if (bx < NU) { const int c0 = (bx >> 3) & (NCH - 1), hp0 = bx & 7; ATT_LOADQ(c0, hp0); ATT_LOADK(c0, hp0, 0); ATT_WRITE(0); }
        for (int unit = bx; unit < NU; unit += G) {
            const int c = (unit >> 3) & (NCH - 1), hp = unit & 7, h = 2 * hp + hl;
            const int un = unit + G, cn = (un >> 3) & (NCH - 1), hpn = un & 7;
            if (hp != hp_tab) { for (int i = tid; i < 1026; i += 512) { const int hh = i >= 513 ? 1 : 0; bt[hh * 516 + (i - hh * 513)] = a.att_rel_bias[(2 * hp + hh) * 513 + (i - hh * 513)] * LOG2E; } hp_tab = hp; }
            const bf16x8 qv0 = qn[0], qv1 = qn[1];
            __syncthreads();
            f32x4 S[36];
            const LAS float* btl = bt + hl * 516 + 256; const int relb = 16 * qt + fr + 512 - 4 * fq;
            const float b512 = btl[256];
#pragma unroll
            for (int g = 0; g < 3; ++g) {
                if (g < 2) ATT_LOADK(c, hp, g + 1); else ATT_LOADV(c, hp, 0);
#pragma unroll
                for (int q3 = 0; q3 < 3; ++q3) { const int j = 3 * g + q3;
#pragma unroll
                    for (int kt4 = 0; kt4 < 4; ++kt4) { f32x4 acc = {0.f, 0.f, 0.f, 0.f};
                        const LAS unsigned char* kp = kvb + (g & 1) * BUFB + q3 * CHB + hl * 9216 + (16 * kt4 + fr) * 144 + 16 * fq;
                        acc = __builtin_amdgcn_mfma_f32_16x16x32_bf16(*(const LAS bf16x8*)kp, qv0, acc, 0, 0, 0);
                        acc = __builtin_amdgcn_mfma_f32_16x16x32_bf16(*(const LAS bf16x8*)(kp + 64), qv1, acc, 0, 0, 0);
#pragma unroll
                        for (int jj = 0; jj < 4; ++jj) { float bias = b512;
                            if (j == 4) { int rel = relb - (64 * j + 16 * kt4 + jj); rel = rel > 256 ? 256 : rel; bias = btl[rel]; }
                            else if (j > 4) bias = btl[relb - (64 * j + 16 * kt4 + jj)];
                            acc[jj] = acc[jj] * (0.125f * LOG2E) + bias; }
                        S[4 * j + kt4] = acc; }
                    __builtin_amdgcn_sched_barrier(0); }
                ATT_WRITE((g + 1) & 1);
                __syncthreads();
            }
            if (c < 8) {
#pragma unroll
                for (int j = 0; j < 8; ++j) if (j < 8 - c) {
#pragma unroll
                    for (int kt4 = 0; kt4 < 4; ++kt4) S[4 * j + kt4] = (f32x4){-1e30f, -1e30f, -1e30f, -1e30f}; } }
            float mx = -1e30f;
#pragma unroll
            for (int i = 0; i < 36; ++i) mx = fmaxf(mx, fmaxf(fmaxf(S[i][0], S[i][1]), fmaxf(S[i][2], S[i][3])));
            mx = fmaxf(mx, __shfl_xor(mx, 16)); mx = fmaxf(mx, __shfl_xor(mx, 32));
            f32x2 l2 = {0.f, 0.f};
            u32x2 PW[36];
#pragma unroll
            for (int i = 0; i < 36; ++i) { const f32x4 d = S[i] - mx; const float p0 = __builtin_amdgcn_exp2f(d[0]), p1 = __builtin_amdgcn_exp2f(d[1]), p2 = __builtin_amdgcn_exp2f(d[2]), p3 = __builtin_amdgcn_exp2f(d[3]);
                l2 = l2 + (f32x2){p0, p1}; l2 = l2 + (f32x2){p2, p3}; PW[i].x = pg8::cvt_pk_bf16(p0, p1); PW[i].y = pg8::cvt_pk_bf16(p2, p3); asm volatile("" : "+v"(PW[i].x), "+v"(PW[i].y));
                if ((i & 3) == 3) __builtin_amdgcn_sched_barrier(0); }
            float l = l2[0] + l2[1];
            l += __shfl_xor(l, 16); l += __shfl_xor(l, 32);
            f32x4 O[4];
#pragma unroll
            for (int dt = 0; dt < 4; ++dt) O[dt] = (f32x4){0.f, 0.f, 0.f, 0.f};
            if (un < NU) ATT_LOADQ(cn, hpn);
#pragma unroll
            for (int g = 0; g < 3; ++g) {
                if (g < 2) ATT_LOADV(c, hp, g + 1); else if (un < NU) ATT_LOADK(cn, hpn, 0);
                const int buf = (3 + g) & 1;
#pragma unroll
                for (int q3 = 0; q3 < 3; ++q3) { const int j = 3 * g + q3;
#pragma unroll
                    for (int a2 = 0; a2 < 2; ++a2) { const u32x4 pw = {PW[4 * j + 2 * a2].x, PW[4 * j + 2 * a2].y, PW[4 * j + 2 * a2 + 1].x, PW[4 * j + 2 * a2 + 1].y};
                        const bf16x8 pa = __builtin_bit_cast(bf16x8, pw);
#pragma unroll
                        for (int dt = 0; dt < 4; ++dt) { const LAS unsigned char* vp = kvb + buf * BUFB + q3 * CHB + hl * 9216 + (16 * dt + fr) * 144 + (32 * a2 + 4 * fq) * 2;
                            const u32x2 lo = *(const LAS u32x2*)vp, hi = *(const LAS u32x2*)(vp + 32);
                            const u32x4 vw = {lo.x, lo.y, hi.x, hi.y};
                            O[dt] = __builtin_amdgcn_mfma_f32_16x16x32_bf16(pa, __builtin_bit_cast(bf16x8, vw), O[dt], 0, 0, 0); } } }
                if (g < 2 || un < NU) ATT_WRITE((3 + g + 1) & 1);
                if (g < 2) __syncthreads();
            }
#pragma unroll
            for (int jj = 0; jj < 4; ++jj) { const float linv = 1.0f / __shfl(l, 4 * fq + jj); const size_t t = (size_t)64 * c + 16 * qt + 4 * fq + jj;
#pragma unroll
                for (int dt = 0; dt < 4; ++dt) ycat[t * D + 64 * h + 16 * dt + fr] = (bf16_t)f2bf(O[dt][jj] * linv); }
        }
#undef ATT_LOADK
#undef ATT_LOADV
#undef ATT_WRITE
#undef ATT_LOADQ
    }
    xcd_barrier(xbar);
    STAMP(4);

    REPS(5) {
        IDS();
        LAS float* red = (LAS float*)(lds + 6144);
        LAS bf16_t* qd = (LAS bf16_t*)(lds + 8192); LAS bf16_t* ki = (LAS bf16_t*)(lds + 25600); LAS bf16_t* aL = (LAS bf16_t*)(lds + 43008);
        const int fr = lane & 15, fq = lane >> 4, dk = tid & 127, seg = tid >> 7;
        f32x4 braw[2][2]; u32x4 qraw[2], kraw[2];
        const int pi = tid >> 4, pg = tid & 15;
#define G3_LOAD(u_) do { const int n_ = (u_) >> 2, hg_ = (u_) & 3; _Pragma("unroll") for (int r = 0; r < 2; ++r) { const size_t t_ = (size_t)n_ * 64 + pi + 32 * r; \
            braw[r][0] = *(const f32x4*)(bcum + t_ * 512 + hg_ * 128 + 8 * pg); braw[r][1] = *(const f32x4*)(bcum + t_ * 512 + hg_ * 128 + 8 * pg + 4); \
            qraw[r] = *(const u32x4*)(projR + t_ * NR + QG + hg_ * 128 + 8 * pg); kraw[r] = *(const u32x4*)(projR + t_ * NR + KG + hg_ * 128 + 8 * pg); } } while (0)
        if (bx < NCH * 4) G3_LOAD(bx);
        for (int unit = bx; unit < NCH * 4; unit += G) {
            const int n = unit >> 2, hg = unit & 3;
            bf16x8 vB[2][2], sB[2][4];
#pragma unroll
            for (int nt2 = 0; nt2 < 2; ++nt2) { const int dvv = 16 * (2 * wave + nt2) + fr;
#pragma unroll
                for (int ks = 0; ks < 2; ++ks) vB[nt2][ks] = *(const bf16x8*)(vT + (size_t)(1024 + hg * 256 + dvv) * T + n * 64 + 32 * ks + 8 * fq);
#pragma unroll
                for (int ks = 0; ks < 4; ++ks) sB[nt2][ks] = *(const bf16x8*)(upd + (size_t)unit * 32768 + dvv * 128 + 32 * ks + 8 * fq); }
#pragma unroll
            for (int r = 0; r < 2; ++r) { const int i = pi + 32 * r; u32x4 qo, ko;
#pragma unroll
                for (int e = 0; e < 4; ++e) { const float b0 = e < 2 ? braw[r][0][2 * e] : braw[r][1][2 * e - 4], b1 = e < 2 ? braw[r][0][2 * e + 1] : braw[r][1][2 * e - 3];
                    qo[e] = pk2(bflo(qraw[r][e]) * 0.08838834764831845f * __expf(b0), bfhi(qraw[r][e]) * 0.08838834764831845f * __expf(b1));
                    ko[e] = pk2(bflo(kraw[r][e]) * __expf(-b0), bfhi(kraw[r][e]) * __expf(-b1)); }
                *(LAS u32x4*)(qd + i * 136 + 8 * pg) = qo; *(LAS u32x4*)(ki + i * 136 + 8 * pg) = ko; }
            LBAR();
            if (unit + G < NCH * 4) G3_LOAD(unit + G);
#pragma unroll
            for (int rep = 0; rep < 2; ++rep) { const int idx = wave + 8 * rep, it = idx >> 2, jt = idx & 3;
                f32x4 c = {0.f, 0.f, 0.f, 0.f};
                if (jt <= it) {
#pragma unroll
                    for (int ks = 0; ks < 4; ++ks) { const bf16x8 av = *(const LAS bf16x8*)(qd + (16 * it + fr) * 136 + 32 * ks + 8 * fq), bv8 = *(const LAS bf16x8*)(ki + (16 * jt + fr) * 136 + 32 * ks + 8 * fq);
                        c = __builtin_amdgcn_mfma_f32_16x16x32_bf16(av, bv8, c, 0, 0, 0); } }
#pragma unroll
                for (int jj = 0; jj < 4; ++jj) { const int i = 16 * it + 4 * fq + jj, j = 16 * jt + fr; aL[i * 72 + j] = (bf16_t)f2bf(j <= i ? c[jj] : 0.f); } }
            LBAR();
            unsigned short rr[4][4][2];
#pragma unroll
            for (int mt = 0; mt < 4; ++mt)
#pragma unroll
                for (int jj = 0; jj < 4; ++jj)
#pragma unroll
                    for (int nt2 = 0; nt2 < 2; ++nt2) rr[mt][jj][nt2] = projR[((size_t)n * 64 + 16 * mt + 4 * fq + jj) * NR + RG + hg * 256 + 16 * (2 * wave + nt2) + fr];
            f32x4 acc[4][2];
#pragma unroll
            for (int mt = 0; mt < 4; ++mt) { acc[mt][0] = (f32x4){0.f, 0.f, 0.f, 0.f}; acc[mt][1] = (f32x4){0.f, 0.f, 0.f, 0.f}; }
#pragma unroll
            for (int nt2 = 0; nt2 < 2; ++nt2)
#pragma unroll
                for (int mt = 0; mt < 4; ++mt) {
#pragma unroll
                    for (int ks = 0; ks < 2; ++ks) acc[mt][nt2] = __builtin_amdgcn_mfma_f32_16x16x32_bf16(*(const LAS bf16x8*)(aL + (16 * mt + fr) * 72 + 32 * ks + 8 * fq), vB[nt2][ks], acc[mt][nt2], 0, 0, 0);
#pragma unroll
                    for (int ks = 0; ks < 4; ++ks) acc[mt][nt2] = __builtin_amdgcn_mfma_f32_16x16x32_bf16(*(const LAS bf16x8*)(qd + (16 * mt + fr) * 136 + 32 * ks + 8 * fq), sB[nt2][ks], acc[mt][nt2], 0, 0, 0); }
#pragma unroll
            for (int mt = 0; mt < 4; ++mt)
#pragma unroll
                for (int jj = 0; jj < 4; ++jj) { float p = acc[mt][0][jj] * acc[mt][0][jj] + acc[mt][1][jj] * acc[mt][1][jj];
                    p += __shfl_xor(p, 1); p += __shfl_xor(p, 2); p += __shfl_xor(p, 4); p += __shfl_xor(p, 8);
                    if (fr == 0) red[wave * 64 + 16 * mt + 4 * fq + jj] = p; }
            LBAR();
            const float gw0 = a.gla_norm_w[16 * (2 * wave) + fr], gw1 = a.gla_norm_w[16 * (2 * wave + 1) + fr];
#pragma unroll
            for (int mt = 0; mt < 4; ++mt)
#pragma unroll
                for (int jj = 0; jj < 4; ++jj) { const int i = 16 * mt + 4 * fq + jj; float ss = 0.f;
#pragma unroll
                    for (int w8 = 0; w8 < 8; ++w8) ss += red[w8 * 64 + i];
                    const float rstd = frsq(ss * (1.0f / 256.0f) + EPS); const size_t t = (size_t)n * 64 + i;
#pragma unroll
                    for (int nt2 = 0; nt2 < 2; ++nt2) { const int dvv = 16 * (2 * wave + nt2) + fr;
                        const float r = bf2f(rr[mt][jj][nt2]);
                        const float y = acc[mt][nt2][jj] * rstd * (nt2 ? gw1 : gw0) * (r * fsigmoid(r));
                        ycat[t * D + 1024 + hg * 256 + dvv] = (bf16_t)f2bf(y); } }
        }
#undef G3_LOAD
    }
    xcd_barrier(xbar);
    STAMP(5);

    { pg8::Gemm g{ycat, WoutT, T, D, D}; pg8::StaticOrder S; S.init(T, D, G, bx, WGM_P5); pg8::EpiResid<true> E{h0, x1b, ssq1};
      pg8::gemm_phase<pg8::EpiResid<true>, pg8::StaticOrder, true, true>(lds, g, S, E); }
    xcd_barrier(xbar);
    STAMP(6);

#ifndef NO_UP
    REPS(6) { pg8::Gemm g{x1b, WupT, T, 2 * FF, D}; pg8::StaticOrder S; S.init(T, 2 * FF, G, bx, WGM_P6); pg8::EpiUp E{gbuf, ssq1, a.w_ffn_conv, a.b_ffn_conv, tailb, headb};
      pg8::gemm_phase<pg8::EpiUp, pg8::StaticOrder, true, true>(lds, g, S, E); }
#endif
    xcd_barrier(xbar);
    STAMP(7);

    { IDS();
    for (int i = gtid; i < NCH * 2 * (FF / 4); i += NT) {
        const int c4 = i % (FF / 4), gj = i / (FF / 4), j = gj & 1, grp = gj >> 1; const int row = grp * 64 + j, C = 4 * c4;
        const float* tl = tailb + (size_t)(grp - 1) * 2 * (2 * FF); const float* hd = headb + (size_t)grp * 2 * (2 * FF);
        const f32x4 z = {0.f, 0.f, 0.f, 0.f};
        f32x4 ug0, uv0, ug1, uv1, ug2, uv2;
        if (j == 0) { ug0 = grp ? *(const f32x4*)(tl + C) : z; uv0 = grp ? *(const f32x4*)(tl + FF + C) : z; ug1 = grp ? *(const f32x4*)(tl + 2 * FF + C) : z; uv1 = grp ? *(const f32x4*)(tl + 3 * FF + C) : z;
                      ug2 = *(const f32x4*)(hd + C); uv2 = *(const f32x4*)(hd + FF + C); }
        else { ug0 = grp ? *(const f32x4*)(tl + 2 * FF + C) : z; uv0 = grp ? *(const f32x4*)(tl + 3 * FF + C) : z; ug1 = *(const f32x4*)(hd + C); uv1 = *(const f32x4*)(hd + FF + C);
               ug2 = *(const f32x4*)(hd + 2 * FF + C); uv2 = *(const f32x4*)(hd + 3 * FF + C); }
        const float* cw = a.w_ffn_conv; const float* cb = a.b_ffn_conv;
        const f32x4 yg = *(const f32x4*)(cb + C) + *(const f32x4*)(cw + C) * ug0 + *(const f32x4*)(cw + 2 * FF + C) * ug1 + *(const f32x4*)(cw + 4 * FF + C) * ug2;
        const f32x4 yv = *(const f32x4*)(cb + FF + C) + *(const f32x4*)(cw + FF + C) * uv0 + *(const f32x4*)(cw + 3 * FF + C) * uv1 + *(const f32x4*)(cw + 5 * FF + C) * uv2;
        u32x2 o; o.x = pk2(pg8::gelu_tanh(yg[0]) * yv[0], pg8::gelu_tanh(yg[1]) * yv[1]); o.y = pk2(pg8::gelu_tanh(yg[2]) * yv[2], pg8::gelu_tanh(yg[3]) * yv[3]);
        *(u32x2*)(gbuf + (size_t)row * FF + C) = o;
    } }
    xcd_barrier(xbar);
    STAMP(8);

    { pg8::Gemm g{gbuf, WdnT, T, D, FF}; pg8::StaticOrder S; S.init(T, D, G, bx, WGM_P8); pg8::EpiResid<true> E{x1b, x2b, ssq2};
      pg8::gemm_phase<pg8::EpiResid<true>, pg8::StaticOrder, true, true>(lds, g, S, E); }
    { pg8::Gemm g{pb, WppT, T, D, PLE}; pg8::StaticOrder S; S.init(T, D, G, bx, WGM_PP); pg8::EpiBf16 E{ppb, D, nullptr, nullptr};
      pg8::gemm_phase<pg8::EpiBf16, pg8::StaticOrder, true, true>(lds, g, S, E); }
    xcd_barrier(xbar);
    STAMP(9);

    { pg8::Gemm g{x2b, WpgT, T, D, D}; pg8::StaticOrder S; S.init(T, D, G, bx, WGM_P9); pg8::EpiPle E{x2b, x3b, ppb, ssq2, ssq3};
      pg8::gemm_phase<pg8::EpiPle, pg8::StaticOrder, true, true>(lds, g, S, E); }
    xcd_barrier(xbar);
    STAMP(10);

    { IDS();
    for (int m = gw; m < T; m += NGW) {
        const float rstd = frsq(ssq3[m] * (1.0f / D) + EPS);
        const u32x2* xr = (const u32x2*)(x3b + (size_t)m * D) + lane; f32x4* orow = (f32x4*)(a.out + (size_t)m * D) + lane; const f32x4* wr4 = (const f32x4*)a.final_norm_w + lane;
#pragma unroll
        for (int j = 0; j < 8; ++j) { const u32x2 xw = xr[64 * j]; const f32x4 w = wr4[64 * j];
            const f32x4 v = {bflo(xw.x) * rstd * w.x, bfhi(xw.x) * rstd * w.y, bflo(xw.y) * rstd * w.z, bfhi(xw.y) * rstd * w.w};
            __builtin_nontemporal_store(v, orow + 64 * j); }
    } }
    if (PROBE_DUP == 7) { for (int i_ = 0; i_ < 20; ++i_) grid.sync(); }
    if (PROBE_T != 0) {
        asm volatile("s_waitcnt vmcnt(0)" ::: "memory"); grid.sync(); STAMP(11); grid.sync();
        unsigned probe_m = 50000u;
        if (PROBE_T != 100) { const unsigned long long* tsb = (const unsigned long long*)(a.ws + 200 * 1024); constexpr int HI_ = PROBE_T == 13 ? 12 : (PROBE_T == 14 ? 4 : (PROBE_T == 15 ? 11 : PROBE_T)), LO_ = PROBE_T == 13 ? 3 : (PROBE_T == 14 ? 12 : (PROBE_T == 15 ? 0 : PROBE_T - 1));
            probe_m = (unsigned)(__hip_atomic_load(tsb + HI_, __ATOMIC_RELAXED, __HIP_MEMORY_SCOPE_AGENT) - __hip_atomic_load(tsb + LO_, __ATOMIC_RELAXED, __HIP_MEMORY_SCOPE_AGENT)); if (PROBE_T == 15) probe_m /= 8; }
        for (unsigned e = blockIdx.x * 512u + threadIdx.x; e < probe_m; e += gridDim.x * 512u) a.out[e] += 0.08f;
    }
}

extern "C" void kernel_launch(void* const* d_in, const int* in_sizes, int n_in, void* d_out, int out_size, void* d_ws, size_t ws_size, hipStream_t stream) {
    static int grid = 0;
    if (grid == 0) {
        if (n_in != 18 || out_size != T * D || ws_size < WS_END) { fprintf(stderr, "kernel_launch: unexpected problem (n_in %d out %d ws %zu)\n", n_in, out_size, ws_size); grid = -1; return; }
        int dev = 0, cus = 0, per_cu = 0;
        hipGetDevice(&dev); hipDeviceGetAttribute(&cus, hipDeviceAttributeMultiprocessorCount, dev);
        if (hipFuncSetAttribute((const void*)fwd_megakernel, hipFuncAttributeMaxDynamicSharedMemorySize, LDS_BYTES) != hipSuccess) { fprintf(stderr, "kernel_launch: hipFuncSetAttribute failed\n"); grid = -1; return; }
        if (hipOccupancyMaxActiveBlocksPerMultiprocessor(&per_cu, (const void*)fwd_megakernel, 512, LDS_BYTES) != hipSuccess || per_cu < 1) { fprintf(stderr, "kernel_launch: occupancy query says %d\n", per_cu); per_cu = 1; }
        (void)hipGetLastError();
        grid = cus * per_cu;
    }
    if (grid < 0) return;
    Args a{};
    const float** f = (const float**)&a;
    for (int i = 0; i < 18; ++i) f[i] = (const float*)d_in[i];
    a.out = (float*)d_out; a.ws = (unsigned char*)d_ws;
    if (hipMemsetAsync((char*)d_ws + WS_BAR, 0, 16384, stream) != hipSuccess) { fprintf(stderr, "kernel_launch: memset of the barrier words failed\n"); return; }
    void* args[] = {&a};
    hipError_t e = hipLaunchCooperativeKernel((const void*)fwd_megakernel, dim3(grid), dim3(512), args, LDS_BYTES, stream);
    if (e != hipSuccess) fprintf(stderr, "cooperative launch failed: %s (grid %d)\n", hipGetErrorString(e), grid);
}
```

```cpp
#include <hip/hip_runtime.h>
#include <hip/hip_cooperative_groups.h>
#include <cstdio>
#include <cstdint>
namespace cg = cooperative_groups;
#ifndef PROBE_DUP
#define PROBE_DUP 0
#endif
#ifndef PROBE_T
#define PROBE_T 0
#endif
#ifndef WGM_P1R
#define WGM_P1R 4
#endif
#ifndef WGM_P1T
#define WGM_P1T 4
#endif
#ifndef WGM_P5
#define WGM_P5 4
#endif
#ifndef WGM_P6
#define WGM_P6 8
#endif
#ifndef WGM_P8
#define WGM_P8 4
#endif
#ifndef WGM_PP
#define WGM_PP 4
#endif
#ifndef WGM_P9
#define WGM_P9 4
#endif
#define REPS(k) for (int rep_ = 0; rep_ < (PROBE_DUP == (k) ? 2 : 1); ++rep_)

#define LAS __attribute__((address_space(3)))
typedef unsigned short bf16_t;
typedef short bf16x8 __attribute__((ext_vector_type(8)));
typedef float f32x4 __attribute__((ext_vector_type(4)));
typedef float f32x2 __attribute__((ext_vector_type(2)));
typedef unsigned u32x4 __attribute__((ext_vector_type(4)));
typedef unsigned u32x2 __attribute__((ext_vector_type(2)));

constexpr int T = 16384, D = 2048, FF = 5632, NR = 4096, PLE = 256, NCH = 256;
constexpr int QA = 0, KA = 1024, QG = 2048, KG = 2560, RG = 3072;
constexpr float EPS = 1e-6f;
constexpr size_t MiB = 1u << 20;
constexpr size_t WS_SSQ1 = 0, WS_SSQ2 = 65536, WS_SSQ3 = 131072, WS_GLR = 1 * MiB, WS_WG = 2 * MiB, WS_WPP = 3 * MiB;
constexpr size_t WS_WIN = 4 * MiB, WS_WOUT = 28 * MiB, WS_WUP = 36 * MiB, WS_WDN = 80 * MiB, WS_WPG = 102 * MiB, WS_PB = 110 * MiB;
constexpr size_t WS_H0 = 118 * MiB;
constexpr size_t WS_PROJ = 182 * MiB;
constexpr size_t WS_VT = 310 * MiB;
constexpr size_t WS_X1B = 182 * MiB, WS_G = 246 * MiB, WS_TAIL = 422 * MiB, WS_HEAD = 444 * MiB, WS_PP = 422 * MiB  , WS_X3B = 182 * MiB  , WS_YCAT = WS_H0, WS_X2B = WS_H0;
constexpr size_t WS_DEC = 256 * 1024, WS_UPD = 406 * MiB, WS_BCUM = 374 * MiB;
constexpr size_t WS_BAR = 800 * 1024;
constexpr size_t WS_GLR1 = 470 * MiB;
constexpr size_t WS_RSTD0 = 900 * 1024;
constexpr size_t WS_END = 512 * MiB;
constexpr int LDS_BYTES = 147456;

__device__ __forceinline__ unsigned f2bf(float f) { unsigned u = __builtin_bit_cast(unsigned, f); return (u + 0x7fffu + ((u >> 16) & 1u)) >> 16; }
typedef __bf16 hwbf16x2 __attribute__((ext_vector_type(2)));
__device__ __forceinline__ unsigned pk2(float lo, float hi) { const f32x2 v = {lo, hi}; return __builtin_bit_cast(unsigned, __builtin_convertvector(v, hwbf16x2)); }
__device__ __forceinline__ float frcp(float x) { return __builtin_amdgcn_rcpf(x); }
__device__ __forceinline__ float frsq(float x) { return __builtin_amdgcn_rsqf(x); }
__device__ __forceinline__ float fsigmoid(float x) { return frcp(1.0f + __builtin_amdgcn_exp2f(-1.4426950408889634f * x)); }
__device__ __forceinline__ float bf2f(unsigned short b) { return __builtin_bit_cast(float, (unsigned)b << 16); }
__device__ __forceinline__ float bflo(unsigned w) { return __builtin_bit_cast(float, w << 16); }
__device__ __forceinline__ float bfhi(unsigned w) { return __builtin_bit_cast(float, w & 0xffff0000u); }
__device__ __forceinline__ float wave_sum(float v) {
#pragma unroll
    for (int o = 1; o < 64; o <<= 1) v += __shfl_xor(v, o);
    return v;
}

namespace pg8 {
#define PG8_LAS __attribute__((address_space(3)))
constexpr int BM = 256, BK = 64, HALF = 128, HTB = HALF * BK * 2, STAGE_BYTES = 8 * HTB, NXCD = 8;
__host__ __device__ __forceinline__ int lds_byte(int r, int c) { const int st = (r >> 4) * 2 + (c >> 5), rr = r & 15, cc = c & 31, ob = rr * 64 + cc * 2; return st * 1024 + (ob ^ (((ob >> 9) & 1) << 5)); }
__host__ __device__ __forceinline__ void stage_rc(int b, int& R, int& C) { const int st = b / 1024, sb = b % 1024, swz = sb ^ (((sb >> 9) & 1) << 5); R = (st >> 1) * 16 + swz / 64; C = (st & 1) * 32 + (swz % 64) / 2; }
__host__ __device__ __forceinline__ int perm32(int rho) { const int n = rho >> 4, i = rho & 15; return 8 * (i >> 2) + 4 * n + (i & 3); }

struct Unit { int pm, pn; };
struct Gemm { const bf16_t* A; const bf16_t* Bt; int M, N, K; };

struct StaticOrder {
    int nM, nN, nwg, G, c, WGM;
    __host__ __device__ void init(int M, int N, int G_, int c_, int wgm) { nM = M / BM; nN = N / BM; nwg = nM * nN; G = G_; c = c_; WGM = wgm; }
    __host__ __device__ bool next(int i, Unit& u) const {
        const long L = (long)i * G + c; if (L >= nwg) return false;
        int wgid = (int)L; { const int q = nwg / NXCD, r = nwg % NXCD, xcd = wgid % NXCD, off = wgid / NXCD; wgid = (xcd < r ? xcd * (q + 1) : r * (q + 1) + (xcd - r) * q) + off; }
        const int nig = WGM * nN, gid = wgid / nig, fm = gid * WGM, gsz = (nM - fm) < WGM ? (nM - fm) : WGM;
        u.pm = fm + ((wgid % nig) % gsz); u.pn = (wgid % nig) / gsz; return true;
    }
    __device__ __forceinline__ void a_ready(const Unit&) const {}
    __device__ __forceinline__ void done(const Unit&) const {}
};

__device__ __forceinline__ unsigned cvt_pk_bf16(float lo, float hi) { return pk2(lo, hi); }

struct EpiBf16 {
    static constexpr bool PERM = true, AFTER_DRAIN = false;
    bf16_t* O; int ldc; const float* rs; const float* cs;
    __device__ __forceinline__ void operator()(const f32x4 (&acc)[2][2][4][2], const Unit& u, int wr, int wc, int fr, int fq) const {
        const int row0 = u.pm * BM + wr * 64 + fr; const int col0 = u.pn * BM + wc * 32 + 8 * fq;
        f32x4 c0[2], c1[2];
#pragma unroll
        for (int bj = 0; bj < 2; ++bj) { c0[bj] = cs ? *(const f32x4*)(cs + col0 + bj * HALF) : (f32x4){1.f, 1.f, 1.f, 1.f}; c1[bj] = cs ? *(const f32x4*)(cs + col0 + bj * HALF + 4) : (f32x4){1.f, 1.f, 1.f, 1.f}; }
#pragma unroll
        for (int ai = 0; ai < 2; ++ai)
#pragma unroll
            for (int m = 0; m < 4; ++m) { const int row = row0 + ai * HALF + m * 16; bf16_t* rowp = O + (size_t)row * ldc + col0; const float r = rs ? rs[row] : 1.0f;
#pragma unroll
                for (int bj = 0; bj < 2; ++bj) { const f32x4 v0 = acc[ai][bj][m][0] * c0[bj] * r, v1 = acc[ai][bj][m][1] * c1[bj] * r;
                    u32x4 w; w.x = cvt_pk_bf16(v0[0], v0[1]); w.y = cvt_pk_bf16(v0[2], v0[3]); w.z = cvt_pk_bf16(v1[0], v1[1]); w.w = cvt_pk_bf16(v1[2], v1[3]);
                    *(u32x4*)(rowp + bj * HALF) = w; } }
    }
};
template <bool BASE_BF16> struct EpiResid {
    static constexpr bool PERM = true, AFTER_DRAIN = false;
    const void* base; bf16_t* ob; float* ssq;
    __device__ __forceinline__ void operator()(const f32x4 (&acc)[2][2][4][2], const Unit& u, int wr, int wc, int fr, int fq) const {
        const int row0 = u.pm * BM + wr * 64 + fr; const int col0 = u.pn * BM + wc * 32 + 8 * fq;
#pragma unroll
        for (int ai = 0; ai < 2; ++ai)
#pragma unroll
            for (int m = 0; m < 4; ++m) { const int row = row0 + ai * HALF + m * 16; const size_t off = (size_t)row * D + col0; float ss = 0.f;
#pragma unroll
                for (int bj = 0; bj < 2; ++bj) {
                    f32x4 b0, b1;
                    if (BASE_BF16) { const u32x4 pw = *(const u32x4*)((const bf16_t*)base + off + bj * HALF); b0 = (f32x4){bflo(pw.x), bfhi(pw.x), bflo(pw.y), bfhi(pw.y)}; b1 = (f32x4){bflo(pw.z), bfhi(pw.z), bflo(pw.w), bfhi(pw.w)}; }
                    else { b0 = *(const f32x4*)((const float*)base + off + bj * HALF); b1 = *(const f32x4*)((const float*)base + off + bj * HALF + 4); }
                    const f32x4 v0 = acc[ai][bj][m][0] + b0, v1 = acc[ai][bj][m][1] + b1;
                    u32x4 w; w.x = cvt_pk_bf16(v0[0], v0[1]); w.y = cvt_pk_bf16(v0[2], v0[3]); w.z = cvt_pk_bf16(v1[0], v1[1]); w.w = cvt_pk_bf16(v1[2], v1[3]);
                    *(u32x4*)(ob + off + bj * HALF) = w;
                    ss += (v0[0] * v0[0] + v0[1] * v0[1]) + (v0[2] * v0[2] + v0[3] * v0[3]) + (v1[0] * v1[0] + v1[1] * v1[1]) + (v1[2] * v1[2] + v1[3] * v1[3]); }
                ss += __shfl_xor(ss, 16); ss += __shfl_xor(ss, 32);
                if (fq == 0) atomicAdd(ssq + row, ss); }
    }
};
struct EpiPle {
    static constexpr bool PERM = true, AFTER_DRAIN = false;
    const bf16_t* x2; bf16_t* x3; const bf16_t* pp; const float* ssq2; float* ssq3;
    __device__ __forceinline__ void operator()(const f32x4 (&acc)[2][2][4][2], const Unit& u, int wr, int wc, int fr, int fq) const {
        const int row0 = u.pm * BM + wr * 64 + fr; const int col0 = u.pn * BM + wc * 32 + 8 * fq;
#pragma unroll
        for (int ai = 0; ai < 2; ++ai)
#pragma unroll
            for (int m = 0; m < 4; ++m) { const int row = row0 + ai * HALF + m * 16; const size_t off = (size_t)row * D + col0; float ss = 0.f;
                const float rstd = frsq(ssq2[row] * (1.0f / D) + EPS);
#pragma unroll
                for (int bj = 0; bj < 2; ++bj) {
                    const u32x4 xw = *(const u32x4*)(x2 + off + bj * HALF);
                    const u32x4 pw = *(const u32x4*)(pp + off + bj * HALF);
                    const f32x4 b0 = {bflo(xw.x), bfhi(xw.x), bflo(xw.y), bfhi(xw.y)}, b1 = {bflo(xw.z), bfhi(xw.z), bflo(xw.w), bfhi(xw.w)};
                    const f32x4 p0 = {bflo(pw.x), bfhi(pw.x), bflo(pw.y), bfhi(pw.y)}, p1 = {bflo(pw.z), bfhi(pw.z), bflo(pw.w), bfhi(pw.w)};
                    f32x4 v0, v1;
#pragma unroll
                    for (int e = 0; e < 4; ++e) { const float g0 = fsigmoid(acc[ai][bj][m][0][e] * rstd), g1 = fsigmoid(acc[ai][bj][m][1][e] * rstd);
                        v0[e] = b0[e] + g0 * p0[e]; v1[e] = b1[e] + g1 * p1[e]; }
                    u32x4 w; w.x = cvt_pk_bf16(v0[0], v0[1]); w.y = cvt_pk_bf16(v0[2], v0[3]); w.z = cvt_pk_bf16(v1[0], v1[1]); w.w = cvt_pk_bf16(v1[2], v1[3]);
                    *(u32x4*)(x3 + off + bj * HALF) = w;
                    ss += (v0[0] * v0[0] + v0[1] * v0[1]) + (v0[2] * v0[2] + v0[3] * v0[3]) + (v1[0] * v1[0] + v1[1] * v1[1]) + (v1[2] * v1[2] + v1[3] * v1[3]); }
                ss += __shfl_xor(ss, 16); ss += __shfl_xor(ss, 32);
                if (fq == 0) atomicAdd(ssq3 + row, ss); }
    }
};
__device__ __forceinline__ float gelu_tanh(float x) {
    const float t = x * x * (-1.5957691216057308f * 1.4426950408889634f * 0.044715f) + (-1.5957691216057308f * 1.4426950408889634f);
    return x * frcp(1.0f + __builtin_amdgcn_exp2f(t * x));
}
template <int CTRL> __device__ __forceinline__ float dppz(float v) { return __builtin_bit_cast(float, __builtin_amdgcn_update_dpp(0, __builtin_bit_cast(int, v), CTRL, 0xf, 0xf, true)); }
#define FMAC_DPP(acc, src, w, CTRL) asm volatile("s_nop 1\n\tv_fmac_f32_dpp %0, %1, %2 " CTRL " row_mask:0xf bank_mask:0xf bound_ctrl:1" : "+v"(acc) : "v"(src), "v"(w))
struct EpiUp {
    static constexpr bool PERM = true, AFTER_DRAIN = false;
    bf16_t* G; const float* ssq1; const float* cw; const float* cb; bf16_t* tail; bf16_t* head;
    __device__ __forceinline__ void operator()(const f32x4 (&acc)[2][2][4][2], const Unit& u, int wr, int wc, int fr, int fq) const {
        const int C0 = u.pn * 128 + wc * 32 + 8 * fq;
#pragma unroll
        for (int ai = 0; ai < 2; ++ai) {
            const int rbase = u.pm * BM + ai * HALF + wr * 64; const int grp = rbase >> 6;
            float rstd[4];
#pragma unroll
            for (int m = 0; m < 4; ++m) rstd[m] = frsq(ssq1[rbase + m * 16 + fr] * (1.0f / D) + EPS);
            if (fr < 2) { bf16_t* hp = head + ((size_t)grp * 2 + fr) * (2 * FF) + C0;
#pragma unroll
                for (int bj = 0; bj < 2; ++bj) { const f32x4 v0 = acc[ai][bj][0][0] * rstd[0], v1 = acc[ai][bj][0][1] * rstd[0];
                    *(u32x4*)(hp + bj * FF) = (u32x4){pk2(v0[0], v0[1]), pk2(v0[2], v0[3]), pk2(v1[0], v1[1]), pk2(v1[2], v1[3])}; } }
            if (fr >= 14) { bf16_t* tp = tail + ((size_t)grp * 2 + (fr - 14)) * (2 * FF) + C0;
#pragma unroll
                for (int bj = 0; bj < 2; ++bj) { const f32x4 v0 = acc[ai][bj][3][0] * rstd[3], v1 = acc[ai][bj][3][1] * rstd[3];
                    *(u32x4*)(tp + bj * FF) = (u32x4){pk2(v0[0], v0[1]), pk2(v0[2], v0[3]), pk2(v1[0], v1[1]), pk2(v1[2], v1[3])}; } }
            __builtin_amdgcn_sched_barrier(0);
            unsigned outw[4][4];
#pragma unroll
            for (int n = 0; n < 2; ++n) {
#pragma unroll
                for (int ep = 0; ep < 2; ++ep) {
                    int C = C0 + 4 * n + 2 * ep; asm volatile("" : "+v"(C));
                    const f32x2 wg0 = *(const f32x2*)(cw + C), wg1 = *(const f32x2*)(cw + 2 * FF + C), wg2 = *(const f32x2*)(cw + 4 * FF + C), bg = *(const f32x2*)(cb + C);
                    const f32x2 wv0 = *(const f32x2*)(cw + FF + C), wv1 = *(const f32x2*)(cw + 3 * FF + C), wv2 = *(const f32x2*)(cw + 5 * FF + C), bv = *(const f32x2*)(cb + FF + C);
                    f32x2 ugp = {0.f, 0.f}, uvp = {0.f, 0.f};
#pragma unroll
                    for (int m = 0; m < 4; ++m) {
                        f32x2 ug = (f32x2){acc[ai][0][m][n][2 * ep], acc[ai][0][m][n][2 * ep + 1]} * rstd[m], uv = (f32x2){acc[ai][1][m][n][2 * ep], acc[ai][1][m][n][2 * ep + 1]} * rstd[m];
                        asm volatile("" : "+v"(ug), "+v"(uv));
                        f32x2 yg = wg2 * ug + bg, yv = wv2 * uv + bv;
#pragma unroll
                        for (int q = 0; q < 2; ++q) {
                            FMAC_DPP(yg[q], ug[q], wg1[q], "row_shr:1"); FMAC_DPP(yv[q], uv[q], wv1[q], "row_shr:1");
                            FMAC_DPP(yg[q], ug[q], wg0[q], "row_shr:2"); FMAC_DPP(yv[q], uv[q], wv0[q], "row_shr:2");
                            if (m > 0) { FMAC_DPP(yg[q], ugp[q], wg1[q], "row_shl:15"); FMAC_DPP(yv[q], uvp[q], wv1[q], "row_shl:15");
                                         FMAC_DPP(yg[q], ugp[q], wg0[q], "row_shl:14"); FMAC_DPP(yv[q], uvp[q], wv0[q], "row_shl:14"); } }
                        f32x2 t = yg * yg * (-1.5957691216057308f * 1.4426950408889634f * 0.044715f) + (-1.5957691216057308f * 1.4426950408889634f);
                        t = t * yg;
                        f32x2 den = {__builtin_amdgcn_exp2f(t[0]), __builtin_amdgcn_exp2f(t[1])}; den = den + 1.0f;
                        const f32x2 rc = {frcp(den[0]), frcp(den[1])};
                        f32x2 o = yg * rc * yv; asm volatile("" : "+v"(o));
                        outw[m][2 * n + ep] = pk2(o[0], o[1]);
                        ugp = ug; uvp = uv;
                    }
                    __builtin_amdgcn_sched_barrier(0);
                }
                __builtin_amdgcn_sched_barrier(0);
            }
#pragma unroll
            for (int m = 0; m < 4; ++m) if (m > 0 || fr >= 2) { u32x4 w = {outw[m][0], outw[m][1], outw[m][2], outw[m][3]}; *(u32x4*)(G + (size_t)(rbase + m * 16 + fr) * FF + C0) = w; }
            __builtin_amdgcn_sched_barrier(0);
        }
    }
};

template <class Epi, class Sched, bool ALIGN_EPI = false, bool SP2 = false>
__device__ __forceinline__ void gemm_phase(PG8_LAS unsigned char* lds, const Gemm g, const Sched& S, const Epi& E) {
    int tid_ = threadIdx.x; asm volatile("" : "+v"(tid_));
    const int tid = tid_, wid = __builtin_amdgcn_readfirstlane(tid >> 6), lane = tid & 63, wr = wid >> 2, wc = wid & 3, fr = lane & 15, fq = lane >> 4;
    const int K = g.K, nt = K / BK;
    unsigned voffA[2], voffB[2];
#pragma unroll
    for (int i = 0; i < 2; ++i) { int R, C; stage_rc(tid * 16 + i * 8192, R, C); const int Rb = Epi::PERM ? ((R & ~31) + perm32(R & 31)) : R;
        voffA[i] = (unsigned)(R * K + C) * 2u; voffB[i] = (unsigned)(Rb * K + C) * 2u; }
    const size_t kstep = (size_t)(BK * 2);
    const size_t hstep = (size_t)HALF * K * 2;
    const size_t tstep = 2 * hstep;
    const unsigned ldsw = (unsigned)wid * 1024u;
    const int aoff = lds_byte(wr * 64 + fr, fq * 8), boff = lds_byte(wc * 32 + fr, fq * 8);
#define PG8_SA(b, h) (((b) * 2 + (h)) * HTB)
#define PG8_SB(b, h) ((4 + (b) * 2 + (h)) * HTB)
#define PG8_STAGE(bufoff, gbase, voff) do { _Pragma("unroll") for (int _i = 0; _i < 2; ++_i) \
        __builtin_amdgcn_global_load_lds((const unsigned*)((const char*)(gbase) + (voff)[_i]), (PG8_LAS unsigned*)(lds + (bufoff) + ldsw + _i * 8192), 16, 0, 0); } while (0)
#define PG8_LDA(dst, b, h) do { _Pragma("unroll") for (int m = 0; m < 4; ++m) _Pragma("unroll") for (int k = 0; k < 2; ++k) dst[m][k] = *(const PG8_LAS bf16x8*)(lds + PG8_SA(b, h) + aoff + m * 2048 + k * 1024); } while (0)
#define PG8_LDB(dst, b, h) do { _Pragma("unroll") for (int n = 0; n < 2; ++n) _Pragma("unroll") for (int k = 0; k < 2; ++k) dst[n][k] = *(const PG8_LAS bf16x8*)(lds + PG8_SB(b, h) + boff + n * 2048 + k * 1024); } while (0)
#define PG8_MMA(ai, bj, At, Bt) do { __builtin_amdgcn_s_setprio(1); _Pragma("unroll") for (int m = 0; m < 4; ++m) _Pragma("unroll") for (int n = 0; n < 2; ++n) _Pragma("unroll") for (int k = 0; k < 2; ++k) \
        acc[ai][bj][m][n] = __builtin_amdgcn_mfma_f32_16x16x32_bf16(Bt[n][k], At[m][k], acc[ai][bj][m][n], 0, 0, 0); __builtin_amdgcn_s_setprio(0); } while (0)
#define PG8_WAIT_V(n) asm volatile("s_waitcnt vmcnt(" #n ")" ::: "memory")
#define PG8_WAIT_L(n) asm volatile("s_waitcnt lgkmcnt(" #n ")" ::: "memory")
#define PG8_BAR __builtin_amdgcn_s_barrier()
#define PG8_SCHED __builtin_amdgcn_sched_barrier(0)
    Unit cur, nxt; int ui = 0;
    if (!S.next(0, cur)) return;
    f32x4 acc[2][2][4][2];
#pragma unroll
    for (int a = 0; a < 2; ++a)
#pragma unroll
        for (int b = 0; b < 2; ++b)
#pragma unroll
            for (int m = 0; m < 4; ++m)
#pragma unroll
                for (int n = 0; n < 2; ++n) acc[a][b][m][n] = (f32x4){0.f, 0.f, 0.f, 0.f};
    bf16x8 At[4][2], B0[2][2], B1[2][2];
    const char* cA = (const char*)g.A + (size_t)cur.pm * tstep; const char* cB = (const char*)g.Bt + (size_t)cur.pn * tstep;
    S.a_ready(cur);
    if constexpr (SP2) {
        PG8_STAGE(PG8_SB(0, 0), cB, voffB); PG8_STAGE(PG8_SB(0, 1), cB + hstep, voffB); PG8_STAGE(PG8_SA(0, 0), cA, voffA); PG8_STAGE(PG8_SA(0, 1), cA + hstep, voffA);
        if (wr == 1) PG8_BAR;
        PG8_WAIT_V(2); PG8_BAR;
        PG8_STAGE(PG8_SB(1, 0), cB + kstep, voffB); PG8_STAGE(PG8_SA(1, 0), cA + kstep, voffA); PG8_STAGE(PG8_SB(1, 1), cB + hstep + kstep, voffB);
        PG8_WAIT_V(6); PG8_BAR;
    } else {
        PG8_STAGE(PG8_SB(0, 0), cB, voffB); PG8_STAGE(PG8_SA(0, 0), cA, voffA); PG8_STAGE(PG8_SB(0, 1), cB + hstep, voffB); PG8_STAGE(PG8_SA(0, 1), cA + hstep, voffA);
        if (wr == 1) PG8_BAR;
        PG8_WAIT_V(4); PG8_BAR;
        PG8_STAGE(PG8_SB(1, 0), cB + kstep, voffB); PG8_STAGE(PG8_SA(1, 0), cA + kstep, voffA); PG8_STAGE(PG8_SB(1, 1), cB + hstep + kstep, voffB);
        PG8_WAIT_V(6); PG8_BAR;
    }
    for (;;) {
        const bool has_next = S.next(ui + 1, nxt);
        const char* nA = has_next ? (const char*)g.A + (size_t)nxt.pm * tstep : cA; const char* nB = has_next ? (const char*)g.Bt + (size_t)nxt.pn * tstep : cB;
        for (int t = 0; t < nt; t += 2) {
            const bool last = (t == nt - 2);
            const char* a1 = cA + (size_t)(t + 1) * kstep;
            const char* a2 = last ? nA : cA + (size_t)(t + 2) * kstep; const char* b2 = last ? nB : cB + (size_t)(t + 2) * kstep;
            const char* a3 = a2 + kstep; const char* b3 = b2 + kstep;
            if (last && has_next) S.a_ready(nxt);
            if constexpr (SP2) {
            PG8_LDB(B0, 0, 0); PG8_LDB(B1, 0, 1); PG8_SCHED; PG8_LDA(At, 0, 0); PG8_STAGE(PG8_SA(1, 1), a1 + hstep, voffA);
            PG8_WAIT_V(8); PG8_WAIT_L(0); PG8_BAR; PG8_MMA(0, 0, At, B0); PG8_MMA(0, 1, At, B1); PG8_BAR; PG8_SCHED;
            PG8_LDA(At, 0, 1); PG8_STAGE(PG8_SB(0, 0), b2, voffB); PG8_STAGE(PG8_SB(0, 1), b2 + hstep, voffB); PG8_STAGE(PG8_SA(0, 0), a2, voffA);
            PG8_WAIT_V(8); PG8_WAIT_L(0); PG8_BAR; PG8_MMA(1, 0, At, B0); PG8_MMA(1, 1, At, B1); PG8_BAR; PG8_SCHED;
            PG8_LDB(B0, 1, 0); PG8_LDB(B1, 1, 1); PG8_SCHED; PG8_LDA(At, 1, 0); PG8_STAGE(PG8_SA(0, 1), a2 + hstep, voffA);
            PG8_WAIT_V(8); PG8_WAIT_L(0); PG8_BAR; PG8_MMA(0, 0, At, B0); PG8_MMA(0, 1, At, B1); PG8_BAR; PG8_SCHED;
            PG8_LDA(At, 1, 1); PG8_STAGE(PG8_SB(1, 0), b3, voffB); PG8_STAGE(PG8_SB(1, 1), b3 + hstep, voffB); PG8_STAGE(PG8_SA(1, 0), a3, voffA);
            PG8_WAIT_V(8); PG8_WAIT_L(0); PG8_BAR; PG8_MMA(1, 0, At, B0); PG8_MMA(1, 1, At, B1); PG8_BAR; PG8_SCHED;
            } else {
            PG8_LDB(B0, 0, 0); PG8_SCHED; PG8_LDA(At, 0, 0); PG8_STAGE(PG8_SA(1, 1), a1 + hstep, voffA);
            PG8_WAIT_L(8); PG8_BAR; PG8_WAIT_L(0); PG8_MMA(0, 0, At, B0); PG8_BAR; PG8_SCHED;
            PG8_LDB(B1, 0, 1); PG8_STAGE(PG8_SB(0, 0), b2, voffB);
            PG8_BAR; PG8_WAIT_L(0); PG8_MMA(0, 1, At, B1); PG8_BAR;
            PG8_LDA(At, 0, 1); PG8_STAGE(PG8_SA(0, 0), a2, voffA);
            PG8_BAR; PG8_WAIT_L(0); PG8_MMA(1, 0, At, B0); PG8_BAR; PG8_SCHED;
            PG8_STAGE(PG8_SB(0, 1), b2 + hstep, voffB);
            PG8_WAIT_V(6); PG8_BAR; PG8_MMA(1, 1, At, B1); PG8_BAR;
            PG8_LDB(B0, 1, 0); PG8_SCHED; PG8_LDA(At, 1, 0); PG8_STAGE(PG8_SA(0, 1), a2 + hstep, voffA);
            PG8_WAIT_L(8); PG8_BAR; PG8_WAIT_L(0); PG8_MMA(0, 0, At, B0); PG8_BAR; PG8_SCHED;
            PG8_LDB(B1, 1, 1); PG8_STAGE(PG8_SB(1, 0), b3, voffB);
            PG8_BAR; PG8_WAIT_L(0); PG8_MMA(0, 1, At, B1); PG8_BAR;
            PG8_LDA(At, 1, 1); PG8_STAGE(PG8_SA(1, 0), a3, voffA);
            PG8_BAR; PG8_WAIT_L(0); PG8_MMA(1, 0, At, B0); PG8_BAR; PG8_SCHED;
            PG8_STAGE(PG8_SB(1, 1), b3 + hstep, voffB);
            PG8_WAIT_V(6); PG8_BAR; PG8_MMA(1, 1, At, B1); PG8_BAR;
            }
        }
        if constexpr (ALIGN_EPI) { if (wr == 0) PG8_BAR; }
        if constexpr (!Epi::AFTER_DRAIN) { E(acc, cur, wr, wc, fr, fq); S.done(cur); }
        if (!has_next) break;
#pragma unroll
        for (int a = 0; a < 2; ++a)
#pragma unroll
            for (int b = 0; b < 2; ++b)
#pragma unroll
                for (int m = 0; m < 4; ++m)
#pragma unroll
                    for (int n = 0; n < 2; ++n) acc[a][b][m][n] = (f32x4){0.f, 0.f, 0.f, 0.f};
        cur = nxt; cA = nA; cB = nB; ++ui;
        if constexpr (ALIGN_EPI) { if (wr == 1) PG8_BAR; }
    }
    PG8_WAIT_V(0);
    if constexpr (!ALIGN_EPI) { if (wr == 0) PG8_BAR; }
    PG8_BAR;
#undef PG8_SA
#undef PG8_SB
#undef PG8_STAGE
#undef PG8_LDA
#undef PG8_LDB
#undef PG8_MMA
#undef PG8_WAIT_V
#undef PG8_WAIT_L
#undef PG8_BAR
#undef PG8_SCHED
}
}

struct Args {
    const float *x, *p, *norm_mix_w, *w_in, *att_rel_bias, *w_gla_gate_up, *b_gla_gate, *gla_norm_w, *w_out, *norm_ffn_w, *w_ffn_up, *w_ffn_conv, *b_ffn_conv, *w_ffn_down,
                *norm_ple_w, *w_ple_gate, *w_ple_proj, *final_norm_w;
    float* out; unsigned char* ws;
};

__device__ __forceinline__ int map_row(int mode, int n) {
    if (mode == 1) { if (n < 2048) return n; if (n < 3072) return n + 2048; if (n < 4096) return n - 1024; if (n < 5120) return n + 1024; return n - 2048; }
    if (mode == 2) { const int half = n >= FF ? 1 : 0; const int c = n - half * FF; return (c >> 7) * 256 + half * 128 + (c & 127); }
    return n;
}
__device__ __forceinline__ void transpose_item(const float* W, int K, int ldn, int nblk, bf16_t* WT, LAS float* scr, int item, int lane, const float* kscale, int mode) {
    const int kb = item / nblk, nb = item % nblk, k0 = 32 * kb, n0 = 128 * nb;
    const int c4 = lane & 31, kh = lane >> 5;
    f32x4 v[16];
#pragma unroll
    for (int i = 0; i < 16; ++i) v[i] = __builtin_nontemporal_load((const f32x4*)(W + (size_t)(k0 + 2 * i + kh) * ldn + n0 + 4 * c4));
#pragma unroll
    for (int i = 0; i < 16; ++i) { f32x4 t = v[i]; if (kscale) t = t * kscale[k0 + 2 * i + kh]; *(LAS f32x4*)(scr + (2 * i + kh) * 132 + 4 * c4) = t; }
    asm volatile("s_waitcnt lgkmcnt(0)" ::: "memory");
    const int c = lane & 3, nl = lane >> 2; const int drow0 = map_row(mode, n0);
#pragma unroll
    for (int j = 0; j < 8; ++j) { const int n = nl + 16 * j; const LAS float* sp = scr + (8 * c) * 132 + n;
        u32x4 o; o.x = pk2(sp[0 * 132], sp[1 * 132]); o.y = pk2(sp[2 * 132], sp[3 * 132]); o.z = pk2(sp[4 * 132], sp[5 * 132]); o.w = pk2(sp[6 * 132], sp[7 * 132]);
        *(u32x4*)(WT + (size_t)(drow0 + n) * K + k0 + 8 * c) = o; }
    asm volatile("s_waitcnt lgkmcnt(0)" ::: "memory");
}

#define XB_TMO      128
#define XB_XCNT(j)  (256  + 64 * (j))
#define XB_XSUB(j)  (1280 + 64 * (j))
#define XB_XGEN(j)  (2304 + 64 * (j))
#define XB_TOP      3328
#define XB_TOPGEN   3392
#define XCD_BAR_WORDS 3456
#define XB_SPIN_CAP (1u << 18)
__device__ __forceinline__ unsigned xb_ld(unsigned* p)              { return __hip_atomic_load(p, __ATOMIC_RELAXED, __HIP_MEMORY_SCOPE_AGENT); }
__device__ __forceinline__ unsigned xb_add(unsigned* p, unsigned v) { return __hip_atomic_fetch_add(p, v, __ATOMIC_RELAXED, __HIP_MEMORY_SCOPE_AGENT); }
__device__ __forceinline__ unsigned xb_xcc_id() { return (unsigned)__builtin_amdgcn_s_getreg((3 << 11) | 20) & 0xFu; }
#define XB_SPIN(cond, bar) do { unsigned _sp = 0; while (cond) { __builtin_amdgcn_s_sleep(1); \
    if ((++_sp & 255u) == 0u) { if (xb_ld(&(bar)[XB_TMO])) break; if (_sp > XB_SPIN_CAP) { atomicAdd(&(bar)[XB_TMO], 1u); break; } } } } while (0)
struct XcdBarrier {
    unsigned* bar; unsigned x;
    volatile LAS unsigned* st;
};
__device__ __forceinline__ XcdBarrier xcd_barrier_post(unsigned* bar, volatile LAS unsigned* st) {
    XcdBarrier b; b.bar = bar; b.x = xb_xcc_id(); b.st = st;
    if (threadIdx.x == 0) (void)xb_add(&bar[XB_XCNT(b.x)], 1u);
    return b;
}
__device__ __forceinline__ void xcd_barrier_complete(unsigned* bar, unsigned x, unsigned& nloc, unsigned& nx) {
    const unsigned G = gridDim.x * gridDim.y * gridDim.z;
    unsigned sum, cnt, mine, sp = 0u;
    for (;;) {
        sum = 0u; cnt = 0u; mine = 0u;
#pragma unroll
        for (unsigned j = 0; j < 16; ++j) { const unsigned c = xb_ld(&bar[XB_XCNT(j)]); sum += c; cnt += (c > 0u) ? 1u : 0u; mine = (j == x) ? c : mine; }
        if (sum == G) break;
        __builtin_amdgcn_s_sleep(1);
        if ((++sp & 255u) == 0u) { if (xb_ld(&bar[XB_TMO])) break; if (sp > XB_SPIN_CAP) { atomicAdd(&bar[XB_TMO], 1u); break; } }
    }
    nloc = mine > 0u ? mine : 1u; nx = cnt > 0u ? cnt : 1u;
}
__device__ __forceinline__ void xcd_barrier(const XcdBarrier& b) {
    asm volatile("s_waitcnt vmcnt(0)" ::: "memory");
    __syncthreads();
    if (threadIdx.x == 0) {
        unsigned* bar = b.bar;
        __builtin_amdgcn_s_waitcnt(0);
        unsigned nloc = b.st[0], nx = b.st[1];
        if (nloc == 0u) { xcd_barrier_complete(bar, b.x, nloc, nx); b.st[0] = nloc; b.st[1] = nx; }
        const unsigned old = xb_add(&bar[XB_XSUB(b.x)], 1u);
        const unsigned gen = old / nloc;
        if (old + 1u == (gen + 1u) * nloc) {
            __builtin_amdgcn_fence(__ATOMIC_RELEASE, "agent");
            asm volatile("s_waitcnt vmcnt(0)" ::: "memory");
            const unsigned og = xb_add(&bar[XB_TOP], 1u);
            const unsigned tg = og / nx;
            if (og + 1u == (tg + 1u) * nx) xb_add(&bar[XB_TOPGEN], 1u);
            else XB_SPIN(xb_ld(&bar[XB_TOPGEN]) == tg, bar);
            __builtin_amdgcn_fence(__ATOMIC_ACQUIRE, "agent");
            xb_add(&bar[XB_XGEN(b.x)], 1u);
            asm volatile("s_waitcnt vmcnt(0)" ::: "memory");
        } else {
            XB_SPIN(xb_ld(&bar[XB_XGEN(b.x)]) == gen, bar);
            __builtin_amdgcn_fence(__ATOMIC_ACQUIRE, "agent");
            asm volatile("s_waitcnt vmcnt(0)" ::: "memory");
        }
    }
    __syncthreads();
}

__device__ __forceinline__ void gla_decay(const Args& a, const float* glr, int n, int hg, int tid, LAS float* gL, LAS float* segtot, float (&bv)[16], float& blast) {
    const int dk = tid & 127, seg = tid >> 7, col = hg * 128 + dk;
    if (tid < 256) ((LAS f32x4*)gL)[tid] = ((const f32x4*)(glr + (size_t)n * 64 * 16))[tid];
    float w[16];
#pragma unroll
    for (int j = 0; j < 16; ++j) w[j] = a.w_gla_gate_up[j * 512 + col];
    const float bias = a.b_gla_gate[col];
    __syncthreads();
    float c = 0.f;
#pragma unroll
    for (int s = 0; s < 16; ++s) { const LAS f32x4* g4 = (const LAS f32x4*)(gL + (16 * seg + s) * 16); float logit = bias;
#pragma unroll
        for (int q = 0; q < 4; ++q) { const f32x4 g = g4[q]; logit += g[0] * w[4 * q] + g[1] * w[4 * q + 1] + g[2] * w[4 * q + 2] + g[3] * w[4 * q + 3]; }
        const float ls = fminf(logit, 0.f) - log1pf(__expf(-fabsf(logit)));
        c += ls * (1.0f / 16.0f); bv[s] = c; if ((s & 3) == 3) asm volatile("" ::: "memory"); }
    segtot[seg * 128 + dk] = c;
    __syncthreads();
    float off = 0.f, tot = 0.f;
#pragma unroll
    for (int q = 0; q < 4; ++q) { const float v = segtot[q * 128 + dk]; tot += v; if (q < seg) off += v; }
#pragma unroll
    for (int s = 0; s < 16; ++s) bv[s] += off;
    blast = tot;
}

#define LBAR() do { asm volatile("s_waitcnt lgkmcnt(0)" ::: "memory"); __builtin_amdgcn_s_barrier(); asm volatile("" ::: "memory"); } while (0)
#define STAMP(k) do { if (PROBE_T != 0 && blockIdx.x == 0 && threadIdx.x == 0) ((unsigned long long*)(a.ws + 200 * 1024))[k] = __builtin_amdgcn_s_memrealtime(); } while (0)
#define IDS() int tid = threadIdx.x; asm volatile("" : "+v"(tid)); const int lane = tid & 63, wave = __builtin_amdgcn_readfirstlane(tid >> 6); const int gw = bx * 8 + wave, gtid = bx * 512 + tid; (void)lane; (void)gw; (void)gtid;
__global__ void __launch_bounds__(512, 2) fwd_megakernel(Args a) {
    extern __shared__ __attribute__((aligned(16))) unsigned char lds_raw[];
    cg::grid_group grid = cg::this_grid();
    LAS unsigned char* lds = (LAS unsigned char*)lds_raw;
    const int tid = threadIdx.x, lane = tid & 63, wave = __builtin_amdgcn_readfirstlane(tid >> 6);
    const int G = gridDim.x, bx = blockIdx.x;
    const int gw = bx * 8 + wave, NGW = G * 8;
    const int gtid = bx * 512 + tid, NT = G * 512;
    unsigned char* ws = a.ws;
    float* ssq1 = (float*)(ws + WS_SSQ1); float* ssq2 = (float*)(ws + WS_SSQ2); float* ssq3 = (float*)(ws + WS_SSQ3);
    float* glr = (float*)(ws + WS_GLR); float* glr1 = (float*)(ws + WS_GLR1); float* decb = (float*)(ws + WS_DEC); float* bcum = (float*)(ws + WS_BCUM); bf16_t* upd = (bf16_t*)(ws + WS_UPD);
    bf16_t* WgT = (bf16_t*)(ws + WS_WG); bf16_t* WppT = (bf16_t*)(ws + WS_WPP); bf16_t* WinT = (bf16_t*)(ws + WS_WIN); bf16_t* WoutT = (bf16_t*)(ws + WS_WOUT);
    bf16_t* WupT = (bf16_t*)(ws + WS_WUP); bf16_t* WdnT = (bf16_t*)(ws + WS_WDN); bf16_t* WpgT = (bf16_t*)(ws + WS_WPG); bf16_t* pb = (bf16_t*)(ws + WS_PB);
    bf16_t* h0 = (bf16_t*)(ws + WS_H0); bf16_t* projR = (bf16_t*)(ws + WS_PROJ); bf16_t* vT = (bf16_t*)(ws + WS_VT);
    bf16_t* ycat = (bf16_t*)a.out;
    float* rstd0 = (float*)(ws + WS_RSTD0); bf16_t* x1b = (bf16_t*)(ws + WS_X1B); bf16_t* gbuf = (bf16_t*)(ws + WS_G);
    bf16_t* tailb = (bf16_t*)(ws + WS_TAIL); bf16_t* headb = (bf16_t*)(ws + WS_HEAD); bf16_t* ppb = (bf16_t*)(ws + WS_PP); bf16_t* x2b = (bf16_t*)(ws + WS_X2B); bf16_t* x3b = (bf16_t*)(ws + WS_X3B);

    volatile LAS unsigned* bst = (volatile LAS unsigned*)(lds + LDS_BYTES - 64);
    if (threadIdx.x < 16) bst[threadIdx.x] = 0u;
    unsigned* barw = (unsigned*)(ws + WS_BAR);
    __syncthreads();
    const XcdBarrier xbar = xcd_barrier_post(barw, bst);
    if (a.out == nullptr) grid.sync();
    STAMP(0);
    REPS(1) {
        LAS float* scr = (LAS float*)(lds + wave * 16896);
        constexpr int I_IN = 64 * 48, I_OUT = 64 * 16, I_UP = 64 * 88, I_DN = 176 * 16, I_PG = 64 * 16, I_PP = 8 * 16;
        constexpr int NITEMS = I_IN + I_OUT + I_UP + I_DN + I_PG + I_PP;
        for (int it = gw; it < NITEMS; it += NGW) {
            int r = it;
            if (r < I_IN) { transpose_item(a.w_in, 2048, 6160, 48, WinT, scr, r, lane, a.norm_mix_w, 1); continue; } r -= I_IN;
            if (r < I_OUT) { transpose_item(a.w_out, 2048, 2048, 16, WoutT, scr, r, lane, nullptr, 0); continue; } r -= I_OUT;
            if (r < I_UP) { transpose_item(a.w_ffn_up, 2048, 2 * FF, 88, WupT, scr, r, lane, a.norm_ffn_w, 2); continue; } r -= I_UP;
            if (r < I_DN) { transpose_item(a.w_ffn_down, FF, 2048, 16, WdnT, scr, r, lane, nullptr, 0); continue; } r -= I_DN;
            if (r < I_PG) { transpose_item(a.w_ple_gate, 2048, 2048, 16, WpgT, scr, r, lane, a.norm_ple_w, 0); continue; } r -= I_PG;
            transpose_item(a.w_ple_proj, PLE, 2048, 16, WppT, scr, r, lane, nullptr, 0);
        }
        for (int i = gtid; i < 16 * 2048; i += NT) { const int j = i >> 11, k = i & 2047; WgT[i] = (bf16_t)f2bf(a.w_in[(size_t)k * 6160 + 6144 + j] * a.norm_mix_w[k]); }
        for (int m = gw; m < T; m += 2 * NGW) {
            const int m1 = m + NGW; const bool two = m1 < T;
            const f32x4* xr0 = (const f32x4*)(a.x + (size_t)m * D) + lane; const f32x4* xr1 = (const f32x4*)(a.x + (size_t)(two ? m1 : m) * D) + lane;
            f32x4 v0[8], v1[8]; float s0 = 0.f, s1 = 0.f;
#pragma unroll
            for (int j = 0; j < 8; ++j) { v0[j] = __builtin_nontemporal_load(xr0 + 64 * j); v1[j] = __builtin_nontemporal_load(xr1 + 64 * j); }
            u32x2* o0 = (u32x2*)(h0 + (size_t)m * D) + lane; u32x2* o1 = (u32x2*)(h0 + (size_t)m1 * D) + lane;
#pragma unroll
            for (int j = 0; j < 8; ++j) { s0 += (v0[j].x * v0[j].x + v0[j].y * v0[j].y) + (v0[j].z * v0[j].z + v0[j].w * v0[j].w); s1 += (v1[j].x * v1[j].x + v1[j].y * v1[j].y) + (v1[j].z * v1[j].z + v1[j].w * v1[j].w);
                u32x2 o; o.x = pk2(v0[j].x, v0[j].y); o.y = pk2(v0[j].z, v0[j].w); o0[64 * j] = o;
                if (two) { u32x2 q; q.x = pk2(v1[j].x, v1[j].y); q.y = pk2(v1[j].z, v1[j].w); o1[64 * j] = q; } }
            s0 = wave_sum(s0); s1 = wave_sum(s1);
            if (lane == 0) { rstd0[m] = frsq(s0 * (1.0f / D) + EPS); if (two) rstd0[m1] = frsq(s1 * (1.0f / D) + EPS); }
        }
        for (int i = gtid; i < T * PLE / 4; i += NT) { const f32x4 v = __builtin_nontemporal_load((const f32x4*)a.p + i); u32x2 o; o.x = pk2(v.x, v.y); o.y = pk2(v.z, v.w); ((u32x2*)pb)[i] = o; }
        for (int i = gtid; i < 3 * T; i += NT) ssq1[i] = 0.f;
    }
    if (PROBE_T != 0) { asm volatile("s_waitcnt vmcnt(0)" ::: "memory"); }
    xcd_barrier(xbar);
    STAMP(1);

    REPS(2) {
        IDS();
        for (int task = gw; task < 2 * (T / 16); task += NGW) {
            const int fr = lane & 15, fq = lane >> 4; const int r0 = (task >> 1) * 16, kh = (task & 1) * (D / 2);
            const bf16_t* ap = h0 + (size_t)(r0 + fr) * D + kh + 8 * fq; const bf16_t* bp = WgT + (size_t)fr * D + kh + 8 * fq;
            f32x4 acc = {0.f, 0.f, 0.f, 0.f};
#pragma unroll 8
            for (int k0 = 0; k0 < D / 2; k0 += 32) { const bf16x8 av = *(const bf16x8*)(ap + k0), bv = *(const bf16x8*)(bp + k0); acc = __builtin_amdgcn_mfma_f32_16x16x32_bf16(av, bv, acc, 0, 0, 0); }
            float* gp = (task & 1) ? glr1 : glr;
#pragma unroll
            for (int j = 0; j < 4; ++j) gp[(size_t)(r0 + 4 * fq + j) * 16 + fr] = acc[j] * rstd0[r0 + 4 * fq + j];
        }
        __syncthreads();
        { pg8::Gemm g{h0, WinT, T, NR, D}; pg8::StaticOrder S; S.init(T, NR, G, bx, WGM_P1R); pg8::EpiBf16 E{projR, NR, rstd0, nullptr};
          pg8::gemm_phase<pg8::EpiBf16, pg8::StaticOrder, true, true>(lds, g, S, E); }
        { pg8::Gemm g{WinT + (size_t)NR * D, h0, 2048, T, D}; pg8::StaticOrder S; S.init(2048, T, G, bx, WGM_P1T); pg8::EpiBf16 E{vT, T, nullptr, rstd0};
          pg8::gemm_phase<pg8::EpiBf16, pg8::StaticOrder, true, true>(lds, g, S, E); }
    }
    xcd_barrier(xbar);
    STAMP(2);

    REPS(3) {
        IDS();
        LAS float* gL = (LAS float*)lds; LAS float* segtot = (LAS float*)(lds + 4096); LAS bf16_t* kT = (LAS bf16_t*)(lds + 8192);
        const int fr = lane & 15, fq = lane >> 4, dk = tid & 127, seg = tid >> 7;
        f32x4 g4r = {0.f, 0.f, 0.f, 0.f}; unsigned short kraw[16]; bf16x8 vB[2][2], vBn[2][2];
#define G1_LOAD(u_, VB) do { const int n_ = (u_) >> 2, hg_ = (u_) & 3; if (tid < 256) g4r = ((const f32x4*)(glr + (size_t)n_ * 64 * 16))[tid] + ((const f32x4*)(glr1 + (size_t)n_ * 64 * 16))[tid]; \
            _Pragma("unroll") for (int s = 0; s < 16; ++s) kraw[s] = projR[((size_t)n_ * 64 + 16 * seg + s) * NR + KG + hg_ * 128 + dk]; \
            _Pragma("unroll") for (int nt2 = 0; nt2 < 2; ++nt2) _Pragma("unroll") for (int ks = 0; ks < 2; ++ks) VB[nt2][ks] = *(const bf16x8*)(vT + (size_t)(1024 + hg_ * 256 + 16 * (2 * wave + nt2) + fr) * T + n_ * 64 + 32 * ks + 8 * fq); } while (0)
        if (bx < NCH * 4) G1_LOAD(bx, vB);
        for (int unit = bx; unit < NCH * 4; unit += G) {
            const int n = unit >> 2, hg = unit & 3, col = hg * 128 + dk;
            float w[16];
#pragma unroll
            for (int j = 0; j < 16; ++j) w[j] = a.w_gla_gate_up[j * 512 + col];
            const float bias = a.b_gla_gate[col];
            if (tid < 256) ((LAS f32x4*)gL)[tid] = g4r;
            LBAR();
            float bv[16]; float c = 0.f;
#pragma unroll
            for (int s = 0; s < 16; ++s) { const LAS f32x4* g4 = (const LAS f32x4*)(gL + (16 * seg + s) * 16); float logit = bias;
#pragma unroll
                for (int q = 0; q < 4; ++q) { const f32x4 g = g4[q]; logit += g[0] * w[4 * q] + g[1] * w[4 * q + 1] + g[2] * w[4 * q + 2] + g[3] * w[4 * q + 3]; }
                const float ls = fminf(logit, 0.f) - __logf(1.0f + __expf(-fabsf(logit)));
                c += ls * (1.0f / 16.0f); bv[s] = c; if ((s & 3) == 3) asm volatile("" ::: "memory"); }
            segtot[seg * 128 + dk] = c;
            LBAR();
            float off = 0.f, blast = 0.f;
#pragma unroll
            for (int q = 0; q < 4; ++q) { const float v = segtot[q * 128 + dk]; blast += v; if (q < seg) off += v; }
            unsigned kw[8];
#pragma unroll
            for (int s = 0; s < 16; s += 2) { const float b0 = bv[s] + off, b1 = bv[s + 1] + off; const size_t t = (size_t)n * 64 + 16 * seg + s;
                bcum[t * 512 + col] = b0; bcum[(t + 1) * 512 + col] = b1;
                kw[s >> 1] = pk2(bf2f(kraw[s]) * __expf(blast - b0), bf2f(kraw[s + 1]) * __expf(blast - b1)); }
            *(LAS u32x4*)(kT + dk * 72 + 16 * seg) = (u32x4){kw[0], kw[1], kw[2], kw[3]}; *(LAS u32x4*)(kT + dk * 72 + 16 * seg + 8) = (u32x4){kw[4], kw[5], kw[6], kw[7]};
            if (seg == 0) decb[(size_t)unit * 128 + dk] = __expf(blast);
            LBAR();
            if (unit + G < NCH * 4) G1_LOAD(unit + G, vBn);
            f32x4 acc[8][2];
#pragma unroll
            for (int mt = 0; mt < 8; ++mt) { acc[mt][0] = (f32x4){0.f, 0.f, 0.f, 0.f}; acc[mt][1] = (f32x4){0.f, 0.f, 0.f, 0.f}; }
#pragma unroll
            for (int mt = 0; mt < 8; ++mt)
#pragma unroll
                for (int ks = 0; ks < 2; ++ks) { const bf16x8 ak = *(const LAS bf16x8*)(kT + (16 * mt + fr) * 72 + 32 * ks + 8 * fq);
                    acc[mt][0] = __builtin_amdgcn_mfma_f32_16x16x32_bf16(ak, vB[0][ks], acc[mt][0], 0, 0, 0);
                    acc[mt][1] = __builtin_amdgcn_mfma_f32_16x16x32_bf16(ak, vB[1][ks], acc[mt][1], 0, 0, 0); }
#pragma unroll
            for (int mt = 0; mt < 8; ++mt)
#pragma unroll
                for (int nt2 = 0; nt2 < 2; ++nt2) { const int dvv = 16 * (2 * wave + nt2) + fr; u32x2 wv; wv.x = pk2(acc[mt][nt2][0], acc[mt][nt2][1]); wv.y = pk2(acc[mt][nt2][2], acc[mt][nt2][3]);
                    *(u32x2*)(upd + (size_t)unit * 32768 + dvv * 128 + 16 * mt + 4 * fq) = wv; }
#pragma unroll
            for (int nt2 = 0; nt2 < 2; ++nt2)
#pragma unroll
                for (int ks = 0; ks < 2; ++ks) vB[nt2][ks] = vBn[nt2][ks];
        }
#undef G1_LOAD
    }
    xcd_barrier(xbar);
    STAMP(3);

    { IDS();
    for (int g2 = bx * 256 + tid; tid < 256 && g2 < 4 * 16384; g2 += G * 256) {
        const int hg = g2 >> 14, rem = (g2 & 16383) * 2, dk = rem & 127;
        unsigned* p = (unsigned*)(upd + (size_t)hg * 32768 + rem); const f32x2* dp = (const f32x2*)(decb + hg * 128 + dk);
        float S0 = 0.f, S1 = 0.f;
        unsigned ua[16], ub[16]; f32x2 da[16], db[16];
#define SCAN_LOAD(U, Dd, n0) do { _Pragma("unroll") for (int k = 0; k < 16; ++k) { U[k] = p[(size_t)((n0) + k) * 65536]; Dd[k] = dp[((n0) + k) * 256]; } } while (0)
#define SCAN_STEP(U, Dd, n0) do { _Pragma("unroll") for (int k = 0; k < 16; ++k) { p[(size_t)((n0) + k) * 65536] = pk2(S0, S1); S0 = Dd[k].x * S0 + bflo(U[k]); S1 = Dd[k].y * S1 + bfhi(U[k]); } } while (0)
        SCAN_LOAD(ua, da, 0);
        for (int n = 0; n < NCH; n += 32) {
            SCAN_LOAD(ub, db, n + 16);
            SCAN_STEP(ua, da, n);
            if (n + 32 < NCH) SCAN_LOAD(ua, da, n + 32);
            SCAN_STEP(ub, db, n + 16);
        }
#undef SCAN_LOAD
#undef SCAN_STEP
    } }
    if (PROBE_T != 0) { asm volatile("s_waitcnt vmcnt(0)" ::: "memory"); grid.sync(); STAMP(12); }
    {
        IDS();
        constexpr int CHB = 18432, BUFB = 3 * CHB;
        LAS unsigned char* kvb = lds; LAS float* bt = (LAS float*)(lds + 2 * BUFB);
        const int fr = lane & 15, fq = lane >> 4, hl = wave >> 2, qt = wave & 3;
        constexpr float LOG2E = 1.4426950408889634f;
        const int prow = (tid >> 3) & 63, pseg = tid & 7, pofs = prow * 144 + pseg * 16;
#define ATT_LOADK(cc, hpp, g) do { _Pragma("unroll") for (int q3 = 0; q3 < 3; ++q3) { const int kc_ = ((cc) - 8 + 3 * (g) + q3) < 0 ? 0 : ((cc) - 8 + 3 * (g) + q3); _Pragma("unroll") for (int r = 0; r < 2; ++r) \
            pre[q3][r] = *(const u32x4*)(projR + (size_t)(kc_ * 64 + prow) * NR + KA + 64 * (2 * (hpp) + r) + 8 * pseg); } } while (0)
#define ATT_LOADV(cc, hpp, g) do { _Pragma("unroll") for (int q3 = 0; q3 < 3; ++q3) { const int kc_ = ((cc) - 8 + 3 * (g) + q3) < 0 ? 0 : ((cc) - 8 + 3 * (g) + q3); _Pragma("unroll") for (int r = 0; r < 2; ++r) \
            pre[q3][r] = *(const u32x4*)(vT + (size_t)(64 * (2 * (hpp) + r) + prow) * T + kc_ * 64 + 8 * pseg); } } while (0)
#define ATT_WRITE(buf) do { _Pragma("unroll") for (int q3 = 0; q3 < 3; ++q3) _Pragma("unroll") for (int r = 0; r < 2; ++r) *(LAS u32x4*)(kvb + (buf) * BUFB + q3 * CHB + r * 9216 + pofs) = pre[q3][r]; } while (0)
#define ATT_LOADQ(cc, hpp) do { _Pragma("unroll") for (int ks = 0; ks < 2; ++ks) qn[ks] = *(const bf16x8*)(projR + (size_t)(64 * (cc) + 16 * qt + fr) * NR + QA + 64 * (2 * (hpp) + hl) + 32 * ks + 8 * fq); } while (0)
        const int NU = NCH * 8 * (PROBE_DUP == 4 ? 2 : 1);
        u32x4 pre[3][2]; bf16x8 qn[2]; int hp_tab = -1;
        if (bx < NU) { const int c0 = (bx >> 3) & (NCH - 1), hp0 = bx & 7; ATT_LOADQ(c0, hp0); ATT_LOADK(c0, hp0, 0); ATT_WRITE(0); }
        for (int unit = bx; unit < NU; unit += G) {
            const int c = (unit >> 3) & (NCH - 1), hp = unit & 7, h = 2 * hp + hl;
            const int un = unit + G, cn = (un >> 3) & (NCH - 1), hpn = un & 7;
            if (hp != hp_tab) { for (int i = tid; i < 1026; i += 512) { const int hh = i >= 513 ? 1 : 0; bt[hh * 516 + (i - hh * 513)] = a.att_rel_bias[(2 * hp + hh) * 513 + (i - hh * 513)] * LOG2E; } hp_tab = hp; }
            const bf16x8 qv0 = qn[0], qv1 = qn[1];
            LBAR();
            f32x4 S[36];
            const LAS float* btl = bt + hl * 516 + 256; const int relb = 16 * qt + fr + 512 - 4 * fq;
            const float b512 = btl[256];
#pragma unroll
            for (int g = 0; g < 3; ++g) {
                if (g < 2) ATT_LOADK(c, hp, g + 1); else ATT_LOADV(c, hp, 0);
#pragma unroll
                for (int q3 = 0; q3 < 3; ++q3) { const int j = 3 * g + q3;
#pragma unroll
                    for (int kt4 = 0; kt4 < 4; ++kt4) { f32x4 acc = {0.f, 0.f, 0.f, 0.f};
                        const LAS unsigned char* kp = kvb + (g & 1) * BUFB + q3 * CHB + hl * 9216 + (16 * kt4 + fr) * 144 + 16 * fq;
                        acc = __builtin_amdgcn_mfma_f32_16x16x32_bf16(*(const LAS bf16x8*)kp, qv0, acc, 0, 0, 0);
                        acc = __builtin_amdgcn_mfma_f32_16x16x32_bf16(*(const LAS bf16x8*)(kp + 64), qv1, acc, 0, 0, 0);
#pragma unroll
                        for (int jj = 0; jj < 4; ++jj) { float bias = b512;
                            if (j == 4) { int rel = relb - (64 * j + 16 * kt4 + jj); rel = rel > 256 ? 256 : rel; bias = btl[rel]; }
                            else if (j > 4) bias = btl[relb - (64 * j + 16 * kt4 + jj)];
                            acc[jj] = acc[jj] * (0.125f * LOG2E) + bias; }
                        S[4 * j + kt4] = acc; }
                    __builtin_amdgcn_sched_barrier(0); }
                ATT_WRITE((g + 1) & 1);
                LBAR();
            }
            if (c < 8) {
#pragma unroll
                for (int j = 0; j < 8; ++j) if (j < 8 - c) {
#pragma unroll
                    for (int kt4 = 0; kt4 < 4; ++kt4) S[4 * j + kt4] = (f32x4){-1e30f, -1e30f, -1e30f, -1e30f}; } }
            float mx = -1e30f;
#pragma unroll
            for (int i = 0; i < 36; ++i) mx = fmaxf(mx, fmaxf(fmaxf(S[i][0], S[i][1]), fmaxf(S[i][2], S[i][3])));
            mx = fmaxf(mx, __shfl_xor(mx, 16)); mx = fmaxf(mx, __shfl_xor(mx, 32));
            f32x2 l2 = {0.f, 0.f};
            u32x2 PW[36];
#pragma unroll
            for (int i = 0; i < 36; ++i) { const f32x4 d = S[i] - mx; const float p0 = __builtin_amdgcn_exp2f(d[0]), p1 = __builtin_amdgcn_exp2f(d[1]), p2 = __builtin_amdgcn_exp2f(d[2]), p3 = __builtin_amdgcn_exp2f(d[3]);
                l2 = l2 + (f32x2){p0, p1}; l2 = l2 + (f32x2){p2, p3}; PW[i].x = pg8::cvt_pk_bf16(p0, p1); PW[i].y = pg8::cvt_pk_bf16(p2, p3); asm volatile("" : "+v"(PW[i].x), "+v"(PW[i].y));
                if ((i & 3) == 3) __builtin_amdgcn_sched_barrier(0); }
            float l = l2[0] + l2[1];
            l += __shfl_xor(l, 16); l += __shfl_xor(l, 32);
            f32x4 O[4];
#pragma unroll
            for (int dt = 0; dt < 4; ++dt) O[dt] = (f32x4){0.f, 0.f, 0.f, 0.f};
            if (un < NU) ATT_LOADQ(cn, hpn);
#pragma unroll
            for (int g = 0; g < 3; ++g) {
                if (g < 2) ATT_LOADV(c, hp, g + 1); else if (un < NU) ATT_LOADK(cn, hpn, 0);
                const int buf = (3 + g) & 1;
#pragma unroll
                for (int q3 = 0; q3 < 3; ++q3) { const int j = 3 * g + q3;
#pragma unroll
                    for (int a2 = 0; a2 < 2; ++a2) { const u32x4 pw = {PW[4 * j + 2 * a2].x, PW[4 * j + 2 * a2].y, PW[4 * j + 2 * a2 + 1].x, PW[4 * j + 2 * a2 + 1].y};
                        const bf16x8 pa = __builtin_bit_cast(bf16x8, pw);
#pragma unroll
                        for (int dt = 0; dt < 4; ++dt) { const LAS unsigned char* vp = kvb + buf * BUFB + q3 * CHB + hl * 9216 + (16 * dt + fr) * 144 + (32 * a2 + 4 * fq) * 2;
                            const u32x2 lo = *(const LAS u32x2*)vp, hi = *(const LAS u32x2*)(vp + 32);
                            const u32x4 vw = {lo.x, lo.y, hi.x, hi.y};
                            O[dt] = __builtin_amdgcn_mfma_f32_16x16x32_bf16(pa, __builtin_bit_cast(bf16x8, vw), O[dt], 0, 0, 0); } } }
                if (g < 2 || un < NU) ATT_WRITE((3 + g + 1) & 1);
                if (g < 2) LBAR();
            }
#pragma unroll
            for (int jj = 0; jj < 4; ++jj) { const float linv = 1.0f / __shfl(l, 4 * fq + jj); const size_t t = (size_t)64 * c + 16 * qt + 4 * fq + jj;
#pragma unroll
                for (int dt = 0; dt < 4; ++dt) ycat[t * D + 64 * h + 16 * dt + fr] = (bf16_t)f2bf(O[dt][jj] * linv); }
        }
#undef ATT_LOADK
#undef ATT_LOADV
#undef ATT_WRITE
#undef ATT_LOADQ
    }
    xcd_barrier(xbar);
    STAMP(4);

    REPS(5) {
        IDS();
        LAS float* red = (LAS float*)(lds + 6144);
        LAS bf16_t* qd = (LAS bf16_t*)(lds + 8192); LAS bf16_t* ki = (LAS bf16_t*)(lds + 25600); LAS bf16_t* aL = (LAS bf16_t*)(lds + 43008);
        const int fr = lane & 15, fq = lane >> 4, dk = tid & 127, seg = tid >> 7;
        f32x4 braw[2][2]; u32x2 qraw[2][2], kraw[2][2];
        const int pi = tid >> 4, pg = tid & 15;
#define G3_LOAD(u_) do { const int n_ = (u_) >> 2, hg_ = (u_) & 3; _Pragma("unroll") for (int r = 0; r < 2; ++r) { const size_t t_ = (size_t)n_ * 64 + pi + 32 * r; \
            _Pragma("unroll") for (int g2 = 0; g2 < 2; ++g2) { braw[r][g2] = *(const f32x4*)(bcum + t_ * 512 + hg_ * 128 + 64 * g2 + 4 * pg); \
            qraw[r][g2] = *(const u32x2*)(projR + t_ * NR + QG + hg_ * 128 + 64 * g2 + 4 * pg); kraw[r][g2] = *(const u32x2*)(projR + t_ * NR + KG + hg_ * 128 + 64 * g2 + 4 * pg); } } } while (0)
        if (bx < NCH * 4) G3_LOAD(bx);
        for (int unit = bx; unit < NCH * 4; unit += G) {
            const int n = unit >> 2, hg = unit & 3;
            bf16x8 vB[2][2], sB[2][4];
#pragma unroll
            for (int nt2 = 0; nt2 < 2; ++nt2) { const int dvv = 16 * (2 * wave + nt2) + fr;
#pragma unroll
                for (int ks = 0; ks < 2; ++ks) vB[nt2][ks] = *(const bf16x8*)(vT + (size_t)(1024 + hg * 256 + dvv) * T + n * 64 + 32 * ks + 8 * fq);
#pragma unroll
                for (int ks = 0; ks < 4; ++ks) sB[nt2][ks] = *(const bf16x8*)(upd + (size_t)unit * 32768 + dvv * 128 + 32 * ks + 8 * fq); }
#pragma unroll
            for (int r = 0; r < 2; ++r) { const int i = pi + 32 * r;
#pragma unroll
                for (int g2 = 0; g2 < 2; ++g2) { u32x2 qo, ko;
#pragma unroll
                    for (int e = 0; e < 2; ++e) { const float b0 = braw[r][g2][2 * e], b1 = braw[r][g2][2 * e + 1];
                        qo[e] = pk2(bflo(qraw[r][g2][e]) * 0.08838834764831845f * __expf(b0), bfhi(qraw[r][g2][e]) * 0.08838834764831845f * __expf(b1));
                        ko[e] = pk2(bflo(kraw[r][g2][e]) * __expf(-b0), bfhi(kraw[r][g2][e]) * __expf(-b1)); }
                    *(LAS u32x2*)(qd + i * 136 + 64 * g2 + 4 * pg) = qo; *(LAS u32x2*)(ki + i * 136 + 64 * g2 + 4 * pg) = ko; } }
            LBAR();
            if (unit + G < NCH * 4) G3_LOAD(unit + G);
#pragma unroll
            for (int rep = 0; rep < 2; ++rep) { const int idx = wave + 8 * rep, it = idx >> 2, jt = idx & 3;
                f32x4 c = {0.f, 0.f, 0.f, 0.f};
                if (jt <= it) {
#pragma unroll
                    for (int ks = 0; ks < 4; ++ks) { const bf16x8 av = *(const LAS bf16x8*)(qd + (16 * it + fr) * 136 + 32 * ks + 8 * fq), bv8 = *(const LAS bf16x8*)(ki + (16 * jt + fr) * 136 + 32 * ks + 8 * fq);
                        c = __builtin_amdgcn_mfma_f32_16x16x32_bf16(av, bv8, c, 0, 0, 0); } }
#pragma unroll
                for (int jj = 0; jj < 4; ++jj) { const int i = 16 * it + 4 * fq + jj, j = 16 * jt + fr; aL[i * 72 + j] = (bf16_t)f2bf(j <= i ? c[jj] : 0.f); } }
            LBAR();
            unsigned short rr[4][4][2];
#pragma unroll
            for (int mt = 0; mt < 4; ++mt)
#pragma unroll
                for (int jj = 0; jj < 4; ++jj)
#pragma unroll
                    for (int nt2 = 0; nt2 < 2; ++nt2) rr[mt][jj][nt2] = projR[((size_t)n * 64 + 16 * mt + 4 * fq + jj) * NR + RG + hg * 256 + 16 * (2 * wave + nt2) + fr];
            f32x4 acc[4][2];
#pragma unroll
            for (int mt = 0; mt < 4; ++mt) { acc[mt][0] = (f32x4){0.f, 0.f, 0.f, 0.f}; acc[mt][1] = (f32x4){0.f, 0.f, 0.f, 0.f}; }
#pragma unroll
            for (int nt2 = 0; nt2 < 2; ++nt2)
#pragma unroll
                for (int mt = 0; mt < 4; ++mt) {
#pragma unroll
                    for (int ks = 0; ks < 2; ++ks) acc[mt][nt2] = __builtin_amdgcn_mfma_f32_16x16x32_bf16(*(const LAS bf16x8*)(aL + (16 * mt + fr) * 72 + 32 * ks + 8 * fq), vB[nt2][ks], acc[mt][nt2], 0, 0, 0);
#pragma unroll
                    for (int ks = 0; ks < 4; ++ks) acc[mt][nt2] = __builtin_amdgcn_mfma_f32_16x16x32_bf16(*(const LAS bf16x8*)(qd + (16 * mt + fr) * 136 + 32 * ks + 8 * fq), sB[nt2][ks], acc[mt][nt2], 0, 0, 0); }
#pragma unroll
            for (int mt = 0; mt < 4; ++mt)
#pragma unroll
                for (int jj = 0; jj < 4; ++jj) { float p = acc[mt][0][jj] * acc[mt][0][jj] + acc[mt][1][jj] * acc[mt][1][jj];
                    p += __shfl_xor(p, 1); p += __shfl_xor(p, 2); p += __shfl_xor(p, 4); p += __shfl_xor(p, 8);
                    if (fr == 0) red[wave * 64 + 16 * mt + 4 * fq + jj] = p; }
            LBAR();
            const float gw0 = a.gla_norm_w[16 * (2 * wave) + fr], gw1 = a.gla_norm_w[16 * (2 * wave + 1) + fr];
#pragma unroll
            for (int mt = 0; mt < 4; ++mt)
#pragma unroll
                for (int jj = 0; jj < 4; ++jj) { const int i = 16 * mt + 4 * fq + jj; float ss = 0.f;
#pragma unroll
                    for (int w8 = 0; w8 < 8; ++w8) ss += red[w8 * 64 + i];
                    const float rstd = frsq(ss * (1.0f / 256.0f) + EPS); const size_t t = (size_t)n * 64 + i;
#pragma unroll
                    for (int nt2 = 0; nt2 < 2; ++nt2) { const int dvv = 16 * (2 * wave + nt2) + fr;
                        const float r = bf2f(rr[mt][jj][nt2]);
                        const float y = acc[mt][nt2][jj] * rstd * (nt2 ? gw1 : gw0) * (r * fsigmoid(r));
                        ycat[t * D + 1024 + hg * 256 + dvv] = (bf16_t)f2bf(y); } }
        }
#undef G3_LOAD
    }
    xcd_barrier(xbar);
    STAMP(5);

    { pg8::Gemm g{ycat, WoutT, T, D, D}; pg8::StaticOrder S; S.init(T, D, G, bx, WGM_P5); pg8::EpiResid<true> E{h0, x1b, ssq1};
      pg8::gemm_phase<pg8::EpiResid<true>, pg8::StaticOrder, true, true>(lds, g, S, E); }
    xcd_barrier(xbar);
    STAMP(6);

#ifndef NO_UP
    REPS(6) { pg8::Gemm g{x1b, WupT, T, 2 * FF, D}; pg8::StaticOrder S; S.init(T, 2 * FF, G, bx, WGM_P6); pg8::EpiUp E{gbuf, ssq1, a.w_ffn_conv, a.b_ffn_conv, tailb, headb};
      pg8::gemm_phase<pg8::EpiUp, pg8::StaticOrder, true, true>(lds, g, S, E); }
#endif
    xcd_barrier(xbar);
    STAMP(7);

    { IDS();
    for (int i = gtid; i < NCH * 2 * (FF / 4); i += NT) {
        const int c4 = i % (FF / 4), gj = i / (FF / 4), j = gj & 1, grp = gj >> 1; const int row = grp * 64 + j, C = 4 * c4;
        const bf16_t* tl = tailb + (size_t)(grp - 1) * 2 * (2 * FF); const bf16_t* hd = headb + (size_t)grp * 2 * (2 * FF);
        const f32x4 z = {0.f, 0.f, 0.f, 0.f};
#define LD4(p_) ({ const u32x2 w_ = *(const u32x2*)(p_); (f32x4){bflo(w_.x), bfhi(w_.x), bflo(w_.y), bfhi(w_.y)}; })
        f32x4 ug0, uv0, ug1, uv1, ug2, uv2;
        if (j == 0) { ug0 = grp ? LD4(tl + C) : z; uv0 = grp ? LD4(tl + FF + C) : z; ug1 = grp ? LD4(tl + 2 * FF + C) : z; uv1 = grp ? LD4(tl + 3 * FF + C) : z;
                      ug2 = LD4(hd + C); uv2 = LD4(hd + FF + C); }
        else { ug0 = grp ? LD4(tl + 2 * FF + C) : z; uv0 = grp ? LD4(tl + 3 * FF + C) : z; ug1 = LD4(hd + C); uv1 = LD4(hd + FF + C);
               ug2 = LD4(hd + 2 * FF + C); uv2 = LD4(hd + 3 * FF + C); }
#undef LD4
        const float* cw = a.w_ffn_conv; const float* cb = a.b_ffn_conv;
        const f32x4 yg = *(const f32x4*)(cb + C) + *(const f32x4*)(cw + C) * ug0 + *(const f32x4*)(cw + 2 * FF + C) * ug1 + *(const f32x4*)(cw + 4 * FF + C) * ug2;
        const f32x4 yv = *(const f32x4*)(cb + FF + C) + *(const f32x4*)(cw + FF + C) * uv0 + *(const f32x4*)(cw + 3 * FF + C) * uv1 + *(const f32x4*)(cw + 5 * FF + C) * uv2;
        u32x2 o; o.x = pk2(pg8::gelu_tanh(yg[0]) * yv[0], pg8::gelu_tanh(yg[1]) * yv[1]); o.y = pk2(pg8::gelu_tanh(yg[2]) * yv[2], pg8::gelu_tanh(yg[3]) * yv[3]);
        *(u32x2*)(gbuf + (size_t)row * FF + C) = o;
    } }
    xcd_barrier(xbar);
    STAMP(8);

    { pg8::Gemm g{gbuf, WdnT, T, D, FF}; pg8::StaticOrder S; S.init(T, D, G, bx, WGM_P8); pg8::EpiResid<true> E{x1b, x2b, ssq2};
      pg8::gemm_phase<pg8::EpiResid<true>, pg8::StaticOrder, true, true>(lds, g, S, E); }
    { pg8::Gemm g{pb, WppT, T, D, PLE}; pg8::StaticOrder S; S.init(T, D, G, bx, WGM_PP); pg8::EpiBf16 E{ppb, D, nullptr, nullptr};
      pg8::gemm_phase<pg8::EpiBf16, pg8::StaticOrder, true, true>(lds, g, S, E); }
    xcd_barrier(xbar);
    STAMP(9);

    { pg8::Gemm g{x2b, WpgT, T, D, D}; pg8::StaticOrder S; S.init(T, D, G, bx, WGM_P9); pg8::EpiPle E{x2b, x3b, ppb, ssq2, ssq3};
      pg8::gemm_phase<pg8::EpiPle, pg8::StaticOrder, true, true>(lds, g, S, E); }
    xcd_barrier(xbar);
    STAMP(10);

    { IDS();
    for (int m = gw; m < T; m += NGW) {
        const float rstd = frsq(ssq3[m] * (1.0f / D) + EPS);
        const u32x2* xr = (const u32x2*)(x3b + (size_t)m * D) + lane; f32x4* orow = (f32x4*)(a.out + (size_t)m * D) + lane; const f32x4* wr4 = (const f32x4*)a.final_norm_w + lane;
#pragma unroll
        for (int j = 0; j < 8; ++j) { const u32x2 xw = xr[64 * j]; const f32x4 w = wr4[64 * j];
            const f32x4 v = {bflo(xw.x) * rstd * w.x, bfhi(xw.x) * rstd * w.y, bflo(xw.y) * rstd * w.z, bfhi(xw.y) * rstd * w.w};
            __builtin_nontemporal_store(v, orow + 64 * j); }
    } }
    if (PROBE_DUP == 7) { for (int i_ = 0; i_ < 20; ++i_) grid.sync(); }
    if (PROBE_T != 0) {
        asm volatile("s_waitcnt vmcnt(0)" ::: "memory"); grid.sync(); STAMP(11); grid.sync();
        unsigned probe_m = 50000u;
        if (PROBE_T != 100) { const unsigned long long* tsb = (const unsigned long long*)(a.ws + 200 * 1024); constexpr int HI_ = PROBE_T == 13 ? 12 : (PROBE_T == 14 ? 4 : (PROBE_T == 15 ? 11 : PROBE_T)), LO_ = PROBE_T == 13 ? 3 : (PROBE_T == 14 ? 12 : (PROBE_T == 15 ? 0 : PROBE_T - 1));
            probe_m = (unsigned)(__hip_atomic_load(tsb + HI_, __ATOMIC_RELAXED, __HIP_MEMORY_SCOPE_AGENT) - __hip_atomic_load(tsb + LO_, __ATOMIC_RELAXED, __HIP_MEMORY_SCOPE_AGENT)); if (PROBE_T == 15) probe_m /= 8; }
        for (unsigned e = blockIdx.x * 512u + threadIdx.x; e < probe_m; e += gridDim.x * 512u) a.out[e] += 0.08f;
    }
}

extern "C" void kernel_launch(void* const* d_in, const int* in_sizes, int n_in, void* d_out, int out_size, void* d_ws, size_t ws_size, hipStream_t stream) {
    static int grid = 0;
    if (grid == 0) {
        if (n_in != 18 || out_size != T * D || ws_size < WS_END) { fprintf(stderr, "kernel_launch: unexpected problem (n_in %d out %d ws %zu)\n", n_in, out_size, ws_size); grid = -1; return; }
        int dev = 0, cus = 0, per_cu = 0;
        hipGetDevice(&dev); hipDeviceGetAttribute(&cus, hipDeviceAttributeMultiprocessorCount, dev);
        if (hipFuncSetAttribute((const void*)fwd_megakernel, hipFuncAttributeMaxDynamicSharedMemorySize, LDS_BYTES) != hipSuccess) { fprintf(stderr, "kernel_launch: hipFuncSetAttribute failed\n"); grid = -1; return; }
        if (hipOccupancyMaxActiveBlocksPerMultiprocessor(&per_cu, (const void*)fwd_megakernel, 512, LDS_BYTES) != hipSuccess || per_cu < 1) { fprintf(stderr, "kernel_launch: occupancy query says %d\n", per_cu); per_cu = 1; }
        (void)hipGetLastError();
        grid = cus * per_cu;
    }
    if (grid < 0) return;
    Args a{};
    const float** f = (const float**)&a;
    for (int i = 0; i < 18; ++i) f[i] = (const float*)d_in[i];
    a.out = (float*)d_out; a.ws = (unsigned char*)d_ws;
    if (hipMemsetAsync((char*)d_ws + WS_BAR, 0, 16384, stream) != hipSuccess) { fprintf(stderr, "kernel_launch: memset of the barrier words failed\n"); return; }
    void* args[] = {&a};
    hipError_t e = hipLaunchCooperativeKernel((const void*)fwd_megakernel, dim3(grid), dim3(512), args, LDS_BYTES, stream);
    if (e != hipSuccess) fprintf(stderr, "cooperative launch failed: %s (grid %d)\n", hipGetErrorString(e), grid);
}
```

```cpp
#include <hip/hip_runtime.h>
#include <hip/hip_cooperative_groups.h>
#include <cstdio>
#include <cstdint>
namespace cg = cooperative_groups;
#ifndef PROBE_DUP
#define PROBE_DUP 0
#endif
#ifndef PROBE_T
#define PROBE_T 0
#endif
#ifndef WGM_P1R
#define WGM_P1R 4
#endif
#ifndef WGM_P1T
#define WGM_P1T 4
#endif
#ifndef WGM_P5
#define WGM_P5 4
#endif
#ifndef WGM_P6
#define WGM_P6 8
#endif
#ifndef WGM_P8
#define WGM_P8 4
#endif
#ifndef WGM_PP
#define WGM_PP 4
#endif
#ifndef WGM_P9
#define WGM_P9 4
#endif
#define REPS(k) for (int rep_ = 0; rep_ < (PROBE_DUP == (k) ? 2 : 1); ++rep_)

#define LAS __attribute__((address_space(3)))
typedef unsigned short bf16_t;
typedef short bf16x8 __attribute__((ext_vector_type(8)));
typedef float f32x4 __attribute__((ext_vector_type(4)));
typedef float f32x2 __attribute__((ext_vector_type(2)));
typedef unsigned u32x4 __attribute__((ext_vector_type(4)));
typedef unsigned u32x2 __attribute__((ext_vector_type(2)));

constexpr int T = 16384, D = 2048, FF = 5632, NR = 4096, PLE = 256, NCH = 256;
constexpr int QA = 0, KA = 1024, QG = 2048, KG = 2560, RG = 3072;
constexpr float EPS = 1e-6f;
constexpr size_t MiB = 1u << 20;
constexpr size_t WS_SSQ1 = 0, WS_SSQ2 = 65536, WS_SSQ3 = 131072, WS_GLR = 1 * MiB, WS_WG = 2 * MiB, WS_WPP = 3 * MiB;
constexpr size_t WS_WIN = 4 * MiB, WS_WOUT = 28 * MiB, WS_WUP = 36 * MiB, WS_WDN = 80 * MiB, WS_WPG = 102 * MiB, WS_PB = 110 * MiB;
constexpr size_t WS_H0 = 118 * MiB;
constexpr size_t WS_PROJ = 182 * MiB;
constexpr size_t WS_VT = 310 * MiB;
constexpr size_t WS_X1B = 182 * MiB, WS_G = 246 * MiB, WS_TAIL = 422 * MiB, WS_HEAD = 444 * MiB, WS_PP = 422 * MiB  , WS_X3B = 182 * MiB  , WS_YCAT = WS_H0, WS_X2B = WS_H0;
constexpr size_t WS_DEC = 256 * 1024, WS_UPD = 406 * MiB, WS_BCUM = 374 * MiB;
constexpr size_t WS_BAR = 800 * 1024;
constexpr size_t WS_GLR1 = 470 * MiB;
constexpr size_t WS_RSTD0 = 900 * 1024;
constexpr size_t WS_END = 512 * MiB;
constexpr int LDS_BYTES = 147456;

__device__ __forceinline__ unsigned f2bf(float f) { unsigned u = __builtin_bit_cast(unsigned, f); return (u + 0x7fffu + ((u >> 16) & 1u)) >> 16; }
typedef __bf16 hwbf16x2 __attribute__((ext_vector_type(2)));
__device__ __forceinline__ unsigned pk2(float lo, float hi) { const f32x2 v = {lo, hi}; return __builtin_bit_cast(unsigned, __builtin_convertvector(v, hwbf16x2)); }
__device__ __forceinline__ float frcp(float x) { return __builtin_amdgcn_rcpf(x); }
__device__ __forceinline__ float frsq(float x) { return __builtin_amdgcn_rsqf(x); }
__device__ __forceinline__ float fsigmoid(float x) { return frcp(1.0f + __builtin_amdgcn_exp2f(-1.4426950408889634f * x)); }
__device__ __forceinline__ float bf2f(unsigned short b) { return __builtin_bit_cast(float, (unsigned)b << 16); }
__device__ __forceinline__ float bflo(unsigned w) { return __builtin_bit_cast(float, w << 16); }
__device__ __forceinline__ float bfhi(unsigned w) { return __builtin_bit_cast(float, w & 0xffff0000u); }
__device__ __forceinline__ float wave_sum(float v) {
#pragma unroll
    for (int o = 1; o < 64; o <<= 1) v += __shfl_xor(v, o);
    return v;
}

namespace pg8 {
#define PG8_LAS __attribute__((address_space(3)))
constexpr int BM = 256, BK = 64, HALF = 128, HTB = HALF * BK * 2, STAGE_BYTES = 8 * HTB, NXCD = 8;
__host__ __device__ __forceinline__ int lds_byte(int r, int c) { const int st = (r >> 4) * 2 + (c >> 5), rr = r & 15, cc = c & 31, ob = rr * 64 + cc * 2; return st * 1024 + (ob ^ (((ob >> 9) & 1) << 5)); }
__host__ __device__ __forceinline__ void stage_rc(int b, int& R, int& C) { const int st = b / 1024, sb = b % 1024, swz = sb ^ (((sb >> 9) & 1) << 5); R = (st >> 1) * 16 + swz / 64; C = (st & 1) * 32 + (swz % 64) / 2; }
__host__ __device__ __forceinline__ int perm32(int rho) { const int n = rho >> 4, i = rho & 15; return 8 * (i >> 2) + 4 * n + (i & 3); }

struct Unit { int pm, pn; };
struct Gemm { const bf16_t* A; const bf16_t* Bt; int M, N, K; };

struct StaticOrder {
    int nM, nN, nwg, G, c, WGM;
    __host__ __device__ void init(int M, int N, int G_, int c_, int wgm) { nM = M / BM; nN = N / BM; nwg = nM * nN; G = G_; c = c_; WGM = wgm; }
    __host__ __device__ bool next(int i, Unit& u) const {
        const long L = (long)i * G + c; if (L >= nwg) return false;
        int wgid = (int)L; { const int q = nwg / NXCD, r = nwg % NXCD, xcd = wgid % NXCD, off = wgid / NXCD; wgid = (xcd < r ? xcd * (q + 1) : r * (q + 1) + (xcd - r) * q) + off; }
        const int nig = WGM * nN, gid = wgid / nig, fm = gid * WGM, gsz = (nM - fm) < WGM ? (nM - fm) : WGM;
        u.pm = fm + ((wgid % nig) % gsz); u.pn = (wgid % nig) / gsz; return true;
    }
    __device__ __forceinline__ void a_ready(const Unit&) const {}
    __device__ __forceinline__ void done(const Unit&) const {}
};

__device__ __forceinline__ unsigned cvt_pk_bf16(float lo, float hi) { return pk2(lo, hi); }

struct EpiBf16 {
    static constexpr bool PERM = true, AFTER_DRAIN = false;
    bf16_t* O; int ldc; const float* rs; const float* cs;
    __device__ __forceinline__ void operator()(const f32x4 (&acc)[2][2][4][2], const Unit& u, int wr, int wc, int fr, int fq) const {
        const int row0 = u.pm * BM + wr * 64 + fr; const int col0 = u.pn * BM + wc * 32 + 8 * fq;
        f32x4 c0[2], c1[2];
#pragma unroll
        for (int bj = 0; bj < 2; ++bj) { c0[bj] = cs ? *(const f32x4*)(cs + col0 + bj * HALF) : (f32x4){1.f, 1.f, 1.f, 1.f}; c1[bj] = cs ? *(const f32x4*)(cs + col0 + bj * HALF + 4) : (f32x4){1.f, 1.f, 1.f, 1.f}; }
#pragma unroll
        for (int ai = 0; ai < 2; ++ai)
#pragma unroll
            for (int m = 0; m < 4; ++m) { const int row = row0 + ai * HALF + m * 16; bf16_t* rowp = O + (size_t)row * ldc + col0; const float r = rs ? rs[row] : 1.0f;
#pragma unroll
                for (int bj = 0; bj < 2; ++bj) { const f32x4 v0 = acc[ai][bj][m][0] * c0[bj] * r, v1 = acc[ai][bj][m][1] * c1[bj] * r;
                    u32x4 w; w.x = cvt_pk_bf16(v0[0], v0[1]); w.y = cvt_pk_bf16(v0[2], v0[3]); w.z = cvt_pk_bf16(v1[0], v1[1]); w.w = cvt_pk_bf16(v1[2], v1[3]);
                    *(u32x4*)(rowp + bj * HALF) = w; } }
    }
};
template <bool BASE_BF16> struct EpiResid {
    static constexpr bool PERM = true, AFTER_DRAIN = false;
    const void* base; bf16_t* ob; float* ssq;
    __device__ __forceinline__ void operator()(const f32x4 (&acc)[2][2][4][2], const Unit& u, int wr, int wc, int fr, int fq) const {
        const int row0 = u.pm * BM + wr * 64 + fr; const int col0 = u.pn * BM + wc * 32 + 8 * fq;
#pragma unroll
        for (int ai = 0; ai < 2; ++ai)
#pragma unroll
            for (int m = 0; m < 4; ++m) { const int row = row0 + ai * HALF + m * 16; const size_t off = (size_t)row * D + col0; float ss = 0.f;
#pragma unroll
                for (int bj = 0; bj < 2; ++bj) {
                    f32x4 b0, b1;
                    if (BASE_BF16) { const u32x4 pw = *(const u32x4*)((const bf16_t*)base + off + bj * HALF); b0 = (f32x4){bflo(pw.x), bfhi(pw.x), bflo(pw.y), bfhi(pw.y)}; b1 = (f32x4){bflo(pw.z), bfhi(pw.z), bflo(pw.w), bfhi(pw.w)}; }
                    else { b0 = *(const f32x4*)((const float*)base + off + bj * HALF); b1 = *(const f32x4*)((const float*)base + off + bj * HALF + 4); }
                    const f32x4 v0 = acc[ai][bj][m][0] + b0, v1 = acc[ai][bj][m][1] + b1;
                    u32x4 w; w.x = cvt_pk_bf16(v0[0], v0[1]); w.y = cvt_pk_bf16(v0[2], v0[3]); w.z = cvt_pk_bf16(v1[0], v1[1]); w.w = cvt_pk_bf16(v1[2], v1[3]);
                    *(u32x4*)(ob + off + bj * HALF) = w;
                    ss += (v0[0] * v0[0] + v0[1] * v0[1]) + (v0[2] * v0[2] + v0[3] * v0[3]) + (v1[0] * v1[0] + v1[1] * v1[1]) + (v1[2] * v1[2] + v1[3] * v1[3]); }
                ss += __shfl_xor(ss, 16); ss += __shfl_xor(ss, 32);
                if (fq == 0) atomicAdd(ssq + row, ss); }
    }
};
struct EpiPle {
    static constexpr bool PERM = true, AFTER_DRAIN = false;
    const bf16_t* x2; bf16_t* x3; const bf16_t* pp; const float* ssq2; float* ssq3;
    __device__ __forceinline__ void operator()(const f32x4 (&acc)[2][2][4][2], const Unit& u, int wr, int wc, int fr, int fq) const {
        const int row0 = u.pm * BM + wr * 64 + fr; const int col0 = u.pn * BM + wc * 32 + 8 * fq;
#pragma unroll
        for (int ai = 0; ai < 2; ++ai)
#pragma unroll
            for (int m = 0; m < 4; ++m) { const int row = row0 + ai * HALF + m * 16; const size_t off = (size_t)row * D + col0; float ss = 0.f;
                const float rstd = frsq(ssq2[row] * (1.0f / D) + EPS);
#pragma unroll
                for (int bj = 0; bj < 2; ++bj) {
                    const u32x4 xw = *(const u32x4*)(x2 + off + bj * HALF);
                    const u32x4 pw = *(const u32x4*)(pp + off + bj * HALF);
                    const f32x4 b0 = {bflo(xw.x), bfhi(xw.x), bflo(xw.y), bfhi(xw.y)}, b1 = {bflo(xw.z), bfhi(xw.z), bflo(xw.w), bfhi(xw.w)};
                    const f32x4 p0 = {bflo(pw.x), bfhi(pw.x), bflo(pw.y), bfhi(pw.y)}, p1 = {bflo(pw.z), bfhi(pw.z), bflo(pw.w), bfhi(pw.w)};
                    f32x4 v0, v1;
#pragma unroll
                    for (int e = 0; e < 4; ++e) { const float g0 = fsigmoid(acc[ai][bj][m][0][e] * rstd), g1 = fsigmoid(acc[ai][bj][m][1][e] * rstd);
                        v0[e] = b0[e] + g0 * p0[e]; v1[e] = b1[e] + g1 * p1[e]; }
                    u32x4 w; w.x = cvt_pk_bf16(v0[0], v0[1]); w.y = cvt_pk_bf16(v0[2], v0[3]); w.z = cvt_pk_bf16(v1[0], v1[1]); w.w = cvt_pk_bf16(v1[2], v1[3]);
                    *(u32x4*)(x3 + off + bj * HALF) = w;
                    ss += (v0[0] * v0[0] + v0[1] * v0[1]) + (v0[2] * v0[2] + v0[3] * v0[3]) + (v1[0] * v1[0] + v1[1] * v1[1]) + (v1[2] * v1[2] + v1[3] * v1[3]); }
                ss += __shfl_xor(ss, 16); ss += __shfl_xor(ss, 32);
                if (fq == 0) atomicAdd(ssq3 + row, ss); }
    }
};
__device__ __forceinline__ float gelu_tanh(float x) {
    const float t = x * x * (-1.5957691216057308f * 1.4426950408889634f * 0.044715f) + (-1.5957691216057308f * 1.4426950408889634f);
    return x * frcp(1.0f + __builtin_amdgcn_exp2f(t * x));
}
template <int CTRL> __device__ __forceinline__ float dppz(float v) { return __builtin_bit_cast(float, __builtin_amdgcn_update_dpp(0, __builtin_bit_cast(int, v), CTRL, 0xf, 0xf, true)); }
#define FMAC_DPP(acc, src, w, CTRL) asm volatile("s_nop 1\n\tv_fmac_f32_dpp %0, %1, %2 " CTRL " row_mask:0xf bank_mask:0xf bound_ctrl:1" : "+v"(acc) : "v"(src), "v"(w))
struct EpiUp {
    static constexpr bool PERM = true, AFTER_DRAIN = false;
    bf16_t* G; const float* ssq1; const float* cw; const float* cb; bf16_t* tail; bf16_t* head;
    __device__ __forceinline__ void operator()(const f32x4 (&acc)[2][2][4][2], const Unit& u, int wr, int wc, int fr, int fq) const {
        const int C0 = u.pn * 128 + wc * 32 + 8 * fq;
#pragma unroll
        for (int ai = 0; ai < 2; ++ai) {
            const int rbase = u.pm * BM + ai * HALF + wr * 64; const int grp = rbase >> 6;
            float rstd[4];
#pragma unroll
            for (int m = 0; m < 4; ++m) rstd[m] = frsq(ssq1[rbase + m * 16 + fr] * (1.0f / D) + EPS);
            if (fr < 2) { bf16_t* hp = head + ((size_t)grp * 2 + fr) * (2 * FF) + C0;
#pragma unroll
                for (int bj = 0; bj < 2; ++bj) { const f32x4 v0 = acc[ai][bj][0][0] * rstd[0], v1 = acc[ai][bj][0][1] * rstd[0];
                    *(u32x4*)(hp + bj * FF) = (u32x4){pk2(v0[0], v0[1]), pk2(v0[2], v0[3]), pk2(v1[0], v1[1]), pk2(v1[2], v1[3])}; } }
            if (fr >= 14) { bf16_t* tp = tail + ((size_t)grp * 2 + (fr - 14)) * (2 * FF) + C0;
#pragma unroll
                for (int bj = 0; bj < 2; ++bj) { const f32x4 v0 = acc[ai][bj][3][0] * rstd[3], v1 = acc[ai][bj][3][1] * rstd[3];
                    *(u32x4*)(tp + bj * FF) = (u32x4){pk2(v0[0], v0[1]), pk2(v0[2], v0[3]), pk2(v1[0], v1[1]), pk2(v1[2], v1[3])}; } }
            __builtin_amdgcn_sched_barrier(0);
            unsigned outw[4][4];
#pragma unroll
            for (int n = 0; n < 2; ++n) {
#pragma unroll
                for (int ep = 0; ep < 2; ++ep) {
                    int C = C0 + 4 * n + 2 * ep; asm volatile("" : "+v"(C));
                    const f32x2 wg0 = *(const f32x2*)(cw + C), wg1 = *(const f32x2*)(cw + 2 * FF + C), wg2 = *(const f32x2*)(cw + 4 * FF + C), bg = *(const f32x2*)(cb + C);
                    const f32x2 wv0 = *(const f32x2*)(cw + FF + C), wv1 = *(const f32x2*)(cw + 3 * FF + C), wv2 = *(const f32x2*)(cw + 5 * FF + C), bv = *(const f32x2*)(cb + FF + C);
                    f32x2 ugp = {0.f, 0.f}, uvp = {0.f, 0.f};
#pragma unroll
                    for (int m = 0; m < 4; ++m) {
                        f32x2 ug = (f32x2){acc[ai][0][m][n][2 * ep], acc[ai][0][m][n][2 * ep + 1]} * rstd[m], uv = (f32x2){acc[ai][1][m][n][2 * ep], acc[ai][1][m][n][2 * ep + 1]} * rstd[m];
                        asm volatile("" : "+v"(ug), "+v"(uv));
                        f32x2 yg = wg2 * ug + bg, yv = wv2 * uv + bv;
#pragma unroll
                        for (int q = 0; q < 2; ++q) {
                            FMAC_DPP(yg[q], ug[q], wg1[q], "row_shr:1"); FMAC_DPP(yv[q], uv[q], wv1[q], "row_shr:1");
                            FMAC_DPP(yg[q], ug[q], wg0[q], "row_shr:2"); FMAC_DPP(yv[q], uv[q], wv0[q], "row_shr:2");
                            if (m > 0) { FMAC_DPP(yg[q], ugp[q], wg1[q], "row_shl:15"); FMAC_DPP(yv[q], uvp[q], wv1[q], "row_shl:15");
                                         FMAC_DPP(yg[q], ugp[q], wg0[q], "row_shl:14"); FMAC_DPP(yv[q], uvp[q], wv0[q], "row_shl:14"); } }
                        f32x2 t = yg * yg * (-1.5957691216057308f * 1.4426950408889634f * 0.044715f) + (-1.5957691216057308f * 1.4426950408889634f);
                        t = t * yg;
                        f32x2 den = {__builtin_amdgcn_exp2f(t[0]), __builtin_amdgcn_exp2f(t[1])}; den = den + 1.0f;
                        const f32x2 rc = {frcp(den[0]), frcp(den[1])};
                        f32x2 o = yg * rc * yv; asm volatile("" : "+v"(o));
                        outw[m][2 * n + ep] = pk2(o[0], o[1]);
                        ugp = ug; uvp = uv;
                    }
                    __builtin_amdgcn_sched_barrier(0);
                }
                __builtin_amdgcn_sched_barrier(0);
            }
#pragma unroll
            for (int m = 0; m < 4; ++m) if (m > 0 || fr >= 2) { u32x4 w = {outw[m][0], outw[m][1], outw[m][2], outw[m][3]}; *(u32x4*)(G + (size_t)(rbase + m * 16 + fr) * FF + C0) = w; }
            __builtin_amdgcn_sched_barrier(0);
        }
    }
};

template <class Epi, class Sched, bool ALIGN_EPI = false, bool SP2 = false>
__device__ __forceinline__ void gemm_phase(PG8_LAS unsigned char* lds, const Gemm g, const Sched& S, const Epi& E) {
    int tid_ = threadIdx.x; asm volatile("" : "+v"(tid_));
    const int tid = tid_, wid = __builtin_amdgcn_readfirstlane(tid >> 6), lane = tid & 63, wr = wid >> 2, wc = wid & 3, fr = lane & 15, fq = lane >> 4;
    const int K = g.K, nt = K / BK;
    unsigned voffA[2], voffB[2];
#pragma unroll
    for (int i = 0; i < 2; ++i) { int R, C; stage_rc(tid * 16 + i * 8192, R, C); const int Rb = Epi::PERM ? ((R & ~31) + perm32(R & 31)) : R;
        voffA[i] = (unsigned)(R * K + C) * 2u; voffB[i] = (unsigned)(Rb * K + C) * 2u; }
    const size_t kstep = (size_t)(BK * 2);
    const size_t hstep = (size_t)HALF * K * 2;
    const size_t tstep = 2 * hstep;
    const unsigned ldsw = (unsigned)wid * 1024u;
    const int aoff = lds_byte(wr * 64 + fr, fq * 8), boff = lds_byte(wc * 32 + fr, fq * 8);
#define PG8_SA(b, h) (((b) * 2 + (h)) * HTB)
#define PG8_SB(b, h) ((4 + (b) * 2 + (h)) * HTB)
#define PG8_STAGE(bufoff, gbase, voff) do { _Pragma("unroll") for (int _i = 0; _i < 2; ++_i) \
        __builtin_amdgcn_global_load_lds((const unsigned*)((const char*)(gbase) + (voff)[_i]), (PG8_LAS unsigned*)(lds + (bufoff) + ldsw + _i * 8192), 16, 0, 0); } while (0)
#define PG8_LDA(dst, b, h) do { _Pragma("unroll") for (int m = 0; m < 4; ++m) _Pragma("unroll") for (int k = 0; k < 2; ++k) dst[m][k] = *(const PG8_LAS bf16x8*)(lds + PG8_SA(b, h) + aoff + m * 2048 + k * 1024); } while (0)
#define PG8_LDB(dst, b, h) do { _Pragma("unroll") for (int n = 0; n < 2; ++n) _Pragma("unroll") for (int k = 0; k < 2; ++k) dst[n][k] = *(const PG8_LAS bf16x8*)(lds + PG8_SB(b, h) + boff + n * 2048 + k * 1024); } while (0)
#define PG8_MMA(ai, bj, At, Bt) do { __builtin_amdgcn_s_setprio(1); _Pragma("unroll") for (int m = 0; m < 4; ++m) _Pragma("unroll") for (int n = 0; n < 2; ++n) _Pragma("unroll") for (int k = 0; k < 2; ++k) \
        acc[ai][bj][m][n] = __builtin_amdgcn_mfma_f32_16x16x32_bf16(Bt[n][k], At[m][k], acc[ai][bj][m][n], 0, 0, 0); __builtin_amdgcn_s_setprio(0); } while (0)
#define PG8_WAIT_V(n) asm volatile("s_waitcnt vmcnt(" #n ")" ::: "memory")
#define PG8_WAIT_L(n) asm volatile("s_waitcnt lgkmcnt(" #n ")" ::: "memory")
#define PG8_BAR __builtin_amdgcn_s_barrier()
#define PG8_SCHED __builtin_amdgcn_sched_barrier(0)
    Unit cur, nxt; int ui = 0;
    if (!S.next(0, cur)) return;
    f32x4 acc[2][2][4][2];
#pragma unroll
    for (int a = 0; a < 2; ++a)
#pragma unroll
        for (int b = 0; b < 2; ++b)
#pragma unroll
            for (int m = 0; m < 4; ++m)
#pragma unroll
                for (int n = 0; n < 2; ++n) acc[a][b][m][n] = (f32x4){0.f, 0.f, 0.f, 0.f};
    bf16x8 At[4][2], B0[2][2], B1[2][2];
    const char* cA = (const char*)g.A + (size_t)cur.pm * tstep; const char* cB = (const char*)g.Bt + (size_t)cur.pn * tstep;
    S.a_ready(cur);
    if constexpr (SP2) {
        PG8_STAGE(PG8_SB(0, 0), cB, voffB); PG8_STAGE(PG8_SB(0, 1), cB + hstep, voffB); PG8_STAGE(PG8_SA(0, 0), cA, voffA); PG8_STAGE(PG8_SA(0, 1), cA + hstep, voffA);
        if (wr == 1) PG8_BAR;
        PG8_WAIT_V(2); PG8_BAR;
        PG8_STAGE(PG8_SB(1, 0), cB + kstep, voffB); PG8_STAGE(PG8_SA(1, 0), cA + kstep, voffA); PG8_STAGE(PG8_SB(1, 1), cB + hstep + kstep, voffB);
        PG8_WAIT_V(6); PG8_BAR;
    } else {
        PG8_STAGE(PG8_SB(0, 0), cB, voffB); PG8_STAGE(PG8_SA(0, 0), cA, voffA); PG8_STAGE(PG8_SB(0, 1), cB + hstep, voffB); PG8_STAGE(PG8_SA(0, 1), cA + hstep, voffA);
        if (wr == 1) PG8_BAR;
        PG8_WAIT_V(4); PG8_BAR;
        PG8_STAGE(PG8_SB(1, 0), cB + kstep, voffB); PG8_STAGE(PG8_SA(1, 0), cA + kstep, voffA); PG8_STAGE(PG8_SB(1, 1), cB + hstep + kstep, voffB);
        PG8_WAIT_V(6); PG8_BAR;
    }
    for (;;) {
        const bool has_next = S.next(ui + 1, nxt);
        const char* nA = has_next ? (const char*)g.A + (size_t)nxt.pm * tstep : cA; const char* nB = has_next ? (const char*)g.Bt + (size_t)nxt.pn * tstep : cB;
        for (int t = 0; t < nt; t += 2) {
            const bool last = (t == nt - 2);
            const char* a1 = cA + (size_t)(t + 1) * kstep;
            const char* a2 = last ? nA : cA + (size_t)(t + 2) * kstep; const char* b2 = last ? nB : cB + (size_t)(t + 2) * kstep;
            const char* a3 = a2 + kstep; const char* b3 = b2 + kstep;
            if (last && has_next) S.a_ready(nxt);
            if constexpr (SP2) {
            PG8_LDB(B0, 0, 0); PG8_LDB(B1, 0, 1); PG8_SCHED; PG8_LDA(At, 0, 0); PG8_STAGE(PG8_SA(1, 1), a1 + hstep, voffA);
            PG8_WAIT_V(8); PG8_WAIT_L(0); PG8_BAR; PG8_MMA(0, 0, At, B0); PG8_MMA(0, 1, At, B1); PG8_BAR; PG8_SCHED;
            PG8_LDA(At, 0, 1); PG8_STAGE(PG8_SB(0, 0), b2, voffB); PG8_STAGE(PG8_SB(0, 1), b2 + hstep, voffB); PG8_STAGE(PG8_SA(0, 0), a2, voffA);
            PG8_WAIT_V(8); PG8_WAIT_L(0); PG8_BAR; PG8_MMA(1, 0, At, B0); PG8_MMA(1, 1, At, B1); PG8_BAR; PG8_SCHED;
            PG8_LDB(B0, 1, 0); PG8_LDB(B1, 1, 1); PG8_SCHED; PG8_LDA(At, 1, 0); PG8_STAGE(PG8_SA(0, 1), a2 + hstep, voffA);
            PG8_WAIT_V(8); PG8_WAIT_L(0); PG8_BAR; PG8_MMA(0, 0, At, B0); PG8_MMA(0, 1, At, B1); PG8_BAR; PG8_SCHED;
            PG8_LDA(At, 1, 1); PG8_STAGE(PG8_SB(1, 0), b3, voffB); PG8_STAGE(PG8_SB(1, 1), b3 + hstep, voffB); PG8_STAGE(PG8_SA(1, 0), a3, voffA);
            PG8_WAIT_V(8); PG8_WAIT_L(0); PG8_BAR; PG8_MMA(1, 0, At, B0); PG8_MMA(1, 1, At, B1); PG8_BAR; PG8_SCHED;
            } else {
            PG8_LDB(B0, 0, 0); PG8_SCHED; PG8_LDA(At, 0, 0); PG8_STAGE(PG8_SA(1, 1), a1 + hstep, voffA);
            PG8_WAIT_L(8); PG8_BAR; PG8_WAIT_L(0); PG8_MMA(0, 0, At, B0); PG8_BAR; PG8_SCHED;
            PG8_LDB(B1, 0, 1); PG8_STAGE(PG8_SB(0, 0), b2, voffB);
            PG8_BAR; PG8_WAIT_L(0); PG8_MMA(0, 1, At, B1); PG8_BAR;
            PG8_LDA(At, 0, 1); PG8_STAGE(PG8_SA(0, 0), a2, voffA);
            PG8_BAR; PG8_WAIT_L(0); PG8_MMA(1, 0, At, B0); PG8_BAR; PG8_SCHED;
            PG8_STAGE(PG8_SB(0, 1), b2 + hstep, voffB);
            PG8_WAIT_V(6); PG8_BAR; PG8_MMA(1, 1, At, B1); PG8_BAR;
            PG8_LDB(B0, 1, 0); PG8_SCHED; PG8_LDA(At, 1, 0); PG8_STAGE(PG8_SA(0, 1), a2 + hstep, voffA);
            PG8_WAIT_L(8); PG8_BAR; PG8_WAIT_L(0); PG8_MMA(0, 0, At, B0); PG8_BAR; PG8_SCHED;
            PG8_LDB(B1, 1, 1); PG8_STAGE(PG8_SB(1, 0), b3, voffB);
            PG8_BAR; PG8_WAIT_L(0); PG8_MMA(0, 1, At, B1); PG8_BAR;
            PG8_LDA(At, 1, 1); PG8_STAGE(PG8_SA(1, 0), a3, voffA);
            PG8_BAR; PG8_WAIT_L(0); PG8_MMA(1, 0, At, B0); PG8_BAR; PG8_SCHED;
            PG8_STAGE(PG8_SB(1, 1), b3 + hstep, voffB);
            PG8_WAIT_V(6); PG8_BAR; PG8_MMA(1, 1, At, B1); PG8_BAR;
            }
        }
        if constexpr (ALIGN_EPI) { if (wr == 0) PG8_BAR; }
        if constexpr (!Epi::AFTER_DRAIN) { E(acc, cur, wr, wc, fr, fq); S.done(cur); }
        if (!has_next) break;
#pragma unroll
        for (int a = 0; a < 2; ++a)
#pragma unroll
            for (int b = 0; b < 2; ++b)
#pragma unroll
                for (int m = 0; m < 4; ++m)
#pragma unroll
                    for (int n = 0; n < 2; ++n) acc[a][b][m][n] = (f32x4){0.f, 0.f, 0.f, 0.f};
        cur = nxt; cA = nA; cB = nB; ++ui;
        if constexpr (ALIGN_EPI) { if (wr == 1) PG8_BAR; }
    }
    PG8_WAIT_V(0);
    if constexpr (!ALIGN_EPI) { if (wr == 0) PG8_BAR; }
    PG8_BAR;
#undef PG8_SA
#undef PG8_SB
#undef PG8_STAGE
#undef PG8_LDA
#undef PG8_LDB
#undef PG8_MMA
#undef PG8_WAIT_V
#undef PG8_WAIT_L
#undef PG8_BAR
#undef PG8_SCHED
}
}

struct Args {
    const float *x, *p, *norm_mix_w, *w_in, *att_rel_bias, *w_gla_gate_up, *b_gla_gate, *gla_norm_w, *w_out, *norm_ffn_w, *w_ffn_up, *w_ffn_conv, *b_ffn_conv, *w_ffn_down,
                *norm_ple_w, *w_ple_gate, *w_ple_proj, *final_norm_w;
    float* out; unsigned char* ws;
};

__device__ __forceinline__ int map_row(int mode, int n) {
    if (mode == 1) { if (n < 2048) return n; if (n < 3072) return n + 2048; if (n < 4096) return n - 1024; if (n < 5120) return n + 1024; return n - 2048; }
    if (mode == 2) { const int half = n >= FF ? 1 : 0; const int c = n - half * FF; return (c >> 7) * 256 + half * 128 + (c & 127); }
    return n;
}
__device__ __forceinline__ void transpose_item(const float* W, int K, int ldn, int nblk, bf16_t* WT, LAS float* scr, int item, int lane, const float* kscale, int mode) {
    const int kb = item / nblk, nb = item % nblk, k0 = 32 * kb, n0 = 128 * nb;
    const int c4 = lane & 31, kh = lane >> 5;
    f32x4 v[16];
#pragma unroll
    for (int i = 0; i < 16; ++i) v[i] = __builtin_nontemporal_load((const f32x4*)(W + (size_t)(k0 + 2 * i + kh) * ldn + n0 + 4 * c4));
#pragma unroll
    for (int i = 0; i < 16; ++i) { f32x4 t = v[i]; if (kscale) t = t * kscale[k0 + 2 * i + kh]; *(LAS f32x4*)(scr + (2 * i + kh) * 132 + 4 * c4) = t; }
    asm volatile("s_waitcnt lgkmcnt(0)" ::: "memory");
    const int c = lane & 3, nl = lane >> 2; const int drow0 = map_row(mode, n0);
#pragma unroll
    for (int j = 0; j < 8; ++j) { const int n = nl + 16 * j; const LAS float* sp = scr + (8 * c) * 132 + n;
        u32x4 o; o.x = pk2(sp[0 * 132], sp[1 * 132]); o.y = pk2(sp[2 * 132], sp[3 * 132]); o.z = pk2(sp[4 * 132], sp[5 * 132]); o.w = pk2(sp[6 * 132], sp[7 * 132]);
        *(u32x4*)(WT + (size_t)(drow0 + n) * K + k0 + 8 * c) = o; }
    asm volatile("s_waitcnt lgkmcnt(0)" ::: "memory");
}

#define XB_TMO      128
#define XB_XCNT(j)  (256  + 64 * (j))
#define XB_XSUB(j)  (1280 + 64 * (j))
#define XB_XGEN(j)  (2304 + 64 * (j))
#define XB_TOP      3328
#define XB_TOPGEN   3392
#define XCD_BAR_WORDS 3456
#define XB_SPIN_CAP (1u << 18)
__device__ __forceinline__ unsigned xb_ld(unsigned* p)              { return __hip_atomic_load(p, __ATOMIC_RELAXED, __HIP_MEMORY_SCOPE_AGENT); }
__device__ __forceinline__ unsigned xb_add(unsigned* p, unsigned v) { return __hip_atomic_fetch_add(p, v, __ATOMIC_RELAXED, __HIP_MEMORY_SCOPE_AGENT); }
__device__ __forceinline__ unsigned xb_xcc_id() { return (unsigned)__builtin_amdgcn_s_getreg((3 << 11) | 20) & 0xFu; }
#define XB_SPIN(cond, bar) do { unsigned _sp = 0; while (cond) { __builtin_amdgcn_s_sleep(1); \
    if ((++_sp & 255u) == 0u) { if (xb_ld(&(bar)[XB_TMO])) break; if (_sp > XB_SPIN_CAP) { atomicAdd(&(bar)[XB_TMO], 1u); break; } } } } while (0)
struct XcdBarrier {
    unsigned* bar; unsigned x;
    volatile LAS unsigned* st;
};
__device__ __forceinline__ XcdBarrier xcd_barrier_post(unsigned* bar, volatile LAS unsigned* st) {
    XcdBarrier b; b.bar = bar; b.x = xb_xcc_id(); b.st = st;
    if (threadIdx.x == 0) (void)xb_add(&bar[XB_XCNT(b.x)], 1u);
    return b;
}
__device__ __forceinline__ void xcd_barrier_complete(unsigned* bar, unsigned x, unsigned& nloc, unsigned& nx) {
    const unsigned G = gridDim.x * gridDim.y * gridDim.z;
    unsigned sum, cnt, mine, sp = 0u;
    for (;;) {
        sum = 0u; cnt = 0u; mine = 0u;
#pragma unroll
        for (unsigned j = 0; j < 16; ++j) { const unsigned c = xb_ld(&bar[XB_XCNT(j)]); sum += c; cnt += (c > 0u) ? 1u : 0u; mine = (j == x) ? c : mine; }
        if (sum == G) break;
        __builtin_amdgcn_s_sleep(1);
        if ((++sp & 255u) == 0u) { if (xb_ld(&bar[XB_TMO])) break; if (sp > XB_SPIN_CAP) { atomicAdd(&bar[XB_TMO], 1u); break; } }
    }
    nloc = mine > 0u ? mine : 1u; nx = cnt > 0u ? cnt : 1u;
}
__device__ __forceinline__ void xcd_barrier(const XcdBarrier& b) {
    asm volatile("s_waitcnt vmcnt(0)" ::: "memory");
    __syncthreads();
    if (threadIdx.x == 0) {
        unsigned* bar = b.bar;
        __builtin_amdgcn_s_waitcnt(0);
        unsigned nloc = b.st[0], nx = b.st[1];
        if (nloc == 0u) { xcd_barrier_complete(bar, b.x, nloc, nx); b.st[0] = nloc; b.st[1] = nx; }
        const unsigned old = xb_add(&bar[XB_XSUB(b.x)], 1u);
        const unsigned gen = old / nloc;
        if (old + 1u == (gen + 1u) * nloc) {
            __builtin_amdgcn_fence(__ATOMIC_RELEASE, "agent");
            asm volatile("s_waitcnt vmcnt(0)" ::: "memory");
            const unsigned og = xb_add(&bar[XB_TOP], 1u);
            const unsigned tg = og / nx;
            if (og + 1u == (tg + 1u) * nx) xb_add(&bar[XB_TOPGEN], 1u);
            else XB_SPIN(xb_ld(&bar[XB_TOPGEN]) == tg, bar);
            __builtin_amdgcn_fence(__ATOMIC_ACQUIRE, "agent");
            xb_add(&bar[XB_XGEN(b.x)], 1u);
            asm volatile("s_waitcnt vmcnt(0)" ::: "memory");
        } else {
            XB_SPIN(xb_ld(&bar[XB_XGEN(b.x)]) == gen, bar);
            __builtin_amdgcn_fence(__ATOMIC_ACQUIRE, "agent");
            asm volatile("s_waitcnt vmcnt(0)" ::: "memory");
        }
    }
    __syncthreads();
}

__device__ __forceinline__ void gla_decay(const Args& a, const float* glr, int n, int hg, int tid, LAS float* gL, LAS float* segtot, float (&bv)[16], float& blast) {
    const int dk = tid & 127, seg = tid >> 7, col = hg * 128 + dk;
    if (tid < 256) ((LAS f32x4*)gL)[tid] = ((const f32x4*)(glr + (size_t)n * 64 * 16))[tid];
    float w[16];
#pragma unroll
    for (int j = 0; j < 16; ++j) w[j] = a.w_gla_gate_up[j * 512 + col];
    const float bias = a.b_gla_gate[col];
    __syncthreads();
    float c = 0.f;
#pragma unroll
    for (int s = 0; s < 16; ++s) { const LAS f32x4* g4 = (const LAS f32x4*)(gL + (16 * seg + s) * 16); float logit = bias;
#pragma unroll
        for (int q = 0; q < 4; ++q) { const f32x4 g = g4[q]; logit += g[0] * w[4 * q] + g[1] * w[4 * q + 1] + g[2] * w[4 * q + 2] + g[3] * w[4 * q + 3]; }
        const float ls = fminf(logit, 0.f) - log1pf(__expf(-fabsf(logit)));
        c += ls * (1.0f / 16.0f); bv[s] = c; if ((s & 3) == 3) asm volatile("" ::: "memory"); }
    segtot[seg * 128 + dk] = c;
    __syncthreads();
    float off = 0.f, tot = 0.f;
#pragma unroll
    for (int q = 0; q < 4; ++q) { const float v = segtot[q * 128 + dk]; tot += v; if (q < seg) off += v; }
#pragma unroll
    for (int s = 0; s < 16; ++s) bv[s] += off;
    blast = tot;
}

#define LBAR() do { asm volatile("s_waitcnt lgkmcnt(0)" ::: "memory"); __builtin_amdgcn_s_barrier(); asm volatile("" ::: "memory"); } while (0)
#define STAMP(k) do { if (PROBE_T != 0 && blockIdx.x == 0 && threadIdx.x == 0) ((unsigned long long*)(a.ws + 200 * 1024))[k] = __builtin_amdgcn_s_memrealtime(); } while (0)
#define IDS() int tid = threadIdx.x; asm volatile("" : "+v"(tid)); const int lane = tid & 63, wave = __builtin_amdgcn_readfirstlane(tid >> 6); const int gw = bx * 8 + wave, gtid = bx * 512 + tid; (void)lane; (void)gw; (void)gtid;
__global__ void __launch_bounds__(512, 2) fwd_megakernel(Args a) {
    extern __shared__ __attribute__((aligned(16))) unsigned char lds_raw[];
    cg::grid_group grid = cg::this_grid();
    LAS unsigned char* lds = (LAS unsigned char*)lds_raw;
    const int tid = threadIdx.x, lane = tid & 63, wave = __builtin_amdgcn_readfirstlane(tid >> 6);
    const int G = gridDim.x, bx = blockIdx.x;
    const int gw = bx * 8 + wave, NGW = G * 8;
    const int gtid = bx * 512 + tid, NT = G * 512;
    unsigned char* ws = a.ws;
    float* ssq1 = (float*)(ws + WS_SSQ1); float* ssq2 = (float*)(ws + WS_SSQ2); float* ssq3 = (float*)(ws + WS_SSQ3);
    float* glr = (float*)(ws + WS_GLR); float* glr1 = (float*)(ws + WS_GLR1); float* decb = (float*)(ws + WS_DEC); float* bcum = (float*)(ws + WS_BCUM); bf16_t* upd = (bf16_t*)(ws + WS_UPD);
    bf16_t* WgT = (bf16_t*)(ws + WS_WG); bf16_t* WppT = (bf16_t*)(ws + WS_WPP); bf16_t* WinT = (bf16_t*)(ws + WS_WIN); bf16_t* WoutT = (bf16_t*)(ws + WS_WOUT);
    bf16_t* WupT = (bf16_t*)(ws + WS_WUP); bf16_t* WdnT = (bf16_t*)(ws + WS_WDN); bf16_t* WpgT = (bf16_t*)(ws + WS_WPG); bf16_t* pb = (bf16_t*)(ws + WS_PB);
    bf16_t* h0 = (bf16_t*)(ws + WS_H0); bf16_t* projR = (bf16_t*)(ws + WS_PROJ); bf16_t* vT = (bf16_t*)(ws + WS_VT);
    bf16_t* ycat = (bf16_t*)a.out;
    float* rstd0 = (float*)(ws + WS_RSTD0); bf16_t* x1b = (bf16_t*)(ws + WS_X1B); bf16_t* gbuf = (bf16_t*)(ws + WS_G);
    bf16_t* tailb = (bf16_t*)(ws + WS_TAIL); bf16_t* headb = (bf16_t*)(ws + WS_HEAD); bf16_t* ppb = (bf16_t*)(ws + WS_PP); bf16_t* x2b = (bf16_t*)(ws + WS_X2B); bf16_t* x3b = (bf16_t*)(ws + WS_X3B);

    volatile LAS unsigned* bst = (volatile LAS unsigned*)(lds + LDS_BYTES - 64);
    if (threadIdx.x < 16) bst[threadIdx.x] = 0u;
    unsigned* barw = (unsigned*)(ws + WS_BAR);
    __syncthreads();
    const XcdBarrier xbar = xcd_barrier_post(barw, bst);
    if (a.out == nullptr) grid.sync();
    STAMP(0);
    REPS(1) {
        LAS float* scr = (LAS float*)(lds + wave * 16896);
        constexpr int I_IN = 64 * 48, I_OUT = 64 * 16, I_UP = 64 * 88, I_DN = 176 * 16, I_PG = 64 * 16, I_PP = 8 * 16;
        constexpr int NITEMS = I_IN + I_OUT + I_UP + I_DN + I_PG + I_PP;
        for (int it = gw; it < NITEMS; it += NGW) {
            int r = it;
            if (r < I_IN) { transpose_item(a.w_in, 2048, 6160, 48, WinT, scr, r, lane, a.norm_mix_w, 1); continue; } r -= I_IN;
            if (r < I_OUT) { transpose_item(a.w_out, 2048, 2048, 16, WoutT, scr, r, lane, nullptr, 0); continue; } r -= I_OUT;
            if (r < I_UP) { transpose_item(a.w_ffn_up, 2048, 2 * FF, 88, WupT, scr, r, lane, a.norm_ffn_w, 2); continue; } r -= I_UP;
            if (r < I_DN) { transpose_item(a.w_ffn_down, FF, 2048, 16, WdnT, scr, r, lane, nullptr, 0); continue; } r -= I_DN;
            if (r < I_PG) { transpose_item(a.w_ple_gate, 2048, 2048, 16, WpgT, scr, r, lane, a.norm_ple_w, 0); continue; } r -= I_PG;
            transpose_item(a.w_ple_proj, PLE, 2048, 16, WppT, scr, r, lane, nullptr, 0);
        }
        for (int i = gtid; i < 16 * 2048; i += NT) { const int j = i >> 11, k = i & 2047; WgT[i] = (bf16_t)f2bf(a.w_in[(size_t)k * 6160 + 6144 + j] * a.norm_mix_w[k]); }
        for (int m = gw; m < T; m += 2 * NGW) {
            const int m1 = m + NGW; const bool two = m1 < T;
            const f32x4* xr0 = (const f32x4*)(a.x + (size_t)m * D) + lane; const f32x4* xr1 = (const f32x4*)(a.x + (size_t)(two ? m1 : m) * D) + lane;
            f32x4 v0[8], v1[8]; float s0 = 0.f, s1 = 0.f;
#pragma unroll
            for (int j = 0; j < 8; ++j) { v0[j] = __builtin_nontemporal_load(xr0 + 64 * j); v1[j] = __builtin_nontemporal_load(xr1 + 64 * j); }
            u32x2* o0 = (u32x2*)(h0 + (size_t)m * D) + lane; u32x2* o1 = (u32x2*)(h0 + (size_t)m1 * D) + lane;
#pragma unroll
            for (int j = 0; j < 8; ++j) { s0 += (v0[j].x * v0[j].x + v0[j].y * v0[j].y) + (v0[j].z * v0[j].z + v0[j].w * v0[j].w); s1 += (v1[j].x * v1[j].x + v1[j].y * v1[j].y) + (v1[j].z * v1[j].z + v1[j].w * v1[j].w);
                u32x2 o; o.x = pk2(v0[j].x, v0[j].y); o.y = pk2(v0[j].z, v0[j].w); o0[64 * j] = o;
                if (two) { u32x2 q; q.x = pk2(v1[j].x, v1[j].y); q.y = pk2(v1[j].z, v1[j].w); o1[64 * j] = q; } }
            s0 = wave_sum(s0); s1 = wave_sum(s1);
            if (lane == 0) { rstd0[m] = frsq(s0 * (1.0f / D) + EPS); if (two) rstd0[m1] = frsq(s1 * (1.0f / D) + EPS); }
        }
        for (int i = gtid; i < T * PLE / 4; i += NT) { const f32x4 v = __builtin_nontemporal_load((const f32x4*)a.p + i); u32x2 o; o.x = pk2(v.x, v.y); o.y = pk2(v.z, v.w); ((u32x2*)pb)[i] = o; }
        for (int i = gtid; i < 3 * T; i += NT) ssq1[i] = 0.f;
    }
    if (PROBE_T != 0) { asm volatile("s_waitcnt vmcnt(0)" ::: "memory"); }
    xcd_barrier(xbar);
    STAMP(1);

    REPS(2) {
        IDS();
        for (int task = gw; task < 2 * (T / 16); task += NGW) {
            const int fr = lane & 15, fq = lane >> 4; const int r0 = (task >> 1) * 16, kh = (task & 1) * (D / 2);
            const bf16_t* ap = h0 + (size_t)(r0 + fr) * D + kh + 8 * fq; const bf16_t* bp = WgT + (size_t)fr * D + kh + 8 * fq;
            f32x4 acc = {0.f, 0.f, 0.f, 0.f};
#pragma unroll 8
            for (int k0 = 0; k0 < D / 2; k0 += 32) { const bf16x8 av = *(const bf16x8*)(ap + k0), bv = *(const bf16x8*)(bp + k0); acc = __builtin_amdgcn_mfma_f32_16x16x32_bf16(av, bv, acc, 0, 0, 0); }
            float* gp = (task & 1) ? glr1 : glr;
#pragma unroll
            for (int j = 0; j < 4; ++j) gp[(size_t)(r0 + 4 * fq + j) * 16 + fr] = acc[j] * rstd0[r0 + 4 * fq + j];
        }
        __syncthreads();
        { pg8::Gemm g{h0, WinT, T, NR, D}; pg8::StaticOrder S; S.init(T, NR, G, bx, WGM_P1R); pg8::EpiBf16 E{projR, NR, rstd0, nullptr};
          pg8::gemm_phase<pg8::EpiBf16, pg8::StaticOrder, true, true>(lds, g, S, E); }
        { pg8::Gemm g{WinT + (size_t)NR * D, h0, 2048, T, D}; pg8::StaticOrder S; S.init(2048, T, G, bx, WGM_P1T); pg8::EpiBf16 E{vT, T, nullptr, rstd0};
          pg8::gemm_phase<pg8::EpiBf16, pg8::StaticOrder, true, true>(lds, g, S, E); }
    }
    xcd_barrier(xbar);
    STAMP(2);

    REPS(3) {
        IDS();
        LAS float* gL = (LAS float*)lds; LAS float* segtot = (LAS float*)(lds + 4096); LAS bf16_t* kT = (LAS bf16_t*)(lds + 8192);
        const int fr = lane & 15, fq = lane >> 4, dk = tid & 127, seg = tid >> 7;
        f32x4 g4r = {0.f, 0.f, 0.f, 0.f}; unsigned short kraw[16]; bf16x8 vB[2][2], vBn[2][2];
#define G1_LOAD(u_, VB) do { const int n_ = (u_) >> 2, hg_ = (u_) & 3; if (tid < 256) g4r = ((const f32x4*)(glr + (size_t)n_ * 64 * 16))[tid] + ((const f32x4*)(glr1 + (size_t)n_ * 64 * 16))[tid]; \
            _Pragma("unroll") for (int s = 0; s < 16; ++s) kraw[s] = projR[((size_t)n_ * 64 + 16 * seg + s) * NR + KG + hg_ * 128 + dk]; \
            _Pragma("unroll") for (int nt2 = 0; nt2 < 2; ++nt2) _Pragma("unroll") for (int ks = 0; ks < 2; ++ks) VB[nt2][ks] = *(const bf16x8*)(vT + (size_t)(1024 + hg_ * 256 + 16 * (2 * wave + nt2) + fr) * T + n_ * 64 + 32 * ks + 8 * fq); } while (0)
        if (bx < NCH * 4) G1_LOAD(bx, vB);
        for (int unit = bx; unit < NCH * 4; unit += G) {
            const int n = unit >> 2, hg = unit & 3, col = hg * 128 + dk;
            float w[16];
#pragma unroll
            for (int j = 0; j < 16; ++j) w[j] = a.w_gla_gate_up[j * 512 + col];
            const float bias = a.b_gla_gate[col];
            if (tid < 256) ((LAS f32x4*)gL)[tid] = g4r;
            LBAR();
            float bv[16]; float c = 0.f;
#pragma unroll
            for (int s = 0; s < 16; ++s) { const LAS f32x4* g4 = (const LAS f32x4*)(gL + (16 * seg + s) * 16); float logit = bias;
#pragma unroll
                for (int q = 0; q < 4; ++q) { const f32x4 g = g4[q]; logit += g[0] * w[4 * q] + g[1] * w[4 * q + 1] + g[2] * w[4 * q + 2] + g[3] * w[4 * q + 3]; }
                const float ls = fminf(logit, 0.f) - __logf(1.0f + __expf(-fabsf(logit)));
                c += ls * (1.0f / 16.0f); bv[s] = c; if ((s & 3) == 3) asm volatile("" ::: "memory"); }
            segtot[seg * 128 + dk] = c;
            LBAR();
            float off = 0.f, blast = 0.f;
#pragma unroll
            for (int q = 0; q < 4; ++q) { const float v = segtot[q * 128 + dk]; blast += v; if (q < seg) off += v; }
            unsigned kw[8];
#pragma unroll
            for (int s = 0; s < 16; s += 2) { const float b0 = bv[s] + off, b1 = bv[s + 1] + off; const size_t t = (size_t)n * 64 + 16 * seg + s;
                bcum[t * 512 + col] = b0; bcum[(t + 1) * 512 + col] = b1;
                kw[s >> 1] = pk2(bf2f(kraw[s]) * __expf(blast - b0), bf2f(kraw[s + 1]) * __expf(blast - b1)); }
            *(LAS u32x4*)(kT + dk * 72 + 16 * seg) = (u32x4){kw[0], kw[1], kw[2], kw[3]}; *(LAS u32x4*)(kT + dk * 72 + 16 * seg + 8) = (u32x4){kw[4], kw[5], kw[6], kw[7]};
            if (seg == 0) decb[(size_t)unit * 128 + dk] = __expf(blast);
            LBAR();
            if (unit + G < NCH * 4) G1_LOAD(unit + G, vBn);
            f32x4 acc[8][2];
#pragma unroll
            for (int mt = 0; mt < 8; ++mt) { acc[mt][0] = (f32x4){0.f, 0.f, 0.f, 0.f}; acc[mt][1] = (f32x4){0.f, 0.f, 0.f, 0.f}; }
#pragma unroll
            for (int mt = 0; mt < 8; ++mt)
#pragma unroll
                for (int ks = 0; ks < 2; ++ks) { const bf16x8 ak = *(const LAS bf16x8*)(kT + (16 * mt + fr) * 72 + 32 * ks + 8 * fq);
                    acc[mt][0] = __builtin_amdgcn_mfma_f32_16x16x32_bf16(ak, vB[0][ks], acc[mt][0], 0, 0, 0);
                    acc[mt][1] = __builtin_amdgcn_mfma_f32_16x16x32_bf16(ak, vB[1][ks], acc[mt][1], 0, 0, 0); }
            { LAS unsigned char* ust = lds + 32768 + wave * 8704;
#pragma unroll
              for (int mt = 0; mt < 8; ++mt)
#pragma unroll
                for (int nt2 = 0; nt2 < 2; ++nt2) { u32x2 wv; wv.x = pk2(acc[mt][nt2][0], acc[mt][nt2][1]); wv.y = pk2(acc[mt][nt2][2], acc[mt][nt2][3]);
                    *(LAS u32x2*)(ust + (16 * nt2 + fr) * 272 + (16 * mt + 4 * fq) * 2) = wv; }
              asm volatile("s_waitcnt lgkmcnt(0)" ::: "memory"); __builtin_amdgcn_wave_barrier();
#pragma unroll
              for (int j = 0; j < 8; ++j) { const int p = lane + 64 * j, row = p >> 4, sg = p & 15;
                  const u32x4 w4 = *(const LAS u32x4*)(ust + row * 272 + sg * 16);
                  *(u32x4*)(upd + (size_t)unit * 32768 + (32 * wave + row) * 128 + 8 * sg) = w4; }
              asm volatile("s_waitcnt lgkmcnt(0)" ::: "memory"); __builtin_amdgcn_wave_barrier(); }
#pragma unroll
            for (int nt2 = 0; nt2 < 2; ++nt2)
#pragma unroll
                for (int ks = 0; ks < 2; ++ks) vB[nt2][ks] = vBn[nt2][ks];
        }
#undef G1_LOAD
    }
    xcd_barrier(xbar);
    STAMP(3);

    { IDS();
    for (int g2 = bx * 256 + tid; tid < 256 && g2 < 4 * 16384; g2 += G * 256) {
        const int hg = g2 >> 14, rem = (g2 & 16383) * 2, dk = rem & 127;
        unsigned* p = (unsigned*)(upd + (size_t)hg * 32768 + rem); const f32x2* dp = (const f32x2*)(decb + hg * 128 + dk);
        float S0 = 0.f, S1 = 0.f;
        unsigned ua[16], ub[16]; f32x2 da[16], db[16];
#define SCAN_LOAD(U, Dd, n0) do { _Pragma("unroll") for (int k = 0; k < 16; ++k) { U[k] = p[(size_t)((n0) + k) * 65536]; Dd[k] = dp[((n0) + k) * 256]; } } while (0)
#define SCAN_STEP(U, Dd, n0) do { _Pragma("unroll") for (int k = 0; k < 16; ++k) { p[(size_t)((n0) + k) * 65536] = pk2(S0, S1); S0 = Dd[k].x * S0 + bflo(U[k]); S1 = Dd[k].y * S1 + bfhi(U[k]); } } while (0)
        SCAN_LOAD(ua, da, 0);
        for (int n = 0; n < NCH; n += 32) {
            SCAN_LOAD(ub, db, n + 16);
            SCAN_STEP(ua, da, n);
            if (n + 32 < NCH) SCAN_LOAD(ua, da, n + 32);
            SCAN_STEP(ub, db, n + 16);
        }
#undef SCAN_LOAD
#undef SCAN_STEP
    } }
    if (PROBE_T != 0) { asm volatile("s_waitcnt vmcnt(0)" ::: "memory"); grid.sync(); STAMP(12); }
    {
        IDS();
        constexpr int CHB = 18432, BUFB = 3 * CHB;
        LAS unsigned char* kvb = lds; LAS float* bt = (LAS float*)(lds + 2 * BUFB);
        const int fr = lane & 15, fq = lane >> 4, hl = wave >> 2, qt = wave & 3;
        constexpr float LOG2E = 1.4426950408889634f;
        const int prow = (tid >> 3) & 63, pseg = tid & 7, pofs = prow * 144 + pseg * 16;
#define ATT_LOADK(cc, hpp, g) do { _Pragma("unroll") for (int q3 = 0; q3 < 3; ++q3) { const int kc_ = ((cc) - 8 + 3 * (g) + q3) < 0 ? 0 : ((cc) - 8 + 3 * (g) + q3); _Pragma("unroll") for (int r = 0; r < 2; ++r) \
            pre[q3][r] = *(const u32x4*)(projR + (size_t)(kc_ * 64 + prow) * NR + KA + 64 * (2 * (hpp) + r) + 8 * pseg); } } while (0)
#define ATT_LOADV(cc, hpp, g) do { _Pragma("unroll") for (int q3 = 0; q3 < 3; ++q3) { const int kc_ = ((cc) - 8 + 3 * (g) + q3) < 0 ? 0 : ((cc) - 8 + 3 * (g) + q3); _Pragma("unroll") for (int r = 0; r < 2; ++r) \
            pre[q3][r] = *(const u32x4*)(vT + (size_t)(64 * (2 * (hpp) + r) + prow) * T + kc_ * 64 + 8 * pseg); } } while (0)
#define ATT_WRITE(buf) do { _Pragma("unroll") for (int q3 = 0; q3 < 3; ++q3) _Pragma("unroll") for (int r = 0; r < 2; ++r) *(LAS u32x4*)(kvb + (buf) * BUFB + q3 * CHB + r * 9216 + pofs) = pre[q3][r]; } while (0)
#define ATT_LOADQ(cc, hpp) do { _Pragma("unroll") for (int ks = 0; ks < 2; ++ks) qn[ks] = *(const bf16x8*)(projR + (size_t)(64 * (cc) + 16 * qt + fr) * NR + QA + 64 * (2 * (hpp) + hl) + 32 * ks + 8 * fq); } while (0)
        const int NU = NCH * 8 * (PROBE_DUP == 4 ? 2 : 1);
        u32x4 pre[3][2]; bf16x8 qn[2]; int hp_tab = -1;
        if (bx < NU) { const int c0 = (bx >> 3) & (NCH - 1), hp0 = bx & 7; ATT_LOADQ(c0, hp0); ATT_LOADK(c0, hp0, 0); ATT_WRITE(0); }
        for (int unit = bx; unit < NU; unit += G) {
            const int c = (unit >> 3) & (NCH - 1), hp = unit & 7, h = 2 * hp + hl;
            const int un = unit + G, cn = (un >> 3) & (NCH - 1), hpn = un & 7;
            if (hp != hp_tab) { for (int i = tid; i < 1026; i += 512) { const int hh = i >= 513 ? 1 : 0; bt[hh * 516 + (i - hh * 513)] = a.att_rel_bias[(2 * hp + hh) * 513 + (i - hh * 513)] * LOG2E; } hp_tab = hp; }
            const bf16x8 qv0 = qn[0], qv1 = qn[1];
            LBAR();
            f32x4 S[36];
            const LAS float* btl = bt + hl * 516 + 256; const int relb = 16 * qt + fr + 512 - 4 * fq;
            const float b512 = btl[256];
#pragma unroll
            for (int g = 0; g < 3; ++g) {
                if (g < 2) ATT_LOADK(c, hp, g + 1); else ATT_LOADV(c, hp, 0);
#pragma unroll
                for (int q3 = 0; q3 < 3; ++q3) { const int j = 3 * g + q3;
#pragma unroll
                    for (int kt4 = 0; kt4 < 4; ++kt4) { f32x4 acc = {0.f, 0.f, 0.f, 0.f};
                        const LAS unsigned char* kp = kvb + (g & 1) * BUFB + q3 * CHB + hl * 9216 + (16 * kt4 + fr) * 144 + 16 * fq;
                        acc = __builtin_amdgcn_mfma_f32_16x16x32_bf16(*(const LAS bf16x8*)kp, qv0, acc, 0, 0, 0);
                        acc = __builtin_amdgcn_mfma_f32_16x16x32_bf16(*(const LAS bf16x8*)(kp + 64), qv1, acc, 0, 0, 0);
#pragma unroll
                        for (int jj = 0; jj < 4; ++jj) { float bias = b512;
                            if (j == 4) { int rel = relb - (64 * j + 16 * kt4 + jj); rel = rel > 256 ? 256 : rel; bias = btl[rel]; }
                            else if (j > 4) bias = btl[relb - (64 * j + 16 * kt4 + jj)];
                            acc[jj] = acc[jj] * (0.125f * LOG2E) + bias; }
                        S[4 * j + kt4] = acc; }
                    __builtin_amdgcn_sched_barrier(0); }
                ATT_WRITE((g + 1) & 1);
                LBAR();
            }
            if (c < 8) {
#pragma unroll
                for (int j = 0; j < 8; ++j) if (j < 8 - c) {
#pragma unroll
                    for (int kt4 = 0; kt4 < 4; ++kt4) S[4 * j + kt4] = (f32x4){-1e30f, -1e30f, -1e30f, -1e30f}; } }
            float mx = -1e30f;
#pragma unroll
            for (int i = 0; i < 36; ++i) mx = fmaxf(mx, fmaxf(fmaxf(S[i][0], S[i][1]), fmaxf(S[i][2], S[i][3])));
            mx = fmaxf(mx, __shfl_xor(mx, 16)); mx = fmaxf(mx, __shfl_xor(mx, 32));
            f32x2 l2 = {0.f, 0.f};
            u32x2 PW[36];
#pragma unroll
            for (int i = 0; i < 36; ++i) { const f32x4 d = S[i] - mx; const float p0 = __builtin_amdgcn_exp2f(d[0]), p1 = __builtin_amdgcn_exp2f(d[1]), p2 = __builtin_amdgcn_exp2f(d[2]), p3 = __builtin_amdgcn_exp2f(d[3]);
                l2 = l2 + (f32x2){p0, p1}; l2 = l2 + (f32x2){p2, p3}; PW[i].x = pg8::cvt_pk_bf16(p0, p1); PW[i].y = pg8::cvt_pk_bf16(p2, p3); asm volatile("" : "+v"(PW[i].x), "+v"(PW[i].y));
                if ((i & 3) == 3) __builtin_amdgcn_sched_barrier(0); }
            float l = l2[0] + l2[1];
            l += __shfl_xor(l, 16); l += __shfl_xor(l, 32);
            f32x4 O[4];
#pragma unroll
            for (int dt = 0; dt < 4; ++dt) O[dt] = (f32x4){0.f, 0.f, 0.f, 0.f};
            if (un < NU) ATT_LOADQ(cn, hpn);
#pragma unroll
            for (int g = 0; g < 3; ++g) {
                if (g < 2) ATT_LOADV(c, hp, g + 1); else if (un < NU) ATT_LOADK(cn, hpn, 0);
                const int buf = (3 + g) & 1;
#pragma unroll
                for (int q3 = 0; q3 < 3; ++q3) { const int j = 3 * g + q3;
#pragma unroll
                    for (int a2 = 0; a2 < 2; ++a2) { const u32x4 pw = {PW[4 * j + 2 * a2].x, PW[4 * j + 2 * a2].y, PW[4 * j + 2 * a2 + 1].x, PW[4 * j + 2 * a2 + 1].y};
                        const bf16x8 pa = __builtin_bit_cast(bf16x8, pw);
#pragma unroll
                        for (int dt = 0; dt < 4; ++dt) { const LAS unsigned char* vp = kvb + buf * BUFB + q3 * CHB + hl * 9216 + (16 * dt + fr) * 144 + (32 * a2 + 4 * fq) * 2;
                            const u32x2 lo = *(const LAS u32x2*)vp, hi = *(const LAS u32x2*)(vp + 32);
                            const u32x4 vw = {lo.x, lo.y, hi.x, hi.y};
                            O[dt] = __builtin_amdgcn_mfma_f32_16x16x32_bf16(pa, __builtin_bit_cast(bf16x8, vw), O[dt], 0, 0, 0); } } }
                if (g < 2 || un < NU) ATT_WRITE((3 + g + 1) & 1);
                if (g < 2) LBAR();
            }
#pragma unroll
            for (int jj = 0; jj < 4; ++jj) { const float linv = 1.0f / __shfl(l, 4 * fq + jj); const size_t t = (size_t)64 * c + 16 * qt + 4 * fq + jj;
#pragma unroll
                for (int dt = 0; dt < 4; ++dt) ycat[t * D + 64 * h + 16 * dt + fr] = (bf16_t)f2bf(O[dt][jj] * linv); }
        }
#undef ATT_LOADK
#undef ATT_LOADV
#undef ATT_WRITE
#undef ATT_LOADQ
    }
    xcd_barrier(xbar);
    STAMP(4);

    REPS(5) {
        IDS();
        LAS float* red = (LAS float*)(lds + 6144);
        LAS bf16_t* qd = (LAS bf16_t*)(lds + 8192); LAS bf16_t* ki = (LAS bf16_t*)(lds + 25600); LAS bf16_t* aL = (LAS bf16_t*)(lds + 43008);
        const int fr = lane & 15, fq = lane >> 4, dk = tid & 127, seg = tid >> 7;
        f32x4 braw[2][2]; u32x2 qraw[2][2], kraw[2][2];
        const int pi = tid >> 4, pg = tid & 15;
#define G3_LOAD(u_) do { const int n_ = (u_) >> 2, hg_ = (u_) & 3; _Pragma("unroll") for (int r = 0; r < 2; ++r) { const size_t t_ = (size_t)n_ * 64 + pi + 32 * r; \
            _Pragma("unroll") for (int g2 = 0; g2 < 2; ++g2) { braw[r][g2] = *(const f32x4*)(bcum + t_ * 512 + hg_ * 128 + 64 * g2 + 4 * pg); \
            qraw[r][g2] = *(const u32x2*)(projR + t_ * NR + QG + hg_ * 128 + 64 * g2 + 4 * pg); kraw[r][g2] = *(const u32x2*)(projR + t_ * NR + KG + hg_ * 128 + 64 * g2 + 4 * pg); } } } while (0)
        if (bx < NCH * 4) G3_LOAD(bx);
        for (int unit = bx; unit < NCH * 4; unit += G) {
            const int n = unit >> 2, hg = unit & 3;
            bf16x8 vB[2][2], sB[2][4];
#pragma unroll
            for (int nt2 = 0; nt2 < 2; ++nt2) { const int dvv = 16 * (2 * wave + nt2) + fr;
#pragma unroll
                for (int ks = 0; ks < 2; ++ks) vB[nt2][ks] = *(const bf16x8*)(vT + (size_t)(1024 + hg * 256 + dvv) * T + n * 64 + 32 * ks + 8 * fq);
#pragma unroll
                for (int ks = 0; ks < 4; ++ks) sB[nt2][ks] = *(const bf16x8*)(upd + (size_t)unit * 32768 + dvv * 128 + 32 * ks + 8 * fq); }
#pragma unroll
            for (int r = 0; r < 2; ++r) { const int i = pi + 32 * r;
#pragma unroll
                for (int g2 = 0; g2 < 2; ++g2) { u32x2 qo, ko;
#pragma unroll
                    for (int e = 0; e < 2; ++e) { const float b0 = braw[r][g2][2 * e], b1 = braw[r][g2][2 * e + 1];
                        qo[e] = pk2(bflo(qraw[r][g2][e]) * 0.08838834764831845f * __expf(b0), bfhi(qraw[r][g2][e]) * 0.08838834764831845f * __expf(b1));
                        ko[e] = pk2(bflo(kraw[r][g2][e]) * __expf(-b0), bfhi(kraw[r][g2][e]) * __expf(-b1)); }
                    *(LAS u32x2*)(qd + i * 136 + 64 * g2 + 4 * pg) = qo; *(LAS u32x2*)(ki + i * 136 + 64 * g2 + 4 * pg) = ko; } }
            LBAR();
            if (unit + G < NCH * 4) G3_LOAD(unit + G);
#pragma unroll
            for (int rep = 0; rep < 2; ++rep) { const int idx = wave + 8 * rep, it = idx >> 2, jt = idx & 3;
                f32x4 c = {0.f, 0.f, 0.f, 0.f};
                if (jt <= it) {
#pragma unroll
                    for (int ks = 0; ks < 4; ++ks) { const bf16x8 av = *(const LAS bf16x8*)(qd + (16 * it + fr) * 136 + 32 * ks + 8 * fq), bv8 = *(const LAS bf16x8*)(ki + (16 * jt + fr) * 136 + 32 * ks + 8 * fq);
                        c = __builtin_amdgcn_mfma_f32_16x16x32_bf16(av, bv8, c, 0, 0, 0); } }
#pragma unroll
                for (int jj = 0; jj < 4; ++jj) { const int i = 16 * it + 4 * fq + jj, j = 16 * jt + fr; aL[i * 72 + j] = (bf16_t)f2bf(j <= i ? c[jj] : 0.f); } }
            LBAR();
            unsigned short rr[4][4][2];
#pragma unroll
            for (int mt = 0; mt < 4; ++mt)
#pragma unroll
                for (int jj = 0; jj < 4; ++jj)
#pragma unroll
                    for (int nt2 = 0; nt2 < 2; ++nt2) rr[mt][jj][nt2] = projR[((size_t)n * 64 + 16 * mt + 4 * fq + jj) * NR + RG + hg * 256 + 16 * (2 * wave + nt2) + fr];
            f32x4 acc[4][2];
#pragma unroll
            for (int mt = 0; mt < 4; ++mt) { acc[mt][0] = (f32x4){0.f, 0.f, 0.f, 0.f}; acc[mt][1] = (f32x4){0.f, 0.f, 0.f, 0.f}; }
#pragma unroll
            for (int nt2 = 0; nt2 < 2; ++nt2)
#pragma unroll
                for (int mt = 0; mt < 4; ++mt) {
#pragma unroll
                    for (int ks = 0; ks < 2; ++ks) acc[mt][nt2] = __builtin_amdgcn_mfma_f32_16x16x32_bf16(*(const LAS bf16x8*)(aL + (16 * mt + fr) * 72 + 32 * ks + 8 * fq), vB[nt2][ks], acc[mt][nt2], 0, 0, 0);
#pragma unroll
                    for (int ks = 0; ks < 4; ++ks) acc[mt][nt2] = __builtin_amdgcn_mfma_f32_16x16x32_bf16(*(const LAS bf16x8*)(qd + (16 * mt + fr) * 136 + 32 * ks + 8 * fq), sB[nt2][ks], acc[mt][nt2], 0, 0, 0); }
#pragma unroll
            for (int mt = 0; mt < 4; ++mt)
#pragma unroll
                for (int jj = 0; jj < 4; ++jj) { float p = acc[mt][0][jj] * acc[mt][0][jj] + acc[mt][1][jj] * acc[mt][1][jj];
                    p += __shfl_xor(p, 1); p += __shfl_xor(p, 2); p += __shfl_xor(p, 4); p += __shfl_xor(p, 8);
                    if (fr == 0) red[wave * 64 + 16 * mt + 4 * fq + jj] = p; }
            LBAR();
            const float gw0 = a.gla_norm_w[16 * (2 * wave) + fr], gw1 = a.gla_norm_w[16 * (2 * wave + 1) + fr];
#pragma unroll
            for (int mt = 0; mt < 4; ++mt)
#pragma unroll
                for (int jj = 0; jj < 4; ++jj) { const int i = 16 * mt + 4 * fq + jj; float ss = 0.f;
#pragma unroll
                    for (int w8 = 0; w8 < 8; ++w8) ss += red[w8 * 64 + i];
                    const float rstd = frsq(ss * (1.0f / 256.0f) + EPS); const size_t t = (size_t)n * 64 + i;
#pragma unroll
                    for (int nt2 = 0; nt2 < 2; ++nt2) { const int dvv = 16 * (2 * wave + nt2) + fr;
                        const float r = bf2f(rr[mt][jj][nt2]);
                        const float y = acc[mt][nt2][jj] * rstd * (nt2 ? gw1 : gw0) * (r * fsigmoid(r));
                        ycat[t * D + 1024 + hg * 256 + dvv] = (bf16_t)f2bf(y); } }
        }
#undef G3_LOAD
    }
    xcd_barrier(xbar);
    STAMP(5);

    { pg8::Gemm g{ycat, WoutT, T, D, D}; pg8::StaticOrder S; S.init(T, D, G, bx, WGM_P5); pg8::EpiResid<true> E{h0, x1b, ssq1};
      pg8::gemm_phase<pg8::EpiResid<true>, pg8::StaticOrder, true, true>(lds, g, S, E); }
    xcd_barrier(xbar);
    STAMP(6);

#ifndef NO_UP
    REPS(6) { pg8::Gemm g{x1b, WupT, T, 2 * FF, D}; pg8::StaticOrder S; S.init(T, 2 * FF, G, bx, WGM_P6); pg8::EpiUp E{gbuf, ssq1, a.w_ffn_conv, a.b_ffn_conv, tailb, headb};
      pg8::gemm_phase<pg8::EpiUp, pg8::StaticOrder, true, true>(lds, g, S, E); }
#endif
    xcd_barrier(xbar);
    STAMP(7);

    { IDS();
    for (int i = gtid; i < NCH * 2 * (FF / 4); i += NT) {
        const int c4 = i % (FF / 4), gj = i / (FF / 4), j = gj & 1, grp = gj >> 1; const int row = grp * 64 + j, C = 4 * c4;
        const bf16_t* tl = tailb + (size_t)(grp - 1) * 2 * (2 * FF); const bf16_t* hd = headb + (size_t)grp * 2 * (2 * FF);
        const f32x4 z = {0.f, 0.f, 0.f, 0.f};
#define LD4(p_) ({ const u32x2 w_ = *(const u32x2*)(p_); (f32x4){bflo(w_.x), bfhi(w_.x), bflo(w_.y), bfhi(w_.y)}; })
        f32x4 ug0, uv0, ug1, uv1, ug2, uv2;
        if (j == 0) { ug0 = grp ? LD4(tl + C) : z; uv0 = grp ? LD4(tl + FF + C) : z; ug1 = grp ? LD4(tl + 2 * FF + C) : z; uv1 = grp ? LD4(tl + 3 * FF + C) : z;
                      ug2 = LD4(hd + C); uv2 = LD4(hd + FF + C); }
        else { ug0 = grp ? LD4(tl + 2 * FF + C) : z; uv0 = grp ? LD4(tl + 3 * FF + C) : z; ug1 = LD4(hd + C); uv1 = LD4(hd + FF + C);
               ug2 = LD4(hd + 2 * FF + C); uv2 = LD4(hd + 3 * FF + C); }
#undef LD4
        const float* cw = a.w_ffn_conv; const float* cb = a.b_ffn_conv;
        const f32x4 yg = *(const f32x4*)(cb + C) + *(const f32x4*)(cw + C) * ug0 + *(const f32x4*)(cw + 2 * FF + C) * ug1 + *(const f32x4*)(cw + 4 * FF + C) * ug2;
        const f32x4 yv = *(const f32x4*)(cb + FF + C) + *(const f32x4*)(cw + FF + C) * uv0 + *(const f32x4*)(cw + 3 * FF + C) * uv1 + *(const f32x4*)(cw + 5 * FF + C) * uv2;
        u32x2 o; o.x = pk2(pg8::gelu_tanh(yg[0]) * yv[0], pg8::gelu_tanh(yg[1]) * yv[1]); o.y = pk2(pg8::gelu_tanh(yg[2]) * yv[2], pg8::gelu_tanh(yg[3]) * yv[3]);
        *(u32x2*)(gbuf + (size_t)row * FF + C) = o;
    } }
    xcd_barrier(xbar);
    STAMP(8);

    { pg8::Gemm g{gbuf, WdnT, T, D, FF}; pg8::StaticOrder S; S.init(T, D, G, bx, WGM_P8); pg8::EpiResid<true> E{x1b, x2b, ssq2};
      pg8::gemm_phase<pg8::EpiResid<true>, pg8::StaticOrder, true, true>(lds, g, S, E); }
    { pg8::Gemm g{pb, WppT, T, D, PLE}; pg8::StaticOrder S; S.init(T, D, G, bx, WGM_PP); pg8::EpiBf16 E{ppb, D, nullptr, nullptr};
      pg8::gemm_phase<pg8::EpiBf16, pg8::StaticOrder, true, true>(lds, g, S, E); }
    xcd_barrier(xbar);
    STAMP(9);

    { pg8::Gemm g{x2b, WpgT, T, D, D}; pg8::StaticOrder S; S.init(T, D, G, bx, WGM_P9); pg8::EpiPle E{x2b, x3b, ppb, ssq2, ssq3};
      pg8::gemm_phase<pg8::EpiPle, pg8::StaticOrder, true, true>(lds, g, S, E); }
    xcd_barrier(xbar);
    STAMP(10);

    { IDS();
    for (int m = gw; m < T; m += NGW) {
        const float rstd = frsq(ssq3[m] * (1.0f / D) + EPS);
        const u32x2* xr = (const u32x2*)(x3b + (size_t)m * D) + lane; f32x4* orow = (f32x4*)(a.out + (size_t)m * D) + lane; const f32x4* wr4 = (const f32x4*)a.final_norm_w + lane;
#pragma unroll
        for (int j = 0; j < 8; ++j) { const u32x2 xw = xr[64 * j]; const f32x4 w = wr4[64 * j];
            const f32x4 v = {bflo(xw.x) * rstd * w.x, bfhi(xw.x) * rstd * w.y, bflo(xw.y) * rstd * w.z, bfhi(xw.y) * rstd * w.w};
            __builtin_nontemporal_store(v, orow + 64 * j); }
    } }
    if (PROBE_DUP == 7) { for (int i_ = 0; i_ < 20; ++i_) grid.sync(); }
    if (PROBE_T != 0) {
        asm volatile("s_waitcnt vmcnt(0)" ::: "memory"); grid.sync(); STAMP(11); grid.sync();
        unsigned probe_m = 50000u;
        if (PROBE_T != 100) { const unsigned long long* tsb = (const unsigned long long*)(a.ws + 200 * 1024); constexpr int HI_ = PROBE_T == 13 ? 12 : (PROBE_T == 14 ? 4 : (PROBE_T == 15 ? 11 : PROBE_T)), LO_ = PROBE_T == 13 ? 3 : (PROBE_T == 14 ? 12 : (PROBE_T == 15 ? 0 : PROBE_T - 1));
            probe_m = (unsigned)(__hip_atomic_load(tsb + HI_, __ATOMIC_RELAXED, __HIP_MEMORY_SCOPE_AGENT) - __hip_atomic_load(tsb + LO_, __ATOMIC_RELAXED, __HIP_MEMORY_SCOPE_AGENT)); if (PROBE_T == 15) probe_m /= 8; }
        for (unsigned e = blockIdx.x * 512u + threadIdx.x; e < probe_m; e += gridDim.x * 512u) a.out[e] += 0.08f;
    }
}

extern "C" void kernel_launch(void* const* d_in, const int* in_sizes, int n_in, void* d_out, int out_size, void* d_ws, size_t ws_size, hipStream_t stream) {
    static int grid = 0;
    if (grid == 0) {
        if (n_in != 18 || out_size != T * D || ws_size < WS_END) { fprintf(stderr, "kernel_launch: unexpected problem (n_in %d out %d ws %zu)\n", n_in, out_size, ws_size); grid = -1; return; }
        int dev = 0, cus = 0, per_cu = 0;
        hipGetDevice(&dev); hipDeviceGetAttribute(&cus, hipDeviceAttributeMultiprocessorCount, dev);
        if (hipFuncSetAttribute((const void*)fwd_megakernel, hipFuncAttributeMaxDynamicSharedMemorySize, LDS_BYTES) != hipSuccess) { fprintf(stderr, "kernel_launch: hipFuncSetAttribute failed\n"); grid = -1; return; }
        if (hipOccupancyMaxActiveBlocksPerMultiprocessor(&per_cu, (const void*)fwd_megakernel, 512, LDS_BYTES) != hipSuccess || per_cu < 1) { fprintf(stderr, "kernel_launch: occupancy query says %d\n", per_cu); per_cu = 1; }
        (void)hipGetLastError();
        grid = cus * per_cu;
    }
    if (grid < 0) return;
    Args a{};
    const float** f = (const float**)&a;
    for (int i = 0; i < 18; ++i) f[i] = (const float*)d_in[i];
    a.out = (float*)d_out; a.ws = (unsigned char*)d_ws;
    if (hipMemsetAsync((char*)d_ws + WS_BAR, 0, 16384, stream) != hipSuccess) { fprintf(stderr, "kernel_launch: memset of the barrier words failed\n"); return; }
    void* args[] = {&a};
    hipError_t e = hipLaunchCooperativeKernel((const void*)fwd_megakernel, dim3(grid), dim3(512), args, LDS_BYTES, stream);
    if (e != hipSuccess) fprintf(stderr, "cooperative launch failed: %s (grid %d)\n", hipGetErrorString(e), grid);
}
```
